# Optimizing an MI355X kernel written in HIP

```python
import jax, jax.numpy as jnp
from jax import lax
import numpy as np

D_MODEL = 1024
BATCH = 8
SEQ = 2048
DEPTH = 1

GLA_HEADS = 4
GLA_DK = D_MODEL // 2 // GLA_HEADS
GLA_DV = D_MODEL // GLA_HEADS
GLA_RANK = 16
GLA_TAU = 16.0
GLA_CHUNK = 64
CONV_WIDTH = D_MODEL
CONV_K = 3
N_EXPERTS = 32
TOP_K = 4
D_FF = D_MODEL
SWIGLU_LIMIT = 7.0
SWIGLU_ALPHA = 1.702
EPS = 1e-6

QK_W = GLA_HEADS * GLA_DK
V_W = GLA_HEADS * GLA_DV
SPLITS = (QK_W, QK_W, V_W, V_W, GLA_RANK, CONV_WIDTH, CONV_WIDTH, CONV_WIDTH, D_MODEL, D_MODEL)
IN_PROJ_W = sum(SPLITS)

kernel_name = "hybrid_gla_shortconv_moe_block"


def rms_norm(x, g):
    xf = x.astype(jnp.float32)
    y = xf * lax.rsqrt(jnp.mean(xf * xf, axis=-1, keepdims=True) + EPS)
    return (y * g.astype(jnp.float32)).astype(x.dtype)


def split_columns(z):
    offsets = [int(o) for o in np.cumsum(SPLITS)[:-1]]
    return jnp.split(z, offsets, axis=-1)


def gla_chunked(q, k, v, log_a):
    B, S, H, DK = q.shape
    DV = v.shape[-1]
    C = GLA_CHUNK
    N = S // C
    f32 = jnp.float32
    qf = q.astype(f32).reshape(B, N, C, H, DK) * (DK ** -0.5)
    kf = k.astype(f32).reshape(B, N, C, H, DK)
    vf = v.astype(f32).reshape(B, N, C, H, DV)
    b = jnp.cumsum(log_a.astype(f32).reshape(B, N, C, H, DK), axis=2)
    b_last = b[:, :, -1]
    q_dec = qf * jnp.exp(b)
    k_inv = kf * jnp.exp(-b)
    k_tail = kf * jnp.exp(b_last[:, :, None] - b)
    scores = jnp.einsum("bnihd,bnjhd->bnhij", q_dec, k_inv)
    causal = jnp.tril(jnp.ones((C, C), dtype=bool))
    scores = jnp.where(causal, scores, 0.0)
    o_intra = jnp.einsum("bnhij,bnjhv->bnihv", scores, vf)
    chunk_update = jnp.einsum("bnjhd,bnjhv->nbhdv", k_tail, vf)
    chunk_decay = jnp.exp(b_last).transpose(1, 0, 2, 3)

    def step(state, inp):
        dec, upd = inp
        return dec[..., None] * state + upd, state

    state0 = jnp.zeros((B, H, DK, DV), f32)
    _, state_in = lax.scan(step, state0, (chunk_decay, chunk_update))
    o_inter = jnp.einsum("bnihd,nbhdv->bnihv", q_dec, state_in)
    return (o_intra + o_inter).reshape(B, S, H, DV).astype(v.dtype)


def causal_dwconv(u, w):
    S = u.shape[1]
    up = jnp.pad(u, ((0, 0), (CONV_K - 1, 0), (0, 0)))
    y = w[0] * up[:, 0:S]
    for i in range(1, CONV_K):
        y = y + w[i] * up[:, i:i + S]
    return y


def moe_ffn(h, w_router, b_router, w_gate_up, b_gate_up, w_down, b_down):
    B, S, D = h.shape
    T = B * S
    xt = h.reshape(T, D)
    logits = jnp.matmul(xt, w_router).astype(jnp.float32) + b_router.astype(jnp.float32)
    top_logit, top_idx = lax.top_k(logits, TOP_K)
    gates = jax.nn.softmax(top_logit, axis=-1)
    flat_e = top_idx.reshape(-1)
    order = jnp.argsort(flat_e)
    e_sorted = flat_e[order]
    tok_sorted = order // TOP_K
    group_sizes = jnp.bincount(flat_e, length=N_EXPERTS).astype(jnp.int32)
    xs = xt[tok_sorted]
    gu = lax.ragged_dot(xs, w_gate_up, group_sizes) + b_gate_up[e_sorted]
    gate, lin = jnp.split(gu, 2, axis=-1)
    gate = jnp.minimum(gate, SWIGLU_LIMIT)
    lin = jnp.clip(lin, -SWIGLU_LIMIT, SWIGLU_LIMIT)
    act = (lin + 1.0) * (gate * jax.nn.sigmoid(SWIGLU_ALPHA * gate))
    out = lax.ragged_dot(act, w_down, group_sizes) + b_down[e_sorted]
    out_pairs = jnp.zeros_like(out).at[order].set(out).reshape(T, TOP_K, D)
    y = jnp.einsum("tkd,tk->td", out_pairs, gates.astype(out.dtype))
    return y.reshape(B, S, D)


def setup_inputs(seed: int = 0) -> dict:
    key = jax.random.key(seed)
    ks = jax.random.split(key, 20)
    f32 = jnp.float32
    L, D, E, F = DEPTH, D_MODEL, N_EXPERTS, D_FF

    def nrm(k, shape, scale):
        return jax.random.normal(k, shape, f32) * scale

    return {
        "x": nrm(ks[0], (BATCH, SEQ, D), 1.0),
        "g_mix": 1.0 + nrm(ks[1], (L, D), 0.02),
        "w_in": nrm(ks[2], (L, D, IN_PROJ_W), D ** -0.5),
        "w_alpha_up": nrm(ks[3], (L, GLA_RANK, QK_W), GLA_RANK ** -0.5),
        "b_alpha": nrm(ks[4], (L, QK_W), 0.1),
        "g_gla": 1.0 + nrm(ks[5], (L, GLA_HEADS, GLA_DV), 0.02),
        "w_conv": nrm(ks[6], (L, CONV_K, CONV_WIDTH), CONV_K ** -0.5),
        "w_branch_a": nrm(ks[7], (L, V_W, D), V_W ** -0.5),
        "w_branch_b": nrm(ks[8], (L, CONV_WIDTH, D), CONV_WIDTH ** -0.5),
        "w_out": nrm(ks[9], (L, D, D), D ** -0.5),
        "g_ffn": 1.0 + nrm(ks[10], (L, D), 0.02),
        "w_router": nrm(ks[11], (L, D, E), D ** -0.5),
        "b_router": nrm(ks[12], (L, E), 0.01),
        "w_gate_up": nrm(ks[13], (L, E, D, 2 * F), D ** -0.5),
        "b_gate_up": nrm(ks[14], (L, E, 2 * F), 0.02),
        "w_down": nrm(ks[15], (L, E, F, D), F ** -0.5),
        "b_down": nrm(ks[16], (L, E, D), 0.02),
        "g_final": 1.0 + nrm(ks[17], (D,), 0.02),
    }


def reference(x, g_mix, w_in, w_alpha_up, b_alpha, g_gla, w_conv, w_branch_a, w_branch_b, w_out,
              g_ffn, w_router, b_router, w_gate_up, b_gate_up, w_down, b_down, g_final):
    B, S, _ = x.shape
    for l in range(DEPTH):
        h = rms_norm(x, g_mix[l])
        z = jnp.matmul(h, w_in[l])
        q, k, v, r, a_lr, c_b, c_c, c_x, g_a, g_b = split_columns(z)
        log_a = jax.nn.log_sigmoid(jnp.matmul(a_lr, w_alpha_up[l]) + b_alpha[l]) / GLA_TAU
        o = gla_chunked(q.reshape(B, S, GLA_HEADS, GLA_DK),
                        k.reshape(B, S, GLA_HEADS, GLA_DK),
                        v.reshape(B, S, GLA_HEADS, GLA_DV),
                        log_a.reshape(B, S, GLA_HEADS, GLA_DK))
        o = rms_norm(o, g_gla[l]) * jax.nn.silu(r).reshape(B, S, GLA_HEADS, GLA_DV)
        y_a = jnp.matmul(o.reshape(B, S, V_W), w_branch_a[l])
        y_conv = causal_dwconv(c_c * c_x, w_conv[l])
        y_b = jnp.matmul(c_b * y_conv, w_branch_b[l])
        mixed = jax.nn.sigmoid(g_a) * y_a + jax.nn.sigmoid(g_b) * y_b
        x = x + jnp.matmul(mixed, w_out[l])
        h = rms_norm(x, g_ffn[l])
        x = x + moe_ffn(h, w_router[l], b_router[l], w_gate_up[l], b_gate_up[l], w_down[l], b_down[l])
    return rms_norm(x, g_final)
```

```cpp
#include <hip/hip_runtime.h>
#include <cstdio>
#include <cstdint>

namespace nv {
constexpr int T = 16384, D = 1024, SEQ = 2048, NZ = 8208, NE = 32, CAP = 16384;
constexpr size_t MiB = 1u << 20;
constexpr size_t WS_CTL = 0;
constexpr size_t WS_LIST = 1 * MiB;
constexpr size_t WS_GATE = 3 * MiB;
constexpr size_t WS_LOGIT = 4 * MiB;
constexpr size_t WS_BUF0 = 8 * MiB;
constexpr size_t WS_LA = 72 * MiB;
constexpr size_t WS_BUF1 = 104 * MiB;
constexpr size_t WS_BUF2 = 168 * MiB;
constexpr size_t WS_BUF3 = 232 * MiB;
constexpr size_t WS_BUF4 = 296 * MiB;
constexpr size_t WS_BUF5 = 360 * MiB;
constexpr size_t WS_Z = 424 * MiB;
constexpr size_t WS_ACT = WS_Z;
constexpr size_t WS_YP = WS_Z + 280 * MiB;
constexpr size_t WS_END = 960 * MiB;

__device__ __forceinline__ float block_sum256(float v, float* red) {
    for (int o = 32; o >= 1; o >>= 1) v += __shfl_xor(v, o);
    __syncthreads();
    if ((threadIdx.x & 63) == 0) red[threadIdx.x >> 6] = v;
    __syncthreads();
    return red[0] + red[1] + red[2] + red[3];
}

__global__ void rmsnorm_rows(const float* x, const float* g, float* out) {
    __shared__ float red[4];
    const size_t row = blockIdx.x;
    float v[4], s = 0.f;
#pragma unroll
    for (int j = 0; j < 4; ++j) { v[j] = x[row * 1024 + threadIdx.x + 256 * j]; s += v[j] * v[j]; }
    s = block_sum256(s, red);
    const float r = 1.0f / sqrtf(s * (1.0f / 1024.0f) + 1e-6f);
#pragma unroll
    for (int j = 0; j < 4; ++j) out[row * 1024 + threadIdx.x + 256 * j] = v[j] * r * g[threadIdx.x + 256 * j];
}

template <class RowF>
__device__ __forceinline__ void tile64(RowF rowptr, const float* Bm, int ldb, int n0, int N, int K, float (&acc)[4][4]) {
    __shared__ float As[16][68];
    __shared__ float Bs[16][64];
    const int tid = threadIdx.x, tx = tid & 15, ty = tid >> 4;
#pragma unroll
    for (int i = 0; i < 4; ++i)
#pragma unroll
        for (int j = 0; j < 4; ++j) acc[i][j] = 0.f;
    const float* ar = rowptr(tid >> 2);
    const int ak = (tid & 3) * 4;
    const int bk = tid >> 4, bn = (tid & 15) * 4;
    for (int k0 = 0; k0 < K; k0 += 16) {
        float4 a = ar ? *(const float4*)(ar + k0 + ak) : make_float4(0.f, 0.f, 0.f, 0.f);
        float4 b = (n0 + bn + 3 < N) ? *(const float4*)(Bm + (size_t)(k0 + bk) * ldb + n0 + bn) : make_float4(0.f, 0.f, 0.f, 0.f);
        __syncthreads();
        As[ak + 0][tid >> 2] = a.x; As[ak + 1][tid >> 2] = a.y; As[ak + 2][tid >> 2] = a.z; As[ak + 3][tid >> 2] = a.w;
        *(float4*)&Bs[bk][bn] = b;
        __syncthreads();
#pragma unroll
        for (int kk = 0; kk < 16; ++kk) {
            const float4 av = *(const float4*)&As[kk][ty * 4];
            const float4 bv = *(const float4*)&Bs[kk][tx * 4];
            const float aa[4] = {av.x, av.y, av.z, av.w}, bb[4] = {bv.x, bv.y, bv.z, bv.w};
#pragma unroll
            for (int i = 0; i < 4; ++i)
#pragma unroll
                for (int j = 0; j < 4; ++j) acc[i][j] += aa[i] * bb[j];
        }
    }
}

__device__ __forceinline__ float sigmoidf_(float x) { return 1.0f / (1.0f + expf(-x)); }
__device__ __forceinline__ float logsigmoidf_(float x) { return fminf(x, 0.f) - log1pf(expf(-fabsf(x))); }

template <int EPI>
__global__ __launch_bounds__(256) void gemm_naive(const float* A, int lda, const float* Bm, int ldb, float* C, int ldc, int M, int N, int K, const float* aux) {
    const int m0 = blockIdx.y * 64, n0 = blockIdx.x * 64;
    float acc[4][4];
    tile64([&](int m) -> const float* { return (m0 + m < M) ? A + (size_t)(m0 + m) * lda : nullptr; }, Bm, ldb, n0, N, K, acc);
    const int tx = threadIdx.x & 15, ty = threadIdx.x >> 4;
#pragma unroll
    for (int i = 0; i < 4; ++i)
#pragma unroll
    for (int j = 0; j < 4; ++j) {
        const int m = m0 + ty * 4 + i, n = n0 + tx * 4 + j;
        if (m < M && n < N) {
            float v = acc[i][j];
            if (EPI == 1) v = logsigmoidf_(v + aux[n]) * (1.0f / 16.0f);
            if (EPI == 2) v += aux[(size_t)m * ldc + n];
            C[(size_t)m * ldc + n] = v;
        }
    }
}

__global__ __launch_bounds__(1024) void gla_naive(const float* Z, const float* la, float* o) {
    const int bh = blockIdx.x, b = bh >> 2, h = bh & 3, tid = threadIdx.x, dv = tid & 255, g = tid >> 8;
    float St[32];
#pragma unroll
    for (int i = 0; i < 32; ++i) St[i] = 0.f;
    __shared__ float qs[128], ks[128], as[128], part[4][256];
    for (int t = 0; t < SEQ; ++t) {
        const size_t row = (size_t)b * SEQ + t;
        if (tid < 128) {
            qs[tid] = Z[row * NZ + h * 128 + tid] * 0.08838834764831845f;
            ks[tid] = Z[row * NZ + 512 + h * 128 + tid];
            as[tid] = expf(la[row * 512 + h * 128 + tid]);
        }
        const float v = Z[row * NZ + 1024 + h * 256 + dv];
        __syncthreads();
        float acc = 0.f;
#pragma unroll
        for (int i = 0; i < 32; ++i) { const int dk = g * 32 + i; St[i] = as[dk] * St[i] + ks[dk] * v; acc += qs[dk] * St[i]; }
        part[g][dv] = acc;
        __syncthreads();
        if (g == 0) o[row * 1024 + h * 256 + dv] = (part[0][dv] + part[1][dv]) + (part[2][dv] + part[3][dv]);
    }
}

__global__ void gla_gate(const float* o, const float* Z, const float* g_gla, float* og) {
    __shared__ float red[4];
    const size_t row = blockIdx.x >> 2; const int h = blockIdx.x & 3, dv = threadIdx.x;
    const float v = o[row * 1024 + h * 256 + dv];
    const float s = block_sum256(v * v, red);
    const float rs = 1.0f / sqrtf(s * (1.0f / 256.0f) + 1e-6f);
    const float r = Z[row * NZ + 2048 + h * 256 + dv];
    og[row * 1024 + h * 256 + dv] = v * rs * g_gla[h * 256 + dv] * (r * sigmoidf_(r));
}

__global__ void conv_naive(const float* Z, const float* w, float* pb) {
    const size_t row = blockIdx.x; const int s = (int)(row % SEQ);
    for (int c = threadIdx.x; c < 1024; c += 256) {
        float y = 0.f;
        for (int i = 0; i < 3; ++i) { const int ss = s - 2 + i; if (ss >= 0) { const size_t r2 = row - 2 + i; y += w[i * 1024 + c] * Z[r2 * NZ + 4112 + c] * Z[r2 * NZ + 5136 + c]; } }
        pb[row * 1024 + c] = Z[row * NZ + 3088 + c] * y;
    }
}

__global__ void mix_naive(const float* Z, const float* ya, const float* yb, float* mix) {
    const size_t row = blockIdx.x;
    for (int c = threadIdx.x; c < 1024; c += 256)
        mix[row * 1024 + c] = sigmoidf_(Z[row * NZ + 6160 + c]) * ya[row * 1024 + c] + sigmoidf_(Z[row * NZ + 7184 + c]) * yb[row * 1024 + c];
}

__global__ void topk_naive(const float* logits, const float* b_router, int* cnt, int* list, float* gate) {
    __shared__ float lg[256][33];
    const int t = blockIdx.x * 256 + threadIdx.x;
    for (int e = 0; e < 32; ++e) lg[threadIdx.x][e] = logits[(size_t)t * 32 + e] + b_router[e];
    float tv[4]; int ti[4];
#pragma unroll
    for (int k = 0; k < 4; ++k) {
        float best = -3.0e38f; int bi = 0;
        for (int e = 0; e < 32; ++e) { const float v = lg[threadIdx.x][e]; if (v > best) { best = v; bi = e; } }
        tv[k] = best; ti[k] = bi; lg[threadIdx.x][bi] = -3.0e38f;
    }
    float den = 0.f, ex[4];
#pragma unroll
    for (int k = 0; k < 4; ++k) { ex[k] = expf(tv[k] - tv[0]); den += ex[k]; }
#pragma unroll
    for (int k = 0; k < 4; ++k) {
        const int slot = atomicAdd(&cnt[ti[k]], 1);
        list[ti[k] * CAP + slot] = t * 4 + k;
        gate[t * 4 + k] = ex[k] / den;
    }
}

__device__ __forceinline__ bool find_expert(const int* cnt, int tile, int& e, int& r0, int& base) {
    int acc = 0;
    for (int i = 0; i < 32; ++i) { const int nt = (cnt[i] + 63) >> 6; if (tile < acc + nt) { e = i; r0 = (tile - acc) * 64; base = acc * 64; return true; } acc += nt; }
    return false;
}

__global__ __launch_bounds__(256) void moe1_naive(const float* h2, const float* wgu, const float* bgu, const int* cnt, const int* list, float* act) {
    int e, r0, base; if (!find_expert(cnt, blockIdx.y, e, r0, base)) return;
    const int n0 = blockIdx.x * 64, ne = cnt[e];
    const int* le = list + e * CAP;
    auto rp = [&](int m) -> const float* { return (r0 + m < ne) ? h2 + (size_t)(le[r0 + m] >> 2) * 1024 : nullptr; };
    float ag[4][4], al[4][4];
    tile64(rp, wgu + (size_t)e * 1024 * 2048, 2048, n0, 2048, 1024, ag);
    tile64(rp, wgu + (size_t)e * 1024 * 2048, 2048, n0 + 1024, 2048, 1024, al);
    const int tx = threadIdx.x & 15, ty = threadIdx.x >> 4;
#pragma unroll
    for (int i = 0; i < 4; ++i)
#pragma unroll
    for (int j = 0; j < 4; ++j) {
        const int m = r0 + ty * 4 + i, n = n0 + tx * 4 + j;
        float gt = ag[i][j] + bgu[e * 2048 + n], ln = al[i][j] + bgu[e * 2048 + 1024 + n];
        gt = fminf(gt, 7.0f); ln = fminf(fmaxf(ln, -7.0f), 7.0f);
        act[(size_t)(base + m) * 1024 + n] = (ln + 1.0f) * (gt * sigmoidf_(1.702f * gt));
    }
}
__global__ __launch_bounds__(256) void moe2_naive(const float* act, const float* wd, const float* bd, const int* cnt, const int* list, const float* gate, float* yp) {
    int e, r0, base; if (!find_expert(cnt, blockIdx.y, e, r0, base)) return;
    const int n0 = blockIdx.x * 64, ne = cnt[e];
    const int* le = list + e * CAP;
    float acc[4][4];
    tile64([&](int m) -> const float* { return act + (size_t)(base + r0 + m) * 1024; }, wd + (size_t)e * 1024 * 1024, 1024, n0, 1024, 1024, acc);
    const int tx = threadIdx.x & 15, ty = threadIdx.x >> 4;
#pragma unroll
    for (int i = 0; i < 4; ++i) {
        const int m = r0 + ty * 4 + i; if (m >= ne) continue;
        const int pid = le[m]; const float gw = gate[pid];
#pragma unroll
        for (int j = 0; j < 4; ++j) { const int n = n0 + tx * 4 + j; yp[(size_t)pid * 1024 + n] = (acc[i][j] + bd[e * 1024 + n]) * gw; }
    }
}
__global__ void final_naive(const float* x1, const float* yp, const float* g, float* out) {
    __shared__ float red[4];
    const size_t row = blockIdx.x;
    float v[4], s = 0.f;
#pragma unroll
    for (int j = 0; j < 4; ++j) { const int c = threadIdx.x + 256 * j; float a = x1[row * 1024 + c];
        for (int k = 0; k < 4; ++k) a += yp[(row * 4 + k) * 1024 + c];
        v[j] = a; s += a * a; }
    s = block_sum256(s, red);
    const float r = 1.0f / sqrtf(s * (1.0f / 1024.0f) + 1e-6f);
#pragma unroll
    for (int j = 0; j < 4; ++j) out[row * 1024 + threadIdx.x + 256 * j] = v[j] * r * g[threadIdx.x + 256 * j];
}
}

extern "C" void kernel_launch(void* const* d_in, const int* in_sizes, int n_in, void* d_out, int out_size, void* d_ws, size_t ws_size, hipStream_t stream) {
    using namespace nv;
    if (ws_size < WS_END) { fprintf(stderr, "ws too small: %zu < %zu\n", ws_size, (size_t)WS_END); return; }
    const float* x = (const float*)d_in[0];
    const float* g_mix = (const float*)d_in[1];
    const float* w_in = (const float*)d_in[2];
    const float* w_alpha_up = (const float*)d_in[3];
    const float* b_alpha = (const float*)d_in[4];
    const float* g_gla = (const float*)d_in[5];
    const float* w_conv = (const float*)d_in[6];
    const float* w_a = (const float*)d_in[7];
    const float* w_b = (const float*)d_in[8];
    const float* w_out = (const float*)d_in[9];
    const float* g_ffn = (const float*)d_in[10];
    const float* w_router = (const float*)d_in[11];
    const float* b_router = (const float*)d_in[12];
    const float* w_gu = (const float*)d_in[13];
    const float* b_gu = (const float*)d_in[14];
    const float* w_d = (const float*)d_in[15];
    const float* b_d = (const float*)d_in[16];
    const float* g_final = (const float*)d_in[17];
    char* ws = (char*)d_ws;
    int* cnt = (int*)(ws + WS_CTL);
    int* list = (int*)(ws + WS_LIST);
    float* gate = (float*)(ws + WS_GATE);
    float* logits = (float*)(ws + WS_LOGIT);
    float* H = (float*)(ws + WS_BUF0);
    float* LA = (float*)(ws + WS_LA);
    float* O = (float*)(ws + WS_BUF1);
    float* OG = (float*)(ws + WS_BUF2);
    float* PB = (float*)(ws + WS_BUF3);
    float* YA = (float*)(ws + WS_BUF4);
    float* YB = (float*)(ws + WS_BUF5);
    float* Z = (float*)(ws + WS_Z);
    float* MIX = O; float* X1 = OG; float* H2 = H;
    float* ACT = (float*)(ws + WS_ACT);
    float* YP = (float*)(ws + WS_YP);
    float* out = (float*)d_out;

    hipMemsetAsync(ws + WS_CTL, 0, 4096, stream);
    rmsnorm_rows<<<T, 256, 0, stream>>>(x, g_mix, H);
    gemm_naive<0><<<dim3((NZ + 63) / 64, T / 64), 256, 0, stream>>>(H, 1024, w_in, NZ, Z, NZ, T, NZ, 1024, nullptr);
    gemm_naive<1><<<dim3(512 / 64, T / 64), 256, 0, stream>>>(Z + 3072, NZ, w_alpha_up, 512, LA, 512, T, 512, 16, b_alpha);
    gla_naive<<<32, 1024, 0, stream>>>(Z, LA, O);
    gla_gate<<<T * 4, 256, 0, stream>>>(O, Z, g_gla, OG);
    conv_naive<<<T, 256, 0, stream>>>(Z, w_conv, PB);
    gemm_naive<0><<<dim3(16, T / 64), 256, 0, stream>>>(OG, 1024, w_a, 1024, YA, 1024, T, 1024, 1024, nullptr);
    gemm_naive<0><<<dim3(16, T / 64), 256, 0, stream>>>(PB, 1024, w_b, 1024, YB, 1024, T, 1024, 1024, nullptr);
    mix_naive<<<T, 256, 0, stream>>>(Z, YA, YB, MIX);
    gemm_naive<2><<<dim3(16, T / 64), 256, 0, stream>>>(MIX, 1024, w_out, 1024, X1, 1024, T, 1024, 1024, x);
    rmsnorm_rows<<<T, 256, 0, stream>>>(X1, g_ffn, H2);
    gemm_naive<0><<<dim3(1, T / 64), 256, 0, stream>>>(H2, 1024, w_router, 32, logits, 32, T, 32, 1024, nullptr);
    topk_naive<<<T / 256, 256, 0, stream>>>(logits, b_router, cnt, list, gate);
    moe1_naive<<<dim3(16, 65536 / 64 + 32), 256, 0, stream>>>(H2, w_gu, b_gu, cnt, list, ACT);
    moe2_naive<<<dim3(16, 65536 / 64 + 32), 256, 0, stream>>>(ACT, w_d, b_d, cnt, list, gate, YP);
    final_naive<<<T, 256, 0, stream>>>(X1, YP, g_final, out);
}
```

```cpp
#include <hip/hip_runtime.h>
#include <cstdio>
#include <cstdint>

#ifndef MK_N_LAUNCHES
#define MK_N_LAUNCHES 1
#endif

#define LAS __attribute__((address_space(3)))
#define GAS __attribute__((address_space(1)))
typedef unsigned short bf16;
typedef short bf16x8 __attribute__((ext_vector_type(8)));
typedef float f32x4 __attribute__((ext_vector_type(4)));
typedef float f32x2 __attribute__((ext_vector_type(2)));
typedef float f32x16 __attribute__((ext_vector_type(16)));
typedef unsigned u32x4 __attribute__((ext_vector_type(4)));
typedef unsigned u32x2 __attribute__((ext_vector_type(2)));
typedef __bf16 bf16x2_t __attribute__((ext_vector_type(2)));

constexpr int NWAVES = 8;
constexpr int M = 16384, D = 1024, SEQ = 2048;
constexpr int NZS = 8208;
constexpr int NZ = 8192;
constexpr int NE = 32, CAP = 16384;
constexpr int NPH = 11;
constexpr int N_LAUNCHES = MK_N_LAUNCHES;
constexpr int ZQ = 0, ZK = 512, ZV = 1024, ZR = 2048, ZCB = 3072, ZCC = 4096, ZCX = 5120, ZGA = 6144, ZGB = 7168;

constexpr size_t MiB = 1u << 20;
constexpr size_t WS_CTL = 0, CTL_ZERO_BYTES = 1 * MiB;
constexpr size_t WS_LIST = 1 * MiB;
constexpr size_t WS_GATE = 3 * MiB;
constexpr size_t WS_DECS = 4 * MiB;
constexpr size_t WS_WIN = 16 * MiB;
constexpr size_t WS_WA = 32 * MiB, WS_WB = 34 * MiB, WS_WO = 36 * MiB;
constexpr size_t WS_WGU = 40 * MiB;
constexpr size_t WS_WD = 168 * MiB;
constexpr size_t WS_XN = 232 * MiB;
constexpr size_t WS_LA = 264 * MiB;
constexpr size_t WS_Z = 296 * MiB;
constexpr size_t WS_YP = WS_Z;
constexpr size_t WS_U = 552 * MiB;
constexpr size_t WS_SIN = 584 * MiB;
constexpr size_t WS_OG = 616 * MiB;
constexpr size_t WS_PB = 648 * MiB;
constexpr size_t WS_M1 = 680 * MiB;
constexpr size_t WS_MIX = 744 * MiB;
constexpr size_t WS_X1 = 776 * MiB;
constexpr size_t WS_ACT = 840 * MiB;
constexpr size_t WS_END = 984 * MiB;
constexpr int CW_TMO = 0;
constexpr int CW_BAR = 4096;
constexpr int CW_CNT = 8192;

constexpr int RING_BYTES = 131072;
constexpr int EXTRA_OFF = RING_BYTES;
constexpr int LDS_BYTES = 155648 + 512;
constexpr int MISC_OFF = 155648;

#define RLX_AGENT __ATOMIC_RELAXED, __HIP_MEMORY_SCOPE_AGENT
#define LDS_WAIT() asm volatile("s_waitcnt lgkmcnt(0)" ::: "memory")
#define VM_WAIT() asm volatile("s_waitcnt vmcnt(0)" ::: "memory")
__device__ __forceinline__ unsigned pk2(float lo, float hi) { f32x2 v = {lo, hi}; bf16x2_t b = __builtin_convertvector(v, bf16x2_t); return __builtin_bit_cast(unsigned, b); }
__device__ __forceinline__ float bf_lo(unsigned w) { return __builtin_bit_cast(float, w << 16); }
__device__ __forceinline__ float bf_hi(unsigned w) { return __builtin_bit_cast(float, w & 0xffff0000u); }
__device__ __forceinline__ float bf1(bf16 b) { return __builtin_bit_cast(float, ((unsigned)b) << 16); }
__device__ __forceinline__ float fast_sigmoid(float x) { return __builtin_amdgcn_rcpf(1.0f + __expf(-x)); }
__device__ __forceinline__ float wave_sum(float v) {
#pragma unroll
    for (int o = 1; o < 64; o <<= 1) v += __shfl_xor(v, o);
    return v;
}

namespace pg8 {
constexpr int BM = 256, BK = 64, HALF = 128, HTB = HALF * BK * 2, STAGE_BYTES = 8 * HTB, NXCD = 8, WGM = 8;
__device__ __forceinline__ int lds_byte(int r, int c) { const int st = (r >> 4) * 2 + (c >> 5), rr = r & 15, cc = c & 31, ob = rr * 64 + cc * 2; return st * 1024 + (ob ^ (((ob >> 9) & 1) << 5)); }
__device__ __forceinline__ void stage_rc(int b, int& R, int& C) { const int st = b / 1024, sb = b % 1024, swz = sb ^ (((sb >> 9) & 1) << 5); R = (st >> 1) * 16 + swz / 64; C = (st & 1) * 32 + (swz % 64) / 2; }
__device__ __forceinline__ int perm32(int rho) { const int n = rho >> 4, i = rho & 15; return 8 * (i >> 2) + 4 * n + (i & 3); }

struct Unit { int pm, pn, e, rt; };

struct StaticOrder {
    int nM, nN, nwg, G, c, K;
    __device__ __forceinline__ void init(int M_, int N_, int K_, int G_, int c_) { nM = M_ / BM; nN = N_ / BM; nwg = nM * nN; G = G_; c = c_; K = K_; }
    __device__ __forceinline__ bool next(int i, Unit& u) const {
        const long L = (long)i * G + c; if (L >= nwg) return false;
        int wgid = (int)L; { const int q = nwg / NXCD, r = nwg % NXCD, xcd = wgid % NXCD, off = wgid / NXCD; wgid = (xcd < r ? xcd * (q + 1) : r * (q + 1) + (xcd - r) * q) + off; }
        const int nig = WGM * nN, gid = wgid / nig, fm = gid * WGM, gsz = (nM - fm) < WGM ? (nM - fm) : WGM;
        u.pm = fm + ((wgid % nig) % gsz); u.pn = (wgid % nig) / gsz; u.e = 0; u.rt = 0; return true;
    }
    __device__ __forceinline__ unsigned arow(const Unit& u, int ui, int r) const { return (unsigned)(u.pm * BM + r) * (unsigned)(K * 2); }
};

template <class Epi, class Sched, bool ALIGN_EPI>
__device__ __forceinline__ void gemm_phase(LAS unsigned char* lds, const bf16* Ag, const bf16* Btg, const int K, const Sched& S, const Epi& E) {
    const int tid = threadIdx.x, wid = __builtin_amdgcn_readfirstlane(tid >> 6), lane = tid & 63, wr = wid >> 2, wc = wid & 3, fr = lane & 15, fq = lane >> 4;
    const int nt = K / BK;
    int RA[2], CA[2]; unsigned voffB[2];
#pragma unroll
    for (int i = 0; i < 2; ++i) { int R, C; stage_rc(tid * 16 + i * 8192, R, C); const int Rb = Epi::PERM ? ((R & ~31) + perm32(R & 31)) : R;
        RA[i] = R; CA[i] = C * 2; voffB[i] = (unsigned)(Rb * K + C) * 2u; }
    const size_t kstep = (size_t)(BK * 2);
    const size_t hstep = (size_t)HALF * K * 2;
    const size_t tstep = 2 * hstep;
    const unsigned ldsw = (unsigned)wid * 1024u;
    const int aoff = lds_byte(wr * 64 + fr, fq * 8), boff = lds_byte(wc * 32 + fr, fq * 8);
#define PG8_SA(b, h) (((b) * 2 + (h)) * HTB)
#define PG8_SB(b, h) ((4 + (b) * 2 + (h)) * HTB)
#define PG8_STAGEB(bufoff, gbase) do { _Pragma("unroll") for (int _i = 0; _i < 2; ++_i) \
        __builtin_amdgcn_global_load_lds((const unsigned*)((const char*)(gbase) + voffB[_i]), (LAS unsigned*)(lds + (bufoff) + ldsw + _i * 8192), 16, 0, 0); } while (0)
#define PG8_STAGEA(bufoff, o0, o1) do { \
        __builtin_amdgcn_global_load_lds((const unsigned*)((const char*)Ag + (o0)), (LAS unsigned*)(lds + (bufoff) + ldsw), 16, 0, 0); \
        __builtin_amdgcn_global_load_lds((const unsigned*)((const char*)Ag + (o1)), (LAS unsigned*)(lds + (bufoff) + ldsw + 8192), 16, 0, 0); } while (0)
#define PG8_LDA(dst, b, h) do { _Pragma("unroll") for (int m = 0; m < 4; ++m) _Pragma("unroll") for (int k = 0; k < 2; ++k) dst[m][k] = *(const LAS bf16x8*)(lds + PG8_SA(b, h) + aoff + m * 2048 + k * 1024); } while (0)
#define PG8_LDB(dst, b, h) do { _Pragma("unroll") for (int n = 0; n < 2; ++n) _Pragma("unroll") for (int k = 0; k < 2; ++k) dst[n][k] = *(const LAS bf16x8*)(lds + PG8_SB(b, h) + boff + n * 2048 + k * 1024); } while (0)
#define PG8_MMA(ai, bj, At, Bt) do { __builtin_amdgcn_s_setprio(1); _Pragma("unroll") for (int m = 0; m < 4; ++m) _Pragma("unroll") for (int n = 0; n < 2; ++n) _Pragma("unroll") for (int k = 0; k < 2; ++k) \
        acc[ai][bj][m][n] = __builtin_amdgcn_mfma_f32_16x16x32_bf16(Bt[n][k], At[m][k], acc[ai][bj][m][n], 0, 0, 0); __builtin_amdgcn_s_setprio(0); } while (0)
#define PG8_WAIT_V(n) asm volatile("s_waitcnt vmcnt(" #n ")" ::: "memory")
#define PG8_WAIT_L(n) asm volatile("s_waitcnt lgkmcnt(" #n ")" ::: "memory")
#define PG8_BAR __builtin_amdgcn_s_barrier()
#define PG8_SCHED __builtin_amdgcn_sched_barrier(0)
    Unit cur, nxt; int ui = 0;
    if (!S.next(0, cur)) return;
    f32x4 acc[2][2][4][2];
#pragma unroll
    for (int a = 0; a < 2; ++a)
#pragma unroll
        for (int b = 0; b < 2; ++b)
#pragma unroll
            for (int m = 0; m < 4; ++m)
#pragma unroll
                for (int n = 0; n < 2; ++n) acc[a][b][m][n] = (f32x4){0.f, 0.f, 0.f, 0.f};
    bf16x8 At[4][2], B0[2][2], B1[2][2];
    unsigned ac00, ac01, ac10, ac11, an00, an01, an10, an11;
    ac00 = S.arow(cur, 0, RA[0]) + CA[0]; ac01 = S.arow(cur, 0, RA[1]) + CA[1]; ac10 = S.arow(cur, 0, HALF + RA[0]) + CA[0]; ac11 = S.arow(cur, 0, HALF + RA[1]) + CA[1];
    const char* cB = (const char*)Btg + (size_t)cur.pn * tstep;
    PG8_STAGEB(PG8_SB(0, 0), cB); PG8_STAGEB(PG8_SB(0, 1), cB + hstep); PG8_STAGEA(PG8_SA(0, 0), ac00, ac01); PG8_STAGEA(PG8_SA(0, 1), ac10, ac11);
    if (wr == 1) PG8_BAR;
    PG8_WAIT_V(2); PG8_BAR;
    PG8_STAGEB(PG8_SB(1, 0), cB + kstep); PG8_STAGEA(PG8_SA(1, 0), ac00 + 128u, ac01 + 128u); PG8_STAGEB(PG8_SB(1, 1), cB + hstep + kstep);
    PG8_WAIT_V(6); PG8_BAR;
    for (;;) {
        const bool has_next = S.next(ui + 1, nxt);
        if (has_next) { an00 = S.arow(nxt, ui + 1, RA[0]) + CA[0]; an01 = S.arow(nxt, ui + 1, RA[1]) + CA[1]; an10 = S.arow(nxt, ui + 1, HALF + RA[0]) + CA[0]; an11 = S.arow(nxt, ui + 1, HALF + RA[1]) + CA[1]; }
        else { an00 = ac00; an01 = ac01; an10 = ac10; an11 = ac11; }
        const char* nB = has_next ? (const char*)Btg + (size_t)nxt.pn * tstep : cB;
        for (int t = 0; t < nt; t += 2) {
            const bool last = (t == nt - 2);
            const unsigned k1 = (unsigned)(t + 1) * 128u, k2 = (unsigned)(t + 2) * 128u;
            const unsigned a200 = last ? an00 : ac00 + k2, a201 = last ? an01 : ac01 + k2, a210 = last ? an10 : ac10 + k2, a211 = last ? an11 : ac11 + k2;
            const char* b2 = last ? nB : cB + (size_t)k2; const char* b3 = b2 + kstep;
            PG8_LDB(B0, 0, 0); PG8_LDB(B1, 0, 1); PG8_SCHED; PG8_LDA(At, 0, 0); PG8_STAGEA(PG8_SA(1, 1), ac10 + k1, ac11 + k1);
            PG8_WAIT_V(8); PG8_WAIT_L(0); PG8_BAR; PG8_MMA(0, 0, At, B0); PG8_MMA(0, 1, At, B1); PG8_BAR; PG8_SCHED;
            PG8_LDA(At, 0, 1); PG8_STAGEB(PG8_SB(0, 0), b2); PG8_STAGEB(PG8_SB(0, 1), b2 + hstep); PG8_STAGEA(PG8_SA(0, 0), a200, a201);
            PG8_WAIT_V(8); PG8_WAIT_L(0); PG8_BAR; PG8_MMA(1, 0, At, B0); PG8_MMA(1, 1, At, B1); PG8_BAR; PG8_SCHED;
            PG8_LDB(B0, 1, 0); PG8_LDB(B1, 1, 1); PG8_SCHED; PG8_LDA(At, 1, 0); PG8_STAGEA(PG8_SA(0, 1), a210, a211);
            PG8_WAIT_V(8); PG8_WAIT_L(0); PG8_BAR; PG8_MMA(0, 0, At, B0); PG8_MMA(0, 1, At, B1); PG8_BAR; PG8_SCHED;
            PG8_LDA(At, 1, 1); PG8_STAGEB(PG8_SB(1, 0), b3); PG8_STAGEB(PG8_SB(1, 1), b3 + hstep); PG8_STAGEA(PG8_SA(1, 0), a200 + 128u, a201 + 128u);
            PG8_WAIT_V(8); PG8_WAIT_L(0); PG8_BAR; PG8_MMA(1, 0, At, B0); PG8_MMA(1, 1, At, B1); PG8_BAR; PG8_SCHED;
        }
        if constexpr (ALIGN_EPI) { if (wr == 0) PG8_BAR; }
        E(acc, cur, wr, wc, fr, fq);
        if (!has_next) break;
#pragma unroll
        for (int a = 0; a < 2; ++a)
#pragma unroll
            for (int b = 0; b < 2; ++b)
#pragma unroll
                for (int m = 0; m < 4; ++m)
#pragma unroll
                    for (int n = 0; n < 2; ++n) acc[a][b][m][n] = (f32x4){0.f, 0.f, 0.f, 0.f};
        cur = nxt; cB = nB; ac00 = an00; ac01 = an01; ac10 = an10; ac11 = an11; ++ui;
        if constexpr (ALIGN_EPI) { if (wr == 1) PG8_BAR; }
    }
    PG8_WAIT_V(0);
    if constexpr (!ALIGN_EPI) { if (wr == 0) PG8_BAR; }
    PG8_BAR;
#undef PG8_SA
#undef PG8_SB
#undef PG8_STAGEA
#undef PG8_STAGEB
#undef PG8_LDA
#undef PG8_LDB
#undef PG8_MMA
#undef PG8_WAIT_V
#undef PG8_WAIT_L
#undef PG8_BAR
#undef PG8_SCHED
}
}

#define XB_TMO      128
#define XB_XCNT(j)  (256  + 64 * (j))
#define XB_XSUB(j)  (1280 + 64 * (j))
#define XB_XGEN(j)  (2304 + 64 * (j))
#define XB_TOP      3328
#define XB_TOPGEN   3392
#define XCD_BAR_WORDS 3456
#define XB_SPIN_CAP (1u << 18)
__device__ __forceinline__ unsigned xb_ld(unsigned* p)              { return __hip_atomic_load(p, __ATOMIC_RELAXED, __HIP_MEMORY_SCOPE_AGENT); }
__device__ __forceinline__ unsigned xb_add(unsigned* p, unsigned v) { return __hip_atomic_fetch_add(p, v, __ATOMIC_RELAXED, __HIP_MEMORY_SCOPE_AGENT); }
__device__ __forceinline__ unsigned xb_xcc_id() { return (unsigned)__builtin_amdgcn_s_getreg((3 << 11) | 20) & 0xFu; }
#define XB_SPIN(cond, bar) do { unsigned _sp = 0; while (cond) { __builtin_amdgcn_s_sleep(1); \
    if ((++_sp & 255u) == 0u) { if (xb_ld(&(bar)[XB_TMO])) break; if (_sp > XB_SPIN_CAP) { atomicAdd(&(bar)[XB_TMO], 1u); break; } } } } while (0)
struct XcdBarrier { unsigned* bar; unsigned x; volatile LAS unsigned* st; };
__device__ __forceinline__ XcdBarrier xcd_barrier_post(unsigned* bar, volatile LAS unsigned* st) {
    XcdBarrier b; b.bar = bar; b.x = xb_xcc_id(); b.st = st;
    if (threadIdx.x == 0) (void)xb_add(&bar[XB_XCNT(b.x)], 1u);
    return b;
}
__device__ __forceinline__ void xcd_barrier_complete(unsigned* bar, unsigned x, unsigned& nloc, unsigned& nx) {
    const unsigned G = gridDim.x * gridDim.y * gridDim.z;
    unsigned sum, cnt, mine, sp = 0u;
    for (;;) {
        sum = 0u; cnt = 0u; mine = 0u;
#pragma unroll
        for (unsigned j = 0; j < 16; ++j) { const unsigned c = xb_ld(&bar[XB_XCNT(j)]); sum += c; cnt += (c > 0u) ? 1u : 0u; mine = (j == x) ? c : mine; }
        if (sum == G) break;
        __builtin_amdgcn_s_sleep(1);
        if ((++sp & 255u) == 0u) { if (xb_ld(&bar[XB_TMO])) break; if (sp > XB_SPIN_CAP) { atomicAdd(&bar[XB_TMO], 1u); break; } }
    }
    nloc = mine > 0u ? mine : 1u; nx = cnt > 0u ? cnt : 1u;
}
__device__ __forceinline__ void xcd_barrier(const XcdBarrier& b) {
    asm volatile("s_waitcnt vmcnt(0)" ::: "memory");
    __syncthreads();
    if (threadIdx.x == 0) {
        unsigned* bar = b.bar;
        __builtin_amdgcn_s_waitcnt(0);
        unsigned nloc = b.st[0], nx = b.st[1];
        if (nloc == 0u) { xcd_barrier_complete(bar, b.x, nloc, nx); b.st[0] = nloc; b.st[1] = nx; }
        const unsigned old = xb_add(&bar[XB_XSUB(b.x)], 1u);
        const unsigned gen = old / nloc;
        if (old + 1u == (gen + 1u) * nloc) {
            __builtin_amdgcn_fence(__ATOMIC_RELEASE, "agent");
            asm volatile("s_waitcnt vmcnt(0)" ::: "memory");
            const unsigned og = xb_add(&bar[XB_TOP], 1u);
            const unsigned tg = og / nx;
            if (og + 1u == (tg + 1u) * nx) xb_add(&bar[XB_TOPGEN], 1u);
            else XB_SPIN(xb_ld(&bar[XB_TOPGEN]) == tg, bar);
            __builtin_amdgcn_fence(__ATOMIC_ACQUIRE, "agent");
            xb_add(&bar[XB_XGEN(b.x)], 1u);
            asm volatile("s_waitcnt vmcnt(0)" ::: "memory");
        } else {
            XB_SPIN(xb_ld(&bar[XB_XGEN(b.x)]) == gen, bar);
            __builtin_amdgcn_fence(__ATOMIC_ACQUIRE, "agent");
            asm volatile("s_waitcnt vmcnt(0)" ::: "memory");
        }
    }
    __syncthreads();
}

struct Frame {
    LAS unsigned char* lds;
    volatile LAS unsigned* MISC;
    unsigned* ctl;
    int tid, lane, wave, vcu, G;
    unsigned char* ws;
    const float *x, *g_mix, *w_in, *w_up, *b_alpha, *g_gla, *w_conv, *w_a, *w_b, *w_out, *g_ffn, *w_router, *b_router, *w_gu, *b_gu, *w_d, *b_d, *g_final;
    float* out;
};
#define WSP(T, off) ((T*)(F.ws + (off)))

__device__ __forceinline__ void tr_item(const float* W, int ld_src, int k0, int n0src, bf16* WT, size_t dst_row0, int K, LAS float* scr, int lane) {
#pragma unroll 8
    for (int i = 0; i < 32; ++i) { const int kk = 2 * i + (lane >> 5); scr[kk * 33 + (lane & 31)] = W[(size_t)(k0 + kk) * ld_src + n0src + (lane & 31)]; }
    LDS_WAIT(); asm volatile("" ::: "memory");
    const int c = lane & 7;
#pragma unroll
    for (int j = 0; j < 4; ++j) { const int n = (lane >> 3) + 8 * j; const LAS float* s = scr + (8 * c) * 33 + n;
        u32x4 o; o.x = pk2(s[0 * 33], s[1 * 33]); o.y = pk2(s[2 * 33], s[3 * 33]); o.z = pk2(s[4 * 33], s[5 * 33]); o.w = pk2(s[6 * 33], s[7 * 33]);
        *(u32x4*)(WT + (dst_row0 + n) * (size_t)K + k0 + 8 * c) = o; }
    LDS_WAIT(); asm volatile("" ::: "memory");
}

__device__ __forceinline__ void p0_prologue(Frame& F) {
    LAS float* scr = (LAS float*)(F.lds + F.wave * 16384);
    const int gw = F.vcu * NWAVES + F.wave, NGW = F.G * NWAVES;
    constexpr int I_IN = 256 * 16, I_SQ = 32 * 16, I_GU = NE * 64 * 16, I_D = NE * 32 * 16;
    constexpr int NITEMS = I_IN + 3 * I_SQ + I_GU + I_D;
    bf16* Win_t = WSP(bf16, WS_WIN);
    for (int it = gw; it < NITEMS; it += NGW) {
        int r = it;
        if (r < I_IN) { const int kb = r >> 8, nb = r & 255, j0 = 32 * nb; tr_item(F.w_in, NZS, 64 * kb, j0 < 3072 ? j0 : j0 + 16, Win_t, j0, 1024, scr, F.lane); continue; } r -= I_IN;
        if (r < I_SQ) { tr_item(F.w_a, 1024, 64 * (r >> 5), 32 * (r & 31), WSP(bf16, WS_WA), 32 * (r & 31), 1024, scr, F.lane); continue; } r -= I_SQ;
        if (r < I_SQ) { tr_item(F.w_b, 1024, 64 * (r >> 5), 32 * (r & 31), WSP(bf16, WS_WB), 32 * (r & 31), 1024, scr, F.lane); continue; } r -= I_SQ;
        if (r < I_SQ) { tr_item(F.w_out, 1024, 64 * (r >> 5), 32 * (r & 31), WSP(bf16, WS_WO), 32 * (r & 31), 1024, scr, F.lane); continue; } r -= I_SQ;
        if (r < I_GU) { const int e = r >> 10, q = r & 1023, kb = q >> 6, nb = q & 63, j0 = 32 * nb, pn = j0 >> 8, within = j0 & 255, half = within >> 7;
            tr_item(F.w_gu + (size_t)e * 1024 * 2048, 2048, 64 * kb, half * 1024 + pn * 128 + (within & 127), WSP(bf16, WS_WGU) + (size_t)e * 2048 * 1024, j0, 1024, scr, F.lane); continue; } r -= I_GU;
        { const int e = r >> 9, q = r & 511, kb = q >> 5, nb = q & 31;
            tr_item(F.w_d + (size_t)e * 1024 * 1024, 1024, 64 * kb, 32 * nb, WSP(bf16, WS_WD) + (size_t)e * 1024 * 1024, 32 * nb, 1024, scr, F.lane); }
    }
    __syncthreads();
    LAS float* Wl = (LAS float*)(F.lds);
    LAS float* WU = (LAS float*)(F.lds + 65536);
    LAS float* BA = (LAS float*)(F.lds + 98304);
    for (int i = 0; i < 32; ++i) { const int idx = F.tid + 512 * i, k = idx >> 4, r = idx & 15; Wl[r * 1024 + k] = F.w_in[(size_t)k * NZS + 3072 + r]; }
    for (int i = 0; i < 16; ++i) { const int idx = F.tid + 512 * i; WU[idx] = F.w_up[idx]; }
    BA[F.tid] = F.b_alpha[F.tid];
    __syncthreads();
    f32x4 g[4];
#pragma unroll
    for (int j = 0; j < 4; ++j) g[j] = *((const f32x4*)F.g_mix + F.lane + 64 * j);
    bf16* XN = WSP(bf16, WS_XN); float* LA = WSP(float, WS_LA);
    for (int m = gw; m < M; m += NGW) {
        const f32x4* xr = (const f32x4*)(F.x + (size_t)m * D) + F.lane;
        f32x4 v[4]; float s = 0.f;
#pragma unroll
        for (int j = 0; j < 4; ++j) { v[j] = xr[64 * j]; s += (v[j].x * v[j].x + v[j].y * v[j].y) + (v[j].z * v[j].z + v[j].w * v[j].w); }
        const float rstd = 1.0f / sqrtf(wave_sum(s) * (1.f / D) + 1e-6f);
        unsigned long long* o8 = (unsigned long long*)(XN + (size_t)m * D) + F.lane;
#pragma unroll
        for (int j = 0; j < 4; ++j) { v[j] = v[j] * rstd * g[j]; o8[64 * j] = (unsigned long long)pk2(v[j].x, v[j].y) | ((unsigned long long)pk2(v[j].z, v[j].w) << 32); }
        float a[16];
#pragma unroll
        for (int r4 = 0; r4 < 4; ++r4) {
#pragma unroll
            for (int rr = 0; rr < 4; ++rr) { const int r = 4 * r4 + rr; float t = 0.f;
#pragma unroll
                for (int j = 0; j < 4; ++j) { const f32x4 w = *(const LAS f32x4*)(Wl + r * 1024 + 256 * j + 4 * F.lane); t += (v[j].x * w.x + v[j].y * w.y) + (v[j].z * w.z + v[j].w * w.w); }
                a[r] = t; }
            asm volatile("" ::: "memory");
        }
#pragma unroll
        for (int q = 0; q < 8; ++q) { const bool up = (F.lane & 32) != 0; const float send = up ? a[q] : a[q + 8]; const float keep = up ? a[q + 8] : a[q]; a[q] = keep + __shfl_xor(send, 32); }
#pragma unroll
        for (int q = 0; q < 4; ++q) { const bool up = (F.lane & 16) != 0; const float send = up ? a[q] : a[q + 4]; const float keep = up ? a[q + 4] : a[q]; a[q] = keep + __shfl_xor(send, 16); }
#pragma unroll
        for (int q = 0; q < 2; ++q) { const bool up = (F.lane & 8) != 0; const float send = up ? a[q] : a[q + 2]; const float keep = up ? a[q + 2] : a[q]; a[q] = keep + __shfl_xor(send, 8); }
        { const bool up = (F.lane & 4) != 0; const float send = up ? a[0] : a[1]; const float keep = up ? a[1] : a[0]; a[0] = keep + __shfl_xor(send, 4); }
        float alv = a[0]; alv += __shfl_xor(alv, 2); alv += __shfl_xor(alv, 1);
        float al[16];
#pragma unroll
        for (int r = 0; r < 16; ++r) al[r] = __builtin_bit_cast(float, __builtin_amdgcn_readlane(__builtin_bit_cast(int, alv), 4 * r));
#pragma unroll
        for (int i = 0; i < 8; ++i) { const int j = F.lane + 64 * i; float pre = BA[j];
#pragma unroll
            for (int r = 0; r < 16; ++r) pre += al[r] * WU[r * 512 + j];
            const float ls = fminf(pre, 0.f) - log1pf(__expf(-fabsf(pre)));
            LA[(size_t)m * 512 + j] = ls * (1.0f / 16.0f);
            if (i & 1) asm volatile("" ::: "memory"); }
    }
}

struct EpiZ {
    static constexpr bool PERM = true;
    bf16* Z;
    __device__ __forceinline__ void operator()(const f32x4 (&acc)[2][2][4][2], const pg8::Unit& u, int wr, int wc, int fr, int fq) const {
        const int row0 = u.pm * 256 + wr * 64 + fr, col0 = u.pn * 256 + wc * 32 + 8 * fq;
        const int kind = u.pn < 2 ? 1 : (u.pn < 8 ? 0 : (u.pn < 12 ? 2 : (u.pn < 24 ? 0 : 3)));
#pragma unroll
        for (int ai = 0; ai < 2; ++ai)
#pragma unroll
            for (int m = 0; m < 4; ++m) { bf16* rowp = Z + (size_t)(row0 + ai * 128 + m * 16) * NZ + col0;
#pragma unroll
                for (int bj = 0; bj < 2; ++bj) { f32x4 v0 = acc[ai][bj][m][0], v1 = acc[ai][bj][m][1];
                    if (kind == 1) { v0 = v0 * 0.08838834764831845f; v1 = v1 * 0.08838834764831845f; }
                    else if (kind == 2) {
#pragma unroll
                        for (int j = 0; j < 4; ++j) { v0[j] = v0[j] * fast_sigmoid(v0[j]); v1[j] = v1[j] * fast_sigmoid(v1[j]); } }
                    else if (kind == 3) {
#pragma unroll
                        for (int j = 0; j < 4; ++j) { v0[j] = fast_sigmoid(v0[j]); v1[j] = fast_sigmoid(v1[j]); } }
                    u32x4 w; w.x = pk2(v0[0], v0[1]); w.y = pk2(v0[2], v0[3]); w.z = pk2(v1[0], v1[1]); w.w = pk2(v1[2], v1[3]);
                    *(u32x4*)(rowp + bj * 128) = w; } }
    }
};

constexpr int QD_STRIDE = 272, KT_STRIDE = 144, SC_STRIDE = 144, OT_STRIDE = 1040;
constexpr int L_QD = 0, L_KI = 17408, L_KT = 34816, L_SC = 53248, L_DEC = 62464, L_SEG = 62976, L_OT = 65536;
__device__ __forceinline__ int crow(int reg, int h) { return (reg & 3) + 8 * (reg >> 2) + 4 * h; }

template <bool OUT>
__device__ __forceinline__ void gla_item(Frame& F, int item) {
    const int bh = item >> 3, sc = item & 7, b = bh >> 2, hd = bh & 3;
    const int t0 = b * SEQ + sc * 256;
    const int tid = F.tid, lane = F.lane, w = F.wave, r32 = lane & 31, h = lane >> 5;
    const bf16* Z = WSP(const bf16, WS_Z);
    const float* LA = WSP(const float, WS_LA);
    LAS unsigned char* L = F.lds;
    f32x16 S[4];
    float* Sbuf = (OUT ? WSP(float, WS_SIN) : WSP(float, WS_U)) + (size_t)item * 32768 + (size_t)w * 4096;
    if (OUT) {
#pragma unroll
        for (int kb = 0; kb < 4; ++kb)
#pragma unroll
            for (int r = 0; r < 16; ++r) S[kb][r] = Sbuf[(kb * 16 + r) * 64 + lane];
    } else {
#pragma unroll
        for (int kb = 0; kb < 4; ++kb)
#pragma unroll
            for (int r = 0; r < 16; ++r) S[kb][r] = 0.f;
    }
    const int d = tid & 127, seg = tid >> 7;
    float btot_run = 0.f;
    for (int c = 0; c < 4; ++c) {
        const int tc = t0 + c * 64;
        float la[16], p[16];
#pragma unroll
        for (int i = 0; i < 16; ++i) la[i] = LA[(size_t)(tc + 16 * seg + i) * 512 + hd * 128 + d];
        bf16 qv[16], kv[16];
#pragma unroll
        for (int i = 0; i < 16; ++i) { const bf16* zr = Z + (size_t)(tc + 16 * seg + i) * NZ; kv[i] = zr[ZK + hd * 128 + d]; if (OUT) qv[i] = zr[ZQ + hd * 128 + d]; }
        bf16x8 Bv[4];
#pragma unroll
        for (int ks = 0; ks < 4; ++ks)
#pragma unroll
            for (int j = 0; j < 8; ++j) Bv[ks][j] = (short)Z[(size_t)(tc + 16 * ks + 8 * h + j) * NZ + ZV + hd * 256 + 32 * w + r32];
        float run = 0.f;
#pragma unroll
        for (int i = 0; i < 16; ++i) { run += la[i]; p[i] = run; }
        LAS float* SEG = (LAS float*)(L + L_SEG);
        SEG[seg * 128 + d] = run;
        __syncthreads();
        const float s0 = SEG[d], s1 = SEG[128 + d], s2 = SEG[256 + d], s3 = SEG[384 + d];
        const float offs = seg == 0 ? 0.f : (seg == 1 ? s0 : (seg == 2 ? s0 + s1 : s0 + s1 + s2));
        const float btot = (s0 + s1) + (s2 + s3);
        if (seg == 0) { ((LAS float*)(L + L_DEC))[d] = __expf(btot); btot_run += btot; }
        {
            unsigned ktp[8];
#pragma unroll
            for (int i = 0; i < 16; i += 2) {
                const float b0 = offs + p[i], b1 = offs + p[i + 1];
                const float k0 = bf1(kv[i]), k1 = bf1(kv[i + 1]);
                ktp[i >> 1] = pk2(k0 * __expf(btot - b0), k1 * __expf(btot - b1));
                if (OUT) {
                    const float q0 = bf1(qv[i]), q1 = bf1(qv[i + 1]);
                    const unsigned qd = pk2(q0 * __expf(b0), q1 * __expf(b1)), ki = pk2(k0 * __expf(-b0), k1 * __expf(-b1));
                    *(LAS bf16*)(L + L_QD + (16 * seg + i) * QD_STRIDE + 2 * d) = (bf16)(qd & 0xffffu); *(LAS bf16*)(L + L_QD + (16 * seg + i + 1) * QD_STRIDE + 2 * d) = (bf16)(qd >> 16);
                    *(LAS bf16*)(L + L_KI + (16 * seg + i) * QD_STRIDE + 2 * d) = (bf16)(ki & 0xffffu); *(LAS bf16*)(L + L_KI + (16 * seg + i + 1) * QD_STRIDE + 2 * d) = (bf16)(ki >> 16);
                }
            }
            *(LAS u32x4*)(L + L_KT + d * KT_STRIDE + 32 * seg) = (u32x4){ktp[0], ktp[1], ktp[2], ktp[3]};
            *(LAS u32x4*)(L + L_KT + d * KT_STRIDE + 32 * seg + 16) = (u32x4){ktp[4], ktp[5], ktp[6], ktp[7]};
        }
        __syncthreads();
        f32x16 o[2];
        if (OUT) {
            if (w < 3) {
                const int ib = w == 0 ? 0 : 1, jb = w == 2 ? 1 : 0;
                f32x16 sacc;
#pragma unroll
                for (int r = 0; r < 16; ++r) sacc[r] = 0.f;
#pragma unroll
                for (int kb = 0; kb < 8; ++kb) {
                    const bf16x8 a = *(const LAS bf16x8*)(L + L_QD + (32 * ib + r32) * QD_STRIDE + 2 * (16 * kb + 8 * h));
                    const bf16x8 bb = *(const LAS bf16x8*)(L + L_KI + (32 * jb + r32) * QD_STRIDE + 2 * (16 * kb + 8 * h));
                    sacc = __builtin_amdgcn_mfma_f32_32x32x16_bf16(a, bb, sacc, 0, 0, 0);
                }
#pragma unroll
                for (int r = 0; r < 16; r += 1) {
                    const int i = 32 * ib + crow(r, h), j = 32 * jb + r32;
                    const float v = (j <= i) ? sacc[r] : 0.f;
                    *(LAS bf16*)(L + L_SC + i * SC_STRIDE + 2 * j) = (bf16)(pk2(v, 0.f) & 0xffffu);
                }
            }
#pragma unroll
            for (int ib = 0; ib < 2; ++ib)
#pragma unroll
                for (int r = 0; r < 16; ++r) o[ib][r] = 0.f;
#pragma unroll
            for (int kb = 0; kb < 4; ++kb)
#pragma unroll
                for (int s = 0; s < 2; ++s) {
                    u32x4 pb; pb.x = pk2(S[kb][8 * s + 0], S[kb][8 * s + 1]); pb.y = pk2(S[kb][8 * s + 2], S[kb][8 * s + 3]); pb.z = pk2(S[kb][8 * s + 4], S[kb][8 * s + 5]); pb.w = pk2(S[kb][8 * s + 6], S[kb][8 * s + 7]);
                    const bf16x8 bfrag = __builtin_bit_cast(bf16x8, pb);
#pragma unroll
                    for (int ib = 0; ib < 2; ++ib) {
                        const LAS unsigned char* qp = L + L_QD + (32 * ib + r32) * QD_STRIDE + 2 * (32 * kb + 16 * s + 4 * h);
                        const u32x2 lo = *(const LAS u32x2*)qp, hi = *(const LAS u32x2*)(qp + 16);
                        const bf16x8 afrag = __builtin_bit_cast(bf16x8, (u32x4){lo.x, lo.y, hi.x, hi.y});
                        o[ib] = __builtin_amdgcn_mfma_f32_32x32x16_bf16(afrag, bfrag, o[ib], 0, 0, 0);
                    }
                }
            __syncthreads();
#pragma unroll
            for (int ks = 0; ks < 4; ++ks)
#pragma unroll
                for (int ib = 0; ib < 2; ++ib) {
                    if (ib == 0 && ks >= 2) continue;
                    const bf16x8 a = *(const LAS bf16x8*)(L + L_SC + (32 * ib + r32) * SC_STRIDE + 2 * (16 * ks + 8 * h));
                    o[ib] = __builtin_amdgcn_mfma_f32_32x32x16_bf16(a, Bv[ks], o[ib], 0, 0, 0);
                }
        }
#pragma unroll
        for (int kb = 0; kb < 4; ++kb) {
#pragma unroll
            for (int g4 = 0; g4 < 4; ++g4) { const f32x4 dc = *(const LAS f32x4*)(L + L_DEC + 4 * (32 * kb + 8 * g4 + 4 * h));
#pragma unroll
                for (int j = 0; j < 4; ++j) S[kb][4 * g4 + j] *= dc[j]; }
#pragma unroll
            for (int ks = 0; ks < 4; ++ks) {
                const bf16x8 a = *(const LAS bf16x8*)(L + L_KT + (32 * kb + r32) * KT_STRIDE + 2 * (16 * ks + 8 * h));
                S[kb] = __builtin_amdgcn_mfma_f32_32x32x16_bf16(a, Bv[ks], S[kb], 0, 0, 0);
            }
        }
        if (OUT) {
#pragma unroll
            for (int ib = 0; ib < 2; ++ib)
#pragma unroll
                for (int r = 0; r < 16; ++r) *(LAS float*)(L + L_OT + (32 * ib + crow(r, h)) * OT_STRIDE + 4 * (32 * w + r32)) = o[ib][r];
            __syncthreads();
            const int tok = tid >> 3, part = tid & 7;
            f32x4 ov[8]; float ss = 0.f;
#pragma unroll
            for (int i = 0; i < 8; ++i) { ov[i] = *(const LAS f32x4*)(L + L_OT + tok * OT_STRIDE + 4 * (32 * part + 4 * i)); ss += (ov[i].x * ov[i].x + ov[i].y * ov[i].y) + (ov[i].z * ov[i].z + ov[i].w * ov[i].w); }
            ss += __shfl_xor(ss, 1); ss += __shfl_xor(ss, 2); ss += __shfl_xor(ss, 4);
            const float rs = 1.0f / sqrtf(ss * (1.0f / 256.0f) + 1e-6f);
            const size_t trow = (size_t)(tc + tok);
            const u32x4* rp = (const u32x4*)(Z + trow * NZ + ZR + hd * 256 + 32 * part);
            const f32x4* gp = (const f32x4*)(F.g_gla + hd * 256 + 32 * part);
            u32x4* op = (u32x4*)(WSP(bf16, WS_OG) + trow * 1024 + hd * 256 + 32 * part);
#pragma unroll
            for (int i = 0; i < 4; ++i) {
                const u32x4 rr = rp[i]; const f32x4 g0 = gp[2 * i], g1 = gp[2 * i + 1]; const f32x4 a0 = ov[2 * i], a1 = ov[2 * i + 1];
                u32x4 ow;
                ow.x = pk2(a0.x * rs * g0.x * bf_lo(rr.x), a0.y * rs * g0.y * bf_hi(rr.x));
                ow.y = pk2(a0.z * rs * g0.z * bf_lo(rr.y), a0.w * rs * g0.w * bf_hi(rr.y));
                ow.z = pk2(a1.x * rs * g1.x * bf_lo(rr.z), a1.y * rs * g1.y * bf_hi(rr.z));
                ow.w = pk2(a1.z * rs * g1.z * bf_lo(rr.w), a1.w * rs * g1.w * bf_hi(rr.w));
                op[i] = ow;
            }
        }
    }
    if (!OUT) {
#pragma unroll
        for (int kb = 0; kb < 4; ++kb)
#pragma unroll
            for (int r = 0; r < 16; ++r) Sbuf[(kb * 16 + r) * 64 + lane] = S[kb][r];
        if (seg == 0) WSP(float, WS_DECS)[item * 128 + d] = __expf(btot_run);
    }
    __syncthreads();
}

__device__ __forceinline__ void conv_rows(Frame& F) {
    const int gw = F.vcu * NWAVES + F.wave, NGW = F.G * NWAVES;
    const bf16* Z = WSP(const bf16, WS_Z); bf16* PB = WSP(bf16, WS_PB);
    for (int blk = gw; blk < M / 8; blk += NGW) {
        const int m0 = blk * 8, s0 = m0 % SEQ;
#pragma unroll
        for (int j = 0; j < 2; ++j) {
            const int c = 8 * F.lane + 512 * j;
            float w0[8], w1[8], w2[8], u1[8], u2[8];
#pragma unroll
            for (int i = 0; i < 8; ++i) { w0[i] = F.w_conv[c + i]; w1[i] = F.w_conv[1024 + c + i]; w2[i] = F.w_conv[2048 + c + i]; u1[i] = 0.f; u2[i] = 0.f; }
            if (s0 > 0) {
                const u32x4 c2 = *(const u32x4*)(Z + (size_t)(m0 - 2) * NZ + ZCC + c), x2 = *(const u32x4*)(Z + (size_t)(m0 - 2) * NZ + ZCX + c);
                const u32x4 c1 = *(const u32x4*)(Z + (size_t)(m0 - 1) * NZ + ZCC + c), x1 = *(const u32x4*)(Z + (size_t)(m0 - 1) * NZ + ZCX + c);
#pragma unroll
                for (int i = 0; i < 4; ++i) { u2[2 * i] = bf_lo(c2[i]) * bf_lo(x2[i]); u2[2 * i + 1] = bf_hi(c2[i]) * bf_hi(x2[i]); u1[2 * i] = bf_lo(c1[i]) * bf_lo(x1[i]); u1[2 * i + 1] = bf_hi(c1[i]) * bf_hi(x1[i]); }
            }
#pragma unroll
            for (int rr = 0; rr < 8; ++rr) {
                const size_t row = (size_t)(m0 + rr);
                const u32x4 cc = *(const u32x4*)(Z + row * NZ + ZCC + c), cx = *(const u32x4*)(Z + row * NZ + ZCX + c), cb = *(const u32x4*)(Z + row * NZ + ZCB + c);
                float u0[8], y[8];
#pragma unroll
                for (int i = 0; i < 4; ++i) { u0[2 * i] = bf_lo(cc[i]) * bf_lo(cx[i]); u0[2 * i + 1] = bf_hi(cc[i]) * bf_hi(cx[i]); }
#pragma unroll
                for (int i = 0; i < 8; ++i) y[i] = w0[i] * u2[i] + w1[i] * u1[i] + w2[i] * u0[i];
                u32x4 ow;
#pragma unroll
                for (int i = 0; i < 4; ++i) ow[i] = pk2(bf_lo(cb[i]) * y[2 * i], bf_hi(cb[i]) * y[2 * i + 1]);
                *(u32x4*)(PB + row * 1024 + c) = ow;
#pragma unroll
                for (int i = 0; i < 8; ++i) { u2[i] = u1[i]; u1[i] = u0[i]; }
            }
        }
    }
}

__device__ __forceinline__ void gla_scan(Frame& F) {
    const float* U = WSP(const float, WS_U); float* SIN = WSP(float, WS_SIN); const float* DECS = WSP(const float, WS_DECS);
    const int gt = F.vcu * 512 + F.tid, NT = F.G * 512;
    for (int idx = gt; idx < 32 * 32768; idx += NT) {
        const int bh = idx >> 15, e = idx & 32767;
        const int ln = e & 63, reg = (e >> 6) & 15, kb = (e >> 10) & 3;
        const int dk = 32 * kb + crow(reg, ln >> 5);
        float s = 0.f;
#pragma unroll
        for (int sc = 0; sc < 8; ++sc) {
            const int item = bh * 8 + sc;
            SIN[(size_t)item * 32768 + e] = s;
            s = DECS[item * 128 + dk] * s + U[(size_t)item * 32768 + e];
        }
    }
}

struct EpiM1 {
    static constexpr bool PERM = true;
    const bf16* Z; float* M1;
    __device__ __forceinline__ void operator()(const f32x4 (&acc)[2][2][4][2], const pg8::Unit& u, int wr, int wc, int fr, int fq) const {
        const int row0 = u.pm * 256 + wr * 64 + fr, col0 = u.pn * 256 + wc * 32 + 8 * fq;
#pragma unroll
        for (int ai = 0; ai < 2; ++ai)
#pragma unroll
            for (int m = 0; m < 4; ++m) { const size_t row = (size_t)(row0 + ai * 128 + m * 16);
#pragma unroll
                for (int bj = 0; bj < 2; ++bj) { const u32x4 sg = *(const u32x4*)(Z + row * NZ + ZGA + col0 + bj * 128);
                    const f32x4 v0 = acc[ai][bj][m][0], v1 = acc[ai][bj][m][1];
                    float* mp = M1 + row * 1024 + col0 + bj * 128;
                    *(f32x4*)mp = (f32x4){v0[0] * bf_lo(sg.x), v0[1] * bf_hi(sg.x), v0[2] * bf_lo(sg.y), v0[3] * bf_hi(sg.y)};
                    *(f32x4*)(mp + 4) = (f32x4){v1[0] * bf_lo(sg.z), v1[1] * bf_hi(sg.z), v1[2] * bf_lo(sg.w), v1[3] * bf_hi(sg.w)}; } }
    }
};
struct EpiMix {
    static constexpr bool PERM = true;
    const bf16* Z; const float* M1; bf16* MIX;
    __device__ __forceinline__ void operator()(const f32x4 (&acc)[2][2][4][2], const pg8::Unit& u, int wr, int wc, int fr, int fq) const {
        const int row0 = u.pm * 256 + wr * 64 + fr, col0 = u.pn * 256 + wc * 32 + 8 * fq;
#pragma unroll
        for (int ai = 0; ai < 2; ++ai)
#pragma unroll
            for (int m = 0; m < 4; ++m) { const size_t row = (size_t)(row0 + ai * 128 + m * 16);
#pragma unroll
                for (int bj = 0; bj < 2; ++bj) { const u32x4 sg = *(const u32x4*)(Z + row * NZ + ZGB + col0 + bj * 128);
                    const f32x4 v0 = acc[ai][bj][m][0], v1 = acc[ai][bj][m][1];
                    const float* mp = M1 + row * 1024 + col0 + bj * 128;
                    const f32x4 m0 = *(const f32x4*)mp, m1 = *(const f32x4*)(mp + 4);
                    u32x4 w;
                    w.x = pk2(m0[0] + v0[0] * bf_lo(sg.x), m0[1] + v0[1] * bf_hi(sg.x)); w.y = pk2(m0[2] + v0[2] * bf_lo(sg.y), m0[3] + v0[3] * bf_hi(sg.y));
                    w.z = pk2(m1[0] + v1[0] * bf_lo(sg.z), m1[1] + v1[1] * bf_hi(sg.z)); w.w = pk2(m1[2] + v1[2] * bf_lo(sg.w), m1[3] + v1[3] * bf_hi(sg.w));
                    *(u32x4*)(MIX + row * 1024 + col0 + bj * 128) = w; } }
    }
};
struct EpiX1 {
    static constexpr bool PERM = false;
    const float* x; float* X1;
    __device__ __forceinline__ void operator()(const f32x4 (&acc)[2][2][4][2], const pg8::Unit& u, int wr, int wc, int fr, int fq) const {
        const int row0 = u.pm * 256 + wr * 64 + fr, col0 = u.pn * 256 + wc * 32 + 4 * fq;
#pragma unroll
        for (int ai = 0; ai < 2; ++ai)
#pragma unroll
            for (int m = 0; m < 4; ++m) { const size_t off = (size_t)(row0 + ai * 128 + m * 16) * 1024 + col0;
#pragma unroll
                for (int bj = 0; bj < 2; ++bj)
#pragma unroll
                    for (int n = 0; n < 2; ++n) { const f32x4 xs = *(const f32x4*)(x + off + bj * 128 + n * 16); *(f32x4*)(X1 + off + bj * 128 + n * 16) = xs + acc[ai][bj][m][n]; } }
    }
};

__device__ __forceinline__ void p5_router(Frame& F) {
    LAS float* WrT = (LAS float*)F.lds;
    LAS int* hist = (LAS int*)(F.lds + EXTRA_OFF);
    LAS int* base = (LAS int*)(F.lds + EXTRA_OFF + 128);
    LAS int* ple = (LAS int*)(F.lds + EXTRA_OFF + 256);
    for (int i = 0; i < 64; ++i) { const int idx = F.tid + 512 * i, k = idx >> 5, e = idx & 31; WrT[e * 1024 + k] = F.w_router[idx]; }
    f32x4 g[4];
#pragma unroll
    for (int j = 0; j < 4; ++j) g[j] = *((const f32x4*)F.g_ffn + F.lane + 64 * j);
    const float brl = F.b_router[F.lane >> 1];
    const float* X1 = WSP(const float, WS_X1); bf16* H2 = WSP(bf16, WS_XN);
    unsigned* cnt = F.ctl + CW_CNT; int* list = WSP(int, WS_LIST); float* gate = WSP(float, WS_GATE);
    const int lane = F.lane;
    for (int grp = F.vcu; grp < M / 64; grp += F.G) {
        if (F.tid < 32) hist[F.tid] = 0;
        __syncthreads();
        for (int i = 0; i < 8; ++i) {
            const int tl = 8 * F.wave + i, m = grp * 64 + tl;
            const f32x4* xr = (const f32x4*)(X1 + (size_t)m * D) + lane;
            f32x4 v[4]; float s = 0.f;
#pragma unroll
            for (int j = 0; j < 4; ++j) { v[j] = xr[64 * j]; s += (v[j].x * v[j].x + v[j].y * v[j].y) + (v[j].z * v[j].z + v[j].w * v[j].w); }
            const float rstd = 1.0f / sqrtf(wave_sum(s) * (1.f / D) + 1e-6f);
            unsigned long long* o8 = (unsigned long long*)(H2 + (size_t)m * D) + lane;
#pragma unroll
            for (int j = 0; j < 4; ++j) { v[j] = v[j] * rstd * g[j]; o8[64 * j] = (unsigned long long)pk2(v[j].x, v[j].y) | ((unsigned long long)pk2(v[j].z, v[j].w) << 32); }
            float a[32];
#pragma unroll
            for (int e = 0; e < 32; ++e) { float t = 0.f;
#pragma unroll
                for (int j = 0; j < 4; ++j) { const f32x4 wv = *(const LAS f32x4*)(WrT + e * 1024 + 256 * j + 4 * lane); t += (v[j].x * wv.x + v[j].y * wv.y) + (v[j].z * wv.z + v[j].w * wv.w); }
                a[e] = t; }
#pragma unroll
            for (int q = 0; q < 16; ++q) { const bool up = (lane & 32) != 0; const float send = up ? a[q] : a[q + 16]; const float keep = up ? a[q + 16] : a[q]; a[q] = keep + __shfl_xor(send, 32); }
#pragma unroll
            for (int q = 0; q < 8; ++q) { const bool up = (lane & 16) != 0; const float send = up ? a[q] : a[q + 8]; const float keep = up ? a[q + 8] : a[q]; a[q] = keep + __shfl_xor(send, 16); }
#pragma unroll
            for (int q = 0; q < 4; ++q) { const bool up = (lane & 8) != 0; const float send = up ? a[q] : a[q + 4]; const float keep = up ? a[q + 4] : a[q]; a[q] = keep + __shfl_xor(send, 8); }
#pragma unroll
            for (int q = 0; q < 2; ++q) { const bool up = (lane & 4) != 0; const float send = up ? a[q] : a[q + 2]; const float keep = up ? a[q + 2] : a[q]; a[q] = keep + __shfl_xor(send, 4); }
            { const bool up = (lane & 2) != 0; const float send = up ? a[0] : a[1]; const float keep = up ? a[1] : a[0]; a[0] = keep + __shfl_xor(send, 2); }
            float lg = a[0] + __shfl_xor(a[0], 1) + brl;
            const int myi = lane >> 1;
            float tv[4]; int ti[4];
#pragma unroll
            for (int k = 0; k < 4; ++k) {
                float bv = lg; int bi = myi;
#pragma unroll
                for (int off = 32; off >= 2; off >>= 1) { const float ov = __shfl_xor(bv, off); const int oi = __shfl_xor(bi, off); if (ov > bv || (ov == bv && oi < bi)) { bv = ov; bi = oi; } }
                tv[k] = bv; ti[k] = bi;
                if (myi == bi) lg = -3.0e38f;
            }
            const float e1 = __expf(tv[1] - tv[0]), e2 = __expf(tv[2] - tv[0]), e3 = __expf(tv[3] - tv[0]);
            const float inv = 1.0f / (1.0f + e1 + e2 + e3);
            if (lane < 4) {
                const int ek = lane == 0 ? ti[0] : (lane == 1 ? ti[1] : (lane == 2 ? ti[2] : ti[3]));
                const float gk = (lane == 0 ? 1.0f : (lane == 1 ? e1 : (lane == 2 ? e2 : e3))) * inv;
                const int lr = __hip_atomic_fetch_add(&hist[ek], 1, __ATOMIC_RELAXED, __HIP_MEMORY_SCOPE_WORKGROUP);
                ple[tl * 4 + lane] = ek | (lr << 8);
                gate[(size_t)m * 4 + lane] = gk;
            }
        }
        __syncthreads();
        if (F.tid < 32) base[F.tid] = (int)__hip_atomic_fetch_add(cnt + F.tid, (unsigned)hist[F.tid], RLX_AGENT);
        __syncthreads();
        if (F.tid < 256) { const int pe = ple[F.tid], e = pe & 255, lr = pe >> 8; list[e * CAP + base[e] + lr] = (grp * 64) * 4 + F.tid; }
        __syncthreads();
    }
}

constexpr int MAXU = 12;
template <int NP>
struct MoeOrder {
    LAS const int* rt0;
    LAS const int* tokl;
    int nwg, G, c;
    __device__ __forceinline__ bool next(int i, pg8::Unit& u) const {
        const long L = (long)i * G + c; if (L >= nwg) return false;
        int wgid = (int)L; { const int q = nwg / 8, r = nwg % 8, xcd = wgid % 8, off = wgid / 8; wgid = (xcd < r ? xcd * (q + 1) : r * (q + 1) + (xcd - r) * q) + off; }
        int e = 0;
#pragma unroll 1
        for (int j = 1; j < 32; ++j) if (wgid >= NP * rt0[j]) e = j;
        const int l = wgid - NP * rt0[e], nte = rt0[e + 1] - rt0[e];
        const int pn = l / nte, rt = l - pn * nte;
        u.pm = rt0[e] + rt; u.pn = e * NP + pn; u.e = e; u.rt = rt; return true;
    }
};
struct MoeOrder1 : MoeOrder<8> {
    __device__ __forceinline__ unsigned arow(const pg8::Unit& u, int ui, int r) const { return (unsigned)tokl[ui * 256 + r] * 2048u; }
};
struct MoeOrder2 : MoeOrder<4> {
    __device__ __forceinline__ unsigned arow(const pg8::Unit& u, int ui, int r) const { return (unsigned)(u.pm * 256 + r) * 2048u; }
};
struct EpiAct {
    static constexpr bool PERM = true;
    const float* b_gu; bf16* ACT;
    __device__ __forceinline__ void operator()(const f32x4 (&acc)[2][2][4][2], const pg8::Unit& u, int wr, int wc, int fr, int fq) const {
        const int pn = u.pn & 7, cl = pn * 128 + wc * 32 + 8 * fq;
        const int row0 = u.pm * 256 + wr * 64 + fr;
        const f32x4 bg0 = *(const f32x4*)(b_gu + u.e * 2048 + cl), bg1 = *(const f32x4*)(b_gu + u.e * 2048 + cl + 4);
        const f32x4 bl0 = *(const f32x4*)(b_gu + u.e * 2048 + 1024 + cl), bl1 = *(const f32x4*)(b_gu + u.e * 2048 + 1024 + cl + 4);
#pragma unroll
        for (int ai = 0; ai < 2; ++ai)
#pragma unroll
            for (int m = 0; m < 4; ++m) {
                f32x4 g0 = acc[ai][0][m][0] + bg0, g1 = acc[ai][0][m][1] + bg1, l0 = acc[ai][1][m][0] + bl0, l1 = acc[ai][1][m][1] + bl1;
                float r0[4], r1[4];
#pragma unroll
                for (int j = 0; j < 4; ++j) {
                    const float ga = fminf(g0[j], 7.0f), gb = fminf(g1[j], 7.0f);
                    const float la = fminf(fmaxf(l0[j], -7.0f), 7.0f), lb = fminf(fmaxf(l1[j], -7.0f), 7.0f);
                    r0[j] = (la + 1.0f) * (ga * fast_sigmoid(1.702f * ga)); r1[j] = (lb + 1.0f) * (gb * fast_sigmoid(1.702f * gb));
                }
                u32x4 w; w.x = pk2(r0[0], r0[1]); w.y = pk2(r0[2], r0[3]); w.z = pk2(r1[0], r1[1]); w.w = pk2(r1[2], r1[3]);
                *(u32x4*)(ACT + (size_t)(row0 + ai * 128 + m * 16) * 1024 + cl) = w;
            }
    }
};
struct EpiYP {
    static constexpr bool PERM = true;
    const float* b_d; const unsigned* cnt; const int* list; const float* gate; bf16* YP;
    __device__ __forceinline__ void operator()(const f32x4 (&acc)[2][2][4][2], const pg8::Unit& u, int wr, int wc, int fr, int fq) const {
        const int pn = u.pn & 3, col0 = pn * 256 + wc * 32 + 8 * fq;
        const int ne = (int)cnt[u.e];
        f32x4 bv[2][2];
#pragma unroll
        for (int bj = 0; bj < 2; ++bj)
#pragma unroll
            for (int n = 0; n < 2; ++n) bv[bj][n] = *(const f32x4*)(b_d + u.e * 1024 + col0 + bj * 128 + 4 * n);
#pragma unroll
        for (int ai = 0; ai < 2; ++ai)
#pragma unroll
            for (int m = 0; m < 4; ++m) {
                const int slot = u.rt * 256 + ai * 128 + wr * 64 + m * 16 + fr;
                if (slot < ne) {
                    const int pid = list[u.e * CAP + slot]; const float gw = gate[pid];
#pragma unroll
                    for (int bj = 0; bj < 2; ++bj) { const f32x4 v0 = (acc[ai][bj][m][0] + bv[bj][0]) * gw, v1 = (acc[ai][bj][m][1] + bv[bj][1]) * gw;
                        u32x4 w; w.x = pk2(v0[0], v0[1]); w.y = pk2(v0[2], v0[3]); w.z = pk2(v1[0], v1[1]); w.w = pk2(v1[2], v1[3]);
                        *(u32x4*)(YP + (size_t)pid * 1024 + col0 + bj * 128) = w; }
                }
            }
    }
};
__device__ __forceinline__ int moe_setup(Frame& F, LAS int* rt0) {
    if (F.tid == 0) { int acc = 0; for (int e = 0; e < 32; ++e) { rt0[e] = acc; acc += ((int)F.ctl[CW_CNT + e] + 255) >> 8; } rt0[32] = acc; }
    __syncthreads();
    return rt0[32];
}

__device__ __forceinline__ void p8_final(Frame& F) {
    const int gw = F.vcu * NWAVES + F.wave, NGW = F.G * NWAVES;
    const float* X1 = WSP(const float, WS_X1); const bf16* YP = WSP(const bf16, WS_YP);
    f32x4 g[4];
#pragma unroll
    for (int j = 0; j < 4; ++j) g[j] = *((const f32x4*)F.g_final + F.lane + 64 * j);
    for (int m = gw; m < M; m += NGW) {
        const f32x4* xr = (const f32x4*)(X1 + (size_t)m * D) + F.lane;
        f32x4 v[4]; float s = 0.f;
#pragma unroll
        for (int j = 0; j < 4; ++j) v[j] = xr[64 * j];
#pragma unroll
        for (int k = 0; k < 4; ++k) { const u32x2* yr = (const u32x2*)(YP + ((size_t)m * 4 + k) * 1024) + F.lane;
#pragma unroll
            for (int j = 0; j < 4; ++j) { const u32x2 y = yr[64 * j]; v[j].x += bf_lo(y.x); v[j].y += bf_hi(y.x); v[j].z += bf_lo(y.y); v[j].w += bf_hi(y.y); } }
#pragma unroll
        for (int j = 0; j < 4; ++j) s += (v[j].x * v[j].x + v[j].y * v[j].y) + (v[j].z * v[j].z + v[j].w * v[j].w);
        const float rstd = 1.0f / sqrtf(wave_sum(s) * (1.f / D) + 1e-6f);
        f32x4* op = (f32x4*)(F.out + (size_t)m * D) + F.lane;
#pragma unroll
        for (int j = 0; j < 4; ++j) op[64 * j] = v[j] * rstd * g[j];
    }
}

struct Args { const float* in[18]; float* out; unsigned char* ws; int ph_lo, ph_hi; };
__global__ void __launch_bounds__(NWAVES * 64, 2) mk_fwd(Args args) {
    extern __shared__ __attribute__((aligned(16))) unsigned char lds[];
    Frame F;
    F.lds = (LAS unsigned char*)lds;
    F.MISC = (volatile LAS unsigned*)(F.lds + MISC_OFF);
    F.tid = threadIdx.x; F.lane = F.tid & 63; F.wave = __builtin_amdgcn_readfirstlane(F.tid >> 6);
    F.G = gridDim.x; { const int bx = blockIdx.x; F.vcu = (F.G % 8 == 0) ? (bx % 8) * (F.G / 8) + bx / 8 : bx; }
    F.ws = args.ws; F.ctl = (unsigned*)(args.ws + WS_CTL);
    F.x = args.in[0]; F.g_mix = args.in[1]; F.w_in = args.in[2]; F.w_up = args.in[3]; F.b_alpha = args.in[4]; F.g_gla = args.in[5]; F.w_conv = args.in[6];
    F.w_a = args.in[7]; F.w_b = args.in[8]; F.w_out = args.in[9]; F.g_ffn = args.in[10]; F.w_router = args.in[11]; F.b_router = args.in[12];
    F.w_gu = args.in[13]; F.b_gu = args.in[14]; F.w_d = args.in[15]; F.b_d = args.in[16]; F.g_final = args.in[17]; F.out = args.out;
    if (F.tid < 128) ((LAS unsigned*)(F.lds + MISC_OFF))[F.tid] = 0u;
    __syncthreads();
    XcdBarrier bar; bar.bar = F.ctl + CW_BAR; bar.x = 0; bar.st = nullptr;
    if (N_LAUNCHES == 1) bar = xcd_barrier_post(F.ctl + CW_BAR, F.MISC + 8);
    const int lo = args.ph_lo, hi = args.ph_hi;
#ifdef MK_ONLY
#define IN(k) ((k) == MK_ONLY && lo <= (k) && (k) < hi)
#else
#define IN(k) (lo <= (k) && (k) < hi)
#endif
#define SEAM(k) do { if (IN(k) && IN((k) + 1)) xcd_barrier(bar); } while (0)

    if (IN(0)) { p0_prologue(F); SEAM(0); }
    if (IN(1)) {
        pg8::StaticOrder S; S.init(M, NZ, D, F.G, (int)blockIdx.x);
        EpiZ E{WSP(bf16, WS_Z)};
        pg8::gemm_phase<EpiZ, pg8::StaticOrder, true>(F.lds, WSP(const bf16, WS_XN), WSP(const bf16, WS_WIN), D, S, E);
        SEAM(1);
    }
    if (IN(2)) { for (int it = F.vcu; it < 256; it += F.G) gla_item<false>(F, it); conv_rows(F); SEAM(2); }
    if (IN(3)) { gla_scan(F); SEAM(3); }
    if (IN(4)) { for (int it = F.vcu; it < 256; it += F.G) gla_item<true>(F, it); SEAM(4); }
    if (IN(5)) {
        pg8::StaticOrder S; S.init(M, D, D, F.G, (int)blockIdx.x);
        EpiM1 E1{WSP(const bf16, WS_Z), WSP(float, WS_M1)};
        pg8::gemm_phase<EpiM1, pg8::StaticOrder, false>(F.lds, WSP(const bf16, WS_OG), WSP(const bf16, WS_WA), D, S, E1);
        EpiMix E2{WSP(const bf16, WS_Z), WSP(const float, WS_M1), WSP(bf16, WS_MIX)};
        pg8::gemm_phase<EpiMix, pg8::StaticOrder, false>(F.lds, WSP(const bf16, WS_PB), WSP(const bf16, WS_WB), D, S, E2);
        SEAM(5);
    }
    if (IN(6)) {
        pg8::StaticOrder S; S.init(M, D, D, F.G, (int)blockIdx.x);
        EpiX1 E{F.x, WSP(float, WS_X1)};
        pg8::gemm_phase<EpiX1, pg8::StaticOrder, false>(F.lds, WSP(const bf16, WS_MIX), WSP(const bf16, WS_WO), D, S, E);
        SEAM(6);
    }
    if (IN(7)) { p5_router(F); SEAM(7); }
    if (IN(8)) {
        LAS int* rt0 = (LAS int*)(F.lds + EXTRA_OFF); LAS int* tokl = (LAS int*)(F.lds + EXTRA_OFF + 256);
        const int R = moe_setup(F, rt0);
        MoeOrder1 S; S.rt0 = rt0; S.tokl = tokl; S.nwg = R * 8; S.G = F.G; S.c = (int)blockIdx.x;
        const int* list = WSP(const int, WS_LIST);
        { pg8::Unit u; for (int ui = 0; ui < MAXU && S.next(ui, u); ++ui) if (F.tid < 256) { const int slot = u.rt * 256 + F.tid; tokl[ui * 256 + F.tid] = slot < (int)F.ctl[CW_CNT + u.e] ? (list[u.e * CAP + slot] >> 2) : 0; } }
        __syncthreads();
        EpiAct E{F.b_gu, WSP(bf16, WS_ACT)};
        pg8::gemm_phase<EpiAct, MoeOrder1, true>(F.lds, WSP(const bf16, WS_XN), WSP(const bf16, WS_WGU), D, S, E);
        SEAM(8);
    }
    if (IN(9)) {
        LAS int* rt0 = (LAS int*)(F.lds + EXTRA_OFF);
        const int R = moe_setup(F, rt0);
        MoeOrder2 S; S.rt0 = rt0; S.tokl = nullptr; S.nwg = R * 4; S.G = F.G; S.c = (int)blockIdx.x;
        EpiYP E{F.b_d, F.ctl + CW_CNT, WSP(const int, WS_LIST), WSP(const float, WS_GATE), WSP(bf16, WS_YP)};
        pg8::gemm_phase<EpiYP, MoeOrder2, true>(F.lds, WSP(const bf16, WS_ACT), WSP(const bf16, WS_WD), D, S, E);
        SEAM(9);
    }
    if (IN(10)) { p8_final(F); }
#undef IN
#undef SEAM
}

extern "C" void kernel_launch(void* const* d_in, const int* in_sizes, int n_in, void* d_out, int out_size, void* d_ws, size_t ws_size, hipStream_t stream) {
    static int grid = 0;
    if (grid == 0) {
        if (n_in != 18 || out_size != M * D || ws_size < WS_END) { fprintf(stderr, "kernel_launch: unexpected shapes (n_in %d, out %d, ws %zu < %zu)\n", n_in, out_size, ws_size, (size_t)WS_END); grid = -1; return; }
        int dev = 0, cus = 0, per_cu = 0;
        if (hipGetDevice(&dev) != hipSuccess || hipDeviceGetAttribute(&cus, hipDeviceAttributeMultiprocessorCount, dev) != hipSuccess) { grid = -1; return; }
        if (hipFuncSetAttribute((const void*)mk_fwd, hipFuncAttributeMaxDynamicSharedMemorySize, LDS_BYTES) != hipSuccess) { fprintf(stderr, "kernel_launch: hipFuncSetAttribute(%d B LDS) failed\n", LDS_BYTES); grid = -1; return; }
        if (hipOccupancyMaxActiveBlocksPerMultiprocessor(&per_cu, (const void*)mk_fwd, NWAVES * 64, LDS_BYTES) != hipSuccess || per_cu < 1) fprintf(stderr, "kernel_launch: occupancy query says %d\n", per_cu);
        (void)hipGetLastError();
        grid = cus;
        if (grid != 256) fprintf(stderr, "kernel_launch: %d CUs (built for 256)\n", grid);
    }
    if (grid < 0) return;
    (void)hipMemsetAsync((char*)d_ws + WS_CTL, 0, CTL_ZERO_BYTES, stream);
    Args a{};
    for (int i = 0; i < 18; ++i) a.in[i] = (const float*)d_in[i];
    a.out = (float*)d_out; a.ws = (unsigned char*)d_ws;
    for (int li = 0; li < N_LAUNCHES; ++li) {
        a.ph_lo = (N_LAUNCHES == 1) ? 0 : li; a.ph_hi = (N_LAUNCHES == 1) ? NPH : li + 1;
        hipLaunchKernelGGL(mk_fwd, dim3(grid), dim3(NWAVES * 64), LDS_BYTES, stream, a);
    }
}
```

```cpp
#include <hip/hip_runtime.h>
#include <cstdio>
#include <cstdint>

#ifndef MK_N_LAUNCHES
#define MK_N_LAUNCHES 1
#endif

#define LAS __attribute__((address_space(3)))
#define GAS __attribute__((address_space(1)))
typedef unsigned short bf16;
typedef short bf16x8 __attribute__((ext_vector_type(8)));
typedef float f32x4 __attribute__((ext_vector_type(4)));
typedef float f32x2 __attribute__((ext_vector_type(2)));
typedef float f32x16 __attribute__((ext_vector_type(16)));
typedef unsigned u32x4 __attribute__((ext_vector_type(4)));
typedef unsigned u32x2 __attribute__((ext_vector_type(2)));
typedef __bf16 bf16x2_t __attribute__((ext_vector_type(2)));

constexpr int NWAVES = 8;
constexpr int M = 16384, D = 1024, SEQ = 2048;
constexpr int NZS = 8208;
constexpr int NZ = 8192;
constexpr int NE = 32, CAP = 16384;
constexpr int NPH = 11;
constexpr int N_LAUNCHES = MK_N_LAUNCHES;
constexpr size_t ZQ = 0, ZK = ZQ + (size_t)4 * M * 128, ZV = ZK + (size_t)4 * M * 128, ZR = ZV + (size_t)4 * M * 256, ZCB = ZR + (size_t)4 * M * 256, ZCC = ZCB + (size_t)M * 1024, ZCX = ZCC + (size_t)M * 1024, ZGA = ZCX + (size_t)M * 1024, ZGB = ZGA + (size_t)M * 1024;

constexpr size_t MiB = 1u << 20;
constexpr size_t WS_CTL = 0, CTL_ZERO_BYTES = 65536;
constexpr size_t WS_LIST = 1 * MiB;
constexpr size_t WS_GATE = 3 * MiB;
constexpr size_t WS_DECS = 4 * MiB;
constexpr size_t WS_WIN = 16 * MiB;
constexpr size_t WS_WA = 32 * MiB, WS_WB = 34 * MiB, WS_WO = 36 * MiB;
constexpr size_t WS_WGU = 40 * MiB;
constexpr size_t WS_WD = 168 * MiB;
constexpr size_t WS_XN = 232 * MiB;
constexpr size_t WS_LA = 264 * MiB;
constexpr size_t WS_Z = 296 * MiB;
constexpr size_t WS_YP = WS_Z;
constexpr size_t WS_U = 552 * MiB;
constexpr size_t WS_SIN = 584 * MiB;
constexpr size_t WS_OG = 616 * MiB;
constexpr size_t WS_PB = 648 * MiB;
constexpr size_t WS_M1 = 680 * MiB;
constexpr size_t WS_MIX = 744 * MiB;
constexpr size_t WS_X1 = 776 * MiB;
constexpr size_t WS_ACT = 840 * MiB;
constexpr size_t WS_END = 984 * MiB;
constexpr int CW_TMO = 0;
constexpr int CW_BAR = 4096;
constexpr int CW_CNT = 8192;
constexpr int CW_STAMP = 12288;

constexpr int RING_BYTES = 131072;
constexpr int EXTRA_OFF = RING_BYTES;
constexpr int LDS_BYTES = 155648 + 512;
constexpr int MISC_OFF = 155648;

#define RLX_AGENT __ATOMIC_RELAXED, __HIP_MEMORY_SCOPE_AGENT
#define LDS_WAIT() asm volatile("s_waitcnt lgkmcnt(0)" ::: "memory")
#define VM_WAIT() asm volatile("s_waitcnt vmcnt(0)" ::: "memory")
__device__ __forceinline__ unsigned pk2(float lo, float hi) { f32x2 v = {lo, hi}; bf16x2_t b = __builtin_convertvector(v, bf16x2_t); return __builtin_bit_cast(unsigned, b); }
__device__ __forceinline__ float bf_lo(unsigned w) { return __builtin_bit_cast(float, w << 16); }
__device__ __forceinline__ float bf_hi(unsigned w) { return __builtin_bit_cast(float, w & 0xffff0000u); }
__device__ __forceinline__ float bf1(bf16 b) { return __builtin_bit_cast(float, ((unsigned)b) << 16); }
__device__ __forceinline__ float fast_sigmoid(float x) { return __builtin_amdgcn_rcpf(1.0f + __expf(-x)); }
__device__ __forceinline__ float wave_sum(float v) {
#pragma unroll
    for (int o = 1; o < 64; o <<= 1) v += __shfl_xor(v, o);
    return v;
}

namespace pg8 {
constexpr int BM = 256, BK = 64, HALF = 128, HTB = HALF * BK * 2, STAGE_BYTES = 8 * HTB, NXCD = 8, WGM = 8;
__device__ __forceinline__ int lds_byte(int r, int c) { const int st = (r >> 4) * 2 + (c >> 5), rr = r & 15, cc = c & 31, ob = rr * 64 + cc * 2; return st * 1024 + (ob ^ (((ob >> 9) & 1) << 5)); }
__device__ __forceinline__ void stage_rc(int b, int& R, int& C) { const int st = b / 1024, sb = b % 1024, swz = sb ^ (((sb >> 9) & 1) << 5); R = (st >> 1) * 16 + swz / 64; C = (st & 1) * 32 + (swz % 64) / 2; }
__device__ __forceinline__ int perm32(int rho) { const int n = rho >> 4, i = rho & 15; return 8 * (i >> 2) + 4 * n + (i & 3); }

struct Unit { int pm, pn, e, rt; };

struct StaticOrder {
    int nM, nN, nwg, G, c, K, reps;
    __device__ __forceinline__ void init(int M_, int N_, int K_, int G_, int c_, int reps_) { nM = M_ / BM; nN = N_ / BM; nwg = nM * nN; G = G_; c = c_; K = K_; reps = reps_; }
    __device__ __forceinline__ bool next(int i, Unit& u) const {
        const long L = (long)i * G + c; if (L >= (long)nwg * reps) return false;
        int wgid = (int)(L % nwg); { const int q = nwg / NXCD, r = nwg % NXCD, xcd = wgid % NXCD, off = wgid / NXCD; wgid = (xcd < r ? xcd * (q + 1) : r * (q + 1) + (xcd - r) * q) + off; }
        const int nig = WGM * nN, gid = wgid / nig, fm = gid * WGM, gsz = (nM - fm) < WGM ? (nM - fm) : WGM;
        u.pm = fm + ((wgid % nig) % gsz); u.pn = (wgid % nig) / gsz; u.e = 0; u.rt = 0; return true;
    }
    __device__ __forceinline__ unsigned arow(const Unit& u, int ui, int r) const { return (unsigned)(u.pm * BM + r) * (unsigned)(K * 2); }
};

template <class Epi, class Sched, bool ALIGN_EPI>
__device__ __forceinline__ void gemm_phase(LAS unsigned char* lds, const bf16* Ag, const bf16* Btg, const int K, const Sched& S, const Epi& E) {
    const int tid = threadIdx.x, wid = __builtin_amdgcn_readfirstlane(tid >> 6), lane = tid & 63, wr = wid >> 2, wc = wid & 3, fr = lane & 15, fq = lane >> 4;
    const int nt = K / BK;
    int RA[2], CA[2]; unsigned voffB[2];
#pragma unroll
    for (int i = 0; i < 2; ++i) { int R, C; stage_rc(tid * 16 + i * 8192, R, C); const int Rb = Epi::PERM ? ((R & ~31) + perm32(R & 31)) : R;
        RA[i] = R; CA[i] = C * 2; voffB[i] = (unsigned)(Rb * K + C) * 2u; }
    const size_t kstep = (size_t)(BK * 2);
    const size_t hstep = (size_t)HALF * K * 2;
    const size_t tstep = 2 * hstep;
    const unsigned ldsw = (unsigned)wid * 1024u;
    const int aoff = lds_byte(wr * 64 + fr, fq * 8), boff = lds_byte(wc * 32 + fr, fq * 8);
#define PG8_SA(b, h) (((b) * 2 + (h)) * HTB)
#define PG8_SB(b, h) ((4 + (b) * 2 + (h)) * HTB)
#define PG8_STAGEB(bufoff, gbase) do { _Pragma("unroll") for (int _i = 0; _i < 2; ++_i) \
        __builtin_amdgcn_global_load_lds((const unsigned*)((const char*)(gbase) + voffB[_i]), (LAS unsigned*)(lds + (bufoff) + ldsw + _i * 8192), 16, 0, 0); } while (0)
#define PG8_STAGEA(bufoff, o0, o1) do { \
        __builtin_amdgcn_global_load_lds((const unsigned*)((const char*)Ag + (o0)), (LAS unsigned*)(lds + (bufoff) + ldsw), 16, 0, 0); \
        __builtin_amdgcn_global_load_lds((const unsigned*)((const char*)Ag + (o1)), (LAS unsigned*)(lds + (bufoff) + ldsw + 8192), 16, 0, 0); } while (0)
#define PG8_LDA(dst, b, h) do { _Pragma("unroll") for (int m = 0; m < 4; ++m) _Pragma("unroll") for (int k = 0; k < 2; ++k) dst[m][k] = *(const LAS bf16x8*)(lds + PG8_SA(b, h) + aoff + m * 2048 + k * 1024); } while (0)
#define PG8_LDB(dst, b, h) do { _Pragma("unroll") for (int n = 0; n < 2; ++n) _Pragma("unroll") for (int k = 0; k < 2; ++k) dst[n][k] = *(const LAS bf16x8*)(lds + PG8_SB(b, h) + boff + n * 2048 + k * 1024); } while (0)
#define PG8_MMA(ai, bj, At, Bt) do { __builtin_amdgcn_s_setprio(1); _Pragma("unroll") for (int m = 0; m < 4; ++m) _Pragma("unroll") for (int n = 0; n < 2; ++n) _Pragma("unroll") for (int k = 0; k < 2; ++k) \
        acc[ai][bj][m][n] = __builtin_amdgcn_mfma_f32_16x16x32_bf16(Bt[n][k], At[m][k], acc[ai][bj][m][n], 0, 0, 0); __builtin_amdgcn_s_setprio(0); } while (0)
#define PG8_WAIT_V(n) asm volatile("s_waitcnt vmcnt(" #n ")" ::: "memory")
#define PG8_WAIT_L(n) asm volatile("s_waitcnt lgkmcnt(" #n ")" ::: "memory")
#define PG8_BAR __builtin_amdgcn_s_barrier()
#define PG8_SCHED __builtin_amdgcn_sched_barrier(0)
    Unit cur, nxt; int ui = 0;
    if (!S.next(0, cur)) return;
    f32x4 acc[2][2][4][2];
#pragma unroll
    for (int a = 0; a < 2; ++a)
#pragma unroll
        for (int b = 0; b < 2; ++b)
#pragma unroll
            for (int m = 0; m < 4; ++m)
#pragma unroll
                for (int n = 0; n < 2; ++n) acc[a][b][m][n] = (f32x4){0.f, 0.f, 0.f, 0.f};
    bf16x8 At[4][2], B0[2][2], B1[2][2];
    unsigned ac00, ac01, ac10, ac11, an00, an01, an10, an11;
    ac00 = S.arow(cur, 0, RA[0]) + CA[0]; ac01 = S.arow(cur, 0, RA[1]) + CA[1]; ac10 = S.arow(cur, 0, HALF + RA[0]) + CA[0]; ac11 = S.arow(cur, 0, HALF + RA[1]) + CA[1];
    const char* cB = (const char*)Btg + (size_t)cur.pn * tstep;
    PG8_STAGEB(PG8_SB(0, 0), cB); PG8_STAGEB(PG8_SB(0, 1), cB + hstep); PG8_STAGEA(PG8_SA(0, 0), ac00, ac01); PG8_STAGEA(PG8_SA(0, 1), ac10, ac11);
    if (wr == 1) PG8_BAR;
    PG8_WAIT_V(2); PG8_BAR;
    PG8_STAGEB(PG8_SB(1, 0), cB + kstep); PG8_STAGEA(PG8_SA(1, 0), ac00 + 128u, ac01 + 128u); PG8_STAGEB(PG8_SB(1, 1), cB + hstep + kstep);
    PG8_WAIT_V(6); PG8_BAR;
    for (;;) {
        const bool has_next = S.next(ui + 1, nxt);
        if (has_next) { an00 = S.arow(nxt, ui + 1, RA[0]) + CA[0]; an01 = S.arow(nxt, ui + 1, RA[1]) + CA[1]; an10 = S.arow(nxt, ui + 1, HALF + RA[0]) + CA[0]; an11 = S.arow(nxt, ui + 1, HALF + RA[1]) + CA[1]; }
        else { an00 = ac00; an01 = ac01; an10 = ac10; an11 = ac11; }
        const char* nB = has_next ? (const char*)Btg + (size_t)nxt.pn * tstep : cB;
        for (int t = 0; t < nt; t += 2) {
            const bool last = (t == nt - 2);
            const unsigned k1 = (unsigned)(t + 1) * 128u, k2 = (unsigned)(t + 2) * 128u;
            const unsigned a200 = last ? an00 : ac00 + k2, a201 = last ? an01 : ac01 + k2, a210 = last ? an10 : ac10 + k2, a211 = last ? an11 : ac11 + k2;
            const char* b2 = last ? nB : cB + (size_t)k2; const char* b3 = b2 + kstep;
            PG8_LDB(B0, 0, 0); PG8_LDB(B1, 0, 1); PG8_SCHED; PG8_LDA(At, 0, 0); PG8_STAGEA(PG8_SA(1, 1), ac10 + k1, ac11 + k1);
            PG8_WAIT_V(8); PG8_WAIT_L(0); PG8_BAR; PG8_MMA(0, 0, At, B0); PG8_MMA(0, 1, At, B1); PG8_BAR; PG8_SCHED;
            PG8_LDA(At, 0, 1); PG8_STAGEB(PG8_SB(0, 0), b2); PG8_STAGEB(PG8_SB(0, 1), b2 + hstep); PG8_STAGEA(PG8_SA(0, 0), a200, a201);
            PG8_WAIT_V(8); PG8_WAIT_L(0); PG8_BAR; PG8_MMA(1, 0, At, B0); PG8_MMA(1, 1, At, B1); PG8_BAR; PG8_SCHED;
            PG8_LDB(B0, 1, 0); PG8_LDB(B1, 1, 1); PG8_SCHED; PG8_LDA(At, 1, 0); PG8_STAGEA(PG8_SA(0, 1), a210, a211);
            PG8_WAIT_V(8); PG8_WAIT_L(0); PG8_BAR; PG8_MMA(0, 0, At, B0); PG8_MMA(0, 1, At, B1); PG8_BAR; PG8_SCHED;
            PG8_LDA(At, 1, 1); PG8_STAGEB(PG8_SB(1, 0), b3); PG8_STAGEB(PG8_SB(1, 1), b3 + hstep); PG8_STAGEA(PG8_SA(1, 0), a200 + 128u, a201 + 128u);
            PG8_WAIT_V(8); PG8_WAIT_L(0); PG8_BAR; PG8_MMA(1, 0, At, B0); PG8_MMA(1, 1, At, B1); PG8_BAR; PG8_SCHED;
        }
        if constexpr (ALIGN_EPI) { if (wr == 0) PG8_BAR; }
        E(acc, cur, wr, wc, fr, fq);
        if (!has_next) break;
#pragma unroll
        for (int a = 0; a < 2; ++a)
#pragma unroll
            for (int b = 0; b < 2; ++b)
#pragma unroll
                for (int m = 0; m < 4; ++m)
#pragma unroll
                    for (int n = 0; n < 2; ++n) acc[a][b][m][n] = (f32x4){0.f, 0.f, 0.f, 0.f};
        cur = nxt; cB = nB; ac00 = an00; ac01 = an01; ac10 = an10; ac11 = an11; ++ui;
        if constexpr (ALIGN_EPI) { if (wr == 1) PG8_BAR; }
    }
    PG8_WAIT_V(0);
    if constexpr (!ALIGN_EPI) { if (wr == 0) PG8_BAR; }
    PG8_BAR;
#undef PG8_SA
#undef PG8_SB
#undef PG8_STAGEA
#undef PG8_STAGEB
#undef PG8_LDA
#undef PG8_LDB
#undef PG8_MMA
#undef PG8_WAIT_V
#undef PG8_WAIT_L
#undef PG8_BAR
#undef PG8_SCHED
}
}

#define XB_TMO      128
#define XB_XCNT(j)  (256  + 64 * (j))
#define XB_XSUB(j)  (1280 + 64 * (j))
#define XB_XGEN(j)  (2304 + 64 * (j))
#define XB_TOP      3328
#define XB_TOPGEN   3392
#define XCD_BAR_WORDS 3456
#define XB_SPIN_CAP (1u << 18)
__device__ __forceinline__ unsigned xb_ld(unsigned* p)              { return __hip_atomic_load(p, __ATOMIC_RELAXED, __HIP_MEMORY_SCOPE_AGENT); }
__device__ __forceinline__ unsigned xb_add(unsigned* p, unsigned v) { return __hip_atomic_fetch_add(p, v, __ATOMIC_RELAXED, __HIP_MEMORY_SCOPE_AGENT); }
__device__ __forceinline__ unsigned xb_xcc_id() { return (unsigned)__builtin_amdgcn_s_getreg((3 << 11) | 20) & 0xFu; }
#define XB_SPIN(cond, bar) do { unsigned _sp = 0; while (cond) { __builtin_amdgcn_s_sleep(1); \
    if ((++_sp & 255u) == 0u) { if (xb_ld(&(bar)[XB_TMO])) break; if (_sp > XB_SPIN_CAP) { atomicAdd(&(bar)[XB_TMO], 1u); break; } } } } while (0)
struct XcdBarrier { unsigned* bar; unsigned x; volatile LAS unsigned* st; };
__device__ __forceinline__ XcdBarrier xcd_barrier_post(unsigned* bar, volatile LAS unsigned* st) {
    XcdBarrier b; b.bar = bar; b.x = xb_xcc_id(); b.st = st;
    if (threadIdx.x == 0) (void)xb_add(&bar[XB_XCNT(b.x)], 1u);
    return b;
}
__device__ __forceinline__ void xcd_barrier_complete(unsigned* bar, unsigned x, unsigned& nloc, unsigned& nx) {
    const unsigned G = gridDim.x * gridDim.y * gridDim.z;
    unsigned sum, cnt, mine, sp = 0u;
    for (;;) {
        sum = 0u; cnt = 0u; mine = 0u;
#pragma unroll
        for (unsigned j = 0; j < 16; ++j) { const unsigned c = xb_ld(&bar[XB_XCNT(j)]); sum += c; cnt += (c > 0u) ? 1u : 0u; mine = (j == x) ? c : mine; }
        if (sum == G) break;
        __builtin_amdgcn_s_sleep(1);
        if ((++sp & 255u) == 0u) { if (xb_ld(&bar[XB_TMO])) break; if (sp > XB_SPIN_CAP) { atomicAdd(&bar[XB_TMO], 1u); break; } }
    }
    nloc = mine > 0u ? mine : 1u; nx = cnt > 0u ? cnt : 1u;
}
__device__ __forceinline__ void xcd_barrier(const XcdBarrier& b) {
    asm volatile("s_waitcnt vmcnt(0)" ::: "memory");
    __syncthreads();
    if (threadIdx.x == 0) {
        unsigned* bar = b.bar;
        __builtin_amdgcn_s_waitcnt(0);
        unsigned nloc = b.st[0], nx = b.st[1];
        if (nloc == 0u) { xcd_barrier_complete(bar, b.x, nloc, nx); b.st[0] = nloc; b.st[1] = nx; }
        const unsigned old = xb_add(&bar[XB_XSUB(b.x)], 1u);
        const unsigned gen = old / nloc;
        if (old + 1u == (gen + 1u) * nloc) {
            __builtin_amdgcn_fence(__ATOMIC_RELEASE, "agent");
            asm volatile("s_waitcnt vmcnt(0)" ::: "memory");
            const unsigned og = xb_add(&bar[XB_TOP], 1u);
            const unsigned tg = og / nx;
            if (og + 1u == (tg + 1u) * nx) xb_add(&bar[XB_TOPGEN], 1u);
            else XB_SPIN(xb_ld(&bar[XB_TOPGEN]) == tg, bar);
            __builtin_amdgcn_fence(__ATOMIC_ACQUIRE, "agent");
            xb_add(&bar[XB_XGEN(b.x)], 1u);
            asm volatile("s_waitcnt vmcnt(0)" ::: "memory");
        } else {
            XB_SPIN(xb_ld(&bar[XB_XGEN(b.x)]) == gen, bar);
            __builtin_amdgcn_fence(__ATOMIC_ACQUIRE, "agent");
            asm volatile("s_waitcnt vmcnt(0)" ::: "memory");
        }
    }
    __syncthreads();
}

struct Frame {
    LAS unsigned char* lds;
    volatile LAS unsigned* MISC;
    unsigned* ctl;
    int tid, lane, wave, vcu, G;
    unsigned char* ws;
    const float *x, *g_mix, *w_in, *w_up, *b_alpha, *g_gla, *w_conv, *w_a, *w_b, *w_out, *g_ffn, *w_router, *b_router, *w_gu, *b_gu, *w_d, *b_d, *g_final;
    float* out;
};
#define WSP(T, off) ((T*)(F.ws + (off)))

__device__ __forceinline__ void tr_item64(const float* W, int ld, int k0, int n0, bf16* WT, size_t dst_row0, int K, LAS unsigned* T, int lane) {
    const int nq = lane & 15, kr = lane >> 4;
    const float* src = W + (size_t)(k0 + 2 * kr) * ld + n0 + 4 * nq;
    f32x4 a0[8], a1[8];
#pragma unroll
    for (int it = 0; it < 8; ++it) { a0[it] = *(const f32x4*)(src + (size_t)(8 * it) * ld); a1[it] = *(const f32x4*)(src + (size_t)(8 * it + 1) * ld); }
    const int c = lane & 7;
#pragma unroll
    for (int hf = 0; hf < 2; ++hf) {
        if ((nq >> 3) == hf) {
#pragma unroll
            for (int it = 0; it < 8; ++it)
#pragma unroll
                for (int q = 0; q < 4; ++q) T[(4 * (nq & 7) + q) * 33 + 4 * it + kr] = pk2(a0[it][q], a1[it][q]);
        }
        LDS_WAIT(); asm volatile("" ::: "memory");
#pragma unroll
        for (int j = 0; j < 4; ++j) { const int n = (lane >> 3) + 8 * j; const LAS unsigned* t = T + n * 33 + 4 * c;
            u32x4 o; o.x = t[0]; o.y = t[1]; o.z = t[2]; o.w = t[3];
            *(u32x4*)(WT + (dst_row0 + 32 * hf + n) * (size_t)K + k0 + 8 * c) = o; }
        LDS_WAIT(); asm volatile("" ::: "memory");
    }
}

constexpr int P0_T_BYTES = 4352;
constexpr int P0_WL = 8 * P0_T_BYTES;
constexpr int P0_WU = P0_WL + 65536;
constexpr int P0_BA = P0_WU + 32768;

__device__ __forceinline__ void p0_items(Frame& F, const int nrep) {
    LAS unsigned* scr = (LAS unsigned*)(F.lds + F.wave * P0_T_BYTES);
    const int gw = F.vcu * NWAVES + F.wave, NGW = F.G * NWAVES;
    constexpr int I_IN = 128 * 16, I_SQ = 16 * 16, I_GU = NE * 32 * 16, I_D = NE * 16 * 16;
    constexpr int NITEMS = I_IN + 3 * I_SQ + I_GU + I_D;
    bf16* Win_t = WSP(bf16, WS_WIN);
    for (int it0 = gw; it0 < NITEMS * nrep; it0 += NGW) {
        int r = it0 % NITEMS;
        if (r < I_IN) { const int kb = r >> 7, nb = r & 127, j0 = 64 * nb; tr_item64(F.w_in, NZS, 64 * kb, j0 < 3072 ? j0 : j0 + 16, Win_t, j0, 1024, scr, F.lane); continue; } r -= I_IN;
        if (r < I_SQ) { tr_item64(F.w_a, 1024, 64 * (r >> 4), 64 * (r & 15), WSP(bf16, WS_WA), 64 * (r & 15), 1024, scr, F.lane); continue; } r -= I_SQ;
        if (r < I_SQ) { tr_item64(F.w_b, 1024, 64 * (r >> 4), 64 * (r & 15), WSP(bf16, WS_WB), 64 * (r & 15), 1024, scr, F.lane); continue; } r -= I_SQ;
        if (r < I_SQ) { tr_item64(F.w_out, 1024, 64 * (r >> 4), 64 * (r & 15), WSP(bf16, WS_WO), 64 * (r & 15), 1024, scr, F.lane); continue; } r -= I_SQ;
        if (r < I_GU) { const int e = r >> 9, q = r & 511, kb = q >> 5, nb = q & 31, j0 = 64 * nb, pn = j0 >> 8, within = j0 & 255, half = within >> 7;
            tr_item64(F.w_gu + (size_t)e * 1024 * 2048, 2048, 64 * kb, half * 1024 + pn * 128 + (within & 127), WSP(bf16, WS_WGU) + (size_t)e * 2048 * 1024, j0, 1024, scr, F.lane); continue; } r -= I_GU;
        { const int e = r >> 8, q = r & 255, kb = q >> 4, nb = q & 15;
            tr_item64(F.w_d + (size_t)e * 1024 * 1024, 1024, 64 * kb, 64 * nb, WSP(bf16, WS_WD) + (size_t)e * 1024 * 1024, 64 * nb, 1024, scr, F.lane); }
    }
}

__device__ __forceinline__ void p0_rows(Frame& F, const int nrep2) {
    const int gw = F.vcu * NWAVES + F.wave, NGW = F.G * NWAVES;
    LAS float* Wl = (LAS float*)(F.lds + P0_WL);
    LAS float* WU = (LAS float*)(F.lds + P0_WU);
    LAS float* BA = (LAS float*)(F.lds + P0_BA);
    f32x4 g[4];
#pragma unroll
    for (int j = 0; j < 4; ++j) g[j] = *((const f32x4*)F.g_mix + F.lane + 64 * j);
    bf16* XN = WSP(bf16, WS_XN); float* LA = WSP(float, WS_LA);
    for (int m0 = gw; m0 < M * nrep2; m0 += NGW) {
        const int m = m0 % M;
        const f32x4* xr = (const f32x4*)(F.x + (size_t)m * D) + F.lane;
        f32x4 v[4]; float s = 0.f;
#pragma unroll
        for (int j = 0; j < 4; ++j) { v[j] = xr[64 * j]; s += (v[j].x * v[j].x + v[j].y * v[j].y) + (v[j].z * v[j].z + v[j].w * v[j].w); }
        const float rstd = 1.0f / sqrtf(wave_sum(s) * (1.f / D) + 1e-6f);
        unsigned long long* o8 = (unsigned long long*)(XN + (size_t)m * D) + F.lane;
#pragma unroll
        for (int j = 0; j < 4; ++j) { v[j] = v[j] * rstd * g[j]; o8[64 * j] = (unsigned long long)pk2(v[j].x, v[j].y) | ((unsigned long long)pk2(v[j].z, v[j].w) << 32); }
        float a[16];
#pragma unroll
        for (int r4 = 0; r4 < 4; ++r4) {
#pragma unroll
            for (int rr = 0; rr < 4; ++rr) { const int r = 4 * r4 + rr; float t = 0.f;
#pragma unroll
                for (int j = 0; j < 4; ++j) { const f32x4 w = *(const LAS f32x4*)(Wl + r * 1024 + 256 * j + 4 * F.lane); t += (v[j].x * w.x + v[j].y * w.y) + (v[j].z * w.z + v[j].w * w.w); }
                a[r] = t; }
            asm volatile("" ::: "memory");
        }
#pragma unroll
        for (int q = 0; q < 8; ++q) { const bool up = (F.lane & 32) != 0; const float send = up ? a[q] : a[q + 8]; const float keep = up ? a[q + 8] : a[q]; a[q] = keep + __shfl_xor(send, 32); }
#pragma unroll
        for (int q = 0; q < 4; ++q) { const bool up = (F.lane & 16) != 0; const float send = up ? a[q] : a[q + 4]; const float keep = up ? a[q + 4] : a[q]; a[q] = keep + __shfl_xor(send, 16); }
#pragma unroll
        for (int q = 0; q < 2; ++q) { const bool up = (F.lane & 8) != 0; const float send = up ? a[q] : a[q + 2]; const float keep = up ? a[q + 2] : a[q]; a[q] = keep + __shfl_xor(send, 8); }
        { const bool up = (F.lane & 4) != 0; const float send = up ? a[0] : a[1]; const float keep = up ? a[1] : a[0]; a[0] = keep + __shfl_xor(send, 4); }
        float alv = a[0]; alv += __shfl_xor(alv, 2); alv += __shfl_xor(alv, 1);
        float al[16];
#pragma unroll
        for (int r = 0; r < 16; ++r) al[r] = __builtin_bit_cast(float, __builtin_amdgcn_readlane(__builtin_bit_cast(int, alv), 4 * r));
#pragma unroll
        for (int i = 0; i < 8; ++i) { const int j = F.lane + 64 * i; float pre = BA[j];
#pragma unroll
            for (int r = 0; r < 16; ++r) pre += al[r] * WU[r * 512 + j];
            const float ls = fminf(pre, 0.f) - __logf(1.0f + __expf(-fabsf(pre)));
            LA[(size_t)m * 512 + j] = ls * (1.0f / 16.0f);
            if (i & 1) asm volatile("" ::: "memory"); }
    }
}

__device__ __forceinline__ void p0_prologue(Frame& F, const int nrep, const int nrep2) {
    {
        LAS float* Wl = (LAS float*)(F.lds + P0_WL); LAS float* WU = (LAS float*)(F.lds + P0_WU); LAS float* BA = (LAS float*)(F.lds + P0_BA);
        for (int i = 0; i < 32; ++i) { const int idx = F.tid + 512 * i, k = idx >> 4, r = idx & 15; Wl[r * 1024 + k] = F.w_in[(size_t)k * NZS + 3072 + r]; }
        for (int i = 0; i < 16; ++i) { const int idx = F.tid + 512 * i; WU[idx] = F.w_up[idx]; }
        BA[F.tid] = F.b_alpha[F.tid];
        __syncthreads();
    }
#pragma unroll 1
    for (int pass = 0; pass < 2; ++pass) {
        if (((pass ^ F.wave) & 1) == 0) p0_items(F, nrep); else p0_rows(F, nrep2);
    }
}

struct EpiZ {
    static constexpr bool PERM = true;
    bf16* Z;
    __device__ __forceinline__ void operator()(const f32x4 (&acc)[2][2][4][2], const pg8::Unit& u, int wr, int wc, int fr, int fq) const {
        const int row0 = u.pm * 256 + wr * 64 + fr, c0 = wc * 32 + 8 * fq;
        const int pn = u.pn;
        const int kind = pn < 2 ? 1 : (pn < 8 ? 0 : (pn < 12 ? 2 : (pn < 24 ? 0 : 3)));
        bf16* base; int ld; size_t bjs;
        if (pn < 4) { base = Z + (pn < 2 ? ZQ : ZK) + (size_t)(2 * (pn & 1)) * M * 128; ld = 128; bjs = (size_t)M * 128; }
        else if (pn < 12) { base = Z + (pn < 8 ? ZV : ZR) + (size_t)(pn & 3) * M * 256; ld = 256; bjs = 128; }
        else { const int t = (pn - 12) >> 2; base = Z + ZCB + (size_t)t * M * 1024 + (size_t)((pn - 12) & 3) * 256; ld = 1024; bjs = 128; }
#pragma unroll
        for (int ai = 0; ai < 2; ++ai)
#pragma unroll
            for (int m = 0; m < 4; ++m) { bf16* rowp = base + (size_t)(row0 + ai * 128 + m * 16) * ld + c0;
#pragma unroll
                for (int bj = 0; bj < 2; ++bj) { f32x4 v0 = acc[ai][bj][m][0], v1 = acc[ai][bj][m][1];
                    if (kind == 1) { v0 = v0 * 0.08838834764831845f; v1 = v1 * 0.08838834764831845f; }
                    else if (kind == 2) {
#pragma unroll
                        for (int j = 0; j < 4; ++j) { v0[j] = v0[j] * fast_sigmoid(v0[j]); v1[j] = v1[j] * fast_sigmoid(v1[j]); } }
                    else if (kind == 3) {
#pragma unroll
                        for (int j = 0; j < 4; ++j) { v0[j] = fast_sigmoid(v0[j]); v1[j] = fast_sigmoid(v1[j]); } }
                    u32x4 w; w.x = pk2(v0[0], v0[1]); w.y = pk2(v0[2], v0[3]); w.z = pk2(v1[0], v1[1]); w.w = pk2(v1[2], v1[3]);
                    *(u32x4*)(rowp + bj * bjs) = w; } }
    }
};

constexpr int QD_STRIDE = 272, KT_STRIDE = 144, SC_STRIDE = 144, OT_STRIDE = 1040;
constexpr int L_QD = 0, L_KI = 17408, L_KT = 34816, L_SC = 53248, L_DEC = 62464, L_SEG = 62976, L_OT = 65536;
__device__ __forceinline__ int crow(int reg, int h) { return (reg & 3) + 8 * (reg >> 2) + 4 * h; }

template <bool OUT>
__device__ __forceinline__ void gla_item(Frame& F, int item) {
    const int bh = item >> 3, sc = item & 7, b = bh >> 2, hd = bh & 3;
    const int t0 = b * SEQ + sc * 256;
    const int tid = F.tid, lane = F.lane, w = F.wave, r32 = lane & 31, h = lane >> 5;
    const bf16* Z = WSP(const bf16, WS_Z);
    const float* LA = WSP(const float, WS_LA);
    LAS unsigned char* L = F.lds;
    f32x16 S[4];
    float* Sbuf = (OUT ? WSP(float, WS_SIN) : WSP(float, WS_U)) + (size_t)item * 32768 + (size_t)w * 4096;
    if (OUT) {
#pragma unroll
        for (int kb = 0; kb < 4; ++kb)
#pragma unroll
            for (int r = 0; r < 16; ++r) S[kb][r] = Sbuf[(kb * 16 + r) * 64 + lane];
    } else {
#pragma unroll
        for (int kb = 0; kb < 4; ++kb)
#pragma unroll
            for (int r = 0; r < 16; ++r) S[kb][r] = 0.f;
    }
    const int d = tid & 127, seg = tid >> 7;
    float btot_run = 0.f;
    for (int c = 0; c < 4; ++c) {
        const int tc = t0 + c * 64;
        float la[16], p[16];
#pragma unroll
        for (int i = 0; i < 16; ++i) la[i] = LA[(size_t)(tc + 16 * seg + i) * 512 + hd * 128 + d];
        bf16 qv[16], kv[16];
#pragma unroll
        for (int i = 0; i < 16; ++i) { const size_t zo = ((size_t)hd * M + tc + 16 * seg + i) * 128 + d; kv[i] = Z[ZK + zo]; if (OUT) qv[i] = Z[ZQ + zo]; }
        bf16x8 Bv[4];
#pragma unroll
        for (int ks = 0; ks < 4; ++ks)
#pragma unroll
            for (int j = 0; j < 8; ++j) Bv[ks][j] = (short)Z[ZV + ((size_t)hd * M + tc + 16 * ks + 8 * h + j) * 256 + 32 * w + r32];
        float run = 0.f;
#pragma unroll
        for (int i = 0; i < 16; ++i) { run += la[i]; p[i] = run; }
        LAS float* SEG = (LAS float*)(L + L_SEG);
        SEG[seg * 128 + d] = run;
        __syncthreads();
        const float s0 = SEG[d], s1 = SEG[128 + d], s2 = SEG[256 + d], s3 = SEG[384 + d];
        const float offs = seg == 0 ? 0.f : (seg == 1 ? s0 : (seg == 2 ? s0 + s1 : s0 + s1 + s2));
        const float btot = (s0 + s1) + (s2 + s3);
        if (seg == 0) { ((LAS float*)(L + L_DEC))[d] = __expf(btot); btot_run += btot; }
        {
            unsigned ktp[8];
#pragma unroll
            for (int i = 0; i < 16; i += 2) {
                const float b0 = offs + p[i], b1 = offs + p[i + 1];
                const float k0 = bf1(kv[i]), k1 = bf1(kv[i + 1]);
                ktp[i >> 1] = pk2(k0 * __expf(btot - b0), k1 * __expf(btot - b1));
                if (OUT) {
                    const float q0 = bf1(qv[i]), q1 = bf1(qv[i + 1]);
                    const unsigned qd = pk2(q0 * __expf(b0), q1 * __expf(b1)), ki = pk2(k0 * __expf(-b0), k1 * __expf(-b1));
                    *(LAS bf16*)(L + L_QD + (16 * seg + i) * QD_STRIDE + 2 * d) = (bf16)(qd & 0xffffu); *(LAS bf16*)(L + L_QD + (16 * seg + i + 1) * QD_STRIDE + 2 * d) = (bf16)(qd >> 16);
                    *(LAS bf16*)(L + L_KI + (16 * seg + i) * QD_STRIDE + 2 * d) = (bf16)(ki & 0xffffu); *(LAS bf16*)(L + L_KI + (16 * seg + i + 1) * QD_STRIDE + 2 * d) = (bf16)(ki >> 16);
                }
            }
            *(LAS u32x4*)(L + L_KT + d * KT_STRIDE + 32 * seg) = (u32x4){ktp[0], ktp[1], ktp[2], ktp[3]};
            *(LAS u32x4*)(L + L_KT + d * KT_STRIDE + 32 * seg + 16) = (u32x4){ktp[4], ktp[5], ktp[6], ktp[7]};
        }
        __syncthreads();
        f32x16 o[2];
        if (OUT) {
            if (w < 3) {
                const int ib = w == 0 ? 0 : 1, jb = w == 2 ? 1 : 0;
                f32x16 sacc;
#pragma unroll
                for (int r = 0; r < 16; ++r) sacc[r] = 0.f;
#pragma unroll
                for (int kb = 0; kb < 8; ++kb) {
                    const bf16x8 a = *(const LAS bf16x8*)(L + L_QD + (32 * ib + r32) * QD_STRIDE + 2 * (16 * kb + 8 * h));
                    const bf16x8 bb = *(const LAS bf16x8*)(L + L_KI + (32 * jb + r32) * QD_STRIDE + 2 * (16 * kb + 8 * h));
                    sacc = __builtin_amdgcn_mfma_f32_32x32x16_bf16(a, bb, sacc, 0, 0, 0);
                }
#pragma unroll
                for (int r = 0; r < 16; r += 1) {
                    const int i = 32 * ib + crow(r, h), j = 32 * jb + r32;
                    const float v = (j <= i) ? sacc[r] : 0.f;
                    *(LAS bf16*)(L + L_SC + i * SC_STRIDE + 2 * j) = (bf16)(pk2(v, 0.f) & 0xffffu);
                }
            }
#pragma unroll
            for (int ib = 0; ib < 2; ++ib)
#pragma unroll
                for (int r = 0; r < 16; ++r) o[ib][r] = 0.f;
#pragma unroll
            for (int kb = 0; kb < 4; ++kb)
#pragma unroll
                for (int s = 0; s < 2; ++s) {
                    u32x4 pb; pb.x = pk2(S[kb][8 * s + 0], S[kb][8 * s + 1]); pb.y = pk2(S[kb][8 * s + 2], S[kb][8 * s + 3]); pb.z = pk2(S[kb][8 * s + 4], S[kb][8 * s + 5]); pb.w = pk2(S[kb][8 * s + 6], S[kb][8 * s + 7]);
                    const bf16x8 bfrag = __builtin_bit_cast(bf16x8, pb);
#pragma unroll
                    for (int ib = 0; ib < 2; ++ib) {
                        const LAS unsigned char* qp = L + L_QD + (32 * ib + r32) * QD_STRIDE + 2 * (32 * kb + 16 * s + 4 * h);
                        const u32x2 lo = *(const LAS u32x2*)qp, hi = *(const LAS u32x2*)(qp + 16);
                        const bf16x8 afrag = __builtin_bit_cast(bf16x8, (u32x4){lo.x, lo.y, hi.x, hi.y});
                        o[ib] = __builtin_amdgcn_mfma_f32_32x32x16_bf16(afrag, bfrag, o[ib], 0, 0, 0);
                    }
                }
            __syncthreads();
#pragma unroll
            for (int ks = 0; ks < 4; ++ks)
#pragma unroll
                for (int ib = 0; ib < 2; ++ib) {
                    if (ib == 0 && ks >= 2) continue;
                    const bf16x8 a = *(const LAS bf16x8*)(L + L_SC + (32 * ib + r32) * SC_STRIDE + 2 * (16 * ks + 8 * h));
                    o[ib] = __builtin_amdgcn_mfma_f32_32x32x16_bf16(a, Bv[ks], o[ib], 0, 0, 0);
                }
        }
#pragma unroll
        for (int kb = 0; kb < 4; ++kb) {
#pragma unroll
            for (int g4 = 0; g4 < 4; ++g4) { const f32x4 dc = *(const LAS f32x4*)(L + L_DEC + 4 * (32 * kb + 8 * g4 + 4 * h));
#pragma unroll
                for (int j = 0; j < 4; ++j) S[kb][4 * g4 + j] *= dc[j]; }
#pragma unroll
            for (int ks = 0; ks < 4; ++ks) {
                const bf16x8 a = *(const LAS bf16x8*)(L + L_KT + (32 * kb + r32) * KT_STRIDE + 2 * (16 * ks + 8 * h));
                S[kb] = __builtin_amdgcn_mfma_f32_32x32x16_bf16(a, Bv[ks], S[kb], 0, 0, 0);
            }
        }
        if (OUT) {
#pragma unroll
            for (int ib = 0; ib < 2; ++ib)
#pragma unroll
                for (int r = 0; r < 16; ++r) *(LAS float*)(L + L_OT + (32 * ib + crow(r, h)) * OT_STRIDE + 4 * (32 * w + r32)) = o[ib][r];
            __syncthreads();
            const int tok = tid >> 3, part = tid & 7;
            f32x4 ov[8]; float ss = 0.f;
#pragma unroll
            for (int i = 0; i < 8; ++i) { ov[i] = *(const LAS f32x4*)(L + L_OT + tok * OT_STRIDE + 4 * (32 * part + 4 * i)); ss += (ov[i].x * ov[i].x + ov[i].y * ov[i].y) + (ov[i].z * ov[i].z + ov[i].w * ov[i].w); }
            ss += __shfl_xor(ss, 1); ss += __shfl_xor(ss, 2); ss += __shfl_xor(ss, 4);
            const float rs = 1.0f / sqrtf(ss * (1.0f / 256.0f) + 1e-6f);
            const size_t trow = (size_t)(tc + tok);
            const u32x4* rp = (const u32x4*)(Z + ZR + ((size_t)hd * M + trow) * 256 + 32 * part);
            const f32x4* gp = (const f32x4*)(F.g_gla + hd * 256 + 32 * part);
            u32x4* op = (u32x4*)(WSP(bf16, WS_OG) + trow * 1024 + hd * 256 + 32 * part);
#pragma unroll
            for (int i = 0; i < 4; ++i) {
                const u32x4 rr = rp[i]; const f32x4 g0 = gp[2 * i], g1 = gp[2 * i + 1]; const f32x4 a0 = ov[2 * i], a1 = ov[2 * i + 1];
                u32x4 ow;
                ow.x = pk2(a0.x * rs * g0.x * bf_lo(rr.x), a0.y * rs * g0.y * bf_hi(rr.x));
                ow.y = pk2(a0.z * rs * g0.z * bf_lo(rr.y), a0.w * rs * g0.w * bf_hi(rr.y));
                ow.z = pk2(a1.x * rs * g1.x * bf_lo(rr.z), a1.y * rs * g1.y * bf_hi(rr.z));
                ow.w = pk2(a1.z * rs * g1.z * bf_lo(rr.w), a1.w * rs * g1.w * bf_hi(rr.w));
                op[i] = ow;
            }
        }
    }
    if (!OUT) {
#pragma unroll
        for (int kb = 0; kb < 4; ++kb)
#pragma unroll
            for (int r = 0; r < 16; ++r) Sbuf[(kb * 16 + r) * 64 + lane] = S[kb][r];
        if (seg == 0) WSP(float, WS_DECS)[item * 128 + d] = __expf(btot_run);
    }
    __syncthreads();
}

__device__ __forceinline__ void conv_rows(Frame& F, const int nrep) {
    const int gw = F.vcu * NWAVES + F.wave, NGW = F.G * NWAVES;
    const bf16* Z = WSP(const bf16, WS_Z); bf16* PB = WSP(bf16, WS_PB);
    for (int blk0 = gw; blk0 < (M / 8) * nrep; blk0 += NGW) {
        const int blk = blk0 % (M / 8);
        const int m0 = blk * 8, s0 = m0 % SEQ;
#pragma unroll 1
        for (int j = 0; j < 2; ++j) {
            const int c = 8 * F.lane + 512 * j;
            const size_t rp = (size_t)(s0 > 0 ? m0 - 2 : m0);
            const u32x4 p2c = *(const u32x4*)(Z + ZCC + rp * 1024 + c), p2x = *(const u32x4*)(Z + ZCX + rp * 1024 + c);
            const u32x4 p1c = *(const u32x4*)(Z + ZCC + (rp + 1) * 1024 + c), p1x = *(const u32x4*)(Z + ZCX + (rp + 1) * 1024 + c);
            float w0[8], w1[8], w2[8];
#pragma unroll
            for (int i = 0; i < 8; ++i) { w0[i] = F.w_conv[c + i]; w1[i] = F.w_conv[1024 + c + i]; w2[i] = F.w_conv[2048 + c + i]; }
            float u1[8], u2[8];
            const float keep = s0 > 0 ? 1.0f : 0.0f;
#pragma unroll
            for (int i = 0; i < 4; ++i) { u2[2 * i] = keep * bf_lo(p2c[i]) * bf_lo(p2x[i]); u2[2 * i + 1] = keep * bf_hi(p2c[i]) * bf_hi(p2x[i]); u1[2 * i] = keep * bf_lo(p1c[i]) * bf_lo(p1x[i]); u1[2 * i + 1] = keep * bf_hi(p1c[i]) * bf_hi(p1x[i]); }
#pragma unroll
            for (int hb = 0; hb < 2; ++hb) {
                u32x4 cc[4], cx[4], cb[4];
#pragma unroll
                for (int rr = 0; rr < 4; ++rr) { const size_t row = (size_t)(m0 + 4 * hb + rr); cc[rr] = *(const u32x4*)(Z + ZCC + row * 1024 + c); cx[rr] = *(const u32x4*)(Z + ZCX + row * 1024 + c); cb[rr] = *(const u32x4*)(Z + ZCB + row * 1024 + c); }
#pragma unroll
                for (int rr = 0; rr < 4; ++rr) {
                    float u0[8], y[8];
#pragma unroll
                    for (int i = 0; i < 4; ++i) { u0[2 * i] = bf_lo(cc[rr][i]) * bf_lo(cx[rr][i]); u0[2 * i + 1] = bf_hi(cc[rr][i]) * bf_hi(cx[rr][i]); }
#pragma unroll
                    for (int i = 0; i < 8; ++i) y[i] = w0[i] * u2[i] + w1[i] * u1[i] + w2[i] * u0[i];
                    u32x4 ow;
#pragma unroll
                    for (int i = 0; i < 4; ++i) ow[i] = pk2(bf_lo(cb[rr][i]) * y[2 * i], bf_hi(cb[rr][i]) * y[2 * i + 1]);
                    *(u32x4*)(PB + (size_t)(m0 + 4 * hb + rr) * 1024 + c) = ow;
#pragma unroll
                    for (int i = 0; i < 8; ++i) { u2[i] = u1[i]; u1[i] = u0[i]; }
                }
                asm volatile("" ::: "memory");
            }
        }
    }
}

__device__ __forceinline__ void gla_scan(Frame& F, const int nrep) {
    const float* U = WSP(const float, WS_U); float* SIN = WSP(float, WS_SIN); const float* DECS = WSP(const float, WS_DECS);
    const int gt = F.vcu * 512 + F.tid, NT = F.G * 512;
    for (int idx0 = gt; idx0 < 32 * 32768 * nrep; idx0 += NT) {
        const int idx = idx0 & (32 * 32768 - 1);
        const int bh = idx >> 15, e = idx & 32767;
        const int ln = e & 63, reg = (e >> 6) & 15, kb = (e >> 10) & 3;
        const int dk = 32 * kb + crow(reg, ln >> 5);
        float s = 0.f;
#pragma unroll
        for (int sc = 0; sc < 8; ++sc) {
            const int item = bh * 8 + sc;
            SIN[(size_t)item * 32768 + e] = s;
            s = DECS[item * 128 + dk] * s + U[(size_t)item * 32768 + e];
        }
    }
}

struct EpiM1 {
    static constexpr bool PERM = true;
    const bf16* Z; float* M1;
    __device__ __forceinline__ void operator()(const f32x4 (&acc)[2][2][4][2], const pg8::Unit& u, int wr, int wc, int fr, int fq) const {
        const int row0 = u.pm * 256 + wr * 64 + fr, col0 = u.pn * 256 + wc * 32 + 8 * fq;
#pragma unroll
        for (int ai = 0; ai < 2; ++ai)
#pragma unroll
            for (int m = 0; m < 4; ++m) { const size_t row = (size_t)(row0 + ai * 128 + m * 16);
#pragma unroll
                for (int bj = 0; bj < 2; ++bj) { const u32x4 sg = *(const u32x4*)(Z + ZGA + row * 1024 + col0 + bj * 128);
                    const f32x4 v0 = acc[ai][bj][m][0], v1 = acc[ai][bj][m][1];
                    float* mp = M1 + row * 1024 + col0 + bj * 128;
                    *(f32x4*)mp = (f32x4){v0[0] * bf_lo(sg.x), v0[1] * bf_hi(sg.x), v0[2] * bf_lo(sg.y), v0[3] * bf_hi(sg.y)};
                    *(f32x4*)(mp + 4) = (f32x4){v1[0] * bf_lo(sg.z), v1[1] * bf_hi(sg.z), v1[2] * bf_lo(sg.w), v1[3] * bf_hi(sg.w)}; } }
    }
};
struct EpiMix {
    static constexpr bool PERM = true;
    const bf16* Z; const float* M1; bf16* MIX;
    __device__ __forceinline__ void operator()(const f32x4 (&acc)[2][2][4][2], const pg8::Unit& u, int wr, int wc, int fr, int fq) const {
        const int row0 = u.pm * 256 + wr * 64 + fr, col0 = u.pn * 256 + wc * 32 + 8 * fq;
#pragma unroll
        for (int ai = 0; ai < 2; ++ai)
#pragma unroll
            for (int m = 0; m < 4; ++m) { const size_t row = (size_t)(row0 + ai * 128 + m * 16);
#pragma unroll
                for (int bj = 0; bj < 2; ++bj) { const u32x4 sg = *(const u32x4*)(Z + ZGB + row * 1024 + col0 + bj * 128);
                    const f32x4 v0 = acc[ai][bj][m][0], v1 = acc[ai][bj][m][1];
                    const float* mp = M1 + row * 1024 + col0 + bj * 128;
                    const f32x4 m0 = *(const f32x4*)mp, m1 = *(const f32x4*)(mp + 4);
                    u32x4 w;
                    w.x = pk2(m0[0] + v0[0] * bf_lo(sg.x), m0[1] + v0[1] * bf_hi(sg.x)); w.y = pk2(m0[2] + v0[2] * bf_lo(sg.y), m0[3] + v0[3] * bf_hi(sg.y));
                    w.z = pk2(m1[0] + v1[0] * bf_lo(sg.z), m1[1] + v1[1] * bf_hi(sg.z)); w.w = pk2(m1[2] + v1[2] * bf_lo(sg.w), m1[3] + v1[3] * bf_hi(sg.w));
                    *(u32x4*)(MIX + row * 1024 + col0 + bj * 128) = w; } }
    }
};
struct EpiX1 {
    static constexpr bool PERM = false;
    const float* x; float* X1;
    __device__ __forceinline__ void operator()(const f32x4 (&acc)[2][2][4][2], const pg8::Unit& u, int wr, int wc, int fr, int fq) const {
        const int row0 = u.pm * 256 + wr * 64 + fr, col0 = u.pn * 256 + wc * 32 + 4 * fq;
#pragma unroll
        for (int ai = 0; ai < 2; ++ai)
#pragma unroll
            for (int m = 0; m < 4; ++m) { const size_t off = (size_t)(row0 + ai * 128 + m * 16) * 1024 + col0;
#pragma unroll
                for (int bj = 0; bj < 2; ++bj)
#pragma unroll
                    for (int n = 0; n < 2; ++n) { const f32x4 xs = *(const f32x4*)(x + off + bj * 128 + n * 16); *(f32x4*)(X1 + off + bj * 128 + n * 16) = xs + acc[ai][bj][m][n]; } }
    }
};

constexpr int WRT_LD = 1028;
__device__ __forceinline__ float reduce32(float (&a)[32], int lane) {
#pragma unroll
    for (int q = 0; q < 16; ++q) { const bool up = (lane & 32) != 0; const float send = up ? a[q] : a[q + 16]; const float keep = up ? a[q + 16] : a[q]; a[q] = keep + __shfl_xor(send, 32); }
#pragma unroll
    for (int q = 0; q < 8; ++q) { const bool up = (lane & 16) != 0; const float send = up ? a[q] : a[q + 8]; const float keep = up ? a[q + 8] : a[q]; a[q] = keep + __shfl_xor(send, 16); }
#pragma unroll
    for (int q = 0; q < 4; ++q) { const bool up = (lane & 8) != 0; const float send = up ? a[q] : a[q + 4]; const float keep = up ? a[q + 4] : a[q]; a[q] = keep + __shfl_xor(send, 8); }
#pragma unroll
    for (int q = 0; q < 2; ++q) { const bool up = (lane & 4) != 0; const float send = up ? a[q] : a[q + 2]; const float keep = up ? a[q + 2] : a[q]; a[q] = keep + __shfl_xor(send, 4); }
    { const bool up = (lane & 2) != 0; const float send = up ? a[0] : a[1]; const float keep = up ? a[1] : a[0]; a[0] = keep + __shfl_xor(send, 2); }
    return a[0] + __shfl_xor(a[0], 1);
}
__device__ __forceinline__ void route_token(float lg, int lane, int tl, size_t m, LAS int* hist, LAS int* ple, float* gate) {
    const int myi = lane >> 1;
    float tv[4]; int ti[4];
#pragma unroll
    for (int k = 0; k < 4; ++k) {
        float bv = lg; int bi = myi;
#pragma unroll
        for (int off = 32; off >= 2; off >>= 1) { const float ov = __shfl_xor(bv, off); const int oi = __shfl_xor(bi, off); if (ov > bv || (ov == bv && oi < bi)) { bv = ov; bi = oi; } }
        tv[k] = bv; ti[k] = bi;
        if (myi == bi) lg = -3.0e38f;
    }
    const float e1 = __expf(tv[1] - tv[0]), e2 = __expf(tv[2] - tv[0]), e3 = __expf(tv[3] - tv[0]);
    const float inv = 1.0f / (1.0f + e1 + e2 + e3);
    if (lane < 4) {
        const int ek = lane == 0 ? ti[0] : (lane == 1 ? ti[1] : (lane == 2 ? ti[2] : ti[3]));
        const float gk = (lane == 0 ? 1.0f : (lane == 1 ? e1 : (lane == 2 ? e2 : e3))) * inv;
        const int lr = __hip_atomic_fetch_add(&hist[ek], 1, __ATOMIC_RELAXED, __HIP_MEMORY_SCOPE_WORKGROUP);
        ple[tl * 4 + lane] = ek | (lr << 8);
        gate[m * 4 + lane] = gk;
    }
}
__device__ __forceinline__ void p5_router(Frame& F) {
    LAS float* WrT = (LAS float*)F.lds;
    LAS int* hist = (LAS int*)(F.lds + EXTRA_OFF + 1024);
    LAS int* base = (LAS int*)(F.lds + EXTRA_OFF + 1024 + 128);
    LAS int* ple = (LAS int*)(F.lds + EXTRA_OFF + 1024 + 256);
    for (int i = 0; i < 64; ++i) { const int idx = F.tid + 512 * i, k = idx >> 5, e = idx & 31; WrT[e * WRT_LD + k] = F.w_router[idx]; }
    f32x4 g[4];
#pragma unroll
    for (int j = 0; j < 4; ++j) g[j] = *((const f32x4*)F.g_ffn + F.lane + 64 * j);
    const float brl = F.b_router[F.lane >> 1];
    const float* X1 = WSP(const float, WS_X1); bf16* H2 = WSP(bf16, WS_XN);
    unsigned* cnt = F.ctl + CW_CNT; int* list = WSP(int, WS_LIST); float* gate = WSP(float, WS_GATE);
    const int lane = F.lane;
    for (int grp = F.vcu; grp < M / 64; grp += F.G) {
        if (F.tid < 32) hist[F.tid] = 0;
        __syncthreads();
        f32x4 nx0[4], nx1[4];
        { const f32x4* xa = (const f32x4*)(X1 + (size_t)(grp * 64 + 8 * F.wave) * D) + lane;
#pragma unroll
          for (int j = 0; j < 4; ++j) { nx0[j] = xa[64 * j]; nx1[j] = xa[256 + 64 * j]; } }
#pragma unroll 1
        for (int i2 = 0; i2 < 4; ++i2) {
            f32x4 v0[4], v1[4];
#pragma unroll
            for (int j = 0; j < 4; ++j) { v0[j] = nx0[j]; v1[j] = nx1[j]; }
            if (i2 < 3) { const f32x4* xa = (const f32x4*)(X1 + (size_t)(grp * 64 + 8 * F.wave + 2 * i2 + 2) * D) + lane;
#pragma unroll
                for (int j = 0; j < 4; ++j) { nx0[j] = xa[64 * j]; nx1[j] = xa[256 + 64 * j]; } }
            { float s0 = 0.f, s1 = 0.f;
#pragma unroll
              for (int j = 0; j < 4; ++j) {
                  s0 += (v0[j].x * v0[j].x + v0[j].y * v0[j].y) + (v0[j].z * v0[j].z + v0[j].w * v0[j].w); s1 += (v1[j].x * v1[j].x + v1[j].y * v1[j].y) + (v1[j].z * v1[j].z + v1[j].w * v1[j].w); }
              const float r0 = 1.0f / sqrtf(wave_sum(s0) * (1.f / D) + 1e-6f), r1 = 1.0f / sqrtf(wave_sum(s1) * (1.f / D) + 1e-6f);
              const size_t m0 = (size_t)(grp * 64 + 8 * F.wave + 2 * i2);
              unsigned long long* o0 = (unsigned long long*)(H2 + m0 * D) + lane; unsigned long long* o1 = (unsigned long long*)(H2 + (m0 + 1) * D) + lane;
#pragma unroll
              for (int j = 0; j < 4; ++j) { v0[j] = v0[j] * r0 * g[j]; v1[j] = v1[j] * r1 * g[j];
                  o0[64 * j] = (unsigned long long)pk2(v0[j].x, v0[j].y) | ((unsigned long long)pk2(v0[j].z, v0[j].w) << 32);
                  o1[64 * j] = (unsigned long long)pk2(v1[j].x, v1[j].y) | ((unsigned long long)pk2(v1[j].z, v1[j].w) << 32); } }
            float a0[32], a1[32];
#pragma unroll
            for (int e4 = 0; e4 < 8; ++e4) {
#pragma unroll
                for (int ee = 0; ee < 4; ++ee) { const int e = 4 * e4 + ee; float t0 = 0.f, t1 = 0.f;
#pragma unroll
                    for (int j = 0; j < 4; ++j) { const f32x4 wv = *(const LAS f32x4*)(WrT + e * WRT_LD + 256 * j + 4 * lane);
                        t0 += (v0[j].x * wv.x + v0[j].y * wv.y) + (v0[j].z * wv.z + v0[j].w * wv.w); t1 += (v1[j].x * wv.x + v1[j].y * wv.y) + (v1[j].z * wv.z + v1[j].w * wv.w); }
                    a0[e] = t0; a1[e] = t1; }
                asm volatile("" ::: "memory");
            }
            const float l0 = reduce32(a0, lane) + brl, l1 = reduce32(a1, lane) + brl;
            const int tl = 8 * F.wave + 2 * i2;
            route_token(l0, lane, tl, (size_t)(grp * 64 + tl), hist, ple, gate);
            route_token(l1, lane, tl + 1, (size_t)(grp * 64 + tl + 1), hist, ple, gate);
        }
        __syncthreads();
        if (F.tid < 32) base[F.tid] = (int)__hip_atomic_fetch_add(cnt + F.tid, (unsigned)hist[F.tid], RLX_AGENT);
        __syncthreads();
        if (F.tid < 256) { const int pe = ple[F.tid], e = pe & 255, lr = pe >> 8; list[e * CAP + base[e] + lr] = (grp * 64) * 4 + F.tid; }
        __syncthreads();
    }
}

#ifndef MK_MAXU
#define MK_MAXU 12
#endif
constexpr int MAXU = MK_MAXU;
template <int NP>
struct MoeOrder {
    LAS const int* rt0;
    LAS const int* tokl;
    int nwg, G, c, reps;
    __device__ __forceinline__ bool next(int i, pg8::Unit& u) const {
        const long L = (long)i * G + c; if (L >= (long)nwg * reps) return false;
        int wgid = (int)(L % nwg); { const int q = nwg / 8, r = nwg % 8, xcd = wgid % 8, off = wgid / 8; wgid = (xcd < r ? xcd * (q + 1) : r * (q + 1) + (xcd - r) * q) + off; }
        int e = 0;
#pragma unroll 1
        for (int j = 1; j < 32; ++j) if (wgid >= NP * rt0[j]) e = j;
        const int l = wgid - NP * rt0[e], nte = rt0[e + 1] - rt0[e];
        const int pn = l / nte, rt = l - pn * nte;
        u.pm = rt0[e] + rt; u.pn = e * NP + pn; u.e = e; u.rt = rt; return true;
    }
};
struct MoeOrder1 : MoeOrder<8> {
    __device__ __forceinline__ unsigned arow(const pg8::Unit& u, int ui, int r) const { return (unsigned)tokl[ui * 256 + r] * 2048u; }
};
struct MoeOrder2 : MoeOrder<4> {
    __device__ __forceinline__ unsigned arow(const pg8::Unit& u, int ui, int r) const { return (unsigned)(u.pm * 256 + r) * 2048u; }
};
struct EpiAct {
    static constexpr bool PERM = true;
    const float* b_gu; bf16* ACT;
    __device__ __forceinline__ void operator()(const f32x4 (&acc)[2][2][4][2], const pg8::Unit& u, int wr, int wc, int fr, int fq) const {
        const int pn = u.pn & 7, cl = pn * 128 + wc * 32 + 8 * fq;
        const int row0 = u.pm * 256 + wr * 64 + fr;
        const f32x4 bg0 = *(const f32x4*)(b_gu + u.e * 2048 + cl), bg1 = *(const f32x4*)(b_gu + u.e * 2048 + cl + 4);
        const f32x4 bl0 = *(const f32x4*)(b_gu + u.e * 2048 + 1024 + cl), bl1 = *(const f32x4*)(b_gu + u.e * 2048 + 1024 + cl + 4);
#pragma unroll
        for (int ai = 0; ai < 2; ++ai)
#pragma unroll
            for (int m = 0; m < 4; ++m) {
                f32x4 g0 = acc[ai][0][m][0] + bg0, g1 = acc[ai][0][m][1] + bg1, l0 = acc[ai][1][m][0] + bl0, l1 = acc[ai][1][m][1] + bl1;
                float r0[4], r1[4];
#pragma unroll
                for (int j = 0; j < 4; ++j) {
                    const float ga = fminf(g0[j], 7.0f), gb = fminf(g1[j], 7.0f);
                    const float la = fminf(fmaxf(l0[j], -7.0f), 7.0f), lb = fminf(fmaxf(l1[j], -7.0f), 7.0f);
                    r0[j] = (la + 1.0f) * (ga * fast_sigmoid(1.702f * ga)); r1[j] = (lb + 1.0f) * (gb * fast_sigmoid(1.702f * gb));
                }
                u32x4 w; w.x = pk2(r0[0], r0[1]); w.y = pk2(r0[2], r0[3]); w.z = pk2(r1[0], r1[1]); w.w = pk2(r1[2], r1[3]);
                *(u32x4*)(ACT + (size_t)(row0 + ai * 128 + m * 16) * 1024 + cl) = w;
            }
    }
};
struct EpiYP {
    static constexpr bool PERM = true;
    const float* b_d; const unsigned* cnt; const int* list; const float* gate; bf16* YP;
    __device__ __forceinline__ void operator()(const f32x4 (&acc)[2][2][4][2], const pg8::Unit& u, int wr, int wc, int fr, int fq) const {
        const int pn = u.pn & 3, col0 = pn * 256 + wc * 32 + 8 * fq;
        const int ne = (int)cnt[u.e];
        f32x4 bv[2][2];
#pragma unroll
        for (int bj = 0; bj < 2; ++bj)
#pragma unroll
            for (int n = 0; n < 2; ++n) bv[bj][n] = *(const f32x4*)(b_d + u.e * 1024 + col0 + bj * 128 + 4 * n);
#pragma unroll
        for (int ai = 0; ai < 2; ++ai)
#pragma unroll
            for (int m = 0; m < 4; ++m) {
                const int slot = u.rt * 256 + ai * 128 + wr * 64 + m * 16 + fr;
                if (slot < ne) {
                    const int pid = list[u.e * CAP + slot]; const float gw = gate[pid];
#pragma unroll
                    for (int bj = 0; bj < 2; ++bj) { const f32x4 v0 = (acc[ai][bj][m][0] + bv[bj][0]) * gw, v1 = (acc[ai][bj][m][1] + bv[bj][1]) * gw;
                        u32x4 w; w.x = pk2(v0[0], v0[1]); w.y = pk2(v0[2], v0[3]); w.z = pk2(v1[0], v1[1]); w.w = pk2(v1[2], v1[3]);
                        *(u32x4*)(YP + (size_t)pid * 1024 + col0 + bj * 128) = w; }
                }
            }
    }
};
__device__ __forceinline__ int moe_setup(Frame& F, LAS int* rt0) {
    if (F.tid == 0) { int acc = 0; for (int e = 0; e < 32; ++e) { rt0[e] = acc; acc += ((int)F.ctl[CW_CNT + e] + 255) >> 8; } rt0[32] = acc; }
    __syncthreads();
    return rt0[32];
}

__device__ __forceinline__ void p8_final(Frame& F, const int nrep) {
    const int gw = F.vcu * NWAVES + F.wave, NGW = F.G * NWAVES;
    const float* X1 = WSP(const float, WS_X1); const bf16* YP = WSP(const bf16, WS_YP);
    f32x4 g[4];
#pragma unroll
    for (int j = 0; j < 4; ++j) g[j] = *((const f32x4*)F.g_final + F.lane + 64 * j);
    float pscale = 1.0f;
#ifdef MK_TPROBE
    { const unsigned long long* st = (const unsigned long long*)(F.ctl + CW_STAMP); const float dt_us = (float)(st[MK_TPROBE_J] - st[MK_TPROBE_I]) * 0.01f; pscale = 1.0f + sqrtf(dt_us * 1e-5f); }
#endif
    for (int m0 = gw; m0 < M * nrep; m0 += NGW) {
        const int m = m0 % M;
        const f32x4* xr = (const f32x4*)(X1 + (size_t)m * D) + F.lane;
        f32x4 v[4]; float s = 0.f;
#pragma unroll
        for (int j = 0; j < 4; ++j) v[j] = xr[64 * j];
#pragma unroll
        for (int k = 0; k < 4; ++k) { const u32x2* yr = (const u32x2*)(YP + ((size_t)m * 4 + k) * 1024) + F.lane;
#pragma unroll
            for (int j = 0; j < 4; ++j) { const u32x2 y = yr[64 * j]; v[j].x += bf_lo(y.x); v[j].y += bf_hi(y.x); v[j].z += bf_lo(y.y); v[j].w += bf_hi(y.y); } }
#pragma unroll
        for (int j = 0; j < 4; ++j) s += (v[j].x * v[j].x + v[j].y * v[j].y) + (v[j].z * v[j].z + v[j].w * v[j].w);
        const float rstd = 1.0f / sqrtf(wave_sum(s) * (1.f / D) + 1e-6f);
        f32x4* op = (f32x4*)(F.out + (size_t)m * D) + F.lane;
#pragma unroll
        for (int j = 0; j < 4; ++j) op[64 * j] = v[j] * (rstd * pscale) * g[j];
    }
}

struct Args { const float* in[18]; float* out; unsigned char* ws; int ph_lo, ph_hi, rep_k, rep_n; };
__global__ void __launch_bounds__(NWAVES * 64, 2) mk_fwd(Args args) {
    extern __shared__ __attribute__((aligned(16))) unsigned char lds[];
    Frame F;
    F.lds = (LAS unsigned char*)lds;
    F.MISC = (volatile LAS unsigned*)(F.lds + MISC_OFF);
    F.tid = threadIdx.x; F.lane = F.tid & 63; F.wave = __builtin_amdgcn_readfirstlane(F.tid >> 6);
    F.G = gridDim.x; { const int bx = blockIdx.x; F.vcu = (F.G % 8 == 0) ? (bx % 8) * (F.G / 8) + bx / 8 : bx; }
    F.ws = args.ws; F.ctl = (unsigned*)(args.ws + WS_CTL);
    F.x = args.in[0]; F.g_mix = args.in[1]; F.w_in = args.in[2]; F.w_up = args.in[3]; F.b_alpha = args.in[4]; F.g_gla = args.in[5]; F.w_conv = args.in[6];
    F.w_a = args.in[7]; F.w_b = args.in[8]; F.w_out = args.in[9]; F.g_ffn = args.in[10]; F.w_router = args.in[11]; F.b_router = args.in[12];
    F.w_gu = args.in[13]; F.b_gu = args.in[14]; F.w_d = args.in[15]; F.b_d = args.in[16]; F.g_final = args.in[17]; F.out = args.out;
    if (F.tid < 128) ((LAS unsigned*)(F.lds + MISC_OFF))[F.tid] = 0u;
    __syncthreads();
    XcdBarrier bar; bar.bar = F.ctl + CW_BAR; bar.x = 0; bar.st = nullptr;
    if (N_LAUNCHES == 1) bar = xcd_barrier_post(F.ctl + CW_BAR, F.MISC + 8);
    const int lo = args.ph_lo, hi = args.ph_hi;
#ifdef MK_ONLY
#define IN(k) ((k) == MK_ONLY && lo <= (k) && (k) < hi)
#else
#define IN(k) (lo <= (k) && (k) < hi)
#endif
#define REPS(k) (((k) == args.rep_k) ? 1 + args.rep_n : 1)
#if defined(MK_TPROBE) || defined(MK_DELAY_K)
#define STAMP(k) do { if (blockIdx.x == 0 && F.tid == 0) ((unsigned long long*)(F.ctl + CW_STAMP))[k] = __builtin_amdgcn_s_memrealtime(); } while (0)
#else
#define STAMP(k) do { } while (0)
#endif
#ifdef MK_DELAY_K
#define DELAY(k) do { if ((k) == MK_DELAY_K) { const unsigned long long dl = __hip_atomic_load((unsigned long long*)(F.ctl + CW_STAMP), RLX_AGENT) + (unsigned long long)(MK_DELAY_US) * 100ull; \
    while (__builtin_amdgcn_s_memrealtime() < dl) __builtin_amdgcn_s_sleep(8); } } while (0)
#else
#define DELAY(k) do { } while (0)
#endif
#define SEAM(k) do { if (IN(k) && IN((k) + 1)) xcd_barrier(bar); STAMP((k) + 1); DELAY(k); } while (0)

    STAMP(0);
    if (IN(0)) { p0_prologue(F, REPS(0), REPS(11)); SEAM(0); }
    if (IN(1)) { const int nrep = REPS(1);
        pg8::StaticOrder S; S.init(M, NZ, D, F.G, (int)blockIdx.x, nrep);
        EpiZ E{WSP(bf16, WS_Z)};
        pg8::gemm_phase<EpiZ, pg8::StaticOrder, true>(F.lds, WSP(const bf16, WS_XN), WSP(const bf16, WS_WIN), D, S, E);
        SEAM(1);
    }
    if (IN(2)) { const int nrep = REPS(2); for (int it = F.vcu; it < 256 * nrep; it += F.G) gla_item<false>(F, it & 255); conv_rows(F, REPS(12)); SEAM(2); }
    if (IN(3)) { gla_scan(F, REPS(3)); SEAM(3); }
    if (IN(4)) { const int nrep = REPS(4); for (int it = F.vcu; it < 256 * nrep; it += F.G) gla_item<true>(F, it & 255); SEAM(4); }
    if (IN(5)) { const int nrep = REPS(5);
        pg8::StaticOrder S; S.init(M, D, D, F.G, (int)blockIdx.x, nrep);
        EpiM1 E1{WSP(const bf16, WS_Z), WSP(float, WS_M1)};
        pg8::gemm_phase<EpiM1, pg8::StaticOrder, false>(F.lds, WSP(const bf16, WS_OG), WSP(const bf16, WS_WA), D, S, E1);
        EpiMix E2{WSP(const bf16, WS_Z), WSP(const float, WS_M1), WSP(bf16, WS_MIX)};
        pg8::gemm_phase<EpiMix, pg8::StaticOrder, false>(F.lds, WSP(const bf16, WS_PB), WSP(const bf16, WS_WB), D, S, E2);
        SEAM(5);
    }
    if (IN(6)) { const int nrep = REPS(6);
        pg8::StaticOrder S; S.init(M, D, D, F.G, (int)blockIdx.x, nrep);
        EpiX1 E{F.x, WSP(float, WS_X1)};
        pg8::gemm_phase<EpiX1, pg8::StaticOrder, false>(F.lds, WSP(const bf16, WS_MIX), WSP(const bf16, WS_WO), D, S, E);
        SEAM(6);
    }
    if (IN(7)) { p5_router(F); SEAM(7); }
    if (IN(8)) { const int nrep = REPS(8);
        LAS int* rt0 = (LAS int*)(F.lds + EXTRA_OFF); LAS int* tokl = (LAS int*)(F.lds + EXTRA_OFF + 256);
        const int R = moe_setup(F, rt0);
        MoeOrder1 S; S.rt0 = rt0; S.tokl = tokl; S.nwg = R * 8; S.G = F.G; S.c = (int)blockIdx.x; S.reps = nrep;
        const int* list = WSP(const int, WS_LIST);
        { pg8::Unit u; for (int ui = 0; ui < MAXU && S.next(ui, u); ++ui) if (F.tid < 256) { const int slot = u.rt * 256 + F.tid; tokl[ui * 256 + F.tid] = slot < (int)F.ctl[CW_CNT + u.e] ? (list[u.e * CAP + slot] >> 2) : 0; } }
        __syncthreads();
        EpiAct E{F.b_gu, WSP(bf16, WS_ACT)};
        pg8::gemm_phase<EpiAct, MoeOrder1, true>(F.lds, WSP(const bf16, WS_XN), WSP(const bf16, WS_WGU), D, S, E);
        SEAM(8);
    }
    if (IN(9)) { const int nrep = REPS(9);
        LAS int* rt0 = (LAS int*)(F.lds + EXTRA_OFF);
        const int R = moe_setup(F, rt0);
        MoeOrder2 S; S.rt0 = rt0; S.tokl = nullptr; S.nwg = R * 4; S.G = F.G; S.c = (int)blockIdx.x; S.reps = nrep;
        EpiYP E{F.b_d, F.ctl + CW_CNT, WSP(const int, WS_LIST), WSP(const float, WS_GATE), WSP(bf16, WS_YP)};
        pg8::gemm_phase<EpiYP, MoeOrder2, true>(F.lds, WSP(const bf16, WS_ACT), WSP(const bf16, WS_WD), D, S, E);
        SEAM(9);
    }
    if (IN(10)) { p8_final(F, REPS(10)); }
#undef IN
#undef SEAM
}

extern "C" void kernel_launch(void* const* d_in, const int* in_sizes, int n_in, void* d_out, int out_size, void* d_ws, size_t ws_size, hipStream_t stream) {
    static int grid = 0;
    if (grid == 0) {
        if (n_in != 18 || out_size != M * D || ws_size < WS_END) { fprintf(stderr, "kernel_launch: unexpected shapes (n_in %d, out %d, ws %zu < %zu)\n", n_in, out_size, ws_size, (size_t)WS_END); grid = -1; return; }
        int dev = 0, cus = 0, per_cu = 0;
        if (hipGetDevice(&dev) != hipSuccess || hipDeviceGetAttribute(&cus, hipDeviceAttributeMultiprocessorCount, dev) != hipSuccess) { grid = -1; return; }
        if (hipFuncSetAttribute((const void*)mk_fwd, hipFuncAttributeMaxDynamicSharedMemorySize, LDS_BYTES) != hipSuccess) { fprintf(stderr, "kernel_launch: hipFuncSetAttribute(%d B LDS) failed\n", LDS_BYTES); grid = -1; return; }
        if (hipOccupancyMaxActiveBlocksPerMultiprocessor(&per_cu, (const void*)mk_fwd, NWAVES * 64, LDS_BYTES) != hipSuccess || per_cu < 1) fprintf(stderr, "kernel_launch: occupancy query says %d\n", per_cu);
        (void)hipGetLastError();
        grid = cus;
        if (grid != 256) fprintf(stderr, "kernel_launch: %d CUs (built for 256)\n", grid);
    }
    if (grid < 0) return;
    (void)hipMemsetAsync((char*)d_ws + WS_CTL, 0, CTL_ZERO_BYTES, stream);
    Args a{};
    for (int i = 0; i < 18; ++i) a.in[i] = (const float*)d_in[i];
    a.out = (float*)d_out; a.ws = (unsigned char*)d_ws;
#ifdef MK_REPEAT
    a.rep_k = MK_REPEAT; a.rep_n = MK_REPEAT_N;
#else
    a.rep_k = -1; a.rep_n = 0;
#endif
    for (int li = 0; li < N_LAUNCHES; ++li) {
        a.ph_lo = (N_LAUNCHES == 1) ? 0 : li; a.ph_hi = (N_LAUNCHES == 1) ? NPH : li + 1;
        hipLaunchKernelGGL(mk_fwd, dim3(grid), dim3(NWAVES * 64), LDS_BYTES, stream, a);
    }
}
```

```cpp
#include <hip/hip_runtime.h>
#include <cstdio>
#include <cstdint>

#ifndef MK_N_LAUNCHES
#define MK_N_LAUNCHES 1
#endif

#define LAS __attribute__((address_space(3)))
#define GAS __attribute__((address_space(1)))
typedef unsigned short bf16;
typedef short bf16x8 __attribute__((ext_vector_type(8)));
typedef float f32x4 __attribute__((ext_vector_type(4)));
typedef float f32x2 __attribute__((ext_vector_type(2)));
typedef float f32x16 __attribute__((ext_vector_type(16)));
typedef unsigned u32x4 __attribute__((ext_vector_type(4)));
typedef unsigned u32x2 __attribute__((ext_vector_type(2)));
typedef __bf16 bf16x2_t __attribute__((ext_vector_type(2)));
typedef int v8i32 __attribute__((ext_vector_type(8)));

constexpr int NWAVES = 8;
constexpr int M = 16384, D = 1024, SEQ = 2048;
constexpr int NZS = 8208;
constexpr int NZ = 8192;
constexpr int NE = 32, CAP = 16384;
constexpr int NPH = 11;
constexpr int N_LAUNCHES = MK_N_LAUNCHES;
constexpr size_t ZQ = 0, ZK = ZQ + (size_t)4 * M * 128, ZV = ZK + (size_t)4 * M * 128, ZR = ZV + (size_t)4 * M * 256, ZCB = ZR + (size_t)4 * M * 256, ZCC = ZCB + (size_t)M * 1024, ZCX = ZCC + (size_t)M * 1024, ZGA = ZCX + (size_t)M * 1024, ZGB = ZGA + (size_t)M * 1024;

constexpr size_t MiB = 1u << 20;
constexpr size_t WS_CTL = 0, CTL_ZERO_BYTES = 65536;
constexpr size_t WS_LIST = 1 * MiB;
constexpr size_t WS_GATE = 3 * MiB;
constexpr size_t WS_DECS = 4 * MiB;
constexpr size_t WS_WIN = 16 * MiB;
constexpr size_t WS_WA = 32 * MiB, WS_WB = 34 * MiB, WS_WO = 36 * MiB;
constexpr size_t WS_WGU = 40 * MiB;
constexpr size_t WS_WD = 168 * MiB;
constexpr size_t WS_XN = 232 * MiB;
constexpr size_t WS_LA = 264 * MiB;
constexpr size_t WS_Z = 296 * MiB;
constexpr size_t WS_YP = WS_Z;
constexpr size_t WS_U = 552 * MiB;
constexpr size_t WS_SIN = 584 * MiB;
constexpr size_t WS_OG = 616 * MiB;
constexpr size_t WS_PB = 648 * MiB;
constexpr size_t WS_M1 = 680 * MiB;
constexpr size_t WS_MIX = 744 * MiB;
constexpr size_t WS_X1 = 776 * MiB;
constexpr size_t WS_ACT = 840 * MiB;
constexpr size_t WS_END = 984 * MiB;
constexpr int CW_TMO = 0;
constexpr int CW_BAR = 4096;
constexpr int CW_CNT = 8192;
constexpr int CW_STAMP = 12288;

constexpr int RING_BYTES = 131072;
constexpr int EXTRA_OFF = RING_BYTES;
constexpr int LDS_BYTES = 155648 + 512;
constexpr int MISC_OFF = 155648;

#define RLX_AGENT __ATOMIC_RELAXED, __HIP_MEMORY_SCOPE_AGENT
#define LDS_WAIT() asm volatile("s_waitcnt lgkmcnt(0)" ::: "memory")
#define VM_WAIT() asm volatile("s_waitcnt vmcnt(0)" ::: "memory")
__device__ __forceinline__ unsigned pk2(float lo, float hi) { f32x2 v = {lo, hi}; bf16x2_t b = __builtin_convertvector(v, bf16x2_t); return __builtin_bit_cast(unsigned, b); }
__device__ __forceinline__ unsigned pk4_fp8(float a, float b, float c, float d) { int w = 0; w = __builtin_amdgcn_cvt_pk_fp8_f32(a, b, w, false); w = __builtin_amdgcn_cvt_pk_fp8_f32(c, d, w, true); return (unsigned)w; }
__device__ __forceinline__ float bf_lo(unsigned w) { return __builtin_bit_cast(float, w << 16); }
__device__ __forceinline__ float bf_hi(unsigned w) { return __builtin_bit_cast(float, w & 0xffff0000u); }
__device__ __forceinline__ float bf1(bf16 b) { return __builtin_bit_cast(float, ((unsigned)b) << 16); }
__device__ __forceinline__ float fast_sigmoid(float x) { return __builtin_amdgcn_rcpf(1.0f + __expf(-x)); }
__device__ __forceinline__ float wave_sum(float v) {
#pragma unroll
    for (int o = 1; o < 64; o <<= 1) v += __shfl_xor(v, o);
    return v;
}

namespace pg8 {
constexpr int BM = 256, BK = 64, HALF = 128, HTB = HALF * BK * 2, STAGE_BYTES = 8 * HTB, NXCD = 8, WGM = 8;
__device__ __forceinline__ int lds_byte(int r, int c) { const int st = (r >> 4) * 2 + (c >> 5), rr = r & 15, cc = c & 31, ob = rr * 64 + cc * 2; return st * 1024 + (ob ^ (((ob >> 9) & 1) << 5)); }
__device__ __forceinline__ void stage_rc(int b, int& R, int& C) { const int st = b / 1024, sb = b % 1024, swz = sb ^ (((sb >> 9) & 1) << 5); R = (st >> 1) * 16 + swz / 64; C = (st & 1) * 32 + (swz % 64) / 2; }
__device__ __forceinline__ int perm32(int rho) { const int n = rho >> 4, i = rho & 15; return 8 * (i >> 2) + 4 * n + (i & 3); }

struct Unit { int pm, pn, e, rt; };

struct StaticOrder {
    int nM, nN, nwg, G, c, K, reps;
    __device__ __forceinline__ void init(int M_, int N_, int K_, int G_, int c_, int reps_) { nM = M_ / BM; nN = N_ / BM; nwg = nM * nN; G = G_; c = c_; K = K_; reps = reps_; }
    __device__ __forceinline__ bool next(int i, Unit& u) const {
        const long L = (long)i * G + c; if (L >= (long)nwg * reps) return false;
        int wgid = (int)(L % nwg); { const int q = nwg / NXCD, r = nwg % NXCD, xcd = wgid % NXCD, off = wgid / NXCD; wgid = (xcd < r ? xcd * (q + 1) : r * (q + 1) + (xcd - r) * q) + off; }
        const int nig = WGM * nN, gid = wgid / nig, fm = gid * WGM, gsz = (nM - fm) < WGM ? (nM - fm) : WGM;
        u.pm = fm + ((wgid % nig) % gsz); u.pn = (wgid % nig) / gsz; u.e = 0; u.rt = 0; return true;
    }
    __device__ __forceinline__ unsigned arow(const Unit& u, int ui, int r) const { return (unsigned)(u.pm * BM + r) * (unsigned)(K * 2); }
};

template <class Epi, class Sched, bool ALIGN_EPI, bool FP8 = false, int SCW = 127>
__device__ __forceinline__ void gemm_phase(LAS unsigned char* lds, const void* Ag, const void* Btg, const int K, const Sched& S, const Epi& E) {
    const int tid = threadIdx.x, wid = __builtin_amdgcn_readfirstlane(tid >> 6), lane = tid & 63, wr = wid >> 2, wc = wid & 3, fr = lane & 15, fq = lane >> 4;
    const int RB = FP8 ? K : 2 * K;
    const int nt = RB / 128;
    int RA[2], CA[2]; unsigned voffB[2];
#pragma unroll
    for (int i = 0; i < 2; ++i) { int R, C; stage_rc(tid * 16 + i * 8192, R, C); const int Rb = Epi::PERM ? ((R & ~31) + perm32(R & 31)) : R;
        RA[i] = R; CA[i] = C * 2; voffB[i] = (unsigned)(Rb * RB + C * 2); }
    const size_t kstep = (size_t)(BK * 2);
    const size_t hstep = (size_t)HALF * RB;
    const size_t tstep = 2 * hstep;
    const unsigned ldsw = (unsigned)wid * 1024u;
    const int aoff = FP8 ? lds_byte(wr * 64 + fr, fq * 16) : lds_byte(wr * 64 + fr, fq * 8), boff = FP8 ? lds_byte(wc * 32 + fr, fq * 16) : lds_byte(wc * 32 + fr, fq * 8);
#define PG8_SA(b, h) (((b) * 2 + (h)) * HTB)
#define PG8_SB(b, h) ((4 + (b) * 2 + (h)) * HTB)
#define PG8_STAGEB(bufoff, gbase) do { _Pragma("unroll") for (int _i = 0; _i < 2; ++_i) \
        __builtin_amdgcn_global_load_lds((const unsigned*)((const char*)(gbase) + voffB[_i]), (LAS unsigned*)(lds + (bufoff) + ldsw + _i * 8192), 16, 0, 0); } while (0)
#define PG8_STAGEA(bufoff, o0, o1) do { \
        __builtin_amdgcn_global_load_lds((const unsigned*)((const char*)Ag + (o0)), (LAS unsigned*)(lds + (bufoff) + ldsw), 16, 0, 0); \
        __builtin_amdgcn_global_load_lds((const unsigned*)((const char*)Ag + (o1)), (LAS unsigned*)(lds + (bufoff) + ldsw + 8192), 16, 0, 0); } while (0)
#define PG8_LDA(dst, b, h) do { if constexpr (FP8) { _Pragma("unroll") for (int m = 0; m < 4; ++m) { dst[m][0] = *(const LAS bf16x8*)(lds + PG8_SA(b, h) + aoff + m * 2048); dst[m][1] = *(const LAS bf16x8*)(lds + PG8_SA(b, h) + aoff + m * 2048 + 16); } } \
        else { _Pragma("unroll") for (int m = 0; m < 4; ++m) _Pragma("unroll") for (int k = 0; k < 2; ++k) dst[m][k] = *(const LAS bf16x8*)(lds + PG8_SA(b, h) + aoff + m * 2048 + k * 1024); } } while (0)
#define PG8_LDB(dst, b, h) do { if constexpr (FP8) { _Pragma("unroll") for (int n = 0; n < 2; ++n) { dst[n][0] = *(const LAS bf16x8*)(lds + PG8_SB(b, h) + boff + n * 2048); dst[n][1] = *(const LAS bf16x8*)(lds + PG8_SB(b, h) + boff + n * 2048 + 16); } } \
        else { _Pragma("unroll") for (int n = 0; n < 2; ++n) _Pragma("unroll") for (int k = 0; k < 2; ++k) dst[n][k] = *(const LAS bf16x8*)(lds + PG8_SB(b, h) + boff + n * 2048 + k * 1024); } } while (0)
#define PG8_F8(x) __builtin_bit_cast(v8i32, __builtin_shufflevector(__builtin_bit_cast(u32x4, (x)[0]), __builtin_bit_cast(u32x4, (x)[1]), 0, 1, 2, 3, 4, 5, 6, 7))
#define PG8_MMA(ai, bj, At, Bt) do { __builtin_amdgcn_s_setprio(1); if constexpr (FP8) { _Pragma("unroll") for (int m = 0; m < 4; ++m) _Pragma("unroll") for (int n = 0; n < 2; ++n) \
        asm volatile("v_mfma_scale_f32_16x16x128_f8f6f4 %0, %1, %2, %0, %3, %4 op_sel_hi:[0,0,0]" : "+v"(acc[ai][bj][m][n]) : "v"(PG8_F8(Bt[n])), "v"(PG8_F8(At[m])), "v"(scw_reg), "v"(sca_reg)); } \
        else { _Pragma("unroll") for (int m = 0; m < 4; ++m) _Pragma("unroll") for (int n = 0; n < 2; ++n) _Pragma("unroll") for (int k = 0; k < 2; ++k) \
        acc[ai][bj][m][n] = __builtin_amdgcn_mfma_f32_16x16x32_bf16(Bt[n][k], At[m][k], acc[ai][bj][m][n], 0, 0, 0); } __builtin_amdgcn_s_setprio(0); } while (0)
#define PG8_WAIT_V(n) asm volatile("s_waitcnt vmcnt(" #n ")" ::: "memory")
#define PG8_WAIT_L(n) asm volatile("s_waitcnt lgkmcnt(" #n ")" ::: "memory")
#define PG8_BAR __builtin_amdgcn_s_barrier()
#define PG8_SCHED __builtin_amdgcn_sched_barrier(0)
    Unit cur, nxt; int ui = 0;
    if (!S.next(0, cur)) return;
    int scw_reg = SCW, sca_reg = 127;
    asm volatile("" : "+v"(scw_reg), "+v"(sca_reg));
    f32x4 acc[2][2][4][2];
#pragma unroll
    for (int a = 0; a < 2; ++a)
#pragma unroll
        for (int b = 0; b < 2; ++b)
#pragma unroll
            for (int m = 0; m < 4; ++m)
#pragma unroll
                for (int n = 0; n < 2; ++n) acc[a][b][m][n] = (f32x4){0.f, 0.f, 0.f, 0.f};
#define PG8_ZPAD() do { if constexpr (FP8) { _Pragma("unroll") for (int a = 0; a < 2; ++a) _Pragma("unroll") for (int b = 0; b < 2; ++b) _Pragma("unroll") for (int m = 0; m < 4; ++m) asm volatile("s_nop 1" : "+v"(acc[a][b][m][0]), "+v"(acc[a][b][m][1])); } } while (0)
    PG8_ZPAD();
    bf16x8 At[4][2], B0[2][2], B1[2][2];
    unsigned ac00, ac01, ac10, ac11;
    ac00 = S.arow(cur, 0, RA[0]) + CA[0]; ac01 = S.arow(cur, 0, RA[1]) + CA[1]; ac10 = S.arow(cur, 0, HALF + RA[0]) + CA[0]; ac11 = S.arow(cur, 0, HALF + RA[1]) + CA[1];
    const char* cB = (const char*)Btg + (size_t)cur.pn * tstep;
    PG8_STAGEB(PG8_SB(0, 0), cB); PG8_STAGEB(PG8_SB(0, 1), cB + hstep); PG8_STAGEA(PG8_SA(0, 0), ac00, ac01); PG8_STAGEA(PG8_SA(0, 1), ac10, ac11);
    if (wr == 1) PG8_BAR;
    PG8_WAIT_V(2); PG8_BAR;
    PG8_STAGEB(PG8_SB(1, 0), cB + kstep); PG8_STAGEA(PG8_SA(1, 0), ac00 + 128u, ac01 + 128u); PG8_STAGEB(PG8_SB(1, 1), cB + hstep + kstep);
    PG8_WAIT_V(6); PG8_BAR;
    for (;;) {
        const bool has_next = S.next(ui + 1, nxt);
        const char* nB = has_next ? (const char*)Btg + (size_t)nxt.pn * tstep : cB;
#pragma unroll 1
        for (int t = 0; t < nt; t += 2) {
            const bool last = (t == nt - 2);
            const unsigned k1 = (unsigned)(t + 1) * 128u, k2 = (unsigned)(t + 2) * 128u;
            unsigned a200 = ac00 + k2, a201 = ac01 + k2, a210 = ac10 + k2, a211 = ac11 + k2;
            if (last) { if (has_next) { a200 = S.arow(nxt, ui + 1, RA[0]) + CA[0]; a201 = S.arow(nxt, ui + 1, RA[1]) + CA[1]; a210 = S.arow(nxt, ui + 1, HALF + RA[0]) + CA[0]; a211 = S.arow(nxt, ui + 1, HALF + RA[1]) + CA[1]; }
                        else { a200 = ac00; a201 = ac01; a210 = ac10; a211 = ac11; } }
            const char* b2 = last ? nB : cB + (size_t)k2; const char* b3 = b2 + kstep;
            PG8_LDB(B0, 0, 0); PG8_LDB(B1, 0, 1); PG8_SCHED; PG8_LDA(At, 0, 0); PG8_STAGEA(PG8_SA(1, 1), ac10 + k1, ac11 + k1);
            PG8_WAIT_V(8); PG8_WAIT_L(0); PG8_BAR; PG8_MMA(0, 0, At, B0); PG8_MMA(0, 1, At, B1); PG8_BAR; PG8_SCHED;
            PG8_LDA(At, 0, 1); PG8_STAGEB(PG8_SB(0, 0), b2); PG8_STAGEB(PG8_SB(0, 1), b2 + hstep); PG8_STAGEA(PG8_SA(0, 0), a200, a201);
            PG8_WAIT_V(8); PG8_WAIT_L(0); PG8_BAR; PG8_MMA(1, 0, At, B0); PG8_MMA(1, 1, At, B1); PG8_BAR; PG8_SCHED;
            PG8_LDB(B0, 1, 0); PG8_LDB(B1, 1, 1); PG8_SCHED; PG8_LDA(At, 1, 0); PG8_STAGEA(PG8_SA(0, 1), a210, a211);
            PG8_WAIT_V(8); PG8_WAIT_L(0); PG8_BAR; PG8_MMA(0, 0, At, B0); PG8_MMA(0, 1, At, B1); PG8_BAR; PG8_SCHED;
            PG8_LDA(At, 1, 1); PG8_STAGEB(PG8_SB(1, 0), b3); PG8_STAGEB(PG8_SB(1, 1), b3 + hstep); PG8_STAGEA(PG8_SA(1, 0), a200 + 128u, a201 + 128u);
            PG8_WAIT_V(8); PG8_WAIT_L(0); PG8_BAR; PG8_MMA(1, 0, At, B0); PG8_MMA(1, 1, At, B1); PG8_BAR; PG8_SCHED;
        }
        if constexpr (FP8) asm volatile("s_nop 15\n\ts_nop 15" ::: "memory");
#pragma unroll
        for (int a = 0; a < 2; ++a)
#pragma unroll
            for (int b = 0; b < 2; ++b)
#pragma unroll
                for (int m = 0; m < 4; ++m) asm volatile("" : "+v"(acc[a][b][m][0]), "+v"(acc[a][b][m][1]));
        if constexpr (ALIGN_EPI) { if (wr == 0) PG8_BAR; }
        E(acc, cur, wr, wc, fr, fq);
        if (!has_next) break;
#pragma unroll
        for (int a = 0; a < 2; ++a)
#pragma unroll
            for (int b = 0; b < 2; ++b)
#pragma unroll
                for (int m = 0; m < 4; ++m)
#pragma unroll
                    for (int n = 0; n < 2; ++n) acc[a][b][m][n] = (f32x4){0.f, 0.f, 0.f, 0.f};
        PG8_ZPAD();
        cur = nxt; cB = nB; ++ui;
        ac00 = S.arow(cur, ui, RA[0]) + CA[0]; ac01 = S.arow(cur, ui, RA[1]) + CA[1]; ac10 = S.arow(cur, ui, HALF + RA[0]) + CA[0]; ac11 = S.arow(cur, ui, HALF + RA[1]) + CA[1];
        if constexpr (ALIGN_EPI) { if (wr == 1) PG8_BAR; }
    }
    PG8_WAIT_V(0);
    if constexpr (!ALIGN_EPI) { if (wr == 0) PG8_BAR; }
    PG8_BAR;
#undef PG8_SA
#undef PG8_SB
#undef PG8_STAGEA
#undef PG8_STAGEB
#undef PG8_LDA
#undef PG8_LDB
#undef PG8_MMA
#undef PG8_F8
#undef PG8_ZPAD
#undef PG8_WAIT_V
#undef PG8_WAIT_L
#undef PG8_BAR
#undef PG8_SCHED
}
}

#define XB_TMO      128
#define XB_XCNT(j)  (256  + 64 * (j))
#define XB_XSUB(j)  (1280 + 64 * (j))
#define XB_XGEN(j)  (2304 + 64 * (j))
#define XB_TOP      3328
#define XB_TOPGEN   3392
#define XCD_BAR_WORDS 3456
#define XB_SPIN_CAP (1u << 18)
__device__ __forceinline__ unsigned xb_ld(unsigned* p)              { return __hip_atomic_load(p, __ATOMIC_RELAXED, __HIP_MEMORY_SCOPE_AGENT); }
__device__ __forceinline__ unsigned xb_add(unsigned* p, unsigned v) { return __hip_atomic_fetch_add(p, v, __ATOMIC_RELAXED, __HIP_MEMORY_SCOPE_AGENT); }
__device__ __forceinline__ unsigned xb_xcc_id() { return (unsigned)__builtin_amdgcn_s_getreg((3 << 11) | 20) & 0xFu; }
#define XB_SPIN(cond, bar) do { unsigned _sp = 0; while (cond) { __builtin_amdgcn_s_sleep(1); \
    if ((++_sp & 255u) == 0u) { if (xb_ld(&(bar)[XB_TMO])) break; if (_sp > XB_SPIN_CAP) { atomicAdd(&(bar)[XB_TMO], 1u); break; } } } } while (0)
struct XcdBarrier { unsigned* bar; unsigned x; volatile LAS unsigned* st; };
__device__ __forceinline__ XcdBarrier xcd_barrier_post(unsigned* bar, volatile LAS unsigned* st) {
    XcdBarrier b; b.bar = bar; b.x = xb_xcc_id(); b.st = st;
    if (threadIdx.x == 0) (void)xb_add(&bar[XB_XCNT(b.x)], 1u);
    return b;
}
__device__ __forceinline__ void xcd_barrier_complete(unsigned* bar, unsigned x, unsigned& nloc, unsigned& nx) {
    const unsigned G = gridDim.x * gridDim.y * gridDim.z;
    unsigned sum, cnt, mine, sp = 0u;
    for (;;) {
        sum = 0u; cnt = 0u; mine = 0u;
#pragma unroll
        for (unsigned j = 0; j < 16; ++j) { const unsigned c = xb_ld(&bar[XB_XCNT(j)]); sum += c; cnt += (c > 0u) ? 1u : 0u; mine = (j == x) ? c : mine; }
        if (sum == G) break;
        __builtin_amdgcn_s_sleep(1);
        if ((++sp & 255u) == 0u) { if (xb_ld(&bar[XB_TMO])) break; if (sp > XB_SPIN_CAP) { atomicAdd(&bar[XB_TMO], 1u); break; } }
    }
    nloc = mine > 0u ? mine : 1u; nx = cnt > 0u ? cnt : 1u;
}
__device__ __forceinline__ void xcd_barrier(const XcdBarrier& b) {
    asm volatile("s_waitcnt vmcnt(0)" ::: "memory");
    __syncthreads();
    if (threadIdx.x == 0) {
        unsigned* bar = b.bar;
        __builtin_amdgcn_s_waitcnt(0);
        unsigned nloc = b.st[0], nx = b.st[1];
        if (nloc == 0u) { xcd_barrier_complete(bar, b.x, nloc, nx); b.st[0] = nloc; b.st[1] = nx; }
        const unsigned old = xb_add(&bar[XB_XSUB(b.x)], 1u);
        const unsigned gen = old / nloc;
        if (old + 1u == (gen + 1u) * nloc) {
            __builtin_amdgcn_fence(__ATOMIC_RELEASE, "agent");
            asm volatile("s_waitcnt vmcnt(0)" ::: "memory");
            const unsigned og = xb_add(&bar[XB_TOP], 1u);
            const unsigned tg = og / nx;
            if (og + 1u == (tg + 1u) * nx) xb_add(&bar[XB_TOPGEN], 1u);
            else XB_SPIN(xb_ld(&bar[XB_TOPGEN]) == tg, bar);
            __builtin_amdgcn_fence(__ATOMIC_ACQUIRE, "agent");
            xb_add(&bar[XB_XGEN(b.x)], 1u);
            asm volatile("s_waitcnt vmcnt(0)" ::: "memory");
        } else {
            XB_SPIN(xb_ld(&bar[XB_XGEN(b.x)]) == gen, bar);
            __builtin_amdgcn_fence(__ATOMIC_ACQUIRE, "agent");
            asm volatile("s_waitcnt vmcnt(0)" ::: "memory");
        }
    }
    __syncthreads();
}

struct Frame {
    LAS unsigned char* lds;
    volatile LAS unsigned* MISC;
    unsigned* ctl;
    int tid, lane, wave, vcu, G;
    unsigned char* ws;
    const float *x, *g_mix, *w_in, *w_up, *b_alpha, *g_gla, *w_conv, *w_a, *w_b, *w_out, *g_ffn, *w_router, *b_router, *w_gu, *b_gu, *w_d, *b_d, *g_final;
    float* out;
};
#define WSP(T, off) ((T*)(F.ws + (off)))

__device__ __forceinline__ void tr_item64(const float* W, int ld, int k0, int n0, bf16* WT, size_t dst_row0, int K, LAS unsigned* T, int lane) {
    const int nq = lane & 15, kr = lane >> 4;
    const float* src = W + (size_t)(k0 + 2 * kr) * ld + n0 + 4 * nq;
    f32x4 a0[8], a1[8];
#pragma unroll
    for (int it = 0; it < 8; ++it) { a0[it] = *(const f32x4*)(src + (size_t)(8 * it) * ld); a1[it] = *(const f32x4*)(src + (size_t)(8 * it + 1) * ld); }
    const int c = lane & 7;
#pragma unroll
    for (int hf = 0; hf < 2; ++hf) {
        if ((nq >> 3) == hf) {
#pragma unroll
            for (int it = 0; it < 8; ++it)
#pragma unroll
                for (int q = 0; q < 4; ++q) T[(4 * (nq & 7) + q) * 33 + 4 * it + kr] = pk2(a0[it][q], a1[it][q]);
        }
        LDS_WAIT(); asm volatile("" ::: "memory");
#pragma unroll
        for (int j = 0; j < 4; ++j) { const int n = (lane >> 3) + 8 * j; const LAS unsigned* t = T + n * 33 + 4 * c;
            u32x4 o; o.x = t[0]; o.y = t[1]; o.z = t[2]; o.w = t[3];
            *(u32x4*)(WT + (dst_row0 + 32 * hf + n) * (size_t)K + k0 + 8 * c) = o; }
        LDS_WAIT(); asm volatile("" ::: "memory");
    }
}

__device__ __forceinline__ void tr_item8(const float* W, int ld, int k0, int n0, unsigned char* WT8, size_t dst_row0, int KB, float scale, LAS unsigned* T, int lane) {
    const int nq = lane & 7, kr = lane >> 3;
    const float* src = W + (size_t)(k0 + 4 * kr) * ld + n0 + 4 * nq;
    f32x4 a[4][4];
#pragma unroll
    for (int it = 0; it < 4; ++it)
#pragma unroll
        for (int j = 0; j < 4; ++j) a[it][j] = *(const f32x4*)(src + (size_t)(32 * it + j) * ld);
#pragma unroll
    for (int it = 0; it < 4; ++it)
#pragma unroll
        for (int q = 0; q < 4; ++q) T[(4 * nq + q) * 33 + 8 * it + kr] = pk4_fp8(a[it][0][q] * scale, a[it][1][q] * scale, a[it][2][q] * scale, a[it][3][q] * scale);
    LDS_WAIT(); asm volatile("" ::: "memory");
    const int c = lane & 7;
#pragma unroll
    for (int j = 0; j < 4; ++j) { const int n = (lane >> 3) + 8 * j; const LAS unsigned* t = T + n * 33 + 4 * c;
        u32x4 o; o.x = t[0]; o.y = t[1]; o.z = t[2]; o.w = t[3];
        *(u32x4*)(WT8 + (dst_row0 + n) * (size_t)KB + k0 + 16 * c) = o; }
    LDS_WAIT(); asm volatile("" ::: "memory");
}

constexpr int P0_T_BYTES = 4352;
constexpr int P0_WL = 8 * P0_T_BYTES;
constexpr int P0_WU = P0_WL + 65536;
constexpr int P0_BA = P0_WU + 32768;

__device__ __forceinline__ void p0_items(Frame& F, const int nrep) {
    LAS unsigned* scr = (LAS unsigned*)(F.lds + F.wave * P0_T_BYTES);
    const int gw = F.vcu * NWAVES + F.wave, NGW = F.G * NWAVES;
    constexpr int I_IN = 128 * 16, I_SQ = 16 * 16, I_GU = NE * 32 * 16, I_D = NE * 16 * 16;
    constexpr int NITEMS = I_IN + 3 * I_SQ + I_GU + I_D;
    bf16* Win_t = WSP(bf16, WS_WIN);
    for (int it0 = gw; it0 < NITEMS * nrep; it0 += NGW) {
        int r = it0 % NITEMS;
        if (r < I_IN) { const int kb = r >> 7, nb = r & 127, j0 = 64 * nb; tr_item64(F.w_in, NZS, 64 * kb, j0 < 3072 ? j0 : j0 + 16, Win_t, j0, 1024, scr, F.lane); continue; } r -= I_IN;
        if (r < I_SQ) { tr_item64(F.w_a, 1024, 64 * (r >> 4), 64 * (r & 15), WSP(bf16, WS_WA), 64 * (r & 15), 1024, scr, F.lane); continue; } r -= I_SQ;
        if (r < I_SQ) { tr_item64(F.w_b, 1024, 64 * (r >> 4), 64 * (r & 15), WSP(bf16, WS_WB), 64 * (r & 15), 1024, scr, F.lane); continue; } r -= I_SQ;
        if (r < I_SQ) { tr_item64(F.w_out, 1024, 64 * (r >> 4), 64 * (r & 15), WSP(bf16, WS_WO), 64 * (r & 15), 1024, scr, F.lane); continue; } r -= I_SQ;
        if (r < I_GU) { const int e = r >> 9, q = r & 511, kb = q >> 6, nb = q & 63, j0 = 32 * nb, pn = j0 >> 8, within = j0 & 255, half = within >> 7;
            tr_item8(F.w_gu + (size_t)e * 1024 * 2048, 2048, 128 * kb, half * 1024 + pn * 128 + (within & 127), WSP(unsigned char, WS_WGU) + (size_t)e * 2048 * 1024, j0, 1024, 32.0f, scr, F.lane); continue; } r -= I_GU;
        { const int e = r >> 8, q = r & 255, kb = q >> 5, nb = q & 31;
            tr_item8(F.w_d + (size_t)e * 1024 * 1024, 1024, 128 * kb, 32 * nb, WSP(unsigned char, WS_WD) + (size_t)e * 1024 * 1024, 32 * nb, 1024, 32.0f, scr, F.lane); }
    }
}

__device__ __forceinline__ void p0_rows(Frame& F, const int nrep2) {
    const int gw = F.vcu * NWAVES + F.wave, NGW = F.G * NWAVES;
    LAS float* Wl = (LAS float*)(F.lds + P0_WL);
    LAS float* WU = (LAS float*)(F.lds + P0_WU);
    LAS float* BA = (LAS float*)(F.lds + P0_BA);
    f32x4 g[4];
#pragma unroll
    for (int j = 0; j < 4; ++j) g[j] = *((const f32x4*)F.g_mix + F.lane + 64 * j);
    bf16* XN = WSP(bf16, WS_XN); float* LA = WSP(float, WS_LA);
    for (int m0 = gw; m0 < M * nrep2; m0 += NGW) {
        const int m = m0 % M;
        const f32x4* xr = (const f32x4*)(F.x + (size_t)m * D) + F.lane;
        f32x4 v[4]; float s = 0.f;
#pragma unroll
        for (int j = 0; j < 4; ++j) { v[j] = xr[64 * j]; s += (v[j].x * v[j].x + v[j].y * v[j].y) + (v[j].z * v[j].z + v[j].w * v[j].w); }
        const float rstd = 1.0f / sqrtf(wave_sum(s) * (1.f / D) + 1e-6f);
        unsigned long long* o8 = (unsigned long long*)(XN + (size_t)m * D) + F.lane;
#pragma unroll
        for (int j = 0; j < 4; ++j) { v[j] = v[j] * rstd * g[j]; o8[64 * j] = (unsigned long long)pk2(v[j].x, v[j].y) | ((unsigned long long)pk2(v[j].z, v[j].w) << 32); }
        float a[16];
#pragma unroll
        for (int r4 = 0; r4 < 4; ++r4) {
#pragma unroll
            for (int rr = 0; rr < 4; ++rr) { const int r = 4 * r4 + rr; float t = 0.f;
#pragma unroll
                for (int j = 0; j < 4; ++j) { const f32x4 w = *(const LAS f32x4*)(Wl + r * 1024 + 256 * j + 4 * F.lane); t += (v[j].x * w.x + v[j].y * w.y) + (v[j].z * w.z + v[j].w * w.w); }
                a[r] = t; }
            asm volatile("" ::: "memory");
        }
#pragma unroll
        for (int q = 0; q < 8; ++q) { const bool up = (F.lane & 32) != 0; const float send = up ? a[q] : a[q + 8]; const float keep = up ? a[q + 8] : a[q]; a[q] = keep + __shfl_xor(send, 32); }
#pragma unroll
        for (int q = 0; q < 4; ++q) { const bool up = (F.lane & 16) != 0; const float send = up ? a[q] : a[q + 4]; const float keep = up ? a[q + 4] : a[q]; a[q] = keep + __shfl_xor(send, 16); }
#pragma unroll
        for (int q = 0; q < 2; ++q) { const bool up = (F.lane & 8) != 0; const float send = up ? a[q] : a[q + 2]; const float keep = up ? a[q + 2] : a[q]; a[q] = keep + __shfl_xor(send, 8); }
        { const bool up = (F.lane & 4) != 0; const float send = up ? a[0] : a[1]; const float keep = up ? a[1] : a[0]; a[0] = keep + __shfl_xor(send, 4); }
        float alv = a[0]; alv += __shfl_xor(alv, 2); alv += __shfl_xor(alv, 1);
        float al[16];
#pragma unroll
        for (int r = 0; r < 16; ++r) al[r] = __builtin_bit_cast(float, __builtin_amdgcn_readlane(__builtin_bit_cast(int, alv), 4 * r));
#pragma unroll
        for (int i = 0; i < 8; ++i) { const int j = F.lane + 64 * i; float pre = BA[j];
#pragma unroll
            for (int r = 0; r < 16; ++r) pre += al[r] * WU[r * 512 + j];
            const float ls = fminf(pre, 0.f) - __logf(1.0f + __expf(-fabsf(pre)));
            LA[((size_t)(i >> 1) * M + m) * 128 + (j & 127)] = ls * (1.0f / 16.0f);
            if (i & 1) asm volatile("" ::: "memory"); }
    }
}

__device__ __forceinline__ void p0_prologue(Frame& F, const int nrep, const int nrep2) {
    {
        LAS float* Wl = (LAS float*)(F.lds + P0_WL); LAS float* WU = (LAS float*)(F.lds + P0_WU); LAS float* BA = (LAS float*)(F.lds + P0_BA);
        for (int i = 0; i < 32; ++i) { const int idx = F.tid + 512 * i, k = idx >> 4, r = idx & 15; Wl[r * 1024 + k] = F.w_in[(size_t)k * NZS + 3072 + r]; }
        for (int i = 0; i < 16; ++i) { const int idx = F.tid + 512 * i; WU[idx] = F.w_up[idx]; }
        BA[F.tid] = F.b_alpha[F.tid];
        __syncthreads();
    }
#pragma unroll 1
    for (int pass = 0; pass < 2; ++pass) {
        if (((pass ^ F.wave) & 1) == 0) p0_items(F, nrep); else p0_rows(F, nrep2);
    }
}

struct EpiZ {
    static constexpr bool PERM = true;
    bf16* Z;
    __device__ __forceinline__ void operator()(const f32x4 (&acc)[2][2][4][2], const pg8::Unit& u, int wr, int wc, int fr, int fq) const {
        const int row0 = u.pm * 256 + wr * 64 + fr, c0 = wc * 32 + 8 * fq;
        const int pn = u.pn;
        const int kind = pn < 2 ? 1 : (pn < 8 ? 0 : (pn < 12 ? 2 : (pn < 24 ? 0 : 3)));
        bf16* base; int ld; size_t bjs;
        if (pn < 4) { base = Z + (pn < 2 ? ZQ : ZK) + (size_t)(2 * (pn & 1)) * M * 128; ld = 128; bjs = (size_t)M * 128; }
        else if (pn < 12) { base = Z + (pn < 8 ? ZV : ZR) + (size_t)(pn & 3) * M * 256; ld = 256; bjs = 128; }
        else { const int t = (pn - 12) >> 2; base = Z + ZCB + (size_t)t * M * 1024 + (size_t)((pn - 12) & 3) * 256; ld = 1024; bjs = 128; }
#pragma unroll
        for (int ai = 0; ai < 2; ++ai)
#pragma unroll
            for (int m = 0; m < 4; ++m) { bf16* rowp = base + (size_t)(row0 + ai * 128 + m * 16) * ld + c0;
#pragma unroll
                for (int bj = 0; bj < 2; ++bj) { f32x4 v0 = acc[ai][bj][m][0], v1 = acc[ai][bj][m][1];
                    if (kind == 1) { v0 = v0 * 0.08838834764831845f; v1 = v1 * 0.08838834764831845f; }
                    else if (kind == 2) {
#pragma unroll
                        for (int j = 0; j < 4; ++j) { v0[j] = v0[j] * fast_sigmoid(v0[j]); v1[j] = v1[j] * fast_sigmoid(v1[j]); } }
                    else if (kind == 3) {
#pragma unroll
                        for (int j = 0; j < 4; ++j) { v0[j] = fast_sigmoid(v0[j]); v1[j] = fast_sigmoid(v1[j]); } }
                    u32x4 w; w.x = pk2(v0[0], v0[1]); w.y = pk2(v0[2], v0[3]); w.z = pk2(v1[0], v1[1]); w.w = pk2(v1[2], v1[3]);
                    *(u32x4*)(rowp + bj * bjs) = w; } }
    }
};

constexpr int QD_STRIDE = 272, KT_STRIDE = 144, SC_STRIDE = 144, OT_STRIDE = 1040;
constexpr int L_QD = 0, L_KI = 17408, L_KT = 34816, L_SC = 53248, L_DEC = 62464, L_SEG = 62976, L_OT = 67584;
__device__ __forceinline__ int crow(int reg, int h) { return (reg & 3) + 8 * (reg >> 2) + 4 * h; }

template <bool OUT>
__device__ __forceinline__ void gla_item(Frame& F, int item) {
    const int bh = item >> 3, sc = item & 7, b = bh >> 2, hd = bh & 3;
    const int t0 = b * SEQ + sc * 256;
    const int tid = F.tid, lane = F.lane, w = F.wave, r32 = lane & 31, h = lane >> 5;
    const bf16* Z = WSP(const bf16, WS_Z);
    const float* LA = WSP(const float, WS_LA);
    LAS unsigned char* L = F.lds;
    f32x16 S[4];
    float* Sbuf = (OUT ? WSP(float, WS_SIN) : WSP(float, WS_U)) + (size_t)item * 32768 + (size_t)w * 4096;
    if (OUT) {
#pragma unroll
        for (int kb = 0; kb < 4; ++kb)
#pragma unroll
            for (int r = 0; r < 16; ++r) S[kb][r] = Sbuf[(kb * 16 + r) * 64 + lane];
    } else {
#pragma unroll
        for (int kb = 0; kb < 4; ++kb)
#pragma unroll
            for (int r = 0; r < 16; ++r) S[kb][r] = 0.f;
    }
    float btot_run0 = 0.f, btot_run1 = 0.f;
    const int tok_n = tid >> 3, part = tid & 7;
    f32x2 la2[8]; unsigned kk[8], qq[8]; bf16x8 Bv[4]; u32x4 rc[4];
#define GLA_LOAD(tcx) do { \
        const size_t rb_ = ((size_t)hd * M + (tcx) + 8 * w) * 128 + 2 * lane; \
        _Pragma("unroll") for (int i = 0; i < 8; ++i) { la2[i] = *(const f32x2*)(LA + rb_ + (size_t)i * 128); kk[i] = *(const unsigned*)(Z + ZK + rb_ + (size_t)i * 128); if (OUT) qq[i] = *(const unsigned*)(Z + ZQ + rb_ + (size_t)i * 128); } \
    } while (0)
#define GLA_LOADV(tcx) do { \
        _Pragma("unroll") for (int ks = 0; ks < 4; ++ks) _Pragma("unroll") for (int j = 0; j < 8; ++j) Bv[ks][j] = (short)Z[ZV + ((size_t)hd * M + (tcx) + 16 * ks + 8 * h + j) * 256 + 32 * w + r32]; \
    } while (0)
#define GLA_LOADR(tcx) do { \
        if (OUT) { const u32x4* rp_ = (const u32x4*)(Z + ZR + ((size_t)hd * M + (tcx) + tok_n) * 256 + 32 * part); _Pragma("unroll") for (int i = 0; i < 4; ++i) rc[i] = rp_[i]; } \
    } while (0)
    GLA_LOAD(t0); GLA_LOADV(t0);
#pragma unroll 1
    for (int c = 0; c < 4; ++c) {
        const int tc = t0 + c * 64;
        float p0[8], p1[8];
        { float r0 = 0.f, r1 = 0.f;
#pragma unroll
          for (int i = 0; i < 8; ++i) { r0 += la2[i].x; r1 += la2[i].y; p0[i] = r0; p1[i] = r1; }
          *(LAS f32x2*)(L + L_SEG + (w * 128 + 2 * lane) * 4) = (f32x2){r0, r1}; }
        GLA_LOADR(tc);
        __syncthreads();
        float off0 = 0.f, off1 = 0.f, bt0 = 0.f, bt1 = 0.f;
#pragma unroll
        for (int sgi = 0; sgi < 8; ++sgi) { const f32x2 sv = *(const LAS f32x2*)(L + L_SEG + (sgi * 128 + 2 * lane) * 4); if (sgi < w) { off0 += sv.x; off1 += sv.y; } bt0 += sv.x; bt1 += sv.y; }
        if (w == 0) { *(LAS f32x2*)(L + L_DEC + 8 * lane) = (f32x2){__expf(bt0), __expf(bt1)}; btot_run0 += bt0; btot_run1 += bt1; }
        {
            unsigned kt0[4], kt1[4];
#pragma unroll
            for (int i = 0; i < 8; i += 2) {
                const float b00 = off0 + p0[i], b01 = off1 + p1[i], b10 = off0 + p0[i + 1], b11 = off1 + p1[i + 1];
                const float k00 = bf_lo(kk[i]), k01 = bf_hi(kk[i]), k10 = bf_lo(kk[i + 1]), k11 = bf_hi(kk[i + 1]);
                kt0[i >> 1] = pk2(k00 * __expf(bt0 - b00), k10 * __expf(bt0 - b10));
                kt1[i >> 1] = pk2(k01 * __expf(bt1 - b01), k11 * __expf(bt1 - b11));
                if (OUT) {
                    const float q00 = bf_lo(qq[i]), q01 = bf_hi(qq[i]), q10 = bf_lo(qq[i + 1]), q11 = bf_hi(qq[i + 1]);
                    *(LAS unsigned*)(L + L_QD + (8 * w + i) * QD_STRIDE + 4 * lane) = pk2(q00 * __expf(b00), q01 * __expf(b01));
                    *(LAS unsigned*)(L + L_QD + (8 * w + i + 1) * QD_STRIDE + 4 * lane) = pk2(q10 * __expf(b10), q11 * __expf(b11));
                    *(LAS unsigned*)(L + L_KI + (8 * w + i) * QD_STRIDE + 4 * lane) = pk2(k00 * __expf(-b00), k01 * __expf(-b01));
                    *(LAS unsigned*)(L + L_KI + (8 * w + i + 1) * QD_STRIDE + 4 * lane) = pk2(k10 * __expf(-b10), k11 * __expf(-b11));
                }
            }
            *(LAS u32x4*)(L + L_KT + (2 * lane) * KT_STRIDE + 16 * w) = (u32x4){kt0[0], kt0[1], kt0[2], kt0[3]};
            *(LAS u32x4*)(L + L_KT + (2 * lane + 1) * KT_STRIDE + 16 * w) = (u32x4){kt1[0], kt1[1], kt1[2], kt1[3]};
        }
        __syncthreads();
        if (c < 3) GLA_LOAD(tc + 64);
        f32x16 o[2];
        if (OUT) {
            if (w < 3) {
                const int ib = w == 0 ? 0 : 1, jb = w == 2 ? 1 : 0;
                f32x16 sacc;
#pragma unroll
                for (int r = 0; r < 16; ++r) sacc[r] = 0.f;
#pragma unroll
                for (int kb = 0; kb < 8; ++kb) {
                    const bf16x8 a = *(const LAS bf16x8*)(L + L_QD + (32 * ib + r32) * QD_STRIDE + 2 * (16 * kb + 8 * h));
                    const bf16x8 bb = *(const LAS bf16x8*)(L + L_KI + (32 * jb + r32) * QD_STRIDE + 2 * (16 * kb + 8 * h));
                    sacc = __builtin_amdgcn_mfma_f32_32x32x16_bf16(a, bb, sacc, 0, 0, 0);
                }
#pragma unroll
                for (int r = 0; r < 16; r += 1) {
                    const int i = 32 * ib + crow(r, h), j = 32 * jb + r32;
                    const float v = (j <= i) ? sacc[r] : 0.f;
                    *(LAS bf16*)(L + L_SC + i * SC_STRIDE + 2 * j) = (bf16)(pk2(v, 0.f) & 0xffffu);
                }
            }
#pragma unroll
            for (int ib = 0; ib < 2; ++ib)
#pragma unroll
                for (int r = 0; r < 16; ++r) o[ib][r] = 0.f;
#pragma unroll
            for (int kb = 0; kb < 4; ++kb)
#pragma unroll
                for (int s2 = 0; s2 < 2; ++s2) {
                    u32x4 pb; pb.x = pk2(S[kb][8 * s2 + 0], S[kb][8 * s2 + 1]); pb.y = pk2(S[kb][8 * s2 + 2], S[kb][8 * s2 + 3]); pb.z = pk2(S[kb][8 * s2 + 4], S[kb][8 * s2 + 5]); pb.w = pk2(S[kb][8 * s2 + 6], S[kb][8 * s2 + 7]);
                    const bf16x8 bfrag = __builtin_bit_cast(bf16x8, pb);
#pragma unroll
                    for (int ib = 0; ib < 2; ++ib) {
                        const LAS unsigned char* qp = L + L_QD + (32 * ib + r32) * QD_STRIDE + 2 * (32 * kb + 16 * s2 + 4 * h);
                        const u32x2 lo = *(const LAS u32x2*)qp, hi = *(const LAS u32x2*)(qp + 16);
                        const bf16x8 afrag = __builtin_bit_cast(bf16x8, (u32x4){lo.x, lo.y, hi.x, hi.y});
                        o[ib] = __builtin_amdgcn_mfma_f32_32x32x16_bf16(afrag, bfrag, o[ib], 0, 0, 0);
                    }
                }
            __syncthreads();
#pragma unroll
            for (int ks = 0; ks < 4; ++ks)
#pragma unroll
                for (int ib = 0; ib < 2; ++ib) {
                    if (ib == 0 && ks >= 2) continue;
                    const bf16x8 a = *(const LAS bf16x8*)(L + L_SC + (32 * ib + r32) * SC_STRIDE + 2 * (16 * ks + 8 * h));
                    o[ib] = __builtin_amdgcn_mfma_f32_32x32x16_bf16(a, Bv[ks], o[ib], 0, 0, 0);
                }
        }
#pragma unroll
        for (int kb = 0; kb < 4; ++kb) {
#pragma unroll
            for (int g4 = 0; g4 < 4; ++g4) { const f32x4 dc = *(const LAS f32x4*)(L + L_DEC + 4 * (32 * kb + 8 * g4 + 4 * h));
#pragma unroll
                for (int j = 0; j < 4; ++j) S[kb][4 * g4 + j] *= dc[j]; }
#pragma unroll
            for (int ks = 0; ks < 4; ++ks) {
                const bf16x8 a = *(const LAS bf16x8*)(L + L_KT + (32 * kb + r32) * KT_STRIDE + 2 * (16 * ks + 8 * h));
                S[kb] = __builtin_amdgcn_mfma_f32_32x32x16_bf16(a, Bv[ks], S[kb], 0, 0, 0);
            }
        }
        if (c < 3) GLA_LOADV(tc + 64);
        if (OUT) {
#pragma unroll
            for (int ib = 0; ib < 2; ++ib)
#pragma unroll
                for (int r = 0; r < 16; ++r) *(LAS float*)(L + L_OT + (32 * ib + crow(r, h)) * OT_STRIDE + 4 * (32 * w + r32)) = o[ib][r];
            __syncthreads();
            f32x4 ov[8]; float ss = 0.f;
#pragma unroll
            for (int i = 0; i < 8; ++i) { ov[i] = *(const LAS f32x4*)(L + L_OT + tok_n * OT_STRIDE + 4 * (32 * part + 4 * i)); ss += (ov[i].x * ov[i].x + ov[i].y * ov[i].y) + (ov[i].z * ov[i].z + ov[i].w * ov[i].w); }
            ss += __shfl_xor(ss, 1); ss += __shfl_xor(ss, 2); ss += __shfl_xor(ss, 4);
            const float rs = 1.0f / sqrtf(ss * (1.0f / 256.0f) + 1e-6f);
            const size_t trow = (size_t)(tc + tok_n);
            const f32x4* gp = (const f32x4*)(F.g_gla + hd * 256 + 32 * part);
            u32x4* op = (u32x4*)(WSP(bf16, WS_OG) + trow * 1024 + hd * 256 + 32 * part);
#pragma unroll
            for (int i = 0; i < 4; ++i) {
                const u32x4 rr = rc[i]; const f32x4 g0 = gp[2 * i], g1 = gp[2 * i + 1]; const f32x4 a0 = ov[2 * i], a1 = ov[2 * i + 1];
                u32x4 ow;
                ow.x = pk2(a0.x * rs * g0.x * bf_lo(rr.x), a0.y * rs * g0.y * bf_hi(rr.x));
                ow.y = pk2(a0.z * rs * g0.z * bf_lo(rr.y), a0.w * rs * g0.w * bf_hi(rr.y));
                ow.z = pk2(a1.x * rs * g1.x * bf_lo(rr.z), a1.y * rs * g1.y * bf_hi(rr.z));
                ow.w = pk2(a1.z * rs * g1.z * bf_lo(rr.w), a1.w * rs * g1.w * bf_hi(rr.w));
                op[i] = ow;
            }
        }
    }
#undef GLA_LOAD
#undef GLA_LOADV
#undef GLA_LOADR
    if (!OUT) {
#pragma unroll
        for (int kb = 0; kb < 4; ++kb)
#pragma unroll
            for (int r = 0; r < 16; ++r) Sbuf[(kb * 16 + r) * 64 + lane] = S[kb][r];
        if (w == 0) *(f32x2*)(WSP(float, WS_DECS) + item * 128 + 2 * lane) = (f32x2){__expf(btot_run0), __expf(btot_run1)};
    }
    __syncthreads();
}

__device__ __forceinline__ void conv_rows(Frame& F, const int nrep) {
    const int gw = F.vcu * NWAVES + F.wave, NGW = F.G * NWAVES;
    const bf16* Z = WSP(const bf16, WS_Z); bf16* PB = WSP(bf16, WS_PB);
    for (int blk0 = gw; blk0 < (M / 8) * nrep; blk0 += NGW) {
        const int blk = blk0 % (M / 8);
        const int m0 = blk * 8, s0 = m0 % SEQ;
#pragma unroll 1
        for (int j = 0; j < 2; ++j) {
            const int c = 8 * F.lane + 512 * j;
            const size_t rp = (size_t)(s0 > 0 ? m0 - 2 : m0);
            const u32x4 p2c = *(const u32x4*)(Z + ZCC + rp * 1024 + c), p2x = *(const u32x4*)(Z + ZCX + rp * 1024 + c);
            const u32x4 p1c = *(const u32x4*)(Z + ZCC + (rp + 1) * 1024 + c), p1x = *(const u32x4*)(Z + ZCX + (rp + 1) * 1024 + c);
            float w0[8], w1[8], w2[8];
#pragma unroll
            for (int i = 0; i < 8; ++i) { w0[i] = F.w_conv[c + i]; w1[i] = F.w_conv[1024 + c + i]; w2[i] = F.w_conv[2048 + c + i]; }
            float u1[8], u2[8];
            const float keep = s0 > 0 ? 1.0f : 0.0f;
#pragma unroll
            for (int i = 0; i < 4; ++i) { u2[2 * i] = keep * bf_lo(p2c[i]) * bf_lo(p2x[i]); u2[2 * i + 1] = keep * bf_hi(p2c[i]) * bf_hi(p2x[i]); u1[2 * i] = keep * bf_lo(p1c[i]) * bf_lo(p1x[i]); u1[2 * i + 1] = keep * bf_hi(p1c[i]) * bf_hi(p1x[i]); }
#pragma unroll
            for (int hb = 0; hb < 2; ++hb) {
                u32x4 cc[4], cx[4], cb[4];
#pragma unroll
                for (int rr = 0; rr < 4; ++rr) { const size_t row = (size_t)(m0 + 4 * hb + rr); cc[rr] = *(const u32x4*)(Z + ZCC + row * 1024 + c); cx[rr] = *(const u32x4*)(Z + ZCX + row * 1024 + c); cb[rr] = *(const u32x4*)(Z + ZCB + row * 1024 + c); }
#pragma unroll
                for (int rr = 0; rr < 4; ++rr) {
                    float u0[8], y[8];
#pragma unroll
                    for (int i = 0; i < 4; ++i) { u0[2 * i] = bf_lo(cc[rr][i]) * bf_lo(cx[rr][i]); u0[2 * i + 1] = bf_hi(cc[rr][i]) * bf_hi(cx[rr][i]); }
#pragma unroll
                    for (int i = 0; i < 8; ++i) y[i] = w0[i] * u2[i] + w1[i] * u1[i] + w2[i] * u0[i];
                    u32x4 ow;
#pragma unroll
                    for (int i = 0; i < 4; ++i) ow[i] = pk2(bf_lo(cb[rr][i]) * y[2 * i], bf_hi(cb[rr][i]) * y[2 * i + 1]);
                    *(u32x4*)(PB + (size_t)(m0 + 4 * hb + rr) * 1024 + c) = ow;
#pragma unroll
                    for (int i = 0; i < 8; ++i) { u2[i] = u1[i]; u1[i] = u0[i]; }
                }
                asm volatile("" ::: "memory");
            }
        }
    }
}

__device__ __forceinline__ void gla_scan(Frame& F, const int nrep) {
    const float* U = WSP(const float, WS_U); float* SIN = WSP(float, WS_SIN); const float* DECS = WSP(const float, WS_DECS);
    const int gt = F.vcu * 512 + F.tid, NT = F.G * 512;
    for (int idx0 = gt; idx0 < 32 * 32768 * nrep; idx0 += NT) {
        const int idx = idx0 & (32 * 32768 - 1);
        const int bh = idx >> 15, e = idx & 32767;
        const int ln = e & 63, reg = (e >> 6) & 15, kb = (e >> 10) & 3;
        const int dk = 32 * kb + crow(reg, ln >> 5);
        float s = 0.f;
#pragma unroll
        for (int sc = 0; sc < 8; ++sc) {
            const int item = bh * 8 + sc;
            SIN[(size_t)item * 32768 + e] = s;
            s = DECS[item * 128 + dk] * s + U[(size_t)item * 32768 + e];
        }
    }
}

struct EpiM1 {
    static constexpr bool PERM = true;
    const bf16* Z; float* M1;
    __device__ __forceinline__ void operator()(const f32x4 (&acc)[2][2][4][2], const pg8::Unit& u, int wr, int wc, int fr, int fq) const {
        const int row0 = u.pm * 256 + wr * 64 + fr, col0 = u.pn * 256 + wc * 32 + 8 * fq;
#pragma unroll
        for (int ai = 0; ai < 2; ++ai)
#pragma unroll
            for (int m = 0; m < 4; ++m) { const size_t row = (size_t)(row0 + ai * 128 + m * 16);
#pragma unroll
                for (int bj = 0; bj < 2; ++bj) { const u32x4 sg = *(const u32x4*)(Z + ZGA + row * 1024 + col0 + bj * 128);
                    const f32x4 v0 = acc[ai][bj][m][0], v1 = acc[ai][bj][m][1];
                    float* mp = M1 + row * 1024 + col0 + bj * 128;
                    *(f32x4*)mp = (f32x4){v0[0] * bf_lo(sg.x), v0[1] * bf_hi(sg.x), v0[2] * bf_lo(sg.y), v0[3] * bf_hi(sg.y)};
                    *(f32x4*)(mp + 4) = (f32x4){v1[0] * bf_lo(sg.z), v1[1] * bf_hi(sg.z), v1[2] * bf_lo(sg.w), v1[3] * bf_hi(sg.w)}; } }
    }
};
struct EpiMix {
    static constexpr bool PERM = true;
    const bf16* Z; const float* M1; bf16* MIX;
    __device__ __forceinline__ void operator()(const f32x4 (&acc)[2][2][4][2], const pg8::Unit& u, int wr, int wc, int fr, int fq) const {
        const int row0 = u.pm * 256 + wr * 64 + fr, col0 = u.pn * 256 + wc * 32 + 8 * fq;
#pragma unroll
        for (int ai = 0; ai < 2; ++ai)
#pragma unroll
            for (int m = 0; m < 4; ++m) { const size_t row = (size_t)(row0 + ai * 128 + m * 16);
#pragma unroll
                for (int bj = 0; bj < 2; ++bj) { const u32x4 sg = *(const u32x4*)(Z + ZGB + row * 1024 + col0 + bj * 128);
                    const f32x4 v0 = acc[ai][bj][m][0], v1 = acc[ai][bj][m][1];
                    const float* mp = M1 + row * 1024 + col0 + bj * 128;
                    const f32x4 m0 = *(const f32x4*)mp, m1 = *(const f32x4*)(mp + 4);
                    u32x4 w;
                    w.x = pk2(m0[0] + v0[0] * bf_lo(sg.x), m0[1] + v0[1] * bf_hi(sg.x)); w.y = pk2(m0[2] + v0[2] * bf_lo(sg.y), m0[3] + v0[3] * bf_hi(sg.y));
                    w.z = pk2(m1[0] + v1[0] * bf_lo(sg.z), m1[1] + v1[1] * bf_hi(sg.z)); w.w = pk2(m1[2] + v1[2] * bf_lo(sg.w), m1[3] + v1[3] * bf_hi(sg.w));
                    *(u32x4*)(MIX + row * 1024 + col0 + bj * 128) = w; } }
    }
};
struct EpiX1 {
    static constexpr bool PERM = false;
    const float* x; float* X1;
    __device__ __forceinline__ void operator()(const f32x4 (&acc)[2][2][4][2], const pg8::Unit& u, int wr, int wc, int fr, int fq) const {
        const int row0 = u.pm * 256 + wr * 64 + fr, col0 = u.pn * 256 + wc * 32 + 4 * fq;
#pragma unroll
        for (int ai = 0; ai < 2; ++ai)
#pragma unroll
            for (int m = 0; m < 4; ++m) { const size_t off = (size_t)(row0 + ai * 128 + m * 16) * 1024 + col0;
#pragma unroll
                for (int bj = 0; bj < 2; ++bj)
#pragma unroll
                    for (int n = 0; n < 2; ++n) { const f32x4 xs = *(const f32x4*)(x + off + bj * 128 + n * 16); *(f32x4*)(X1 + off + bj * 128 + n * 16) = xs + acc[ai][bj][m][n]; } }
    }
};

constexpr int WRT_LD = 1028;
__device__ __forceinline__ float reduce32(float (&a)[32], int lane) {
#pragma unroll
    for (int q = 0; q < 16; ++q) { const bool up = (lane & 32) != 0; const float send = up ? a[q] : a[q + 16]; const float keep = up ? a[q + 16] : a[q]; a[q] = keep + __shfl_xor(send, 32); }
#pragma unroll
    for (int q = 0; q < 8; ++q) { const bool up = (lane & 16) != 0; const float send = up ? a[q] : a[q + 8]; const float keep = up ? a[q + 8] : a[q]; a[q] = keep + __shfl_xor(send, 16); }
#pragma unroll
    for (int q = 0; q < 4; ++q) { const bool up = (lane & 8) != 0; const float send = up ? a[q] : a[q + 4]; const float keep = up ? a[q + 4] : a[q]; a[q] = keep + __shfl_xor(send, 8); }
#pragma unroll
    for (int q = 0; q < 2; ++q) { const bool up = (lane & 4) != 0; const float send = up ? a[q] : a[q + 2]; const float keep = up ? a[q + 2] : a[q]; a[q] = keep + __shfl_xor(send, 4); }
    { const bool up = (lane & 2) != 0; const float send = up ? a[0] : a[1]; const float keep = up ? a[1] : a[0]; a[0] = keep + __shfl_xor(send, 2); }
    return a[0] + __shfl_xor(a[0], 1);
}
__device__ __forceinline__ void route_token(float lg, int lane, int tl, size_t m, LAS int* hist, LAS int* ple, float* gate) {
    const int myi = lane >> 1;
    float tv[4]; int ti[4];
#pragma unroll
    for (int k = 0; k < 4; ++k) {
        float bv = lg; int bi = myi;
#pragma unroll
        for (int off = 32; off >= 2; off >>= 1) { const float ov = __shfl_xor(bv, off); const int oi = __shfl_xor(bi, off); if (ov > bv || (ov == bv && oi < bi)) { bv = ov; bi = oi; } }
        tv[k] = bv; ti[k] = bi;
        if (myi == bi) lg = -3.0e38f;
    }
    const float e1 = __expf(tv[1] - tv[0]), e2 = __expf(tv[2] - tv[0]), e3 = __expf(tv[3] - tv[0]);
    const float inv = 1.0f / (1.0f + e1 + e2 + e3);
    if (lane < 4) {
        const int ek = lane == 0 ? ti[0] : (lane == 1 ? ti[1] : (lane == 2 ? ti[2] : ti[3]));
        const float gk = (lane == 0 ? 1.0f : (lane == 1 ? e1 : (lane == 2 ? e2 : e3))) * inv;
        const int lr = __hip_atomic_fetch_add(&hist[ek], 1, __ATOMIC_RELAXED, __HIP_MEMORY_SCOPE_WORKGROUP);
        ple[tl * 4 + lane] = ek | (lr << 8);
        gate[m * 4 + lane] = gk;
    }
}
__device__ __forceinline__ void p5_router(Frame& F) {
    LAS float* WrT = (LAS float*)F.lds;
    LAS int* hist = (LAS int*)(F.lds + EXTRA_OFF + 1024);
    LAS int* base = (LAS int*)(F.lds + EXTRA_OFF + 1024 + 128);
    LAS int* ple = (LAS int*)(F.lds + EXTRA_OFF + 1024 + 256);
    for (int i = 0; i < 64; ++i) { const int idx = F.tid + 512 * i, k = idx >> 5, e = idx & 31; WrT[e * WRT_LD + k] = F.w_router[idx]; }
    f32x4 g[4];
#pragma unroll
    for (int j = 0; j < 4; ++j) g[j] = *((const f32x4*)F.g_ffn + F.lane + 64 * j);
    const float brl = F.b_router[F.lane >> 1];
    const float* X1 = WSP(const float, WS_X1); unsigned char* H2 = WSP(unsigned char, WS_XN);
    unsigned* cnt = F.ctl + CW_CNT; int* list = WSP(int, WS_LIST); float* gate = WSP(float, WS_GATE);
    const int lane = F.lane;
    for (int grp = F.vcu; grp < M / 64; grp += F.G) {
        if (F.tid < 32) hist[F.tid] = 0;
        __syncthreads();
        f32x4 nx0[4], nx1[4];
        { const f32x4* xa = (const f32x4*)(X1 + (size_t)(grp * 64 + 8 * F.wave) * D) + lane;
#pragma unroll
          for (int j = 0; j < 4; ++j) { nx0[j] = xa[64 * j]; nx1[j] = xa[256 + 64 * j]; } }
#pragma unroll 1
        for (int i2 = 0; i2 < 4; ++i2) {
            f32x4 v0[4], v1[4];
#pragma unroll
            for (int j = 0; j < 4; ++j) { v0[j] = nx0[j]; v1[j] = nx1[j]; }
            if (i2 < 3) { const f32x4* xa = (const f32x4*)(X1 + (size_t)(grp * 64 + 8 * F.wave + 2 * i2 + 2) * D) + lane;
#pragma unroll
                for (int j = 0; j < 4; ++j) { nx0[j] = xa[64 * j]; nx1[j] = xa[256 + 64 * j]; } }
            { float s0 = 0.f, s1 = 0.f;
#pragma unroll
              for (int j = 0; j < 4; ++j) {
                  s0 += (v0[j].x * v0[j].x + v0[j].y * v0[j].y) + (v0[j].z * v0[j].z + v0[j].w * v0[j].w); s1 += (v1[j].x * v1[j].x + v1[j].y * v1[j].y) + (v1[j].z * v1[j].z + v1[j].w * v1[j].w); }
              const float r0 = 1.0f / sqrtf(wave_sum(s0) * (1.f / D) + 1e-6f), r1 = 1.0f / sqrtf(wave_sum(s1) * (1.f / D) + 1e-6f);
              const size_t m0 = (size_t)(grp * 64 + 8 * F.wave + 2 * i2);
              unsigned* o0 = (unsigned*)(H2 + m0 * D) + lane; unsigned* o1 = (unsigned*)(H2 + (m0 + 1) * D) + lane;
#pragma unroll
              for (int j = 0; j < 4; ++j) { v0[j] = v0[j] * r0 * g[j]; v1[j] = v1[j] * r1 * g[j];
                  o0[64 * j] = pk4_fp8(v0[j].x, v0[j].y, v0[j].z, v0[j].w);
                  o1[64 * j] = pk4_fp8(v1[j].x, v1[j].y, v1[j].z, v1[j].w); } }
            float a0[32], a1[32];
#pragma unroll
            for (int e4 = 0; e4 < 8; ++e4) {
#pragma unroll
                for (int ee = 0; ee < 4; ++ee) { const int e = 4 * e4 + ee; float t0 = 0.f, t1 = 0.f;
#pragma unroll
                    for (int j = 0; j < 4; ++j) { const f32x4 wv = *(const LAS f32x4*)(WrT + e * WRT_LD + 256 * j + 4 * lane);
                        t0 += (v0[j].x * wv.x + v0[j].y * wv.y) + (v0[j].z * wv.z + v0[j].w * wv.w); t1 += (v1[j].x * wv.x + v1[j].y * wv.y) + (v1[j].z * wv.z + v1[j].w * wv.w); }
                    a0[e] = t0; a1[e] = t1; }
                asm volatile("" ::: "memory");
            }
            const float l0 = reduce32(a0, lane) + brl, l1 = reduce32(a1, lane) + brl;
            const int tl = 8 * F.wave + 2 * i2;
            route_token(l0, lane, tl, (size_t)(grp * 64 + tl), hist, ple, gate);
            route_token(l1, lane, tl + 1, (size_t)(grp * 64 + tl + 1), hist, ple, gate);
        }
        __syncthreads();
        if (F.tid < 32) base[F.tid] = (int)__hip_atomic_fetch_add(cnt + F.tid, (unsigned)hist[F.tid], RLX_AGENT);
        __syncthreads();
        if (F.tid < 256) { const int pe = ple[F.tid], e = pe & 255, lr = pe >> 8; list[e * CAP + base[e] + lr] = (grp * 64) * 4 + F.tid; }
        __syncthreads();
    }
}

#ifndef MK_MAXU
#define MK_MAXU 12
#endif
constexpr int MAXU = MK_MAXU;
template <int NP>
struct MoeOrder {
    LAS const int* rt0;
    LAS const int* tokl;
    int nwg, G, c, reps;
    __device__ __forceinline__ bool next(int i, pg8::Unit& u) const {
        const long L = (long)i * G + c; if (L >= (long)nwg * reps) return false;
        int wgid = (int)(L % nwg); { const int q = nwg / 8, r = nwg % 8, xcd = wgid % 8, off = wgid / 8; wgid = (xcd < r ? xcd * (q + 1) : r * (q + 1) + (xcd - r) * q) + off; }
        int e = 0;
#pragma unroll 1
        for (int j = 1; j < 32; ++j) if (wgid >= NP * rt0[j]) e = j;
        const int l = wgid - NP * rt0[e], nte = rt0[e + 1] - rt0[e];
        const int pn = l / nte, rt = l - pn * nte;
        u.pm = __builtin_amdgcn_readfirstlane(rt0[e] + rt); u.pn = __builtin_amdgcn_readfirstlane(e * NP + pn); u.e = __builtin_amdgcn_readfirstlane(e); u.rt = __builtin_amdgcn_readfirstlane(rt); return true;
    }
};
struct MoeOrder1 : MoeOrder<8> {
    __device__ __forceinline__ unsigned arow(const pg8::Unit& u, int ui, int r) const { return (unsigned)tokl[ui * 256 + r] * 1024u; }
};
struct MoeOrder2 : MoeOrder<4> {
    __device__ __forceinline__ unsigned arow(const pg8::Unit& u, int ui, int r) const { return (unsigned)(u.pm * 256 + r) * 1024u; }
};
struct EpiAct {
    static constexpr bool PERM = true;
    const float* b_gu; unsigned char* ACT;
    __device__ __forceinline__ void operator()(const f32x4 (&acc)[2][2][4][2], const pg8::Unit& u, int wr, int wc, int fr, int fq) const {
        const int pn = u.pn & 7, cl = pn * 128 + wc * 32 + 8 * fq;
        const int row0 = u.pm * 256 + wr * 64 + fr;
        const f32x4 bg0 = *(const f32x4*)(b_gu + u.e * 2048 + cl), bg1 = *(const f32x4*)(b_gu + u.e * 2048 + cl + 4);
        const f32x4 bl0 = *(const f32x4*)(b_gu + u.e * 2048 + 1024 + cl), bl1 = *(const f32x4*)(b_gu + u.e * 2048 + 1024 + cl + 4);
#pragma unroll
        for (int ai = 0; ai < 2; ++ai)
#pragma unroll
            for (int m = 0; m < 4; ++m) {
                f32x4 g0 = acc[ai][0][m][0] + bg0, g1 = acc[ai][0][m][1] + bg1, l0 = acc[ai][1][m][0] + bl0, l1 = acc[ai][1][m][1] + bl1;
                float r0[4], r1[4];
#pragma unroll
                for (int j = 0; j < 4; ++j) {
                    const float ga = fminf(g0[j], 7.0f), gb = fminf(g1[j], 7.0f);
                    const float la = fminf(fmaxf(l0[j], -7.0f), 7.0f), lb = fminf(fmaxf(l1[j], -7.0f), 7.0f);
                    r0[j] = (la + 1.0f) * (ga * fast_sigmoid(1.702f * ga)); r1[j] = (lb + 1.0f) * (gb * fast_sigmoid(1.702f * gb));
                }
                u32x2 w; w.x = pk4_fp8(r0[0], r0[1], r0[2], r0[3]); w.y = pk4_fp8(r1[0], r1[1], r1[2], r1[3]);
                *(u32x2*)(ACT + (size_t)(row0 + ai * 128 + m * 16) * 1024 + cl) = w;
            }
    }
};
struct EpiYP {
    static constexpr bool PERM = true;
    const float* b_d; const unsigned* cnt; const int* list; const float* gate; bf16* YP;
    __device__ __forceinline__ void operator()(const f32x4 (&acc)[2][2][4][2], const pg8::Unit& u, int wr, int wc, int fr, int fq) const {
        const int pn = u.pn & 3, col0 = pn * 256 + wc * 32 + 8 * fq;
        const int ne = (int)cnt[u.e];
        f32x4 bv[2][2];
#pragma unroll
        for (int bj = 0; bj < 2; ++bj)
#pragma unroll
            for (int n = 0; n < 2; ++n) bv[bj][n] = *(const f32x4*)(b_d + u.e * 1024 + col0 + bj * 128 + 4 * n);
#pragma unroll
        for (int ai = 0; ai < 2; ++ai)
#pragma unroll
            for (int m = 0; m < 4; ++m) {
                const int slot = u.rt * 256 + ai * 128 + wr * 64 + m * 16 + fr;
                if (slot < ne) {
                    const int pid = list[u.e * CAP + slot]; const float gw = gate[pid];
#pragma unroll
                    for (int bj = 0; bj < 2; ++bj) { const f32x4 v0 = (acc[ai][bj][m][0] + bv[bj][0]) * gw, v1 = (acc[ai][bj][m][1] + bv[bj][1]) * gw;
                        u32x4 w; w.x = pk2(v0[0], v0[1]); w.y = pk2(v0[2], v0[3]); w.z = pk2(v1[0], v1[1]); w.w = pk2(v1[2], v1[3]);
                        *(u32x4*)(YP + (size_t)pid * 1024 + col0 + bj * 128) = w; }
                }
            }
    }
};
__device__ __forceinline__ int moe_setup(Frame& F, LAS int* rt0) {
    if (F.tid == 0) { int acc = 0; for (int e = 0; e < 32; ++e) { rt0[e] = acc; acc += ((int)F.ctl[CW_CNT + e] + 255) >> 8; } rt0[32] = acc; }
    __syncthreads();
    return rt0[32];
}

__device__ __forceinline__ void p8_final(Frame& F, const int nrep) {
    const int gw = F.vcu * NWAVES + F.wave, NGW = F.G * NWAVES;
    const float* X1 = WSP(const float, WS_X1); const bf16* YP = WSP(const bf16, WS_YP);
    f32x4 g[4];
#pragma unroll
    for (int j = 0; j < 4; ++j) g[j] = *((const f32x4*)F.g_final + F.lane + 64 * j);
    float pscale = 1.0f;
#ifdef MK_TPROBE
    { const unsigned long long* st = (const unsigned long long*)(F.ctl + CW_STAMP); const float dt_us = (float)(st[MK_TPROBE_J] - st[MK_TPROBE_I]) * 0.01f; pscale = 1.0f + sqrtf(dt_us * 1e-5f); }
#endif
    for (int m0 = gw; m0 < M * nrep; m0 += NGW) {
        const int m = m0 % M;
        const f32x4* xr = (const f32x4*)(X1 + (size_t)m * D) + F.lane;
        f32x4 v[4]; float s = 0.f;
#pragma unroll
        for (int j = 0; j < 4; ++j) v[j] = xr[64 * j];
#pragma unroll
        for (int k = 0; k < 4; ++k) { const u32x2* yr = (const u32x2*)(YP + ((size_t)m * 4 + k) * 1024) + F.lane;
#pragma unroll
            for (int j = 0; j < 4; ++j) { const u32x2 y = yr[64 * j]; v[j].x += bf_lo(y.x); v[j].y += bf_hi(y.x); v[j].z += bf_lo(y.y); v[j].w += bf_hi(y.y); } }
#pragma unroll
        for (int j = 0; j < 4; ++j) s += (v[j].x * v[j].x + v[j].y * v[j].y) + (v[j].z * v[j].z + v[j].w * v[j].w);
        const float rstd = 1.0f / sqrtf(wave_sum(s) * (1.f / D) + 1e-6f);
        f32x4* op = (f32x4*)(F.out + (size_t)m * D) + F.lane;
#pragma unroll
        for (int j = 0; j < 4; ++j) op[64 * j] = v[j] * (rstd * pscale) * g[j];
    }
}

struct Args { const float* in[18]; float* out; unsigned char* ws; int ph_lo, ph_hi, rep_k, rep_n; };
__global__ void __launch_bounds__(NWAVES * 64, 2) mk_fwd(Args args) {
    extern __shared__ __attribute__((aligned(16))) unsigned char lds[];
    Frame F;
    F.lds = (LAS unsigned char*)lds;
    F.MISC = (volatile LAS unsigned*)(F.lds + MISC_OFF);
    F.tid = threadIdx.x; F.lane = F.tid & 63; F.wave = __builtin_amdgcn_readfirstlane(F.tid >> 6);
    F.G = gridDim.x; { const int bx = blockIdx.x; F.vcu = (F.G % 8 == 0) ? (bx % 8) * (F.G / 8) + bx / 8 : bx; }
    F.ws = args.ws; F.ctl = (unsigned*)(args.ws + WS_CTL);
    F.x = args.in[0]; F.g_mix = args.in[1]; F.w_in = args.in[2]; F.w_up = args.in[3]; F.b_alpha = args.in[4]; F.g_gla = args.in[5]; F.w_conv = args.in[6];
    F.w_a = args.in[7]; F.w_b = args.in[8]; F.w_out = args.in[9]; F.g_ffn = args.in[10]; F.w_router = args.in[11]; F.b_router = args.in[12];
    F.w_gu = args.in[13]; F.b_gu = args.in[14]; F.w_d = args.in[15]; F.b_d = args.in[16]; F.g_final = args.in[17]; F.out = args.out;
    if (F.tid < 128) ((LAS unsigned*)(F.lds + MISC_OFF))[F.tid] = 0u;
    __syncthreads();
    XcdBarrier bar; bar.bar = F.ctl + CW_BAR; bar.x = 0; bar.st = nullptr;
    if (N_LAUNCHES == 1) bar = xcd_barrier_post(F.ctl + CW_BAR, F.MISC + 8);
    const int lo = args.ph_lo, hi = args.ph_hi;
#ifdef MK_ONLY
#define IN(k) ((k) == MK_ONLY && lo <= (k) && (k) < hi)
#else
#define IN(k) (lo <= (k) && (k) < hi)
#endif
#define REPS(k) (((k) == args.rep_k) ? 1 + args.rep_n : 1)
#if defined(MK_TPROBE) || defined(MK_DELAY_K)
#define STAMP(k) do { if (blockIdx.x == 0 && F.tid == 0) ((unsigned long long*)(F.ctl + CW_STAMP))[k] = __builtin_amdgcn_s_memrealtime(); } while (0)
#else
#define STAMP(k) do { } while (0)
#endif
#ifdef MK_DELAY_K
#define DELAY(k) do { if ((k) == MK_DELAY_K) { const unsigned long long dl = __hip_atomic_load((unsigned long long*)(F.ctl + CW_STAMP), RLX_AGENT) + (unsigned long long)(MK_DELAY_US) * 100ull; \
    while (__builtin_amdgcn_s_memrealtime() < dl) __builtin_amdgcn_s_sleep(8); } } while (0)
#else
#define DELAY(k) do { } while (0)
#endif
#define SEAM(k) do { if (IN(k) && IN((k) + 1)) xcd_barrier(bar); STAMP((k) + 1); DELAY(k); } while (0)

    STAMP(0);
    if (IN(0)) { p0_prologue(F, REPS(0), REPS(11)); SEAM(0); }
    if (IN(1)) { const int nrep = REPS(1);
        pg8::StaticOrder S; S.init(M, NZ, D, F.G, (int)blockIdx.x, nrep);
        EpiZ E{WSP(bf16, WS_Z)};
        pg8::gemm_phase<EpiZ, pg8::StaticOrder, true>(F.lds, WSP(const bf16, WS_XN), WSP(const bf16, WS_WIN), D, S, E);
        SEAM(1);
    }
    if (IN(2)) { const int nrep = REPS(2); for (int it = F.vcu; it < 256 * nrep; it += F.G) gla_item<false>(F, it & 255); conv_rows(F, REPS(12)); SEAM(2); }
    if (IN(3)) { gla_scan(F, REPS(3)); SEAM(3); }
    if (IN(4)) { const int nrep = REPS(4); for (int it = F.vcu; it < 256 * nrep; it += F.G) gla_item<true>(F, it & 255); SEAM(4); }
    if (IN(5)) { const int nrep = REPS(5);
        pg8::StaticOrder S; S.init(M, D, D, F.G, (int)blockIdx.x, nrep);
        EpiM1 E1{WSP(const bf16, WS_Z), WSP(float, WS_M1)};
        pg8::gemm_phase<EpiM1, pg8::StaticOrder, false>(F.lds, WSP(const bf16, WS_OG), WSP(const bf16, WS_WA), D, S, E1);
        EpiMix E2{WSP(const bf16, WS_Z), WSP(const float, WS_M1), WSP(bf16, WS_MIX)};
        pg8::gemm_phase<EpiMix, pg8::StaticOrder, false>(F.lds, WSP(const bf16, WS_PB), WSP(const bf16, WS_WB), D, S, E2);
        SEAM(5);
    }
    if (IN(6)) { const int nrep = REPS(6);
        pg8::StaticOrder S; S.init(M, D, D, F.G, (int)blockIdx.x, nrep);
        EpiX1 E{F.x, WSP(float, WS_X1)};
        pg8::gemm_phase<EpiX1, pg8::StaticOrder, false>(F.lds, WSP(const bf16, WS_MIX), WSP(const bf16, WS_WO), D, S, E);
        SEAM(6);
    }
    if (IN(7)) { p5_router(F); SEAM(7); }
    if (IN(8)) { const int nrep = REPS(8);
        LAS int* rt0 = (LAS int*)(F.lds + EXTRA_OFF); LAS int* tokl = (LAS int*)(F.lds + EXTRA_OFF + 256);
        const int R = moe_setup(F, rt0);
        MoeOrder1 S; S.rt0 = rt0; S.tokl = tokl; S.nwg = R * 8; S.G = F.G; S.c = (int)blockIdx.x; S.reps = nrep;
        const int* list = WSP(const int, WS_LIST);
        { pg8::Unit u; for (int ui = 0; ui < MAXU && S.next(ui, u); ++ui) if (F.tid < 256) { const int slot = u.rt * 256 + F.tid; tokl[ui * 256 + F.tid] = slot < (int)F.ctl[CW_CNT + u.e] ? (list[u.e * CAP + slot] >> 2) : 0; } }
        __syncthreads();
        EpiAct E{F.b_gu, WSP(unsigned char, WS_ACT)};
        pg8::gemm_phase<EpiAct, MoeOrder1, true, true, 122>(F.lds, WSP(const void, WS_XN), WSP(const void, WS_WGU), D, S, E);
        SEAM(8);
    }
    if (IN(9)) { const int nrep = REPS(9);
        LAS int* rt0 = (LAS int*)(F.lds + EXTRA_OFF);
        const int R = moe_setup(F, rt0);
        MoeOrder2 S; S.rt0 = rt0; S.tokl = nullptr; S.nwg = R * 4; S.G = F.G; S.c = (int)blockIdx.x; S.reps = nrep;
        EpiYP E{F.b_d, F.ctl + CW_CNT, WSP(const int, WS_LIST), WSP(const float, WS_GATE), WSP(bf16, WS_YP)};
        pg8::gemm_phase<EpiYP, MoeOrder2, true, true, 122>(F.lds, WSP(const void, WS_ACT), WSP(const void, WS_WD), D, S, E);
        SEAM(9);
    }
    if (IN(10)) { p8_final(F, REPS(10)); }
#undef IN
#undef SEAM
}

extern "C" void kernel_launch(void* const* d_in, const int* in_sizes, int n_in, void* d_out, int out_size, void* d_ws, size_t ws_size, hipStream_t stream) {
    static int grid = 0;
    if (grid == 0) {
        if (n_in != 18 || out_size != M * D || ws_size < WS_END) { fprintf(stderr, "kernel_launch: unexpected shapes (n_in %d, out %d, ws %zu < %zu)\n", n_in, out_size, ws_size, (size_t)WS_END); grid = -1; return; }
        int dev = 0, cus = 0, per_cu = 0;
        if (hipGetDevice(&dev) != hipSuccess || hipDeviceGetAttribute(&cus, hipDeviceAttributeMultiprocessorCount, dev) != hipSuccess) { grid = -1; return; }
        if (hipFuncSetAttribute((const void*)mk_fwd, hipFuncAttributeMaxDynamicSharedMemorySize, LDS_BYTES) != hipSuccess) { fprintf(stderr, "kernel_launch: hipFuncSetAttribute(%d B LDS) failed\n", LDS_BYTES); grid = -1; return; }
        if (hipOccupancyMaxActiveBlocksPerMultiprocessor(&per_cu, (const void*)mk_fwd, NWAVES * 64, LDS_BYTES) != hipSuccess || per_cu < 1) fprintf(stderr, "kernel_launch: occupancy query says %d\n", per_cu);
        (void)hipGetLastError();
        grid = cus;
        if (grid != 256) fprintf(stderr, "kernel_launch: %d CUs (built for 256)\n", grid);
    }
    if (grid < 0) return;
    (void)hipMemsetAsync((char*)d_ws + WS_CTL, 0, CTL_ZERO_BYTES, stream);
    Args a{};
    for (int i = 0; i < 18; ++i) a.in[i] = (const float*)d_in[i];
    a.out = (float*)d_out; a.ws = (unsigned char*)d_ws;
#ifdef MK_REPEAT
    a.rep_k = MK_REPEAT; a.rep_n = MK_REPEAT_N;
#else
    a.rep_k = -1; a.rep_n = 0;
#endif
    for (int li = 0; li < N_LAUNCHES; ++li) {
        a.ph_lo = (N_LAUNCHES == 1) ? 0 : li; a.ph_hi = (N_LAUNCHES == 1) ? NPH : li + 1;
        hipLaunchKernelGGL(mk_fwd, dim3(grid), dim3(NWAVES * 64), LDS_BYTES, stream, a);
    }
}
```

```cpp
#include <hip/hip_runtime.h>
#include <cstdio>
#include <cstdint>

#ifndef MK_N_LAUNCHES
#define MK_N_LAUNCHES 1
#endif

#define LAS __attribute__((address_space(3)))
#define GAS __attribute__((address_space(1)))
typedef unsigned short bf16;
typedef short bf16x8 __attribute__((ext_vector_type(8)));
typedef float f32x4 __attribute__((ext_vector_type(4)));
typedef float f32x2 __attribute__((ext_vector_type(2)));
typedef float f32x16 __attribute__((ext_vector_type(16)));
typedef unsigned u32x4 __attribute__((ext_vector_type(4)));
typedef unsigned u32x2 __attribute__((ext_vector_type(2)));
typedef __bf16 bf16x2_t __attribute__((ext_vector_type(2)));
typedef int v8i32 __attribute__((ext_vector_type(8)));

constexpr int NWAVES = 8;
constexpr int M = 16384, D = 1024, SEQ = 2048;
constexpr int NZS = 8208;
constexpr int NZ = 8192;
constexpr int NE = 32, CAP = 16384;
constexpr int NPH = 11;
constexpr int N_LAUNCHES = MK_N_LAUNCHES;
constexpr size_t ZQ = 0, ZK = ZQ + (size_t)4 * M * 128, ZV = ZK + (size_t)4 * M * 128, ZR = ZV + (size_t)4 * M * 256, ZCB = ZR + (size_t)4 * M * 256, ZCC = ZCB + (size_t)M * 1024, ZCX = ZCC + (size_t)M * 1024, ZGA = ZCX + (size_t)M * 1024, ZGB = ZGA + (size_t)M * 1024;

constexpr size_t MiB = 1u << 20;
constexpr size_t WS_CTL = 0, CTL_ZERO_BYTES = 65536;
constexpr size_t WS_LIST = 1 * MiB;
constexpr size_t WS_GATE = 3 * MiB;
constexpr size_t WS_DECS = 4 * MiB;
constexpr size_t WS_WIN = 16 * MiB;
constexpr size_t WS_WA = 32 * MiB, WS_WB = 34 * MiB, WS_WO = 36 * MiB;
constexpr size_t WS_WGU = 40 * MiB;
constexpr size_t WS_WD = 168 * MiB;
constexpr size_t WS_XN = 232 * MiB;
constexpr size_t WS_LA = 264 * MiB;
constexpr size_t WS_Z = 296 * MiB;
constexpr size_t WS_YP = WS_Z;
constexpr size_t WS_U = 552 * MiB;
constexpr size_t WS_SIN = 584 * MiB;
constexpr size_t WS_OG = 616 * MiB;
constexpr size_t WS_PB = 648 * MiB;
constexpr size_t WS_M1 = 680 * MiB;
constexpr size_t WS_MIX = 744 * MiB;
constexpr size_t WS_X1 = 776 * MiB;
constexpr size_t WS_ACT = 840 * MiB;
constexpr size_t WS_END = 984 * MiB;
constexpr int CW_TMO = 0;
constexpr int CW_BAR = 4096;
constexpr int CW_CNT = 8192;
constexpr int CW_STAMP = 12288;

constexpr int RING_BYTES = 131072;
constexpr int EXTRA_OFF = RING_BYTES;
constexpr int LDS_BYTES = 155648 + 512;
constexpr int MISC_OFF = 155648;

#define RLX_AGENT __ATOMIC_RELAXED, __HIP_MEMORY_SCOPE_AGENT
#define LDS_WAIT() asm volatile("s_waitcnt lgkmcnt(0)" ::: "memory")
#define VM_WAIT() asm volatile("s_waitcnt vmcnt(0)" ::: "memory")
__device__ __forceinline__ unsigned pk2(float lo, float hi) { f32x2 v = {lo, hi}; bf16x2_t b = __builtin_convertvector(v, bf16x2_t); return __builtin_bit_cast(unsigned, b); }
__device__ __forceinline__ unsigned pk4_fp8(float a, float b, float c, float d) { int w = 0; w = __builtin_amdgcn_cvt_pk_fp8_f32(a, b, w, false); w = __builtin_amdgcn_cvt_pk_fp8_f32(c, d, w, true); return (unsigned)w; }
__device__ __forceinline__ float bf_lo(unsigned w) { return __builtin_bit_cast(float, w << 16); }
__device__ __forceinline__ float bf_hi(unsigned w) { return __builtin_bit_cast(float, w & 0xffff0000u); }
__device__ __forceinline__ float bf1(bf16 b) { return __builtin_bit_cast(float, ((unsigned)b) << 16); }
__device__ __forceinline__ float fast_sigmoid(float x) { return __builtin_amdgcn_rcpf(1.0f + __expf(-x)); }
__device__ __forceinline__ float wave_sum(float v) {
#pragma unroll
    for (int o = 1; o < 64; o <<= 1) v += __shfl_xor(v, o);
    return v;
}

namespace pg8 {
constexpr int BM = 256, BK = 64, HALF = 128, HTB = HALF * BK * 2, STAGE_BYTES = 8 * HTB, NXCD = 8, WGM = 8;
__device__ __forceinline__ int lds_byte(int r, int c) { const int st = (r >> 4) * 2 + (c >> 5), rr = r & 15, cc = c & 31, ob = rr * 64 + cc * 2; return st * 1024 + (ob ^ (((ob >> 9) & 1) << 5)); }
__device__ __forceinline__ void stage_rc(int b, int& R, int& C) { const int st = b / 1024, sb = b % 1024, swz = sb ^ (((sb >> 9) & 1) << 5); R = (st >> 1) * 16 + swz / 64; C = (st & 1) * 32 + (swz % 64) / 2; }
__device__ __forceinline__ int perm32(int rho) { const int n = rho >> 4, i = rho & 15; return 8 * (i >> 2) + 4 * n + (i & 3); }

struct Unit { int pm, pn, e, rt; };

struct StaticOrder {
    int nM, nN, nwg, G, c, K, reps;
    __device__ __forceinline__ void init(int M_, int N_, int K_, int G_, int c_, int reps_) { nM = M_ / BM; nN = N_ / BM; nwg = nM * nN; G = G_; c = c_; K = K_; reps = reps_; }
    __device__ __forceinline__ bool next(int i, Unit& u) const {
        const long L = (long)i * G + c; if (L >= (long)nwg * reps) return false;
        int wgid = (int)(L % nwg); { const int q = nwg / NXCD, r = nwg % NXCD, xcd = wgid % NXCD, off = wgid / NXCD; wgid = (xcd < r ? xcd * (q + 1) : r * (q + 1) + (xcd - r) * q) + off; }
        const int nig = WGM * nN, gid = wgid / nig, fm = gid * WGM, gsz = (nM - fm) < WGM ? (nM - fm) : WGM;
        u.pm = fm + ((wgid % nig) % gsz); u.pn = (wgid % nig) / gsz; u.e = 0; u.rt = 0; return true;
    }
    __device__ __forceinline__ unsigned arow(const Unit& u, int ui, int r) const { return (unsigned)(u.pm * BM + r) * (unsigned)(K * 2); }
    __device__ __forceinline__ void after_unit(int ui) const {}
};

template <class Epi, class Sched, bool ALIGN_EPI, bool FP8 = false, int SCW = 127>
__device__ __forceinline__ void gemm_phase(LAS unsigned char* lds, const void* Ag, const void* Btg, const int K, const Sched& S, const Epi& E) {
    const int tid = threadIdx.x, wid = __builtin_amdgcn_readfirstlane(tid >> 6), lane = tid & 63, wr = wid >> 2, wc = wid & 3, fr = lane & 15, fq = lane >> 4;
    const int RB = FP8 ? K : 2 * K;
    const int nt = RB / 128;
    int RA[2], CA[2]; unsigned voffB[2];
#pragma unroll
    for (int i = 0; i < 2; ++i) { int R, C; stage_rc(tid * 16 + i * 8192, R, C); const int Rb = Epi::PERM ? ((R & ~31) + perm32(R & 31)) : R;
        RA[i] = R; CA[i] = C * 2; voffB[i] = (unsigned)(Rb * RB + C * 2); }
    const size_t kstep = (size_t)(BK * 2);
    const size_t hstep = (size_t)HALF * RB;
    const size_t tstep = 2 * hstep;
    const unsigned ldsw = (unsigned)wid * 1024u;
    const int aoff = lds_byte(wr * 64 + fr, fq * 8), boff = lds_byte(wc * 32 + fr, fq * 8);
#define PG8_SA(b, h) (((b) * 2 + (h)) * HTB)
#define PG8_SB(b, h) ((4 + (b) * 2 + (h)) * HTB)
#define PG8_STAGEB(bufoff, gbase) do { _Pragma("unroll") for (int _i = 0; _i < 2; ++_i) \
        __builtin_amdgcn_global_load_lds((const unsigned*)((const char*)(gbase) + voffB[_i]), (LAS unsigned*)(lds + (bufoff) + ldsw + _i * 8192), 16, 0, 0); } while (0)
#define PG8_STAGEA(bufoff, o0, o1) do { \
        __builtin_amdgcn_global_load_lds((const unsigned*)((const char*)Ag + (o0)), (LAS unsigned*)(lds + (bufoff) + ldsw), 16, 0, 0); \
        __builtin_amdgcn_global_load_lds((const unsigned*)((const char*)Ag + (o1)), (LAS unsigned*)(lds + (bufoff) + ldsw + 8192), 16, 0, 0); } while (0)
#define PG8_LDA(dst, b, h) do { if constexpr (FP8) { _Pragma("unroll") for (int m = 0; m < 4; ++m) { dst[m][0] = *(const LAS bf16x8*)(lds + PG8_SA(b, h) + aoff + m * 2048); dst[m][1] = *(const LAS bf16x8*)(lds + PG8_SA(b, h) + aoff + m * 2048 + 1024); } } \
        else { _Pragma("unroll") for (int m = 0; m < 4; ++m) _Pragma("unroll") for (int k = 0; k < 2; ++k) dst[m][k] = *(const LAS bf16x8*)(lds + PG8_SA(b, h) + aoff + m * 2048 + k * 1024); } } while (0)
#define PG8_LDB(dst, b, h) do { if constexpr (FP8) { _Pragma("unroll") for (int n = 0; n < 2; ++n) { dst[n][0] = *(const LAS bf16x8*)(lds + PG8_SB(b, h) + boff + n * 2048); dst[n][1] = *(const LAS bf16x8*)(lds + PG8_SB(b, h) + boff + n * 2048 + 1024); } } \
        else { _Pragma("unroll") for (int n = 0; n < 2; ++n) _Pragma("unroll") for (int k = 0; k < 2; ++k) dst[n][k] = *(const LAS bf16x8*)(lds + PG8_SB(b, h) + boff + n * 2048 + k * 1024); } } while (0)
#define PG8_F8(x) __builtin_bit_cast(v8i32, __builtin_shufflevector(__builtin_bit_cast(u32x4, (x)[0]), __builtin_bit_cast(u32x4, (x)[1]), 0, 1, 2, 3, 4, 5, 6, 7))
#define PG8_MMA(ai, bj, At, Bt) do { __builtin_amdgcn_s_setprio(1); if constexpr (FP8) { _Pragma("unroll") for (int m = 0; m < 4; ++m) _Pragma("unroll") for (int n = 0; n < 2; ++n) \
        asm volatile("v_mfma_scale_f32_16x16x128_f8f6f4 %0, %1, %2, %0, %3, %4 op_sel_hi:[0,0,0]" : "+v"(acc[ai][bj][m][n]) : "v"(PG8_F8(Bt[n])), "v"(PG8_F8(At[m])), "v"(scw_reg), "v"(sca_reg)); } \
        else { _Pragma("unroll") for (int m = 0; m < 4; ++m) _Pragma("unroll") for (int n = 0; n < 2; ++n) _Pragma("unroll") for (int k = 0; k < 2; ++k) \
        acc[ai][bj][m][n] = __builtin_amdgcn_mfma_f32_16x16x32_bf16(Bt[n][k], At[m][k], acc[ai][bj][m][n], 0, 0, 0); } __builtin_amdgcn_s_setprio(0); } while (0)
#define PG8_WAIT_V(n) asm volatile("s_waitcnt vmcnt(" #n ")" ::: "memory")
#define PG8_WAIT_L(n) asm volatile("s_waitcnt lgkmcnt(" #n ")" ::: "memory")
#define PG8_BAR __builtin_amdgcn_s_barrier()
#define PG8_SCHED __builtin_amdgcn_sched_barrier(0)
    Unit cur, nxt; int ui = 0;
    if (!S.next(0, cur)) return;
    int scw_reg = SCW, sca_reg = 127;
    asm volatile("" : "+v"(scw_reg), "+v"(sca_reg));
    f32x4 acc[2][2][4][2];
#pragma unroll
    for (int a = 0; a < 2; ++a)
#pragma unroll
        for (int b = 0; b < 2; ++b)
#pragma unroll
            for (int m = 0; m < 4; ++m)
#pragma unroll
                for (int n = 0; n < 2; ++n) acc[a][b][m][n] = (f32x4){0.f, 0.f, 0.f, 0.f};
#define PG8_ZPAD() do { if constexpr (FP8) { _Pragma("unroll") for (int a = 0; a < 2; ++a) _Pragma("unroll") for (int b = 0; b < 2; ++b) _Pragma("unroll") for (int m = 0; m < 4; ++m) asm volatile("s_nop 1" : "+v"(acc[a][b][m][0]), "+v"(acc[a][b][m][1])); } } while (0)
    PG8_ZPAD();
    bf16x8 At[4][2], B0[2][2], B1[2][2];
    unsigned ac00, ac01, ac10, ac11;
    ac00 = S.arow(cur, 0, RA[0]) + CA[0]; ac01 = S.arow(cur, 0, RA[1]) + CA[1]; ac10 = S.arow(cur, 0, HALF + RA[0]) + CA[0]; ac11 = S.arow(cur, 0, HALF + RA[1]) + CA[1];
    const char* cB = (const char*)Btg + (size_t)cur.pn * tstep;
    PG8_STAGEB(PG8_SB(0, 0), cB); PG8_STAGEB(PG8_SB(0, 1), cB + hstep); PG8_STAGEA(PG8_SA(0, 0), ac00, ac01); PG8_STAGEA(PG8_SA(0, 1), ac10, ac11);
    if (wr == 1) PG8_BAR;
    PG8_WAIT_V(2); PG8_BAR;
    PG8_STAGEB(PG8_SB(1, 0), cB + kstep); PG8_STAGEA(PG8_SA(1, 0), ac00 + 128u, ac01 + 128u); PG8_STAGEB(PG8_SB(1, 1), cB + hstep + kstep);
    PG8_WAIT_V(6); PG8_BAR;
    for (;;) {
        const bool has_next = S.next(ui + 1, nxt);
        const char* nB = has_next ? (const char*)Btg + (size_t)nxt.pn * tstep : cB;
#pragma unroll 1
        for (int t = 0; t < nt; t += 2) {
            const bool last = (t == nt - 2);
            const unsigned k1 = (unsigned)(t + 1) * 128u, k2 = (unsigned)(t + 2) * 128u;
            unsigned a200 = ac00 + k2, a201 = ac01 + k2, a210 = ac10 + k2, a211 = ac11 + k2;
            if (last) { if (has_next) { a200 = S.arow(nxt, ui + 1, RA[0]) + CA[0]; a201 = S.arow(nxt, ui + 1, RA[1]) + CA[1]; a210 = S.arow(nxt, ui + 1, HALF + RA[0]) + CA[0]; a211 = S.arow(nxt, ui + 1, HALF + RA[1]) + CA[1]; }
                        else { a200 = ac00; a201 = ac01; a210 = ac10; a211 = ac11; } }
            const char* b2 = last ? nB : cB + (size_t)k2; const char* b3 = b2 + kstep;
            PG8_LDB(B0, 0, 0); PG8_LDB(B1, 0, 1); PG8_SCHED; PG8_LDA(At, 0, 0); PG8_STAGEA(PG8_SA(1, 1), ac10 + k1, ac11 + k1);
            PG8_WAIT_V(8); PG8_WAIT_L(0); PG8_BAR; PG8_MMA(0, 0, At, B0); PG8_MMA(0, 1, At, B1); PG8_BAR; PG8_SCHED;
            PG8_LDA(At, 0, 1); PG8_STAGEB(PG8_SB(0, 0), b2); PG8_STAGEB(PG8_SB(0, 1), b2 + hstep); PG8_STAGEA(PG8_SA(0, 0), a200, a201);
            PG8_WAIT_V(8); PG8_WAIT_L(0); PG8_BAR; PG8_MMA(1, 0, At, B0); PG8_MMA(1, 1, At, B1); PG8_BAR; PG8_SCHED;
            PG8_LDB(B0, 1, 0); PG8_LDB(B1, 1, 1); PG8_SCHED; PG8_LDA(At, 1, 0); PG8_STAGEA(PG8_SA(0, 1), a210, a211);
            PG8_WAIT_V(8); PG8_WAIT_L(0); PG8_BAR; PG8_MMA(0, 0, At, B0); PG8_MMA(0, 1, At, B1); PG8_BAR; PG8_SCHED;
            PG8_LDA(At, 1, 1); PG8_STAGEB(PG8_SB(1, 0), b3); PG8_STAGEB(PG8_SB(1, 1), b3 + hstep); PG8_STAGEA(PG8_SA(1, 0), a200 + 128u, a201 + 128u);
            PG8_WAIT_V(8); PG8_WAIT_L(0); PG8_BAR; PG8_MMA(1, 0, At, B0); PG8_MMA(1, 1, At, B1); PG8_BAR; PG8_SCHED;
        }
        if constexpr (FP8) asm volatile("s_nop 15\n\ts_nop 15" ::: "memory");
#pragma unroll
        for (int a = 0; a < 2; ++a)
#pragma unroll
            for (int b = 0; b < 2; ++b)
#pragma unroll
                for (int m = 0; m < 4; ++m) asm volatile("" : "+v"(acc[a][b][m][0]), "+v"(acc[a][b][m][1]));
        if constexpr (ALIGN_EPI) { if (wr == 0) PG8_BAR; }
        E(acc, cur, wr, wc, fr, fq);
        S.after_unit(ui);
        if (!has_next) break;
#pragma unroll
        for (int a = 0; a < 2; ++a)
#pragma unroll
            for (int b = 0; b < 2; ++b)
#pragma unroll
                for (int m = 0; m < 4; ++m)
#pragma unroll
                    for (int n = 0; n < 2; ++n) acc[a][b][m][n] = (f32x4){0.f, 0.f, 0.f, 0.f};
        PG8_ZPAD();
        cur = nxt; cB = nB; ++ui;
        ac00 = S.arow(cur, ui, RA[0]) + CA[0]; ac01 = S.arow(cur, ui, RA[1]) + CA[1]; ac10 = S.arow(cur, ui, HALF + RA[0]) + CA[0]; ac11 = S.arow(cur, ui, HALF + RA[1]) + CA[1];
        if constexpr (ALIGN_EPI) { if (wr == 1) PG8_BAR; }
    }
    PG8_WAIT_V(0);
    if constexpr (!ALIGN_EPI) { if (wr == 0) PG8_BAR; }
    PG8_BAR;
#undef PG8_SA
#undef PG8_SB
#undef PG8_STAGEA
#undef PG8_STAGEB
#undef PG8_LDA
#undef PG8_LDB
#undef PG8_MMA
#undef PG8_F8
#undef PG8_ZPAD
#undef PG8_WAIT_V
#undef PG8_WAIT_L
#undef PG8_BAR
#undef PG8_SCHED
}
}

#define XB_TMO      128
#define XB_XCNT(j)  (256  + 64 * (j))
#define XB_XSUB(j)  (1280 + 64 * (j))
#define XB_XGEN(j)  (2304 + 64 * (j))
#define XB_TOP      3328
#define XB_TOPGEN   3392
#define XCD_BAR_WORDS 3456
#define XB_SPIN_CAP (1u << 18)
__device__ __forceinline__ unsigned xb_ld(unsigned* p)              { return __hip_atomic_load(p, __ATOMIC_RELAXED, __HIP_MEMORY_SCOPE_AGENT); }
__device__ __forceinline__ unsigned xb_add(unsigned* p, unsigned v) { return __hip_atomic_fetch_add(p, v, __ATOMIC_RELAXED, __HIP_MEMORY_SCOPE_AGENT); }
__device__ __forceinline__ unsigned xb_xcc_id() { return (unsigned)__builtin_amdgcn_s_getreg((3 << 11) | 20) & 0xFu; }
#define XB_SPIN(cond, bar) do { unsigned _sp = 0; while (cond) { __builtin_amdgcn_s_sleep(1); \
    if ((++_sp & 255u) == 0u) { if (xb_ld(&(bar)[XB_TMO])) break; if (_sp > XB_SPIN_CAP) { atomicAdd(&(bar)[XB_TMO], 1u); break; } } } } while (0)
struct XcdBarrier { unsigned* bar; unsigned x; volatile LAS unsigned* st; };
__device__ __forceinline__ XcdBarrier xcd_barrier_post(unsigned* bar, volatile LAS unsigned* st) {
    XcdBarrier b; b.bar = bar; b.x = xb_xcc_id(); b.st = st;
    if (threadIdx.x == 0) (void)xb_add(&bar[XB_XCNT(b.x)], 1u);
    return b;
}
__device__ __forceinline__ void xcd_barrier_complete(unsigned* bar, unsigned x, unsigned& nloc, unsigned& nx) {
    const unsigned G = gridDim.x * gridDim.y * gridDim.z;
    unsigned sum, cnt, mine, sp = 0u;
    for (;;) {
        sum = 0u; cnt = 0u; mine = 0u;
#pragma unroll
        for (unsigned j = 0; j < 16; ++j) { const unsigned c = xb_ld(&bar[XB_XCNT(j)]); sum += c; cnt += (c > 0u) ? 1u : 0u; mine = (j == x) ? c : mine; }
        if (sum == G) break;
        __builtin_amdgcn_s_sleep(1);
        if ((++sp & 255u) == 0u) { if (xb_ld(&bar[XB_TMO])) break; if (sp > XB_SPIN_CAP) { atomicAdd(&bar[XB_TMO], 1u); break; } }
    }
    nloc = mine > 0u ? mine : 1u; nx = cnt > 0u ? cnt : 1u;
}
__device__ __forceinline__ void xcd_barrier(const XcdBarrier& b) {
    asm volatile("s_waitcnt vmcnt(0)" ::: "memory");
    __syncthreads();
    if (threadIdx.x == 0) {
        unsigned* bar = b.bar;
        __builtin_amdgcn_s_waitcnt(0);
        unsigned nloc = b.st[0], nx = b.st[1];
        if (nloc == 0u) { xcd_barrier_complete(bar, b.x, nloc, nx); b.st[0] = nloc; b.st[1] = nx; }
        const unsigned old = xb_add(&bar[XB_XSUB(b.x)], 1u);
        const unsigned gen = old / nloc;
        if (old + 1u == (gen + 1u) * nloc) {
            __builtin_amdgcn_fence(__ATOMIC_RELEASE, "agent");
            asm volatile("s_waitcnt vmcnt(0)" ::: "memory");
            const unsigned og = xb_add(&bar[XB_TOP], 1u);
            const unsigned tg = og / nx;
            if (og + 1u == (tg + 1u) * nx) xb_add(&bar[XB_TOPGEN], 1u);
            else XB_SPIN(xb_ld(&bar[XB_TOPGEN]) == tg, bar);
            __builtin_amdgcn_fence(__ATOMIC_ACQUIRE, "agent");
            xb_add(&bar[XB_XGEN(b.x)], 1u);
            asm volatile("s_waitcnt vmcnt(0)" ::: "memory");
        } else {
            XB_SPIN(xb_ld(&bar[XB_XGEN(b.x)]) == gen, bar);
            __builtin_amdgcn_fence(__ATOMIC_ACQUIRE, "agent");
            asm volatile("s_waitcnt vmcnt(0)" ::: "memory");
        }
    }
    __syncthreads();
}

struct Frame {
    LAS unsigned char* lds;
    volatile LAS unsigned* MISC;
    unsigned* ctl;
    int tid, lane, wave, vcu, G;
    unsigned char* ws;
    const float *x, *g_mix, *w_in, *w_up, *b_alpha, *g_gla, *w_conv, *w_a, *w_b, *w_out, *g_ffn, *w_router, *b_router, *w_gu, *b_gu, *w_d, *b_d, *g_final;
    float* out;
};
#define WSP(T, off) ((T*)(F.ws + (off)))

__device__ __forceinline__ void tr_item64(const float* W, int ld, int k0, int n0, bf16* WT, size_t dst_row0, int K, LAS unsigned* T, int lane) {
    const int nq = lane & 15, kr = lane >> 4;
    const float* src = W + (size_t)(k0 + 2 * kr) * ld + n0 + 4 * nq;
    f32x4 a0[8], a1[8];
#pragma unroll
    for (int it = 0; it < 8; ++it) { a0[it] = *(const f32x4*)(src + (size_t)(8 * it) * ld); a1[it] = *(const f32x4*)(src + (size_t)(8 * it + 1) * ld); }
    const int c = lane & 7;
#pragma unroll
    for (int hf = 0; hf < 2; ++hf) {
        if ((nq >> 3) == hf) {
#pragma unroll
            for (int it = 0; it < 8; ++it)
#pragma unroll
                for (int q = 0; q < 4; ++q) T[(4 * (nq & 7) + q) * 33 + 4 * it + kr] = pk2(a0[it][q], a1[it][q]);
        }
        LDS_WAIT(); asm volatile("" ::: "memory");
#pragma unroll
        for (int j = 0; j < 4; ++j) { const int n = (lane >> 3) + 8 * j; const LAS unsigned* t = T + n * 33 + 4 * c;
            u32x4 o; o.x = t[0]; o.y = t[1]; o.z = t[2]; o.w = t[3];
            *(u32x4*)(WT + (dst_row0 + 32 * hf + n) * (size_t)K + k0 + 8 * c) = o; }
        LDS_WAIT(); asm volatile("" ::: "memory");
    }
}

__device__ __forceinline__ void tr_item8(const float* W, int ld, int k0, int n0, unsigned char* WT8, size_t dst_row0, int KB, float scale, LAS unsigned* T, int lane) {
    const int nq = lane & 7, kr = lane >> 3;
    const float* src = W + (size_t)(k0 + 4 * kr) * ld + n0 + 4 * nq;
    f32x4 a[4][4];
#pragma unroll
    for (int it = 0; it < 4; ++it)
#pragma unroll
        for (int j = 0; j < 4; ++j) a[it][j] = *(const f32x4*)(src + (size_t)(32 * it + j) * ld);
    const int c = lane & 7;
#pragma unroll
    for (int hf = 0; hf < 2; ++hf) {
        if ((nq >> 2) == hf) {
#pragma unroll
            for (int it = 0; it < 4; ++it)
#pragma unroll
                for (int q = 0; q < 4; ++q) T[(4 * (nq & 3) + q) * 33 + 8 * it + kr] = pk4_fp8(a[it][0][q] * scale, a[it][1][q] * scale, a[it][2][q] * scale, a[it][3][q] * scale);
        }
        LDS_WAIT(); asm volatile("" ::: "memory");
#pragma unroll
        for (int j = 0; j < 2; ++j) { const int n = (lane >> 3) + 8 * j; const LAS unsigned* t = T + n * 33 + 4 * c;
            u32x4 o; o.x = t[0]; o.y = t[1]; o.z = t[2]; o.w = t[3];
            *(u32x4*)(WT8 + (dst_row0 + 16 * hf + n) * (size_t)KB + k0 + 16 * c) = o; }
        LDS_WAIT(); asm volatile("" ::: "memory");
    }
}
__device__ __forceinline__ void moe_convert_share(const float* w_gu, const float* w_d, unsigned char* ws, LAS unsigned char* lds, int c, int G, int wave, int lane) {
    LAS unsigned* T = (LAS unsigned*)(lds + EXTRA_OFF + wave * 2176);
    constexpr int I_GU = NE * 64 * 8, I_D = NE * 32 * 8;
    for (int it = c * NWAVES + wave; it < I_GU + I_D; it += G * NWAVES) {
        int r = it;
        if (r < I_GU) { const int e = r >> 9, q = r & 511, kb = q >> 6, nb = q & 63, j0 = 32 * nb, pn = j0 >> 8, within = j0 & 255, half = within >> 7;
            tr_item8(w_gu + (size_t)e * 1024 * 2048, 2048, 128 * kb, half * 1024 + pn * 128 + (within & 127), ws + WS_WGU + (size_t)e * 2048 * 1024, j0, 1024, 32.0f, T, lane); continue; } r -= I_GU;
        { const int e = r >> 8, q = r & 255, kb = q >> 5, nb = q & 31;
            tr_item8(w_d + (size_t)e * 1024 * 1024, 1024, 128 * kb, 32 * nb, ws + WS_WD + (size_t)e * 1024 * 1024, 32 * nb, 1024, 32.0f, T, lane); }
    }
}
struct P1Order : pg8::StaticOrder {
    const float* w_gu; const float* w_d; unsigned char* ws; LAS unsigned char* lds; int slot, wave, lane;
    __device__ __forceinline__ void after_unit(int ui) const { if (ui == slot) { int ln = lane; asm volatile("" : "+v"(ln));
            moe_convert_share(w_gu, w_d, ws, lds, c, G, wave, ln); } }
};

constexpr int P0_T_BYTES = 4352;
constexpr int P0_WL = 8 * P0_T_BYTES;
constexpr int P0_WU = P0_WL + 65536;
constexpr int P0_BA = P0_WU + 32768;

__device__ __forceinline__ void p0_items(Frame& F, const int nrep) {
    LAS unsigned* scr = (LAS unsigned*)(F.lds + F.wave * P0_T_BYTES);
    const int gw = F.vcu * NWAVES + F.wave, NGW = F.G * NWAVES;
    constexpr int I_IN = 128 * 16, I_SQ = 16 * 16;
    constexpr int NITEMS = I_IN + 3 * I_SQ;
    bf16* Win_t = WSP(bf16, WS_WIN);
    for (int it0 = gw; it0 < NITEMS * nrep; it0 += NGW) {
        int r = it0 % NITEMS;
        if (r < I_IN) { const int kb = r >> 7, nb = r & 127, j0 = 64 * nb; tr_item64(F.w_in, NZS, 64 * kb, j0 < 3072 ? j0 : j0 + 16, Win_t, j0, 1024, scr, F.lane); continue; } r -= I_IN;
        if (r < I_SQ) { tr_item64(F.w_a, 1024, 64 * (r >> 4), 64 * (r & 15), WSP(bf16, WS_WA), 64 * (r & 15), 1024, scr, F.lane); continue; } r -= I_SQ;
        if (r < I_SQ) { tr_item64(F.w_b, 1024, 64 * (r >> 4), 64 * (r & 15), WSP(bf16, WS_WB), 64 * (r & 15), 1024, scr, F.lane); continue; } r -= I_SQ;
        tr_item64(F.w_out, 1024, 64 * (r >> 4), 64 * (r & 15), WSP(bf16, WS_WO), 64 * (r & 15), 1024, scr, F.lane);
    }
}

__device__ __forceinline__ void p0_rows(Frame& F, const int nrep2) {
    const int gw = F.vcu * NWAVES + F.wave, NGW = F.G * NWAVES;
    LAS float* Wl = (LAS float*)(F.lds + P0_WL);
    LAS float* WU = (LAS float*)(F.lds + P0_WU);
    LAS float* BA = (LAS float*)(F.lds + P0_BA);
    f32x4 g[4];
#pragma unroll
    for (int j = 0; j < 4; ++j) g[j] = *((const f32x4*)F.g_mix + F.lane + 64 * j);
    bf16* XN = WSP(bf16, WS_XN); float* LA = WSP(float, WS_LA);
    for (int m0 = gw; m0 < M * nrep2; m0 += NGW) {
        const int m = m0 % M;
        const f32x4* xr = (const f32x4*)(F.x + (size_t)m * D) + F.lane;
        f32x4 v[4]; float s = 0.f;
#pragma unroll
        for (int j = 0; j < 4; ++j) { v[j] = xr[64 * j]; s += (v[j].x * v[j].x + v[j].y * v[j].y) + (v[j].z * v[j].z + v[j].w * v[j].w); }
        const float rstd = 1.0f / sqrtf(wave_sum(s) * (1.f / D) + 1e-6f);
        unsigned long long* o8 = (unsigned long long*)(XN + (size_t)m * D) + F.lane;
#pragma unroll
        for (int j = 0; j < 4; ++j) { v[j] = v[j] * rstd * g[j]; o8[64 * j] = (unsigned long long)pk2(v[j].x, v[j].y) | ((unsigned long long)pk2(v[j].z, v[j].w) << 32); }
        float a[16];
#pragma unroll
        for (int r4 = 0; r4 < 4; ++r4) {
#pragma unroll
            for (int rr = 0; rr < 4; ++rr) { const int r = 4 * r4 + rr; float t = 0.f;
#pragma unroll
                for (int j = 0; j < 4; ++j) { const f32x4 w = *(const LAS f32x4*)(Wl + r * 1024 + 256 * j + 4 * F.lane); t = fmaf(v[j].x, w.x, t); t = fmaf(v[j].y, w.y, t); t = fmaf(v[j].z, w.z, t); t = fmaf(v[j].w, w.w, t); }
                a[r] = t; }
            asm volatile("" ::: "memory");
        }
#pragma unroll
        for (int q = 0; q < 8; ++q) { const bool up = (F.lane & 32) != 0; const float send = up ? a[q] : a[q + 8]; const float keep = up ? a[q + 8] : a[q]; a[q] = keep + __shfl_xor(send, 32); }
#pragma unroll
        for (int q = 0; q < 4; ++q) { const bool up = (F.lane & 16) != 0; const float send = up ? a[q] : a[q + 4]; const float keep = up ? a[q + 4] : a[q]; a[q] = keep + __shfl_xor(send, 16); }
#pragma unroll
        for (int q = 0; q < 2; ++q) { const bool up = (F.lane & 8) != 0; const float send = up ? a[q] : a[q + 2]; const float keep = up ? a[q + 2] : a[q]; a[q] = keep + __shfl_xor(send, 8); }
        { const bool up = (F.lane & 4) != 0; const float send = up ? a[0] : a[1]; const float keep = up ? a[1] : a[0]; a[0] = keep + __shfl_xor(send, 4); }
        float alv = a[0]; alv += __shfl_xor(alv, 2); alv += __shfl_xor(alv, 1);
        float al[16];
#pragma unroll
        for (int r = 0; r < 16; ++r) al[r] = __builtin_bit_cast(float, __builtin_amdgcn_readlane(__builtin_bit_cast(int, alv), 4 * r));
#pragma unroll
        for (int i = 0; i < 8; ++i) { const int j = F.lane + 64 * i; float pre = BA[j];
#pragma unroll
            for (int r = 0; r < 16; ++r) pre = fmaf(al[r], WU[r * 512 + j], pre);
            const float ls = fminf(pre, 0.f) - __logf(1.0f + __expf(-fabsf(pre)));
            LA[((size_t)(i >> 1) * M + m) * 128 + (j & 127)] = ls * (1.0f / 16.0f);
            if (i & 1) asm volatile("" ::: "memory"); }
    }
}

__device__ __forceinline__ void p0_prologue(Frame& F, const int nrep, const int nrep2) {
    {
        LAS float* Wl = (LAS float*)(F.lds + P0_WL); LAS float* WU = (LAS float*)(F.lds + P0_WU); LAS float* BA = (LAS float*)(F.lds + P0_BA);
        for (int i = 0; i < 32; ++i) { const int idx = F.tid + 512 * i, k = idx >> 4, r = idx & 15; Wl[r * 1024 + k] = F.w_in[(size_t)k * NZS + 3072 + r]; }
        for (int i = 0; i < 16; ++i) { const int idx = F.tid + 512 * i; WU[idx] = F.w_up[idx]; }
        BA[F.tid] = F.b_alpha[F.tid];
        __syncthreads();
    }
#pragma unroll 1
    for (int pass = 0; pass < 2; ++pass) {
        if (((pass ^ F.wave) & 1) == 0) p0_items(F, nrep); else p0_rows(F, nrep2);
    }
}

struct EpiZ {
    static constexpr bool PERM = true;
    bf16* Z;
    __device__ __forceinline__ void operator()(const f32x4 (&acc)[2][2][4][2], const pg8::Unit& u, int wr, int wc, int fr, int fq) const {
        const int row0 = u.pm * 256 + wr * 64 + fr, c0 = wc * 32 + 8 * fq;
        const int pn = u.pn;
        const int kind = pn < 2 ? 1 : (pn < 8 ? 0 : (pn < 12 ? 2 : (pn < 24 ? 0 : 3)));
        bf16* base; int ld; size_t bjs;
        if (pn < 4) { base = Z + (pn < 2 ? ZQ : ZK) + (size_t)(2 * (pn & 1)) * M * 128; ld = 128; bjs = (size_t)M * 128; }
        else if (pn < 12) { base = Z + (pn < 8 ? ZV : ZR) + (size_t)(pn & 3) * M * 256; ld = 256; bjs = 128; }
        else { const int t = (pn - 12) >> 2; base = Z + ZCB + (size_t)t * M * 1024 + (size_t)((pn - 12) & 3) * 256; ld = 1024; bjs = 128; }
#pragma unroll
        for (int ai = 0; ai < 2; ++ai)
#pragma unroll
            for (int m = 0; m < 4; ++m) { bf16* rowp = base + (size_t)(row0 + ai * 128 + m * 16) * ld + c0;
#pragma unroll
                for (int bj = 0; bj < 2; ++bj) { f32x4 v0 = acc[ai][bj][m][0], v1 = acc[ai][bj][m][1];
                    if (kind == 1) { v0 = v0 * 0.08838834764831845f; v1 = v1 * 0.08838834764831845f; }
                    else if (kind == 2) {
#pragma unroll
                        for (int j = 0; j < 4; ++j) { v0[j] = v0[j] * fast_sigmoid(v0[j]); v1[j] = v1[j] * fast_sigmoid(v1[j]); } }
                    else if (kind == 3) {
#pragma unroll
                        for (int j = 0; j < 4; ++j) { v0[j] = fast_sigmoid(v0[j]); v1[j] = fast_sigmoid(v1[j]); } }
                    u32x4 w; w.x = pk2(v0[0], v0[1]); w.y = pk2(v0[2], v0[3]); w.z = pk2(v1[0], v1[1]); w.w = pk2(v1[2], v1[3]);
                    *(u32x4*)(rowp + bj * bjs) = w; } }
    }
};

constexpr int QD_STRIDE = 272, KT_STRIDE = 144, SC_STRIDE = 144, OT_STRIDE = 1040;
constexpr int L_QD = 0, L_KI = 17408, L_KT = 34816, L_SC = 53248, L_DEC = 62464, L_SEG = 62976, L_OT = 67584;
__device__ __forceinline__ int crow(int reg, int h) { return (reg & 3) + 8 * (reg >> 2) + 4 * h; }

template <bool OUT>
__device__ __forceinline__ void gla_item(Frame& F, int item) {
    const int bh = item >> 3, sc = item & 7, b = bh >> 2, hd = bh & 3;
    const int t0 = b * SEQ + sc * 256;
    const int tid = F.tid, lane = F.lane, w = F.wave, r32 = lane & 31, h = lane >> 5;
    const bf16* Z = WSP(const bf16, WS_Z);
    const float* LA = WSP(const float, WS_LA);
    LAS unsigned char* L = F.lds;
    f32x16 S[4];
    float* Sbuf = (OUT ? WSP(float, WS_SIN) : WSP(float, WS_U)) + (size_t)item * 32768 + (size_t)w * 4096;
    if (OUT) {
#pragma unroll
        for (int kb = 0; kb < 4; ++kb)
#pragma unroll
            for (int r = 0; r < 16; ++r) S[kb][r] = Sbuf[(kb * 16 + r) * 64 + lane];
    } else {
#pragma unroll
        for (int kb = 0; kb < 4; ++kb)
#pragma unroll
            for (int r = 0; r < 16; ++r) S[kb][r] = 0.f;
    }
    float btot_run0 = 0.f, btot_run1 = 0.f;
    const int tok_n = tid >> 3, part = tid & 7;
    f32x2 la2[8]; unsigned kk[8], qq[8]; bf16x8 Bv[4]; u32x4 rc[4];
#define GLA_LOAD(tcx) do { \
        const size_t rb_ = ((size_t)hd * M + (tcx) + 8 * w) * 128 + 2 * lane; \
        _Pragma("unroll") for (int i = 0; i < 8; ++i) { la2[i] = *(const f32x2*)(LA + rb_ + (size_t)i * 128); kk[i] = *(const unsigned*)(Z + ZK + rb_ + (size_t)i * 128); if (OUT) qq[i] = *(const unsigned*)(Z + ZQ + rb_ + (size_t)i * 128); } \
    } while (0)
#define GLA_LOADV(tcx) do { \
        _Pragma("unroll") for (int ks = 0; ks < 4; ++ks) _Pragma("unroll") for (int j = 0; j < 8; ++j) Bv[ks][j] = (short)Z[ZV + ((size_t)hd * M + (tcx) + 16 * ks + 8 * h + j) * 256 + 32 * w + r32]; \
    } while (0)
#define GLA_LOADR(tcx) do { \
        if (OUT) { const u32x4* rp_ = (const u32x4*)(Z + ZR + ((size_t)hd * M + (tcx) + tok_n) * 256 + 32 * part); _Pragma("unroll") for (int i = 0; i < 4; ++i) rc[i] = rp_[i]; } \
    } while (0)
    GLA_LOAD(t0); GLA_LOADV(t0);
#pragma unroll 1
    for (int c = 0; c < 4; ++c) {
        const int tc = t0 + c * 64;
        float p0[8], p1[8];
        { float r0 = 0.f, r1 = 0.f;
#pragma unroll
          for (int i = 0; i < 8; ++i) { r0 += la2[i].x; r1 += la2[i].y; p0[i] = r0; p1[i] = r1; }
          *(LAS f32x2*)(L + L_SEG + (w * 128 + 2 * lane) * 4) = (f32x2){r0, r1}; }
        GLA_LOADR(tc);
        __syncthreads();
        float off0 = 0.f, off1 = 0.f, bt0 = 0.f, bt1 = 0.f;
#pragma unroll
        for (int sgi = 0; sgi < 8; ++sgi) { const f32x2 sv = *(const LAS f32x2*)(L + L_SEG + (sgi * 128 + 2 * lane) * 4); if (sgi < w) { off0 += sv.x; off1 += sv.y; } bt0 += sv.x; bt1 += sv.y; }
        if (w == 0) { *(LAS f32x2*)(L + L_DEC + 8 * lane) = (f32x2){__expf(bt0), __expf(bt1)}; btot_run0 += bt0; btot_run1 += bt1; }
        {
            unsigned kt0[4], kt1[4];
#pragma unroll
            for (int i = 0; i < 8; i += 2) {
                const float b00 = off0 + p0[i], b01 = off1 + p1[i], b10 = off0 + p0[i + 1], b11 = off1 + p1[i + 1];
                const float k00 = bf_lo(kk[i]), k01 = bf_hi(kk[i]), k10 = bf_lo(kk[i + 1]), k11 = bf_hi(kk[i + 1]);
                kt0[i >> 1] = pk2(k00 * __expf(bt0 - b00), k10 * __expf(bt0 - b10));
                kt1[i >> 1] = pk2(k01 * __expf(bt1 - b01), k11 * __expf(bt1 - b11));
                if (OUT) {
                    const float q00 = bf_lo(qq[i]), q01 = bf_hi(qq[i]), q10 = bf_lo(qq[i + 1]), q11 = bf_hi(qq[i + 1]);
                    *(LAS unsigned*)(L + L_QD + (8 * w + i) * QD_STRIDE + 4 * lane) = pk2(q00 * __expf(b00), q01 * __expf(b01));
                    *(LAS unsigned*)(L + L_QD + (8 * w + i + 1) * QD_STRIDE + 4 * lane) = pk2(q10 * __expf(b10), q11 * __expf(b11));
                    *(LAS unsigned*)(L + L_KI + (8 * w + i) * QD_STRIDE + 4 * lane) = pk2(k00 * __expf(-b00), k01 * __expf(-b01));
                    *(LAS unsigned*)(L + L_KI + (8 * w + i + 1) * QD_STRIDE + 4 * lane) = pk2(k10 * __expf(-b10), k11 * __expf(-b11));
                }
            }
            *(LAS u32x4*)(L + L_KT + (2 * lane) * KT_STRIDE + 16 * w) = (u32x4){kt0[0], kt0[1], kt0[2], kt0[3]};
            *(LAS u32x4*)(L + L_KT + (2 * lane + 1) * KT_STRIDE + 16 * w) = (u32x4){kt1[0], kt1[1], kt1[2], kt1[3]};
        }
        __syncthreads();
        if (c < 3) GLA_LOAD(tc + 64);
        f32x16 o[2];
        if (OUT) {
            if (w < 3) {
                const int ib = w == 0 ? 0 : 1, jb = w == 2 ? 1 : 0;
                f32x16 sacc;
#pragma unroll
                for (int r = 0; r < 16; ++r) sacc[r] = 0.f;
#pragma unroll
                for (int kb = 0; kb < 8; ++kb) {
                    const bf16x8 a = *(const LAS bf16x8*)(L + L_QD + (32 * ib + r32) * QD_STRIDE + 2 * (16 * kb + 8 * h));
                    const bf16x8 bb = *(const LAS bf16x8*)(L + L_KI + (32 * jb + r32) * QD_STRIDE + 2 * (16 * kb + 8 * h));
                    sacc = __builtin_amdgcn_mfma_f32_32x32x16_bf16(a, bb, sacc, 0, 0, 0);
                }
#pragma unroll
                for (int r = 0; r < 16; r += 1) {
                    const int i = 32 * ib + crow(r, h), j = 32 * jb + r32;
                    const float v = (j <= i) ? sacc[r] : 0.f;
                    *(LAS bf16*)(L + L_SC + i * SC_STRIDE + 2 * j) = (bf16)(pk2(v, 0.f) & 0xffffu);
                }
            }
#pragma unroll
            for (int ib = 0; ib < 2; ++ib)
#pragma unroll
                for (int r = 0; r < 16; ++r) o[ib][r] = 0.f;
#pragma unroll
            for (int kb = 0; kb < 4; ++kb)
#pragma unroll
                for (int s2 = 0; s2 < 2; ++s2) {
                    u32x4 pb; pb.x = pk2(S[kb][8 * s2 + 0], S[kb][8 * s2 + 1]); pb.y = pk2(S[kb][8 * s2 + 2], S[kb][8 * s2 + 3]); pb.z = pk2(S[kb][8 * s2 + 4], S[kb][8 * s2 + 5]); pb.w = pk2(S[kb][8 * s2 + 6], S[kb][8 * s2 + 7]);
                    const bf16x8 bfrag = __builtin_bit_cast(bf16x8, pb);
#pragma unroll
                    for (int ib = 0; ib < 2; ++ib) {
                        const LAS unsigned char* qp = L + L_QD + (32 * ib + r32) * QD_STRIDE + 2 * (32 * kb + 16 * s2 + 4 * h);
                        const u32x2 lo = *(const LAS u32x2*)qp, hi = *(const LAS u32x2*)(qp + 16);
                        const bf16x8 afrag = __builtin_bit_cast(bf16x8, (u32x4){lo.x, lo.y, hi.x, hi.y});
                        o[ib] = __builtin_amdgcn_mfma_f32_32x32x16_bf16(afrag, bfrag, o[ib], 0, 0, 0);
                    }
                }
            __syncthreads();
#pragma unroll
            for (int ks = 0; ks < 4; ++ks)
#pragma unroll
                for (int ib = 0; ib < 2; ++ib) {
                    if (ib == 0 && ks >= 2) continue;
                    const bf16x8 a = *(const LAS bf16x8*)(L + L_SC + (32 * ib + r32) * SC_STRIDE + 2 * (16 * ks + 8 * h));
                    o[ib] = __builtin_amdgcn_mfma_f32_32x32x16_bf16(a, Bv[ks], o[ib], 0, 0, 0);
                }
        }
#pragma unroll
        for (int kb = 0; kb < 4; ++kb) {
#pragma unroll
            for (int g4 = 0; g4 < 4; ++g4) { const f32x4 dc = *(const LAS f32x4*)(L + L_DEC + 4 * (32 * kb + 8 * g4 + 4 * h));
#pragma unroll
                for (int j = 0; j < 4; ++j) S[kb][4 * g4 + j] *= dc[j]; }
#pragma unroll
            for (int ks = 0; ks < 4; ++ks) {
                const bf16x8 a = *(const LAS bf16x8*)(L + L_KT + (32 * kb + r32) * KT_STRIDE + 2 * (16 * ks + 8 * h));
                S[kb] = __builtin_amdgcn_mfma_f32_32x32x16_bf16(a, Bv[ks], S[kb], 0, 0, 0);
            }
        }
        if (c < 3) GLA_LOADV(tc + 64);
        if (OUT) {
#pragma unroll
            for (int ib = 0; ib < 2; ++ib)
#pragma unroll
                for (int r = 0; r < 16; ++r) *(LAS float*)(L + L_OT + (32 * ib + crow(r, h)) * OT_STRIDE + 4 * (32 * w + r32)) = o[ib][r];
            __syncthreads();
            f32x4 ov[8]; float ss = 0.f;
#pragma unroll
            for (int i = 0; i < 8; ++i) { ov[i] = *(const LAS f32x4*)(L + L_OT + tok_n * OT_STRIDE + 4 * (32 * part + 4 * i)); ss += (ov[i].x * ov[i].x + ov[i].y * ov[i].y) + (ov[i].z * ov[i].z + ov[i].w * ov[i].w); }
            ss += __shfl_xor(ss, 1); ss += __shfl_xor(ss, 2); ss += __shfl_xor(ss, 4);
            const float rs = 1.0f / sqrtf(ss * (1.0f / 256.0f) + 1e-6f);
            const size_t trow = (size_t)(tc + tok_n);
            const f32x4* gp = (const f32x4*)(F.g_gla + hd * 256 + 32 * part);
            u32x4* op = (u32x4*)(WSP(bf16, WS_OG) + trow * 1024 + hd * 256 + 32 * part);
#pragma unroll
            for (int i = 0; i < 4; ++i) {
                const u32x4 rr = rc[i]; const f32x4 g0 = gp[2 * i], g1 = gp[2 * i + 1]; const f32x4 a0 = ov[2 * i], a1 = ov[2 * i + 1];
                u32x4 ow;
                ow.x = pk2(a0.x * rs * g0.x * bf_lo(rr.x), a0.y * rs * g0.y * bf_hi(rr.x));
                ow.y = pk2(a0.z * rs * g0.z * bf_lo(rr.y), a0.w * rs * g0.w * bf_hi(rr.y));
                ow.z = pk2(a1.x * rs * g1.x * bf_lo(rr.z), a1.y * rs * g1.y * bf_hi(rr.z));
                ow.w = pk2(a1.z * rs * g1.z * bf_lo(rr.w), a1.w * rs * g1.w * bf_hi(rr.w));
                op[i] = ow;
            }
        }
    }
#undef GLA_LOAD
#undef GLA_LOADV
#undef GLA_LOADR
    if (!OUT) {
#pragma unroll
        for (int kb = 0; kb < 4; ++kb)
#pragma unroll
            for (int r = 0; r < 16; ++r) Sbuf[(kb * 16 + r) * 64 + lane] = S[kb][r];
        if (w == 0) *(f32x2*)(WSP(float, WS_DECS) + item * 128 + 2 * lane) = (f32x2){__expf(btot_run0), __expf(btot_run1)};
    }
    __syncthreads();
}

__device__ __forceinline__ void conv_rows(Frame& F, const int nrep) {
    const int gw = F.vcu * NWAVES + F.wave, NGW = F.G * NWAVES;
    const bf16* Z = WSP(const bf16, WS_Z); bf16* PB = WSP(bf16, WS_PB);
    for (int blk0 = gw; blk0 < (M / 8) * nrep; blk0 += NGW) {
        const int blk = blk0 % (M / 8);
        const int m0 = blk * 8, s0 = m0 % SEQ;
#pragma unroll 1
        for (int j = 0; j < 2; ++j) {
            const int c = 8 * F.lane + 512 * j;
            const size_t rp = (size_t)(s0 > 0 ? m0 - 2 : m0);
            const u32x4 p2c = *(const u32x4*)(Z + ZCC + rp * 1024 + c), p2x = *(const u32x4*)(Z + ZCX + rp * 1024 + c);
            const u32x4 p1c = *(const u32x4*)(Z + ZCC + (rp + 1) * 1024 + c), p1x = *(const u32x4*)(Z + ZCX + (rp + 1) * 1024 + c);
            float w0[8], w1[8], w2[8];
#pragma unroll
            for (int i = 0; i < 8; ++i) { w0[i] = F.w_conv[c + i]; w1[i] = F.w_conv[1024 + c + i]; w2[i] = F.w_conv[2048 + c + i]; }
            float u1[8], u2[8];
            const float keep = s0 > 0 ? 1.0f : 0.0f;
#pragma unroll
            for (int i = 0; i < 4; ++i) { u2[2 * i] = keep * bf_lo(p2c[i]) * bf_lo(p2x[i]); u2[2 * i + 1] = keep * bf_hi(p2c[i]) * bf_hi(p2x[i]); u1[2 * i] = keep * bf_lo(p1c[i]) * bf_lo(p1x[i]); u1[2 * i + 1] = keep * bf_hi(p1c[i]) * bf_hi(p1x[i]); }
#pragma unroll
            for (int hb = 0; hb < 2; ++hb) {
                u32x4 cc[4], cx[4], cb[4];
#pragma unroll
                for (int rr = 0; rr < 4; ++rr) { const size_t row = (size_t)(m0 + 4 * hb + rr); cc[rr] = *(const u32x4*)(Z + ZCC + row * 1024 + c); cx[rr] = *(const u32x4*)(Z + ZCX + row * 1024 + c); cb[rr] = *(const u32x4*)(Z + ZCB + row * 1024 + c); }
#pragma unroll
                for (int rr = 0; rr < 4; ++rr) {
                    float u0[8], y[8];
#pragma unroll
                    for (int i = 0; i < 4; ++i) { u0[2 * i] = bf_lo(cc[rr][i]) * bf_lo(cx[rr][i]); u0[2 * i + 1] = bf_hi(cc[rr][i]) * bf_hi(cx[rr][i]); }
#pragma unroll
                    for (int i = 0; i < 8; ++i) y[i] = w0[i] * u2[i] + w1[i] * u1[i] + w2[i] * u0[i];
                    u32x4 ow;
#pragma unroll
                    for (int i = 0; i < 4; ++i) ow[i] = pk2(bf_lo(cb[rr][i]) * y[2 * i], bf_hi(cb[rr][i]) * y[2 * i + 1]);
                    *(u32x4*)(PB + (size_t)(m0 + 4 * hb + rr) * 1024 + c) = ow;
#pragma unroll
                    for (int i = 0; i < 8; ++i) { u2[i] = u1[i]; u1[i] = u0[i]; }
                }
                asm volatile("" ::: "memory");
            }
        }
    }
}

__device__ __forceinline__ void gla_scan(Frame& F, const int nrep) {
    const float* U = WSP(const float, WS_U); float* SIN = WSP(float, WS_SIN); const float* DECS = WSP(const float, WS_DECS);
    const int gt = F.vcu * 512 + F.tid, NT = F.G * 512;
    for (int idx0 = gt; idx0 < 32 * 32768 * nrep; idx0 += NT) {
        const int idx = idx0 & (32 * 32768 - 1);
        const int bh = idx >> 15, e = idx & 32767;
        const int ln = e & 63, reg = (e >> 6) & 15, kb = (e >> 10) & 3;
        const int dk = 32 * kb + crow(reg, ln >> 5);
        float s = 0.f;
#pragma unroll
        for (int sc = 0; sc < 8; ++sc) {
            const int item = bh * 8 + sc;
            SIN[(size_t)item * 32768 + e] = s;
            s = DECS[item * 128 + dk] * s + U[(size_t)item * 32768 + e];
        }
    }
}

struct EpiM1 {
    static constexpr bool PERM = true;
    const bf16* Z; float* M1;
    __device__ __forceinline__ void operator()(const f32x4 (&acc)[2][2][4][2], const pg8::Unit& u, int wr, int wc, int fr, int fq) const {
        const int row0 = u.pm * 256 + wr * 64 + fr, col0 = u.pn * 256 + wc * 32 + 8 * fq;
#pragma unroll
        for (int ai = 0; ai < 2; ++ai)
#pragma unroll
            for (int m = 0; m < 4; ++m) { const size_t row = (size_t)(row0 + ai * 128 + m * 16);
#pragma unroll
                for (int bj = 0; bj < 2; ++bj) { const u32x4 sg = *(const u32x4*)(Z + ZGA + row * 1024 + col0 + bj * 128);
                    const f32x4 v0 = acc[ai][bj][m][0], v1 = acc[ai][bj][m][1];
                    float* mp = M1 + row * 1024 + col0 + bj * 128;
                    *(f32x4*)mp = (f32x4){v0[0] * bf_lo(sg.x), v0[1] * bf_hi(sg.x), v0[2] * bf_lo(sg.y), v0[3] * bf_hi(sg.y)};
                    *(f32x4*)(mp + 4) = (f32x4){v1[0] * bf_lo(sg.z), v1[1] * bf_hi(sg.z), v1[2] * bf_lo(sg.w), v1[3] * bf_hi(sg.w)}; } }
    }
};
struct EpiMix {
    static constexpr bool PERM = true;
    const bf16* Z; const float* M1; bf16* MIX;
    __device__ __forceinline__ void operator()(const f32x4 (&acc)[2][2][4][2], const pg8::Unit& u, int wr, int wc, int fr, int fq) const {
        const int row0 = u.pm * 256 + wr * 64 + fr, col0 = u.pn * 256 + wc * 32 + 8 * fq;
#pragma unroll
        for (int ai = 0; ai < 2; ++ai)
#pragma unroll
            for (int m = 0; m < 4; ++m) { const size_t row = (size_t)(row0 + ai * 128 + m * 16);
#pragma unroll
                for (int bj = 0; bj < 2; ++bj) { const u32x4 sg = *(const u32x4*)(Z + ZGB + row * 1024 + col0 + bj * 128);
                    const f32x4 v0 = acc[ai][bj][m][0], v1 = acc[ai][bj][m][1];
                    const float* mp = M1 + row * 1024 + col0 + bj * 128;
                    const f32x4 m0 = *(const f32x4*)mp, m1 = *(const f32x4*)(mp + 4);
                    u32x4 w;
                    w.x = pk2(m0[0] + v0[0] * bf_lo(sg.x), m0[1] + v0[1] * bf_hi(sg.x)); w.y = pk2(m0[2] + v0[2] * bf_lo(sg.y), m0[3] + v0[3] * bf_hi(sg.y));
                    w.z = pk2(m1[0] + v1[0] * bf_lo(sg.z), m1[1] + v1[1] * bf_hi(sg.z)); w.w = pk2(m1[2] + v1[2] * bf_lo(sg.w), m1[3] + v1[3] * bf_hi(sg.w));
                    *(u32x4*)(MIX + row * 1024 + col0 + bj * 128) = w; } }
    }
};
struct EpiX1 {
    static constexpr bool PERM = false;
    const float* x; float* X1;
    __device__ __forceinline__ void operator()(const f32x4 (&acc)[2][2][4][2], const pg8::Unit& u, int wr, int wc, int fr, int fq) const {
        const int row0 = u.pm * 256 + wr * 64 + fr, col0 = u.pn * 256 + wc * 32 + 4 * fq;
#pragma unroll
        for (int ai = 0; ai < 2; ++ai)
#pragma unroll
            for (int m = 0; m < 4; ++m) { const size_t off = (size_t)(row0 + ai * 128 + m * 16) * 1024 + col0;
#pragma unroll
                for (int bj = 0; bj < 2; ++bj)
#pragma unroll
                    for (int n = 0; n < 2; ++n) { const f32x4 xs = *(const f32x4*)(x + off + bj * 128 + n * 16); *(f32x4*)(X1 + off + bj * 128 + n * 16) = xs + acc[ai][bj][m][n]; } }
    }
};

constexpr int WRT_LD = 1028;
__device__ __forceinline__ void route_pair(float lg, int lane, int tl, size_t m, LAS int* hist, LAS int* ple, float* gate) {
    const int myi = lane & 31;
    float tv[4]; int ti[4];
#pragma unroll
    for (int k = 0; k < 4; ++k) {
        float bv = lg; int bi = myi;
#pragma unroll
        for (int off = 16; off >= 1; off >>= 1) { const float ov = __shfl_xor(bv, off); const int oi = __shfl_xor(bi, off); if (ov > bv || (ov == bv && oi < bi)) { bv = ov; bi = oi; } }
        tv[k] = bv; ti[k] = bi;
        if (myi == bi) lg = -3.0e38f;
    }
    const float e1 = __expf(tv[1] - tv[0]), e2 = __expf(tv[2] - tv[0]), e3 = __expf(tv[3] - tv[0]);
    const float inv = 1.0f / (1.0f + e1 + e2 + e3);
    if (myi < 4) {
        const int ek = myi == 0 ? ti[0] : (myi == 1 ? ti[1] : (myi == 2 ? ti[2] : ti[3]));
        const float gk = (myi == 0 ? 1.0f : (myi == 1 ? e1 : (myi == 2 ? e2 : e3))) * inv;
        const int lr = __hip_atomic_fetch_add(&hist[ek], 1, __ATOMIC_RELAXED, __HIP_MEMORY_SCOPE_WORKGROUP);
        ple[tl * 4 + myi] = ek | (lr << 8);
        gate[m * 4 + myi] = gk;
    }
}
__device__ __forceinline__ void p5_router(Frame& F) {
    LAS float* WrT = (LAS float*)F.lds;
    LAS int* hist = (LAS int*)(F.lds + EXTRA_OFF + 1024);
    LAS int* base = (LAS int*)(F.lds + EXTRA_OFF + 1024 + 128);
    LAS int* ple = (LAS int*)(F.lds + EXTRA_OFF + 1024 + 256);
    for (int i = 0; i < 64; ++i) { const int idx = F.tid + 512 * i, k = idx >> 5, e = idx & 31; WrT[e * WRT_LD + k] = F.w_router[idx]; }
    f32x4 g[4];
#pragma unroll
    for (int j = 0; j < 4; ++j) g[j] = *((const f32x4*)F.g_ffn + F.lane + 64 * j);
    const float brl = F.b_router[F.lane & 31];
    const float* X1 = WSP(const float, WS_X1); unsigned char* H2 = WSP(unsigned char, WS_XN);
    unsigned* cnt = F.ctl + CW_CNT; int* list = WSP(int, WS_LIST); float* gate = WSP(float, WS_GATE);
    const int lane = F.lane;
    for (int grp = F.vcu; grp < M / 64; grp += F.G) {
        if (F.tid < 32) hist[F.tid] = 0;
        __syncthreads();
        f32x4 nx0[4], nx1[4];
        { const f32x4* xa = (const f32x4*)(X1 + (size_t)(grp * 64 + 8 * F.wave) * D) + lane;
#pragma unroll
          for (int j = 0; j < 4; ++j) { nx0[j] = xa[64 * j]; nx1[j] = xa[256 + 64 * j]; } }
#pragma unroll 1
        for (int i2 = 0; i2 < 4; ++i2) {
            f32x4 v0[4], v1[4];
#pragma unroll
            for (int j = 0; j < 4; ++j) { v0[j] = nx0[j]; v1[j] = nx1[j]; }
            if (i2 < 3) { const f32x4* xa = (const f32x4*)(X1 + (size_t)(grp * 64 + 8 * F.wave + 2 * i2 + 2) * D) + lane;
#pragma unroll
                for (int j = 0; j < 4; ++j) { nx0[j] = xa[64 * j]; nx1[j] = xa[256 + 64 * j]; } }
            f32x2 vp[4][4];
            { float s0 = 0.f, s1 = 0.f;
#pragma unroll
              for (int j = 0; j < 4; ++j) {
#pragma unroll
                  for (int c = 0; c < 4; ++c) { s0 = fmaf(v0[j][c], v0[j][c], s0); s1 = fmaf(v1[j][c], v1[j][c], s1); } }
              const float r0 = 1.0f / sqrtf(wave_sum(s0) * (1.f / D) + 1e-6f), r1 = 1.0f / sqrtf(wave_sum(s1) * (1.f / D) + 1e-6f);
              const size_t m0 = (size_t)(grp * 64 + 8 * F.wave + 2 * i2);
              unsigned* o0 = (unsigned*)(H2 + m0 * D) + lane; unsigned* o1 = (unsigned*)(H2 + (m0 + 1) * D) + lane;
#pragma unroll
              for (int j = 0; j < 4; ++j) { v0[j] = v0[j] * r0 * g[j]; v1[j] = v1[j] * r1 * g[j];
                  o0[64 * j] = pk4_fp8(v0[j].x, v0[j].y, v0[j].z, v0[j].w);
                  o1[64 * j] = pk4_fp8(v1[j].x, v1[j].y, v1[j].z, v1[j].w);
#pragma unroll
                  for (int c = 0; c < 4; ++c) vp[j][c] = (f32x2){v0[j][c], v1[j][c]}; } }
            f32x2 a2[32];
#pragma unroll
            for (int e4 = 0; e4 < 8; ++e4) {
#pragma unroll
                for (int ee = 0; ee < 4; ++ee) { const int e = 4 * e4 + ee; f32x2 t = {0.f, 0.f};
#pragma unroll
                    for (int j = 0; j < 4; ++j) { const f32x4 wv = *(const LAS f32x4*)(WrT + e * WRT_LD + 256 * j + 4 * lane);
#pragma unroll
                        for (int c = 0; c < 4; ++c) t = __builtin_elementwise_fma(vp[j][c], (f32x2){wv[c], wv[c]}, t); }
                    a2[e] = t; }
                asm volatile("" ::: "memory");
            }
            float a[32];
            { const bool up = (lane & 32) != 0;
#pragma unroll
              for (int q = 0; q < 32; ++q) { const float send = up ? a2[q].x : a2[q].y; const float keep = up ? a2[q].y : a2[q].x; a[q] = keep + __shfl_xor(send, 32); } }
#pragma unroll
            for (int q = 0; q < 16; ++q) { const bool up = (lane & 16) != 0; const float send = up ? a[q] : a[q + 16]; const float keep = up ? a[q + 16] : a[q]; a[q] = keep + __shfl_xor(send, 16); }
#pragma unroll
            for (int q = 0; q < 8; ++q) { const bool up = (lane & 8) != 0; const float send = up ? a[q] : a[q + 8]; const float keep = up ? a[q + 8] : a[q]; a[q] = keep + __shfl_xor(send, 8); }
#pragma unroll
            for (int q = 0; q < 4; ++q) { const bool up = (lane & 4) != 0; const float send = up ? a[q] : a[q + 4]; const float keep = up ? a[q + 4] : a[q]; a[q] = keep + __shfl_xor(send, 4); }
#pragma unroll
            for (int q = 0; q < 2; ++q) { const bool up = (lane & 2) != 0; const float send = up ? a[q] : a[q + 2]; const float keep = up ? a[q + 2] : a[q]; a[q] = keep + __shfl_xor(send, 2); }
            { const bool up = (lane & 1) != 0; const float send = up ? a[0] : a[1]; const float keep = up ? a[1] : a[0]; a[0] = keep + __shfl_xor(send, 1); }
            const int tl = 8 * F.wave + 2 * i2 + (lane >> 5);
            route_pair(a[0] + brl, lane, tl, (size_t)(grp * 64 + tl), hist, ple, gate);
        }
        __syncthreads();
        if (F.tid < 32) base[F.tid] = (int)__hip_atomic_fetch_add(cnt + F.tid, (unsigned)hist[F.tid], RLX_AGENT);
        __syncthreads();
        if (F.tid < 256) { const int pe = ple[F.tid], e = pe & 255, lr = pe >> 8; list[e * CAP + base[e] + lr] = (grp * 64) * 4 + F.tid; }
        __syncthreads();
    }
}

#ifndef MK_MAXU
#define MK_MAXU 12
#endif
constexpr int MAXU = MK_MAXU;
template <int NP>
struct MoeOrder {
    LAS const int* rt0;
    LAS const int* tokl;
    int nwg, G, c, reps;
    __device__ __forceinline__ bool next(int i, pg8::Unit& u) const {
        const long L = (long)i * G + c; if (L >= (long)nwg * reps) return false;
        int wgid = (int)(L % nwg); { const int q = nwg / 8, r = nwg % 8, xcd = wgid % 8, off = wgid / 8; wgid = (xcd < r ? xcd * (q + 1) : r * (q + 1) + (xcd - r) * q) + off; }
        int e = 0;
#pragma unroll 1
        for (int j = 1; j < 32; ++j) if (wgid >= NP * rt0[j]) e = j;
        const int l = wgid - NP * rt0[e], nte = rt0[e + 1] - rt0[e];
        const int pn = l / nte, rt = l - pn * nte;
        u.pm = __builtin_amdgcn_readfirstlane(rt0[e] + rt); u.pn = __builtin_amdgcn_readfirstlane(e * NP + pn); u.e = __builtin_amdgcn_readfirstlane(e); u.rt = __builtin_amdgcn_readfirstlane(rt); return true;
    }
};
struct MoeOrder1 : MoeOrder<8> {
    __device__ __forceinline__ void after_unit(int ui) const {}
    __device__ __forceinline__ unsigned arow(const pg8::Unit& u, int ui, int r) const { return (unsigned)tokl[ui * 256 + r] * 1024u; }
};
struct MoeOrder2 : MoeOrder<4> {
    __device__ __forceinline__ void after_unit(int ui) const {}
    __device__ __forceinline__ unsigned arow(const pg8::Unit& u, int ui, int r) const { return (unsigned)(u.pm * 256 + r) * 1024u; }
};
struct EpiAct {
    static constexpr bool PERM = true;
    const float* b_gu; unsigned char* ACT;
    __device__ __forceinline__ void operator()(const f32x4 (&acc)[2][2][4][2], const pg8::Unit& u, int wr, int wc, int fr, int fq) const {
        const int pn = u.pn & 7, cl = pn * 128 + wc * 32 + 8 * fq;
        const int row0 = u.pm * 256 + wr * 64 + fr;
        const f32x4 bg0 = *(const f32x4*)(b_gu + u.e * 2048 + cl), bg1 = *(const f32x4*)(b_gu + u.e * 2048 + cl + 4);
        const f32x4 bl0 = *(const f32x4*)(b_gu + u.e * 2048 + 1024 + cl), bl1 = *(const f32x4*)(b_gu + u.e * 2048 + 1024 + cl + 4);
#pragma unroll
        for (int ai = 0; ai < 2; ++ai)
#pragma unroll
            for (int m = 0; m < 4; ++m) {
                f32x4 g0 = acc[ai][0][m][0] + bg0, g1 = acc[ai][0][m][1] + bg1, l0 = acc[ai][1][m][0] + bl0, l1 = acc[ai][1][m][1] + bl1;
                float r0[4], r1[4];
#pragma unroll
                for (int j = 0; j < 4; ++j) {
                    const float ga = fminf(g0[j], 7.0f), gb = fminf(g1[j], 7.0f);
                    const float la = fminf(fmaxf(l0[j], -7.0f), 7.0f), lb = fminf(fmaxf(l1[j], -7.0f), 7.0f);
                    r0[j] = (la + 1.0f) * (ga * fast_sigmoid(1.702f * ga)); r1[j] = (lb + 1.0f) * (gb * fast_sigmoid(1.702f * gb));
                }
                u32x2 w; w.x = pk4_fp8(r0[0], r0[1], r0[2], r0[3]); w.y = pk4_fp8(r1[0], r1[1], r1[2], r1[3]);
                *(u32x2*)(ACT + (size_t)(row0 + ai * 128 + m * 16) * 1024 + cl) = w;
            }
    }
};
struct EpiYP {
    static constexpr bool PERM = true;
    const float* b_d; const unsigned* cnt; const int* list; const float* gate; bf16* YP;
    __device__ __forceinline__ void operator()(const f32x4 (&acc)[2][2][4][2], const pg8::Unit& u, int wr, int wc, int fr, int fq) const {
        const int pn = u.pn & 3, col0 = pn * 256 + wc * 32 + 8 * fq;
        const int ne = (int)cnt[u.e];
        f32x4 bv[2][2];
#pragma unroll
        for (int bj = 0; bj < 2; ++bj)
#pragma unroll
            for (int n = 0; n < 2; ++n) bv[bj][n] = *(const f32x4*)(b_d + u.e * 1024 + col0 + bj * 128 + 4 * n);
#pragma unroll
        for (int ai = 0; ai < 2; ++ai)
#pragma unroll
            for (int m = 0; m < 4; ++m) {
                const int slot = u.rt * 256 + ai * 128 + wr * 64 + m * 16 + fr;
                if (slot < ne) {
                    const int pid = list[u.e * CAP + slot]; const float gw = gate[pid];
#pragma unroll
                    for (int bj = 0; bj < 2; ++bj) { const f32x4 v0 = (acc[ai][bj][m][0] + bv[bj][0]) * gw, v1 = (acc[ai][bj][m][1] + bv[bj][1]) * gw;
                        u32x4 w; w.x = pk2(v0[0], v0[1]); w.y = pk2(v0[2], v0[3]); w.z = pk2(v1[0], v1[1]); w.w = pk2(v1[2], v1[3]);
                        *(u32x4*)(YP + (size_t)pid * 1024 + col0 + bj * 128) = w; }
                }
            }
    }
};
__device__ __forceinline__ int moe_setup(Frame& F, LAS int* rt0) {
    if (F.tid == 0) { int acc = 0; for (int e = 0; e < 32; ++e) { rt0[e] = acc; acc += ((int)F.ctl[CW_CNT + e] + 255) >> 8; } rt0[32] = acc; }
    __syncthreads();
    return rt0[32];
}

__device__ __forceinline__ void p8_final(Frame& F, const int nrep) {
    const int gw = F.vcu * NWAVES + F.wave, NGW = F.G * NWAVES;
    const float* X1 = WSP(const float, WS_X1); const bf16* YP = WSP(const bf16, WS_YP);
    f32x4 g[4];
#pragma unroll
    for (int j = 0; j < 4; ++j) g[j] = *((const f32x4*)F.g_final + F.lane + 64 * j);
    float pscale = 1.0f;
#ifdef MK_TPROBE
    { const unsigned long long* st = (const unsigned long long*)(F.ctl + CW_STAMP); const float dt_us = (float)(st[MK_TPROBE_J] - st[MK_TPROBE_I]) * 0.01f; pscale = 1.0f + sqrtf(dt_us * 1e-5f); }
#endif
    for (int m0 = gw; m0 < M * nrep; m0 += NGW) {
        const int m = m0 % M;
        const f32x4* xr = (const f32x4*)(X1 + (size_t)m * D) + F.lane;
        f32x4 v[4]; float s = 0.f;
#pragma unroll
        for (int j = 0; j < 4; ++j) v[j] = xr[64 * j];
#pragma unroll
        for (int k = 0; k < 4; ++k) { const u32x2* yr = (const u32x2*)(YP + ((size_t)m * 4 + k) * 1024) + F.lane;
#pragma unroll
            for (int j = 0; j < 4; ++j) { const u32x2 y = yr[64 * j]; v[j].x += bf_lo(y.x); v[j].y += bf_hi(y.x); v[j].z += bf_lo(y.y); v[j].w += bf_hi(y.y); } }
#pragma unroll
        for (int j = 0; j < 4; ++j) s += (v[j].x * v[j].x + v[j].y * v[j].y) + (v[j].z * v[j].z + v[j].w * v[j].w);
        const float rstd = 1.0f / sqrtf(wave_sum(s) * (1.f / D) + 1e-6f);
        f32x4* op = (f32x4*)(F.out + (size_t)m * D) + F.lane;
#pragma unroll
        for (int j = 0; j < 4; ++j) op[64 * j] = v[j] * (rstd * pscale) * g[j];
    }
}

struct Args { const float* in[18]; float* out; unsigned char* ws; int ph_lo, ph_hi, rep_k, rep_n; };
__global__ void __launch_bounds__(NWAVES * 64, 2) mk_fwd(Args args) {
    extern __shared__ __attribute__((aligned(16))) unsigned char lds[];
    Frame F;
    F.lds = (LAS unsigned char*)lds;
    F.MISC = (volatile LAS unsigned*)(F.lds + MISC_OFF);
    F.tid = threadIdx.x; F.lane = F.tid & 63; F.wave = __builtin_amdgcn_readfirstlane(F.tid >> 6);
    F.G = gridDim.x; { const int bx = blockIdx.x; F.vcu = (F.G % 8 == 0) ? (bx % 8) * (F.G / 8) + bx / 8 : bx; }
    F.ws = args.ws; F.ctl = (unsigned*)(args.ws + WS_CTL);
    F.x = args.in[0]; F.g_mix = args.in[1]; F.w_in = args.in[2]; F.w_up = args.in[3]; F.b_alpha = args.in[4]; F.g_gla = args.in[5]; F.w_conv = args.in[6];
    F.w_a = args.in[7]; F.w_b = args.in[8]; F.w_out = args.in[9]; F.g_ffn = args.in[10]; F.w_router = args.in[11]; F.b_router = args.in[12];
    F.w_gu = args.in[13]; F.b_gu = args.in[14]; F.w_d = args.in[15]; F.b_d = args.in[16]; F.g_final = args.in[17]; F.out = args.out;
    if (F.tid < 128) ((LAS unsigned*)(F.lds + MISC_OFF))[F.tid] = 0u;
    __syncthreads();
    XcdBarrier bar; bar.bar = F.ctl + CW_BAR; bar.x = 0; bar.st = nullptr;
    if (N_LAUNCHES == 1) bar = xcd_barrier_post(F.ctl + CW_BAR, F.MISC + 8);
    const int lo = args.ph_lo, hi = args.ph_hi;
#ifdef MK_ONLY
#define IN(k) ((k) == MK_ONLY && lo <= (k) && (k) < hi)
#else
#define IN(k) (lo <= (k) && (k) < hi)
#endif
#define REPS(k) (((k) == args.rep_k) ? 1 + args.rep_n : 1)
#if defined(MK_TPROBE) || defined(MK_DELAY_K)
#define STAMP(k) do { if (blockIdx.x == 0 && F.tid == 0) ((unsigned long long*)(F.ctl + CW_STAMP))[k] = __builtin_amdgcn_s_memrealtime(); } while (0)
#else
#define STAMP(k) do { } while (0)
#endif
#ifdef MK_DELAY_K
#define DELAY(k) do { if ((k) == MK_DELAY_K) { const unsigned long long dl = __hip_atomic_load((unsigned long long*)(F.ctl + CW_STAMP), RLX_AGENT) + (unsigned long long)(MK_DELAY_US) * 100ull; \
    while (__builtin_amdgcn_s_memrealtime() < dl) __builtin_amdgcn_s_sleep(8); } } while (0)
#else
#define DELAY(k) do { } while (0)
#endif
#define SEAM(k) do { if (IN(k) && IN((k) + 1)) xcd_barrier(bar); STAMP((k) + 1); DELAY(k); } while (0)

    STAMP(0);
    if (IN(0)) { p0_prologue(F, REPS(0), REPS(11)); SEAM(0); }
    if (IN(1)) { const int nrep = REPS(1);
        P1Order S; S.init(M, NZ, D, F.G, (int)blockIdx.x, nrep); S.w_gu = F.w_gu; S.w_d = F.w_d; S.ws = F.ws; S.lds = F.lds; S.slot = ((int)blockIdx.x >> 3) & 7; S.wave = F.wave; S.lane = F.lane;
        EpiZ E{WSP(bf16, WS_Z)};
        pg8::gemm_phase<EpiZ, P1Order, true>(F.lds, WSP(const bf16, WS_XN), WSP(const bf16, WS_WIN), D, S, E);
        SEAM(1);
    }
    if (IN(2)) { const int nrep = REPS(2); for (int it = F.vcu; it < 256 * nrep; it += F.G) gla_item<false>(F, it & 255); conv_rows(F, REPS(12)); SEAM(2); }
    if (IN(3)) { gla_scan(F, REPS(3)); SEAM(3); }
    if (IN(4)) { const int nrep = REPS(4); for (int it = F.vcu; it < 256 * nrep; it += F.G) gla_item<true>(F, it & 255); SEAM(4); }
    if (IN(5)) { const int nrep = REPS(5);
        pg8::StaticOrder S; S.init(M, D, D, F.G, (int)blockIdx.x, nrep);
        EpiM1 E1{WSP(const bf16, WS_Z), WSP(float, WS_M1)};
        pg8::gemm_phase<EpiM1, pg8::StaticOrder, false>(F.lds, WSP(const bf16, WS_OG), WSP(const bf16, WS_WA), D, S, E1);
        EpiMix E2{WSP(const bf16, WS_Z), WSP(const float, WS_M1), WSP(bf16, WS_MIX)};
        pg8::gemm_phase<EpiMix, pg8::StaticOrder, false>(F.lds, WSP(const bf16, WS_PB), WSP(const bf16, WS_WB), D, S, E2);
        SEAM(5);
    }
    if (IN(6)) { const int nrep = REPS(6);
        pg8::StaticOrder S; S.init(M, D, D, F.G, (int)blockIdx.x, nrep);
        EpiX1 E{F.x, WSP(float, WS_X1)};
        pg8::gemm_phase<EpiX1, pg8::StaticOrder, false>(F.lds, WSP(const bf16, WS_MIX), WSP(const bf16, WS_WO), D, S, E);
        SEAM(6);
    }
    if (IN(7)) { p5_router(F); SEAM(7); }
    if (IN(8)) { const int nrep = REPS(8);
        LAS int* rt0 = (LAS int*)(F.lds + EXTRA_OFF); LAS int* tokl = (LAS int*)(F.lds + EXTRA_OFF + 256);
        const int R = moe_setup(F, rt0);
        MoeOrder1 S; S.rt0 = rt0; S.tokl = tokl; S.nwg = R * 8; S.G = F.G; S.c = (int)blockIdx.x; S.reps = nrep;
        const int* list = WSP(const int, WS_LIST);
        { pg8::Unit u; for (int ui = 0; ui < MAXU && S.next(ui, u); ++ui) if (F.tid < 256) { const int slot = u.rt * 256 + F.tid; tokl[ui * 256 + F.tid] = slot < (int)F.ctl[CW_CNT + u.e] ? (list[u.e * CAP + slot] >> 2) : 0; } }
        __syncthreads();
        EpiAct E{F.b_gu, WSP(unsigned char, WS_ACT)};
        pg8::gemm_phase<EpiAct, MoeOrder1, true, true, 122>(F.lds, WSP(const void, WS_XN), WSP(const void, WS_WGU), D, S, E);
        SEAM(8);
    }
    if (IN(9)) { const int nrep = REPS(9);
        LAS int* rt0 = (LAS int*)(F.lds + EXTRA_OFF);
        const int R = moe_setup(F, rt0);
        MoeOrder2 S; S.rt0 = rt0; S.tokl = nullptr; S.nwg = R * 4; S.G = F.G; S.c = (int)blockIdx.x; S.reps = nrep;
        EpiYP E{F.b_d, F.ctl + CW_CNT, WSP(const int, WS_LIST), WSP(const float, WS_GATE), WSP(bf16, WS_YP)};
        pg8::gemm_phase<EpiYP, MoeOrder2, true, true, 122>(F.lds, WSP(const void, WS_ACT), WSP(const void, WS_WD), D, S, E);
        SEAM(9);
    }
    if (IN(10)) { p8_final(F, REPS(10)); }
#undef IN
#undef SEAM
}

extern "C" void kernel_launch(void* const* d_in, const int* in_sizes, int n_in, void* d_out, int out_size, void* d_ws, size_t ws_size, hipStream_t stream) {
    static int grid = 0;
    if (grid == 0) {
        if (n_in != 18 || out_size != M * D || ws_size < WS_END) { fprintf(stderr, "kernel_launch: unexpected shapes (n_in %d, out %d, ws %zu < %zu)\n", n_in, out_size, ws_size, (size_t)WS_END); grid = -1; return; }
        int dev = 0, cus = 0, per_cu = 0;
        if (hipGetDevice(&dev) != hipSuccess || hipDeviceGetAttribute(&cus, hipDeviceAttributeMultiprocessorCount, dev) != hipSuccess) { grid = -1; return; }
        if (hipFuncSetAttribute((const void*)mk_fwd, hipFuncAttributeMaxDynamicSharedMemorySize, LDS_BYTES) != hipSuccess) { fprintf(stderr, "kernel_launch: hipFuncSetAttribute(%d B LDS) failed\n", LDS_BYTES); grid = -1; return; }
        if (hipOccupancyMaxActiveBlocksPerMultiprocessor(&per_cu, (const void*)mk_fwd, NWAVES * 64, LDS_BYTES) != hipSuccess || per_cu < 1) fprintf(stderr, "kernel_launch: occupancy query says %d\n", per_cu);
        (void)hipGetLastError();
        grid = cus;
        if (grid != 256) fprintf(stderr, "kernel_launch: %d CUs (built for 256)\n", grid);
    }
    if (grid < 0) return;
    (void)hipMemsetAsync((char*)d_ws + WS_CTL, 0, CTL_ZERO_BYTES, stream);
    Args a{};
    for (int i = 0; i < 18; ++i) a.in[i] = (const float*)d_in[i];
    a.out = (float*)d_out; a.ws = (unsigned char*)d_ws;
#ifdef MK_REPEAT
    a.rep_k = MK_REPEAT; a.rep_n = MK_REPEAT_N;
#else
    a.rep_k = -1; a.rep_n = 0;
#endif
    for (int li = 0; li < N_LAUNCHES; ++li) {
        a.ph_lo = (N_LAUNCHES == 1) ? 0 : li; a.ph_hi = (N_LAUNCHES == 1) ? NPH : li + 1;
        hipLaunchKernelGGL(mk_fwd, dim3(grid), dim3(NWAVES * 64), LDS_BYTES, stream, a);
    }
}
```

```cpp
#include <hip/hip_runtime.h>
#include <cstdio>
#include <cstdint>

#ifndef MK_N_LAUNCHES
#define MK_N_LAUNCHES 1
#endif

#define LAS __attribute__((address_space(3)))
#define GAS __attribute__((address_space(1)))
typedef unsigned short bf16;
typedef short bf16x8 __attribute__((ext_vector_type(8)));
typedef float f32x4 __attribute__((ext_vector_type(4)));
typedef float f32x2 __attribute__((ext_vector_type(2)));
typedef float f32x16 __attribute__((ext_vector_type(16)));
typedef unsigned u32x4 __attribute__((ext_vector_type(4)));
typedef unsigned u32x2 __attribute__((ext_vector_type(2)));
typedef __bf16 bf16x2_t __attribute__((ext_vector_type(2)));
typedef int v8i32 __attribute__((ext_vector_type(8)));

constexpr int NWAVES = 8;
constexpr int M = 16384, D = 1024, SEQ = 2048;
constexpr int NZS = 8208;
constexpr int NZ = 8192;
constexpr int NE = 32, CAP = 16384;
constexpr int NPH = 11;
constexpr int N_LAUNCHES = MK_N_LAUNCHES;
constexpr size_t ZQ = 0, ZK = ZQ + (size_t)4 * M * 128, ZV = ZK + (size_t)4 * M * 128, ZR = ZV + (size_t)4 * M * 256, ZCB = ZR + (size_t)4 * M * 256, ZCC = ZCB + (size_t)M * 1024, ZCX = ZCC + (size_t)M * 1024, ZGA = ZCX + (size_t)M * 1024, ZGB = ZGA + (size_t)M * 1024;

constexpr size_t MiB = 1u << 20;
constexpr size_t WS_CTL = 0, CTL_ZERO_BYTES = 65536;
constexpr size_t WS_LIST = 1 * MiB;
constexpr size_t WS_GATE = 3 * MiB;
constexpr size_t WS_DECS = 4 * MiB;
constexpr size_t WS_WIN = 16 * MiB;
constexpr size_t WS_WA = 32 * MiB, WS_WB = 34 * MiB, WS_WO = 36 * MiB;
constexpr size_t WS_WGU = 40 * MiB;
constexpr size_t WS_WD = 168 * MiB;
constexpr size_t WS_XN = 232 * MiB;
constexpr size_t WS_LA = 264 * MiB;
constexpr size_t WS_Z = 296 * MiB;
constexpr size_t WS_YP = WS_Z;
constexpr size_t WS_U = 552 * MiB;
constexpr size_t WS_SIN = 584 * MiB;
constexpr size_t WS_OG = 616 * MiB;
constexpr size_t WS_PB = 648 * MiB;
constexpr size_t WS_M1 = 680 * MiB;
constexpr size_t WS_MIX = 744 * MiB;
constexpr size_t WS_X1 = 776 * MiB;
constexpr size_t WS_ACT = 840 * MiB;
constexpr size_t WS_END = 984 * MiB;
constexpr int CW_TMO = 0;
constexpr int CW_BAR = 4096;
constexpr int CW_CNT = 8192;
constexpr int CW_STAMP = 12288;

constexpr int RING_BYTES = 131072;
constexpr int EXTRA_OFF = RING_BYTES;
constexpr int LDS_BYTES = 155648 + 512;
constexpr int MISC_OFF = 155648;

#define RLX_AGENT __ATOMIC_RELAXED, __HIP_MEMORY_SCOPE_AGENT
#define LDS_WAIT() asm volatile("s_waitcnt lgkmcnt(0)" ::: "memory")
#define VM_WAIT() asm volatile("s_waitcnt vmcnt(0)" ::: "memory")
__device__ __forceinline__ unsigned pk2(float lo, float hi) { f32x2 v = {lo, hi}; bf16x2_t b = __builtin_convertvector(v, bf16x2_t); return __builtin_bit_cast(unsigned, b); }
__device__ __forceinline__ unsigned pk4_fp8(float a, float b, float c, float d) { int w = 0; w = __builtin_amdgcn_cvt_pk_fp8_f32(a, b, w, false); w = __builtin_amdgcn_cvt_pk_fp8_f32(c, d, w, true); return (unsigned)w; }
__device__ __forceinline__ float bf_lo(unsigned w) { return __builtin_bit_cast(float, w << 16); }
__device__ __forceinline__ float bf_hi(unsigned w) { return __builtin_bit_cast(float, w & 0xffff0000u); }
__device__ __forceinline__ float bf1(bf16 b) { return __builtin_bit_cast(float, ((unsigned)b) << 16); }
__device__ __forceinline__ float fast_sigmoid(float x) { return __builtin_amdgcn_rcpf(1.0f + __expf(-x)); }
__device__ __forceinline__ float wave_sum(float v) {
#pragma unroll
    for (int o = 1; o < 64; o <<= 1) v += __shfl_xor(v, o);
    return v;
}

namespace pg8 {
constexpr int BM = 256, BK = 64, HALF = 128, HTB = HALF * BK * 2, STAGE_BYTES = 8 * HTB, NXCD = 8, WGM = 8;
__device__ __forceinline__ int lds_byte(int r, int c) { const int st = (r >> 4) * 2 + (c >> 5), rr = r & 15, cc = c & 31, ob = rr * 64 + cc * 2; return st * 1024 + (ob ^ (((ob >> 9) & 1) << 5)); }
__device__ __forceinline__ void stage_rc(int b, int& R, int& C) { const int st = b / 1024, sb = b % 1024, swz = sb ^ (((sb >> 9) & 1) << 5); R = (st >> 1) * 16 + swz / 64; C = (st & 1) * 32 + (swz % 64) / 2; }
__device__ __forceinline__ int perm32(int rho) { const int n = rho >> 4, i = rho & 15; return 8 * (i >> 2) + 4 * n + (i & 3); }

struct Unit { int pm, pn, e, rt; };

struct StaticOrder {
    int nM, nN, nwg, G, c, K, reps;
    __device__ __forceinline__ void init(int M_, int N_, int K_, int G_, int c_, int reps_) { nM = M_ / BM; nN = N_ / BM; nwg = nM * nN; G = G_; c = c_; K = K_; reps = reps_; }
    __device__ __forceinline__ bool next(int i, Unit& u) const {
        const long L = (long)i * G + c; if (L >= (long)nwg * reps) return false;
        int wgid = (int)(L % nwg); { const int q = nwg / NXCD, r = nwg % NXCD, xcd = wgid % NXCD, off = wgid / NXCD; wgid = (xcd < r ? xcd * (q + 1) : r * (q + 1) + (xcd - r) * q) + off; }
        const int nig = WGM * nN, gid = wgid / nig, fm = gid * WGM, gsz = (nM - fm) < WGM ? (nM - fm) : WGM;
        u.pm = fm + ((wgid % nig) % gsz); u.pn = (wgid % nig) / gsz; u.e = 0; u.rt = 0; return true;
    }
    __device__ __forceinline__ unsigned arow(const Unit& u, int ui, int r) const { return (unsigned)(u.pm * BM + r) * (unsigned)(K * 2); }
    __device__ __forceinline__ void after_unit(int ui) const {}
};

template <class Epi, class Sched, bool ALIGN_EPI, bool FP8 = false, int SCW = 127>
__device__ __forceinline__ void gemm_phase(LAS unsigned char* lds, const void* Ag, const void* Btg, const int K, const Sched& S, const Epi& E) {
    const int tid = threadIdx.x, wid = __builtin_amdgcn_readfirstlane(tid >> 6), lane = tid & 63, wr = wid >> 2, wc = wid & 3, fr = lane & 15, fq = lane >> 4;
    const int RB = FP8 ? K : 2 * K;
    const int nt = RB / 128;
    int RA[2], CA[2]; unsigned voffB[2];
#pragma unroll
    for (int i = 0; i < 2; ++i) { int R, C; stage_rc(tid * 16 + i * 8192, R, C); const int Rb = Epi::PERM ? ((R & ~31) + perm32(R & 31)) : R;
        RA[i] = R; CA[i] = C * 2; voffB[i] = (unsigned)(Rb * RB + C * 2); }
    const size_t kstep = (size_t)(BK * 2);
    const size_t hstep = (size_t)HALF * RB;
    const size_t tstep = 2 * hstep;
    const unsigned ldsw = (unsigned)wid * 1024u;
    const int aoff = lds_byte(wr * 64 + fr, fq * 8), boff = lds_byte(wc * 32 + fr, fq * 8);
#define PG8_SA(b, h) (((b) * 2 + (h)) * HTB)
#define PG8_SB(b, h) ((4 + (b) * 2 + (h)) * HTB)
#define PG8_STAGEB(bufoff, gbase) do { _Pragma("unroll") for (int _i = 0; _i < 2; ++_i) \
        __builtin_amdgcn_global_load_lds((const unsigned*)((const char*)(gbase) + voffB[_i]), (LAS unsigned*)(lds + (bufoff) + ldsw + _i * 8192), 16, 0, 0); } while (0)
#define PG8_STAGEA(bufoff, o0, o1) do { \
        __builtin_amdgcn_global_load_lds((const unsigned*)((const char*)Ag + (o0)), (LAS unsigned*)(lds + (bufoff) + ldsw), 16, 0, 0); \
        __builtin_amdgcn_global_load_lds((const unsigned*)((const char*)Ag + (o1)), (LAS unsigned*)(lds + (bufoff) + ldsw + 8192), 16, 0, 0); } while (0)
#define PG8_LDA(dst, b, h) do { if constexpr (FP8) { _Pragma("unroll") for (int m = 0; m < 4; ++m) { dst[m][0] = *(const LAS bf16x8*)(lds + PG8_SA(b, h) + aoff + m * 2048); dst[m][1] = *(const LAS bf16x8*)(lds + PG8_SA(b, h) + aoff + m * 2048 + 1024); } } \
        else { _Pragma("unroll") for (int m = 0; m < 4; ++m) _Pragma("unroll") for (int k = 0; k < 2; ++k) dst[m][k] = *(const LAS bf16x8*)(lds + PG8_SA(b, h) + aoff + m * 2048 + k * 1024); } } while (0)
#define PG8_LDB(dst, b, h) do { if constexpr (FP8) { _Pragma("unroll") for (int n = 0; n < 2; ++n) { dst[n][0] = *(const LAS bf16x8*)(lds + PG8_SB(b, h) + boff + n * 2048); dst[n][1] = *(const LAS bf16x8*)(lds + PG8_SB(b, h) + boff + n * 2048 + 1024); } } \
        else { _Pragma("unroll") for (int n = 0; n < 2; ++n) _Pragma("unroll") for (int k = 0; k < 2; ++k) dst[n][k] = *(const LAS bf16x8*)(lds + PG8_SB(b, h) + boff + n * 2048 + k * 1024); } } while (0)
#define PG8_F8(x) __builtin_bit_cast(v8i32, __builtin_shufflevector(__builtin_bit_cast(u32x4, (x)[0]), __builtin_bit_cast(u32x4, (x)[1]), 0, 1, 2, 3, 4, 5, 6, 7))
#define PG8_MMA(ai, bj, At, Bt) do { __builtin_amdgcn_s_setprio(1); if constexpr (FP8) { _Pragma("unroll") for (int m = 0; m < 4; ++m) _Pragma("unroll") for (int n = 0; n < 2; ++n) \
        asm volatile("v_mfma_scale_f32_16x16x128_f8f6f4 %0, %1, %2, %0, %3, %4 op_sel_hi:[0,0,0]" : "+v"(acc[ai][bj][m][n]) : "v"(PG8_F8(Bt[n])), "v"(PG8_F8(At[m])), "v"(scw_reg), "v"(sca_reg)); } \
        else { _Pragma("unroll") for (int m = 0; m < 4; ++m) _Pragma("unroll") for (int n = 0; n < 2; ++n) _Pragma("unroll") for (int k = 0; k < 2; ++k) \
        acc[ai][bj][m][n] = __builtin_amdgcn_mfma_f32_16x16x32_bf16(Bt[n][k], At[m][k], acc[ai][bj][m][n], 0, 0, 0); } __builtin_amdgcn_s_setprio(0); } while (0)
#define PG8_WAIT_V(n) asm volatile("s_waitcnt vmcnt(" #n ")" ::: "memory")
#define PG8_WAIT_L(n) asm volatile("s_waitcnt lgkmcnt(" #n ")" ::: "memory")
#define PG8_BAR __builtin_amdgcn_s_barrier()
#define PG8_SCHED __builtin_amdgcn_sched_barrier(0)
    Unit cur, nxt; int ui = 0;
    if (!S.next(0, cur)) return;
    int scw_reg = SCW, sca_reg = 127;
    asm volatile("" : "+v"(scw_reg), "+v"(sca_reg));
    f32x4 acc[2][2][4][2];
#pragma unroll
    for (int a = 0; a < 2; ++a)
#pragma unroll
        for (int b = 0; b < 2; ++b)
#pragma unroll
            for (int m = 0; m < 4; ++m)
#pragma unroll
                for (int n = 0; n < 2; ++n) acc[a][b][m][n] = (f32x4){0.f, 0.f, 0.f, 0.f};
#define PG8_ZPAD() do { if constexpr (FP8) { _Pragma("unroll") for (int a = 0; a < 2; ++a) _Pragma("unroll") for (int b = 0; b < 2; ++b) _Pragma("unroll") for (int m = 0; m < 4; ++m) asm volatile("s_nop 1" : "+v"(acc[a][b][m][0]), "+v"(acc[a][b][m][1])); } } while (0)
    PG8_ZPAD();
    bf16x8 At[4][2], B0[2][2], B1[2][2];
    unsigned ac00, ac01, ac10, ac11;
    ac00 = S.arow(cur, 0, RA[0]) + CA[0]; ac01 = S.arow(cur, 0, RA[1]) + CA[1]; ac10 = S.arow(cur, 0, HALF + RA[0]) + CA[0]; ac11 = S.arow(cur, 0, HALF + RA[1]) + CA[1];
    const char* cB = (const char*)Btg + (size_t)cur.pn * tstep;
    PG8_STAGEB(PG8_SB(0, 0), cB); PG8_STAGEB(PG8_SB(0, 1), cB + hstep); PG8_STAGEA(PG8_SA(0, 0), ac00, ac01); PG8_STAGEA(PG8_SA(0, 1), ac10, ac11);
    if (wr == 1) PG8_BAR;
    PG8_WAIT_V(2); PG8_BAR;
    PG8_STAGEB(PG8_SB(1, 0), cB + kstep); PG8_STAGEA(PG8_SA(1, 0), ac00 + 128u, ac01 + 128u); PG8_STAGEB(PG8_SB(1, 1), cB + hstep + kstep);
    PG8_WAIT_V(6); PG8_BAR;
    for (;;) {
        const bool has_next = S.next(ui + 1, nxt);
        const char* nB = has_next ? (const char*)Btg + (size_t)nxt.pn * tstep : cB;
#pragma unroll 1
        for (int t = 0; t < nt; t += 2) {
            const bool last = (t == nt - 2);
            const unsigned k1 = (unsigned)(t + 1) * 128u, k2 = (unsigned)(t + 2) * 128u;
            unsigned a200 = ac00 + k2, a201 = ac01 + k2, a210 = ac10 + k2, a211 = ac11 + k2;
            if (last) { if (has_next) { a200 = S.arow(nxt, ui + 1, RA[0]) + CA[0]; a201 = S.arow(nxt, ui + 1, RA[1]) + CA[1]; a210 = S.arow(nxt, ui + 1, HALF + RA[0]) + CA[0]; a211 = S.arow(nxt, ui + 1, HALF + RA[1]) + CA[1]; }
                        else { a200 = ac00; a201 = ac01; a210 = ac10; a211 = ac11; } }
            const char* b2 = last ? nB : cB + (size_t)k2; const char* b3 = b2 + kstep;
            PG8_LDB(B0, 0, 0); PG8_LDB(B1, 0, 1); PG8_SCHED; PG8_LDA(At, 0, 0); PG8_STAGEA(PG8_SA(1, 1), ac10 + k1, ac11 + k1);
            PG8_WAIT_V(8); PG8_WAIT_L(0); PG8_BAR; PG8_MMA(0, 0, At, B0); PG8_MMA(0, 1, At, B1); PG8_BAR; PG8_SCHED;
            PG8_LDA(At, 0, 1); PG8_STAGEB(PG8_SB(0, 0), b2); PG8_STAGEB(PG8_SB(0, 1), b2 + hstep); PG8_STAGEA(PG8_SA(0, 0), a200, a201);
            PG8_WAIT_V(8); PG8_WAIT_L(0); PG8_BAR; PG8_MMA(1, 0, At, B0); PG8_MMA(1, 1, At, B1); PG8_BAR; PG8_SCHED;
            PG8_LDB(B0, 1, 0); PG8_LDB(B1, 1, 1); PG8_SCHED; PG8_LDA(At, 1, 0); PG8_STAGEA(PG8_SA(0, 1), a210, a211);
            PG8_WAIT_V(8); PG8_WAIT_L(0); PG8_BAR; PG8_MMA(0, 0, At, B0); PG8_MMA(0, 1, At, B1); PG8_BAR; PG8_SCHED;
            PG8_LDA(At, 1, 1); PG8_STAGEB(PG8_SB(1, 0), b3); PG8_STAGEB(PG8_SB(1, 1), b3 + hstep); PG8_STAGEA(PG8_SA(1, 0), a200 + 128u, a201 + 128u);
            PG8_WAIT_V(8); PG8_WAIT_L(0); PG8_BAR; PG8_MMA(1, 0, At, B0); PG8_MMA(1, 1, At, B1); PG8_BAR; PG8_SCHED;
        }
        if constexpr (FP8) asm volatile("s_nop 15\n\ts_nop 15" ::: "memory");
#pragma unroll
        for (int a = 0; a < 2; ++a)
#pragma unroll
            for (int b = 0; b < 2; ++b)
#pragma unroll
                for (int m = 0; m < 4; ++m) asm volatile("" : "+v"(acc[a][b][m][0]), "+v"(acc[a][b][m][1]));
        if constexpr (ALIGN_EPI) { if (wr == 0) PG8_BAR; }
        E(acc, cur, wr, wc, fr, fq);
        S.after_unit(ui);
        if (!has_next) break;
#pragma unroll
        for (int a = 0; a < 2; ++a)
#pragma unroll
            for (int b = 0; b < 2; ++b)
#pragma unroll
                for (int m = 0; m < 4; ++m)
#pragma unroll
                    for (int n = 0; n < 2; ++n) acc[a][b][m][n] = (f32x4){0.f, 0.f, 0.f, 0.f};
        PG8_ZPAD();
        cur = nxt; cB = nB; ++ui;
        ac00 = S.arow(cur, ui, RA[0]) + CA[0]; ac01 = S.arow(cur, ui, RA[1]) + CA[1]; ac10 = S.arow(cur, ui, HALF + RA[0]) + CA[0]; ac11 = S.arow(cur, ui, HALF + RA[1]) + CA[1];
        if constexpr (ALIGN_EPI) { if (wr == 1) PG8_BAR; }
    }
    PG8_WAIT_V(0);
    if constexpr (!ALIGN_EPI) { if (wr == 0) PG8_BAR; }
    PG8_BAR;
#undef PG8_SA
#undef PG8_SB
#undef PG8_STAGEA
#undef PG8_STAGEB
#undef PG8_LDA
#undef PG8_LDB
#undef PG8_MMA
#undef PG8_F8
#undef PG8_ZPAD
#undef PG8_WAIT_V
#undef PG8_WAIT_L
#undef PG8_BAR
#undef PG8_SCHED
}
}

#define XB_TMO      128
#define XB_XCNT(j)  (256  + 64 * (j))
#define XB_XSUB(j)  (1280 + 64 * (j))
#define XB_XGEN(j)  (2304 + 64 * (j))
#define XB_TOP      3328
#define XB_TOPGEN   3392
#define XCD_BAR_WORDS 3456
#define XB_SPIN_CAP (1u << 18)
__device__ __forceinline__ unsigned xb_ld(unsigned* p)              { return __hip_atomic_load(p, __ATOMIC_RELAXED, __HIP_MEMORY_SCOPE_AGENT); }
__device__ __forceinline__ unsigned xb_add(unsigned* p, unsigned v) { return __hip_atomic_fetch_add(p, v, __ATOMIC_RELAXED, __HIP_MEMORY_SCOPE_AGENT); }
__device__ __forceinline__ unsigned xb_xcc_id() { return (unsigned)__builtin_amdgcn_s_getreg((3 << 11) | 20) & 0xFu; }
#define XB_SPIN(cond, bar) do { unsigned _sp = 0; while (cond) { __builtin_amdgcn_s_sleep(1); \
    if ((++_sp & 255u) == 0u) { if (xb_ld(&(bar)[XB_TMO])) break; if (_sp > XB_SPIN_CAP) { atomicAdd(&(bar)[XB_TMO], 1u); break; } } } } while (0)
struct XcdBarrier { unsigned* bar; unsigned x; volatile LAS unsigned* st; };
__device__ __forceinline__ XcdBarrier xcd_barrier_post(unsigned* bar, volatile LAS unsigned* st) {
    XcdBarrier b; b.bar = bar; b.x = xb_xcc_id(); b.st = st;
    if (threadIdx.x == 0) (void)xb_add(&bar[XB_XCNT(b.x)], 1u);
    return b;
}
__device__ __forceinline__ void xcd_barrier_complete(unsigned* bar, unsigned x, unsigned& nloc, unsigned& nx) {
    const unsigned G = gridDim.x * gridDim.y * gridDim.z;
    unsigned sum, cnt, mine, sp = 0u;
    for (;;) {
        sum = 0u; cnt = 0u; mine = 0u;
#pragma unroll
        for (unsigned j = 0; j < 16; ++j) { const unsigned c = xb_ld(&bar[XB_XCNT(j)]); sum += c; cnt += (c > 0u) ? 1u : 0u; mine = (j == x) ? c : mine; }
        if (sum == G) break;
        __builtin_amdgcn_s_sleep(1);
        if ((++sp & 255u) == 0u) { if (xb_ld(&bar[XB_TMO])) break; if (sp > XB_SPIN_CAP) { atomicAdd(&bar[XB_TMO], 1u); break; } }
    }
    nloc = mine > 0u ? mine : 1u; nx = cnt > 0u ? cnt : 1u;
}
__device__ __forceinline__ void xcd_barrier(const XcdBarrier& b) {
    asm volatile("s_waitcnt vmcnt(0)" ::: "memory");
    __syncthreads();
    if (threadIdx.x == 0) {
        unsigned* bar = b.bar;
        __builtin_amdgcn_s_waitcnt(0);
        unsigned nloc = b.st[0], nx = b.st[1];
        if (nloc == 0u) { xcd_barrier_complete(bar, b.x, nloc, nx); b.st[0] = nloc; b.st[1] = nx; }
        const unsigned old = xb_add(&bar[XB_XSUB(b.x)], 1u);
        const unsigned gen = old / nloc;
        if (old + 1u == (gen + 1u) * nloc) {
            __builtin_amdgcn_fence(__ATOMIC_RELEASE, "agent");
            asm volatile("s_waitcnt vmcnt(0)" ::: "memory");
            const unsigned og = xb_add(&bar[XB_TOP], 1u);
            const unsigned tg = og / nx;
            if (og + 1u == (tg + 1u) * nx) xb_add(&bar[XB_TOPGEN], 1u);
            else XB_SPIN(xb_ld(&bar[XB_TOPGEN]) == tg, bar);
            __builtin_amdgcn_fence(__ATOMIC_ACQUIRE, "agent");
            xb_add(&bar[XB_XGEN(b.x)], 1u);
            asm volatile("s_waitcnt vmcnt(0)" ::: "memory");
        } else {
            XB_SPIN(xb_ld(&bar[XB_XGEN(b.x)]) == gen, bar);
            __builtin_amdgcn_fence(__ATOMIC_ACQUIRE, "agent");
            asm volatile("s_waitcnt vmcnt(0)" ::: "memory");
        }
    }
    __syncthreads();
}

struct Frame {
    LAS unsigned char* lds;
    volatile LAS unsigned* MISC;
    unsigned* ctl;
    int tid, lane, wave, vcu, G;
    unsigned char* ws;
    const float *x, *g_mix, *w_in, *w_up, *b_alpha, *g_gla, *w_conv, *w_a, *w_b, *w_out, *g_ffn, *w_router, *b_router, *w_gu, *b_gu, *w_d, *b_d, *g_final;
    float* out;
};
#define WSP(T, off) ((T*)(F.ws + (off)))

__device__ __forceinline__ void tr_item64(const float* W, int ld, int k0, int n0, bf16* WT, size_t dst_row0, int K, LAS unsigned* T, int lane) {
    const int nq = lane & 15, kr = lane >> 4;
    const float* src = W + (size_t)(k0 + 2 * kr) * ld + n0 + 4 * nq;
    f32x4 a0[8], a1[8];
#pragma unroll
    for (int it = 0; it < 8; ++it) { a0[it] = *(const f32x4*)(src + (size_t)(8 * it) * ld); a1[it] = *(const f32x4*)(src + (size_t)(8 * it + 1) * ld); }
    const int c = lane & 7;
#pragma unroll
    for (int hf = 0; hf < 2; ++hf) {
        if ((nq >> 3) == hf) {
#pragma unroll
            for (int it = 0; it < 8; ++it)
#pragma unroll
                for (int q = 0; q < 4; ++q) T[(4 * (nq & 7) + q) * 33 + 4 * it + kr] = pk2(a0[it][q], a1[it][q]);
        }
        LDS_WAIT(); asm volatile("" ::: "memory");
#pragma unroll
        for (int j = 0; j < 4; ++j) { const int n = (lane >> 3) + 8 * j; const LAS unsigned* t = T + n * 33 + 4 * c;
            u32x4 o; o.x = t[0]; o.y = t[1]; o.z = t[2]; o.w = t[3];
            *(u32x4*)(WT + (dst_row0 + 32 * hf + n) * (size_t)K + k0 + 8 * c) = o; }
        LDS_WAIT(); asm volatile("" ::: "memory");
    }
}

__device__ __forceinline__ void tr_item8(const float* W, int ld, int k0, int n0, unsigned char* WT8, size_t dst_row0, int KB, float scale, LAS unsigned* T, int lane) {
    const int nq = lane & 7, kr = lane >> 3;
    const float* src = W + (size_t)(k0 + 4 * kr) * ld + n0 + 4 * nq;
    f32x4 a[4][4];
#pragma unroll
    for (int it = 0; it < 4; ++it)
#pragma unroll
        for (int j = 0; j < 4; ++j) a[it][j] = *(const f32x4*)(src + (size_t)(32 * it + j) * ld);
    const int c = lane & 7;
#pragma unroll
    for (int hf = 0; hf < 2; ++hf) {
        if ((nq >> 2) == hf) {
#pragma unroll
            for (int it = 0; it < 4; ++it)
#pragma unroll
                for (int q = 0; q < 4; ++q) T[(4 * (nq & 3) + q) * 33 + 8 * it + kr] = pk4_fp8(a[it][0][q] * scale, a[it][1][q] * scale, a[it][2][q] * scale, a[it][3][q] * scale);
        }
        LDS_WAIT(); asm volatile("" ::: "memory");
#pragma unroll
        for (int j = 0; j < 2; ++j) { const int n = (lane >> 3) + 8 * j; const LAS unsigned* t = T + n * 33 + 4 * c;
            u32x4 o; o.x = t[0]; o.y = t[1]; o.z = t[2]; o.w = t[3];
            *(u32x4*)(WT8 + (dst_row0 + 16 * hf + n) * (size_t)KB + k0 + 16 * c) = o; }
        LDS_WAIT(); asm volatile("" ::: "memory");
    }
}
__device__ __forceinline__ void moe_convert_share(const float* w_gu, const float* w_d, unsigned char* ws, LAS unsigned char* lds, int c, int G, int wave, int lane) {
    LAS unsigned* T = (LAS unsigned*)(lds + EXTRA_OFF + wave * 2176);
    constexpr int I_GU = NE * 64 * 8, I_D = NE * 32 * 8;
    for (int it = c * NWAVES + wave; it < I_GU + I_D; it += G * NWAVES) {
        int r = it;
        if (r < I_GU) { const int e = r >> 9, q = r & 511, kb = q >> 6, nb = q & 63, j0 = 32 * nb, pn = j0 >> 8, within = j0 & 255, half = within >> 7;
            tr_item8(w_gu + (size_t)e * 1024 * 2048, 2048, 128 * kb, half * 1024 + pn * 128 + (within & 127), ws + WS_WGU + (size_t)e * 2048 * 1024, j0, 1024, 32.0f, T, lane); continue; } r -= I_GU;
        { const int e = r >> 8, q = r & 255, kb = q >> 5, nb = q & 31;
            tr_item8(w_d + (size_t)e * 1024 * 1024, 1024, 128 * kb, 32 * nb, ws + WS_WD + (size_t)e * 1024 * 1024, 32 * nb, 1024, 32.0f, T, lane); }
    }
}
struct P1Order : pg8::StaticOrder {
    const float* w_gu; const float* w_d; unsigned char* ws; LAS unsigned char* lds; int slot, wave, lane;
    __device__ __forceinline__ void after_unit(int ui) const { if (ui == slot) { int ln = lane; asm volatile("" : "+v"(ln));
            moe_convert_share(w_gu, w_d, ws, lds, c, G, wave, ln); } }
};

constexpr int P0_T_BYTES = 4352;
constexpr int P0_WL = 8 * P0_T_BYTES;
constexpr int P0_WU = P0_WL + 65536;
constexpr int P0_BA = P0_WU + 32768;

__device__ __forceinline__ void p0_items(Frame& F, const int nrep) {
    LAS unsigned* scr = (LAS unsigned*)(F.lds + F.wave * P0_T_BYTES);
    const int gw = F.vcu * NWAVES + F.wave, NGW = F.G * NWAVES;
    constexpr int I_IN = 128 * 16, I_SQ = 16 * 16;
    constexpr int NITEMS = I_IN + 3 * I_SQ;
    bf16* Win_t = WSP(bf16, WS_WIN);
    for (int it0 = gw; it0 < NITEMS * nrep; it0 += NGW) {
        int r = it0 % NITEMS;
        if (r < I_IN) { const int kb = r >> 7, nb = r & 127, j0 = 64 * nb; tr_item64(F.w_in, NZS, 64 * kb, j0 < 3072 ? j0 : j0 + 16, Win_t, j0, 1024, scr, F.lane); continue; } r -= I_IN;
        if (r < I_SQ) { tr_item64(F.w_a, 1024, 64 * (r >> 4), 64 * (r & 15), WSP(bf16, WS_WA), 64 * (r & 15), 1024, scr, F.lane); continue; } r -= I_SQ;
        if (r < I_SQ) { tr_item64(F.w_b, 1024, 64 * (r >> 4), 64 * (r & 15), WSP(bf16, WS_WB), 64 * (r & 15), 1024, scr, F.lane); continue; } r -= I_SQ;
        tr_item64(F.w_out, 1024, 64 * (r >> 4), 64 * (r & 15), WSP(bf16, WS_WO), 64 * (r & 15), 1024, scr, F.lane);
    }
}

__device__ __forceinline__ void p0_rows(Frame& F, const int nrep2) {
    const int gw = F.vcu * NWAVES + F.wave, NGW = F.G * NWAVES;
    LAS float* Wl = (LAS float*)(F.lds + P0_WL);
    LAS float* WU = (LAS float*)(F.lds + P0_WU);
    LAS float* BA = (LAS float*)(F.lds + P0_BA);
    f32x4 g[4];
#pragma unroll
    for (int j = 0; j < 4; ++j) g[j] = *((const f32x4*)F.g_mix + F.lane + 64 * j);
    bf16* XN = WSP(bf16, WS_XN); float* LA = WSP(float, WS_LA);
    f32x4 nx[4];
    if (gw < M * nrep2) { const f32x4* xr = (const f32x4*)(F.x + (size_t)(gw % M) * D) + F.lane;
#pragma unroll
        for (int j = 0; j < 4; ++j) nx[j] = xr[64 * j]; }
#pragma unroll 1
    for (int m0 = gw; m0 < M * nrep2; m0 += NGW) {
        const int m = m0 % M;
        f32x4 v[4]; float s = 0.f;
#pragma unroll
        for (int j = 0; j < 4; ++j) { v[j] = nx[j]; s += (v[j].x * v[j].x + v[j].y * v[j].y) + (v[j].z * v[j].z + v[j].w * v[j].w); }
        if (m0 + NGW < M * nrep2) { const f32x4* xr = (const f32x4*)(F.x + (size_t)((m0 + NGW) % M) * D) + F.lane;
#pragma unroll
            for (int j = 0; j < 4; ++j) nx[j] = xr[64 * j]; }
        const float rstd = 1.0f / sqrtf(wave_sum(s) * (1.f / D) + 1e-6f);
        unsigned long long* o8 = (unsigned long long*)(XN + (size_t)m * D) + F.lane;
#pragma unroll
        for (int j = 0; j < 4; ++j) { v[j] = v[j] * rstd * g[j]; o8[64 * j] = (unsigned long long)pk2(v[j].x, v[j].y) | ((unsigned long long)pk2(v[j].z, v[j].w) << 32); }
        float a[16];
#pragma unroll
        for (int r4 = 0; r4 < 4; ++r4) {
#pragma unroll
            for (int rr = 0; rr < 4; ++rr) { const int r = 4 * r4 + rr; float t = 0.f;
#pragma unroll
                for (int j = 0; j < 4; ++j) { const f32x4 w = *(const LAS f32x4*)(Wl + r * 1024 + 256 * j + 4 * F.lane); t = fmaf(v[j].x, w.x, t); t = fmaf(v[j].y, w.y, t); t = fmaf(v[j].z, w.z, t); t = fmaf(v[j].w, w.w, t); }
                a[r] = t; }
            asm volatile("" ::: "memory");
        }
#pragma unroll
        for (int q = 0; q < 8; ++q) { const bool up = (F.lane & 32) != 0; const float send = up ? a[q] : a[q + 8]; const float keep = up ? a[q + 8] : a[q]; a[q] = keep + __shfl_xor(send, 32); }
#pragma unroll
        for (int q = 0; q < 4; ++q) { const bool up = (F.lane & 16) != 0; const float send = up ? a[q] : a[q + 4]; const float keep = up ? a[q + 4] : a[q]; a[q] = keep + __shfl_xor(send, 16); }
#pragma unroll
        for (int q = 0; q < 2; ++q) { const bool up = (F.lane & 8) != 0; const float send = up ? a[q] : a[q + 2]; const float keep = up ? a[q + 2] : a[q]; a[q] = keep + __shfl_xor(send, 8); }
        { const bool up = (F.lane & 4) != 0; const float send = up ? a[0] : a[1]; const float keep = up ? a[1] : a[0]; a[0] = keep + __shfl_xor(send, 4); }
        float alv = a[0]; alv += __shfl_xor(alv, 2); alv += __shfl_xor(alv, 1);
        float al[16];
#pragma unroll
        for (int r = 0; r < 16; ++r) al[r] = __builtin_bit_cast(float, __builtin_amdgcn_readlane(__builtin_bit_cast(int, alv), 4 * r));
#pragma unroll
        for (int i = 0; i < 8; ++i) { const int j = F.lane + 64 * i; float pre = BA[j];
#pragma unroll
            for (int r = 0; r < 16; ++r) pre = fmaf(al[r], WU[r * 512 + j], pre);
            const float ls = fminf(pre, 0.f) - __logf(1.0f + __expf(-fabsf(pre)));
            LA[((size_t)(i >> 1) * M + m) * 128 + (j & 127)] = ls * (1.0f / 16.0f);
            if (i & 1) asm volatile("" ::: "memory"); }
    }
}

__device__ __forceinline__ void p0_prologue(Frame& F, const int nrep, const int nrep2) {
    {
        LAS float* Wl = (LAS float*)(F.lds + P0_WL); LAS float* WU = (LAS float*)(F.lds + P0_WU); LAS float* BA = (LAS float*)(F.lds + P0_BA);
        for (int i = 0; i < 32; ++i) { const int idx = F.tid + 512 * i, k = idx >> 4, r = idx & 15; Wl[r * 1024 + k] = F.w_in[(size_t)k * NZS + 3072 + r]; }
        for (int i = 0; i < 16; ++i) { const int idx = F.tid + 512 * i; WU[idx] = F.w_up[idx]; }
        BA[F.tid] = F.b_alpha[F.tid];
        __syncthreads();
    }
#pragma unroll 1
    for (int pass = 0; pass < 2; ++pass) {
        if (((pass ^ F.wave) & 1) == 0) p0_items(F, nrep); else p0_rows(F, nrep2);
    }
}

struct EpiZ {
    static constexpr bool PERM = true;
    bf16* Z;
    __device__ __forceinline__ void operator()(const f32x4 (&acc)[2][2][4][2], const pg8::Unit& u, int wr, int wc, int fr, int fq) const {
        const int row0 = u.pm * 256 + wr * 64 + fr, c0 = wc * 32 + 8 * fq;
        const int pn = u.pn;
        const int kind = pn < 2 ? 1 : (pn < 8 ? 0 : (pn < 12 ? 2 : (pn < 24 ? 0 : 3)));
        bf16* base; int ld; size_t bjs;
        if (pn < 4) { base = Z + (pn < 2 ? ZQ : ZK) + (size_t)(2 * (pn & 1)) * M * 128; ld = 128; bjs = (size_t)M * 128; }
        else if (pn < 12) { base = Z + (pn < 8 ? ZV : ZR) + (size_t)(pn & 3) * M * 256; ld = 256; bjs = 128; }
        else { const int t = (pn - 12) >> 2; base = Z + ZCB + (size_t)t * M * 1024 + (size_t)((pn - 12) & 3) * 256; ld = 1024; bjs = 128; }
#pragma unroll
        for (int ai = 0; ai < 2; ++ai)
#pragma unroll
            for (int m = 0; m < 4; ++m) { bf16* rowp = base + (size_t)(row0 + ai * 128 + m * 16) * ld + c0;
#pragma unroll
                for (int bj = 0; bj < 2; ++bj) { f32x4 v0 = acc[ai][bj][m][0], v1 = acc[ai][bj][m][1];
                    if (kind == 1) { v0 = v0 * 0.08838834764831845f; v1 = v1 * 0.08838834764831845f; }
                    else if (kind == 2) {
#pragma unroll
                        for (int j = 0; j < 4; ++j) { v0[j] = v0[j] * fast_sigmoid(v0[j]); v1[j] = v1[j] * fast_sigmoid(v1[j]); } }
                    else if (kind == 3) {
#pragma unroll
                        for (int j = 0; j < 4; ++j) { v0[j] = fast_sigmoid(v0[j]); v1[j] = fast_sigmoid(v1[j]); } }
                    u32x4 w; w.x = pk2(v0[0], v0[1]); w.y = pk2(v0[2], v0[3]); w.z = pk2(v1[0], v1[1]); w.w = pk2(v1[2], v1[3]);
                    *(u32x4*)(rowp + bj * bjs) = w; } }
    }
};

constexpr int QD_STRIDE = 272, KT_STRIDE = 144, SC_STRIDE = 144, OT_STRIDE = 1040;
constexpr int L_QD = 0, L_KI = 17408, L_KT = 34816, L_SC = 53248, L_DEC = 62464, L_SEG = 62976, L_OT = 67584;
__device__ __forceinline__ int crow(int reg, int h) { return (reg & 3) + 8 * (reg >> 2) + 4 * h; }

template <bool OUT>
__device__ __forceinline__ void gla_item(Frame& F, int item) {
    const int bh = item >> 3, sc = item & 7, b = bh >> 2, hd = bh & 3;
    const int t0 = b * SEQ + sc * 256;
    const int tid = F.tid, lane = F.lane, w = F.wave, r32 = lane & 31, h = lane >> 5;
    const bf16* Z = WSP(const bf16, WS_Z);
    const float* LA = WSP(const float, WS_LA);
    LAS unsigned char* L = F.lds;
    f32x16 S[4];
    float* Sbuf = (OUT ? WSP(float, WS_SIN) : WSP(float, WS_U)) + (size_t)item * 32768 + (size_t)w * 4096;
    if (OUT) {
#pragma unroll
        for (int kb = 0; kb < 4; ++kb)
#pragma unroll
            for (int r = 0; r < 16; ++r) S[kb][r] = Sbuf[(kb * 16 + r) * 64 + lane];
    } else {
#pragma unroll
        for (int kb = 0; kb < 4; ++kb)
#pragma unroll
            for (int r = 0; r < 16; ++r) S[kb][r] = 0.f;
    }
    float btot_run0 = 0.f, btot_run1 = 0.f;
    const int tok_n = tid >> 3, part = tid & 7;
    f32x2 la2[8]; unsigned kk[8], qq[8]; bf16x8 Bv[4]; u32x4 rc[4];
#define GLA_LOAD(tcx) do { \
        const size_t rb_ = ((size_t)hd * M + (tcx) + 8 * w) * 128 + 2 * lane; \
        _Pragma("unroll") for (int i = 0; i < 8; ++i) { la2[i] = *(const f32x2*)(LA + rb_ + (size_t)i * 128); kk[i] = *(const unsigned*)(Z + ZK + rb_ + (size_t)i * 128); if (OUT) qq[i] = *(const unsigned*)(Z + ZQ + rb_ + (size_t)i * 128); } \
    } while (0)
#define GLA_LOADV(tcx) do { \
        _Pragma("unroll") for (int ks = 0; ks < 4; ++ks) _Pragma("unroll") for (int j = 0; j < 8; ++j) Bv[ks][j] = (short)Z[ZV + ((size_t)hd * M + (tcx) + 16 * ks + 8 * h + j) * 256 + 32 * w + r32]; \
    } while (0)
#define GLA_LOADR(tcx) do { \
        if (OUT) { const u32x4* rp_ = (const u32x4*)(Z + ZR + ((size_t)hd * M + (tcx) + tok_n) * 256 + 32 * part); _Pragma("unroll") for (int i = 0; i < 4; ++i) rc[i] = rp_[i]; } \
    } while (0)
    GLA_LOAD(t0); GLA_LOADV(t0);
#pragma unroll 1
    for (int c = 0; c < 4; ++c) {
        const int tc = t0 + c * 64;
        float p0[8], p1[8];
        { float r0 = 0.f, r1 = 0.f;
#pragma unroll
          for (int i = 0; i < 8; ++i) { r0 += la2[i].x; r1 += la2[i].y; p0[i] = r0; p1[i] = r1; }
          *(LAS f32x2*)(L + L_SEG + (w * 128 + 2 * lane) * 4) = (f32x2){r0, r1}; }
        GLA_LOADR(tc);
        __syncthreads();
        float off0 = 0.f, off1 = 0.f, bt0 = 0.f, bt1 = 0.f;
#pragma unroll
        for (int sgi = 0; sgi < 8; ++sgi) { const f32x2 sv = *(const LAS f32x2*)(L + L_SEG + (sgi * 128 + 2 * lane) * 4); if (sgi < w) { off0 += sv.x; off1 += sv.y; } bt0 += sv.x; bt1 += sv.y; }
        if (w == 0) { *(LAS f32x2*)(L + L_DEC + 8 * lane) = (f32x2){__expf(bt0), __expf(bt1)}; btot_run0 += bt0; btot_run1 += bt1; }
        {
            unsigned kt0[4], kt1[4];
#pragma unroll
            for (int i = 0; i < 8; i += 2) {
                const float b00 = off0 + p0[i], b01 = off1 + p1[i], b10 = off0 + p0[i + 1], b11 = off1 + p1[i + 1];
                const float k00 = bf_lo(kk[i]), k01 = bf_hi(kk[i]), k10 = bf_lo(kk[i + 1]), k11 = bf_hi(kk[i + 1]);
                kt0[i >> 1] = pk2(k00 * __expf(bt0 - b00), k10 * __expf(bt0 - b10));
                kt1[i >> 1] = pk2(k01 * __expf(bt1 - b01), k11 * __expf(bt1 - b11));
                if (OUT) {
                    const float q00 = bf_lo(qq[i]), q01 = bf_hi(qq[i]), q10 = bf_lo(qq[i + 1]), q11 = bf_hi(qq[i + 1]);
                    *(LAS unsigned*)(L + L_QD + (8 * w + i) * QD_STRIDE + 4 * lane) = pk2(q00 * __expf(b00), q01 * __expf(b01));
                    *(LAS unsigned*)(L + L_QD + (8 * w + i + 1) * QD_STRIDE + 4 * lane) = pk2(q10 * __expf(b10), q11 * __expf(b11));
                    *(LAS unsigned*)(L + L_KI + (8 * w + i) * QD_STRIDE + 4 * lane) = pk2(k00 * __expf(-b00), k01 * __expf(-b01));
                    *(LAS unsigned*)(L + L_KI + (8 * w + i + 1) * QD_STRIDE + 4 * lane) = pk2(k10 * __expf(-b10), k11 * __expf(-b11));
                }
            }
            *(LAS u32x4*)(L + L_KT + (2 * lane) * KT_STRIDE + 16 * w) = (u32x4){kt0[0], kt0[1], kt0[2], kt0[3]};
            *(LAS u32x4*)(L + L_KT + (2 * lane + 1) * KT_STRIDE + 16 * w) = (u32x4){kt1[0], kt1[1], kt1[2], kt1[3]};
        }
        __syncthreads();
        if (c < 3) GLA_LOAD(tc + 64);
        f32x16 o[2];
        if (OUT) {
            if (w < 3) {
                const int ib = w == 0 ? 0 : 1, jb = w == 2 ? 1 : 0;
                f32x16 sacc;
#pragma unroll
                for (int r = 0; r < 16; ++r) sacc[r] = 0.f;
#pragma unroll
                for (int kb = 0; kb < 8; ++kb) {
                    const bf16x8 a = *(const LAS bf16x8*)(L + L_QD + (32 * ib + r32) * QD_STRIDE + 2 * (16 * kb + 8 * h));
                    const bf16x8 bb = *(const LAS bf16x8*)(L + L_KI + (32 * jb + r32) * QD_STRIDE + 2 * (16 * kb + 8 * h));
                    sacc = __builtin_amdgcn_mfma_f32_32x32x16_bf16(a, bb, sacc, 0, 0, 0);
                }
#pragma unroll
                for (int r = 0; r < 16; r += 1) {
                    const int i = 32 * ib + crow(r, h), j = 32 * jb + r32;
                    const float v = (j <= i) ? sacc[r] : 0.f;
                    *(LAS bf16*)(L + L_SC + i * SC_STRIDE + 2 * j) = (bf16)(pk2(v, 0.f) & 0xffffu);
                }
            }
#pragma unroll
            for (int ib = 0; ib < 2; ++ib)
#pragma unroll
                for (int r = 0; r < 16; ++r) o[ib][r] = 0.f;
#pragma unroll
            for (int kb = 0; kb < 4; ++kb)
#pragma unroll
                for (int s2 = 0; s2 < 2; ++s2) {
                    u32x4 pb; pb.x = pk2(S[kb][8 * s2 + 0], S[kb][8 * s2 + 1]); pb.y = pk2(S[kb][8 * s2 + 2], S[kb][8 * s2 + 3]); pb.z = pk2(S[kb][8 * s2 + 4], S[kb][8 * s2 + 5]); pb.w = pk2(S[kb][8 * s2 + 6], S[kb][8 * s2 + 7]);
                    const bf16x8 bfrag = __builtin_bit_cast(bf16x8, pb);
#pragma unroll
                    for (int ib = 0; ib < 2; ++ib) {
                        const LAS unsigned char* qp = L + L_QD + (32 * ib + r32) * QD_STRIDE + 2 * (32 * kb + 16 * s2 + 4 * h);
                        const u32x2 lo = *(const LAS u32x2*)qp, hi = *(const LAS u32x2*)(qp + 16);
                        const bf16x8 afrag = __builtin_bit_cast(bf16x8, (u32x4){lo.x, lo.y, hi.x, hi.y});
                        o[ib] = __builtin_amdgcn_mfma_f32_32x32x16_bf16(afrag, bfrag, o[ib], 0, 0, 0);
                    }
                }
            __syncthreads();
#pragma unroll
            for (int ks = 0; ks < 4; ++ks)
#pragma unroll
                for (int ib = 0; ib < 2; ++ib) {
                    if (ib == 0 && ks >= 2) continue;
                    const bf16x8 a = *(const LAS bf16x8*)(L + L_SC + (32 * ib + r32) * SC_STRIDE + 2 * (16 * ks + 8 * h));
                    o[ib] = __builtin_amdgcn_mfma_f32_32x32x16_bf16(a, Bv[ks], o[ib], 0, 0, 0);
                }
        }
#pragma unroll
        for (int kb = 0; kb < 4; ++kb) {
#pragma unroll
            for (int g4 = 0; g4 < 4; ++g4) { const f32x4 dc = *(const LAS f32x4*)(L + L_DEC + 4 * (32 * kb + 8 * g4 + 4 * h));
#pragma unroll
                for (int j = 0; j < 4; ++j) S[kb][4 * g4 + j] *= dc[j]; }
#pragma unroll
            for (int ks = 0; ks < 4; ++ks) {
                const bf16x8 a = *(const LAS bf16x8*)(L + L_KT + (32 * kb + r32) * KT_STRIDE + 2 * (16 * ks + 8 * h));
                S[kb] = __builtin_amdgcn_mfma_f32_32x32x16_bf16(a, Bv[ks], S[kb], 0, 0, 0);
            }
        }
        if (c < 3) GLA_LOADV(tc + 64);
        if (OUT) {
#pragma unroll
            for (int ib = 0; ib < 2; ++ib)
#pragma unroll
                for (int r = 0; r < 16; ++r) *(LAS float*)(L + L_OT + (32 * ib + crow(r, h)) * OT_STRIDE + 4 * (32 * w + r32)) = o[ib][r];
            __syncthreads();
            f32x4 ov[8]; float ss = 0.f;
#pragma unroll
            for (int i = 0; i < 8; ++i) { ov[i] = *(const LAS f32x4*)(L + L_OT + tok_n * OT_STRIDE + 4 * (32 * part + 4 * i)); ss += (ov[i].x * ov[i].x + ov[i].y * ov[i].y) + (ov[i].z * ov[i].z + ov[i].w * ov[i].w); }
            ss += __shfl_xor(ss, 1); ss += __shfl_xor(ss, 2); ss += __shfl_xor(ss, 4);
            const float rs = 1.0f / sqrtf(ss * (1.0f / 256.0f) + 1e-6f);
            const size_t trow = (size_t)(tc + tok_n);
            const f32x4* gp = (const f32x4*)(F.g_gla + hd * 256 + 32 * part);
            u32x4* op = (u32x4*)(WSP(bf16, WS_OG) + trow * 1024 + hd * 256 + 32 * part);
#pragma unroll
            for (int i = 0; i < 4; ++i) {
                const u32x4 rr = rc[i]; const f32x4 g0 = gp[2 * i], g1 = gp[2 * i + 1]; const f32x4 a0 = ov[2 * i], a1 = ov[2 * i + 1];
                u32x4 ow;
                ow.x = pk2(a0.x * rs * g0.x * bf_lo(rr.x), a0.y * rs * g0.y * bf_hi(rr.x));
                ow.y = pk2(a0.z * rs * g0.z * bf_lo(rr.y), a0.w * rs * g0.w * bf_hi(rr.y));
                ow.z = pk2(a1.x * rs * g1.x * bf_lo(rr.z), a1.y * rs * g1.y * bf_hi(rr.z));
                ow.w = pk2(a1.z * rs * g1.z * bf_lo(rr.w), a1.w * rs * g1.w * bf_hi(rr.w));
                op[i] = ow;
            }
        }
    }
#undef GLA_LOAD
#undef GLA_LOADV
#undef GLA_LOADR
    if (!OUT) {
#pragma unroll
        for (int kb = 0; kb < 4; ++kb)
#pragma unroll
            for (int r = 0; r < 16; ++r) Sbuf[(kb * 16 + r) * 64 + lane] = S[kb][r];
        if (w == 0) *(f32x2*)(WSP(float, WS_DECS) + item * 128 + 2 * lane) = (f32x2){__expf(btot_run0), __expf(btot_run1)};
    }
    __syncthreads();
}

__device__ __forceinline__ void conv_rows(Frame& F, const int nrep) {
    const int gw = F.vcu * NWAVES + F.wave, NGW = F.G * NWAVES;
    const bf16* Z = WSP(const bf16, WS_Z); bf16* PB = WSP(bf16, WS_PB);
    for (int blk0 = gw; blk0 < (M / 8) * nrep; blk0 += NGW) {
        const int blk = blk0 % (M / 8);
        const int m0 = blk * 8, s0 = m0 % SEQ;
#pragma unroll 1
        for (int j = 0; j < 2; ++j) {
            const int c = 8 * F.lane + 512 * j;
            const size_t rp = (size_t)(s0 > 0 ? m0 - 2 : m0);
            const u32x4 p2c = *(const u32x4*)(Z + ZCC + rp * 1024 + c), p2x = *(const u32x4*)(Z + ZCX + rp * 1024 + c);
            const u32x4 p1c = *(const u32x4*)(Z + ZCC + (rp + 1) * 1024 + c), p1x = *(const u32x4*)(Z + ZCX + (rp + 1) * 1024 + c);
            float w0[8], w1[8], w2[8];
#pragma unroll
            for (int i = 0; i < 8; ++i) { w0[i] = F.w_conv[c + i]; w1[i] = F.w_conv[1024 + c + i]; w2[i] = F.w_conv[2048 + c + i]; }
            float u1[8], u2[8];
            const float keep = s0 > 0 ? 1.0f : 0.0f;
#pragma unroll
            for (int i = 0; i < 4; ++i) { u2[2 * i] = keep * bf_lo(p2c[i]) * bf_lo(p2x[i]); u2[2 * i + 1] = keep * bf_hi(p2c[i]) * bf_hi(p2x[i]); u1[2 * i] = keep * bf_lo(p1c[i]) * bf_lo(p1x[i]); u1[2 * i + 1] = keep * bf_hi(p1c[i]) * bf_hi(p1x[i]); }
#pragma unroll
            for (int hb = 0; hb < 2; ++hb) {
                u32x4 cc[4], cx[4], cb[4];
#pragma unroll
                for (int rr = 0; rr < 4; ++rr) { const size_t row = (size_t)(m0 + 4 * hb + rr); cc[rr] = *(const u32x4*)(Z + ZCC + row * 1024 + c); cx[rr] = *(const u32x4*)(Z + ZCX + row * 1024 + c); cb[rr] = *(const u32x4*)(Z + ZCB + row * 1024 + c); }
#pragma unroll
                for (int rr = 0; rr < 4; ++rr) {
                    float u0[8], y[8];
#pragma unroll
                    for (int i = 0; i < 4; ++i) { u0[2 * i] = bf_lo(cc[rr][i]) * bf_lo(cx[rr][i]); u0[2 * i + 1] = bf_hi(cc[rr][i]) * bf_hi(cx[rr][i]); }
#pragma unroll
                    for (int i = 0; i < 8; ++i) y[i] = w0[i] * u2[i] + w1[i] * u1[i] + w2[i] * u0[i];
                    u32x4 ow;
#pragma unroll
                    for (int i = 0; i < 4; ++i) ow[i] = pk2(bf_lo(cb[rr][i]) * y[2 * i], bf_hi(cb[rr][i]) * y[2 * i + 1]);
                    *(u32x4*)(PB + (size_t)(m0 + 4 * hb + rr) * 1024 + c) = ow;
#pragma unroll
                    for (int i = 0; i < 8; ++i) { u2[i] = u1[i]; u1[i] = u0[i]; }
                }
                asm volatile("" ::: "memory");
            }
        }
    }
}

__device__ __forceinline__ void gla_scan(Frame& F, const int nrep) {
    const float* U = WSP(const float, WS_U); float* SIN = WSP(float, WS_SIN); const float* DECS = WSP(const float, WS_DECS);
    const int gt = F.vcu * 512 + F.tid, NT = F.G * 512;
    for (int idx0 = gt; idx0 < 32 * 32768 * nrep; idx0 += NT) {
        const int idx = idx0 & (32 * 32768 - 1);
        const int bh = idx >> 15, e = idx & 32767;
        const int ln = e & 63, reg = (e >> 6) & 15, kb = (e >> 10) & 3;
        const int dk = 32 * kb + crow(reg, ln >> 5);
        float s = 0.f;
#pragma unroll
        for (int sc = 0; sc < 8; ++sc) {
            const int item = bh * 8 + sc;
            SIN[(size_t)item * 32768 + e] = s;
            s = DECS[item * 128 + dk] * s + U[(size_t)item * 32768 + e];
        }
    }
}

struct P3Order : pg8::StaticOrder {
    __device__ __forceinline__ bool next(int i, pg8::Unit& u) const {
        if (!pg8::StaticOrder::next(i >> 1, u)) return false;
        u.e = i & 1; u.pn += 4 * u.e; return true;
    }
    __device__ __forceinline__ unsigned arow(const pg8::Unit& u, int ui, int r) const { return (unsigned)(u.e * M + u.pm * 256 + r) * 2048u; }
    __device__ __forceinline__ void after_unit(int ui) const {}
};
struct EpiBranch {
    static constexpr bool PERM = true;
    const bf16* Z; bf16* M1; bf16* MIX;
    __device__ __forceinline__ void operator()(const f32x4 (&acc)[2][2][4][2], const pg8::Unit& u, int wr, int wc, int fr, int fq) const {
        const int row0 = u.pm * 256 + wr * 64 + fr, col0 = (u.pn & 3) * 256 + wc * 32 + 8 * fq;
        const bf16* G = Z + (u.e ? ZGB : ZGA);
#pragma unroll
        for (int ai = 0; ai < 2; ++ai)
#pragma unroll
            for (int m = 0; m < 4; ++m) { const size_t row = (size_t)(row0 + ai * 128 + m * 16);
#pragma unroll
                for (int bj = 0; bj < 2; ++bj) { const u32x4 sg = *(const u32x4*)(G + row * 1024 + col0 + bj * 128);
                    const f32x4 v0 = acc[ai][bj][m][0], v1 = acc[ai][bj][m][1];
                    float r[8] = {v0[0] * bf_lo(sg.x), v0[1] * bf_hi(sg.x), v0[2] * bf_lo(sg.y), v0[3] * bf_hi(sg.y), v1[0] * bf_lo(sg.z), v1[1] * bf_hi(sg.z), v1[2] * bf_lo(sg.w), v1[3] * bf_hi(sg.w)};
                    if (u.e) { const u32x4 mm = *(const u32x4*)(M1 + row * 1024 + col0 + bj * 128);
                        r[0] += bf_lo(mm.x); r[1] += bf_hi(mm.x); r[2] += bf_lo(mm.y); r[3] += bf_hi(mm.y); r[4] += bf_lo(mm.z); r[5] += bf_hi(mm.z); r[6] += bf_lo(mm.w); r[7] += bf_hi(mm.w); }
                    u32x4 w; w.x = pk2(r[0], r[1]); w.y = pk2(r[2], r[3]); w.z = pk2(r[4], r[5]); w.w = pk2(r[6], r[7]);
                    *(u32x4*)((u.e ? MIX : M1) + row * 1024 + col0 + bj * 128) = w; } }
    }
};
struct EpiX1 {
    static constexpr bool PERM = false;
    const float* x; float* X1;
    __device__ __forceinline__ void operator()(const f32x4 (&acc)[2][2][4][2], const pg8::Unit& u, int wr, int wc, int fr, int fq) const {
        const int row0 = u.pm * 256 + wr * 64 + fr, col0 = u.pn * 256 + wc * 32 + 4 * fq;
#pragma unroll
        for (int ai = 0; ai < 2; ++ai)
#pragma unroll
            for (int m = 0; m < 4; ++m) { const size_t off = (size_t)(row0 + ai * 128 + m * 16) * 1024 + col0;
#pragma unroll
                for (int bj = 0; bj < 2; ++bj)
#pragma unroll
                    for (int n = 0; n < 2; ++n) { const f32x4 xs = *(const f32x4*)(x + off + bj * 128 + n * 16); *(f32x4*)(X1 + off + bj * 128 + n * 16) = xs + acc[ai][bj][m][n]; } }
    }
};

constexpr int WRT_LD = 1028;
__device__ __forceinline__ void route_pair(float lg, int lane, int tl, size_t m, LAS int* hist, LAS int* ple, float* gate) {
    const int myi = lane & 31;
    float tv[4]; int ti[4];
#pragma unroll
    for (int k = 0; k < 4; ++k) {
        float bv = lg; int bi = myi;
#pragma unroll
        for (int off = 16; off >= 1; off >>= 1) { const float ov = __shfl_xor(bv, off); const int oi = __shfl_xor(bi, off); if (ov > bv || (ov == bv && oi < bi)) { bv = ov; bi = oi; } }
        tv[k] = bv; ti[k] = bi;
        if (myi == bi) lg = -3.0e38f;
    }
    const float e1 = __expf(tv[1] - tv[0]), e2 = __expf(tv[2] - tv[0]), e3 = __expf(tv[3] - tv[0]);
    const float inv = 1.0f / (1.0f + e1 + e2 + e3);
    if (myi < 4) {
        const int ek = myi == 0 ? ti[0] : (myi == 1 ? ti[1] : (myi == 2 ? ti[2] : ti[3]));
        const float gk = (myi == 0 ? 1.0f : (myi == 1 ? e1 : (myi == 2 ? e2 : e3))) * inv;
        const int lr = __hip_atomic_fetch_add(&hist[ek], 1, __ATOMIC_RELAXED, __HIP_MEMORY_SCOPE_WORKGROUP);
        ple[tl * 4 + myi] = ek | (lr << 8);
        gate[m * 4 + myi] = gk;
    }
}
__device__ __forceinline__ void p5_router(Frame& F) {
    LAS float* WrT = (LAS float*)F.lds;
    LAS int* hist = (LAS int*)(F.lds + EXTRA_OFF + 1024);
    LAS int* base = (LAS int*)(F.lds + EXTRA_OFF + 1024 + 128);
    LAS int* ple = (LAS int*)(F.lds + EXTRA_OFF + 1024 + 256);
    for (int i = 0; i < 64; ++i) { const int idx = F.tid + 512 * i, k = idx >> 5, e = idx & 31; WrT[e * WRT_LD + k] = F.w_router[idx]; }
    f32x4 g[4];
#pragma unroll
    for (int j = 0; j < 4; ++j) g[j] = *((const f32x4*)F.g_ffn + F.lane + 64 * j);
    const float brl = F.b_router[F.lane & 31];
    const float* X1 = WSP(const float, WS_X1); unsigned char* H2 = WSP(unsigned char, WS_XN);
    unsigned* cnt = F.ctl + CW_CNT; int* list = WSP(int, WS_LIST); float* gate = WSP(float, WS_GATE);
    const int lane = F.lane;
    for (int grp = F.vcu; grp < M / 64; grp += F.G) {
        if (F.tid < 32) hist[F.tid] = 0;
        __syncthreads();
        f32x4 nx0[4], nx1[4];
        { const f32x4* xa = (const f32x4*)(X1 + (size_t)(grp * 64 + 8 * F.wave) * D) + lane;
#pragma unroll
          for (int j = 0; j < 4; ++j) { nx0[j] = xa[64 * j]; nx1[j] = xa[256 + 64 * j]; } }
#pragma unroll 1
        for (int i2 = 0; i2 < 4; ++i2) {
            f32x4 v0[4], v1[4];
#pragma unroll
            for (int j = 0; j < 4; ++j) { v0[j] = nx0[j]; v1[j] = nx1[j]; }
            if (i2 < 3) { const f32x4* xa = (const f32x4*)(X1 + (size_t)(grp * 64 + 8 * F.wave + 2 * i2 + 2) * D) + lane;
#pragma unroll
                for (int j = 0; j < 4; ++j) { nx0[j] = xa[64 * j]; nx1[j] = xa[256 + 64 * j]; } }
            f32x2 vp[4][4];
            { float s0 = 0.f, s1 = 0.f;
#pragma unroll
              for (int j = 0; j < 4; ++j) {
#pragma unroll
                  for (int c = 0; c < 4; ++c) { s0 = fmaf(v0[j][c], v0[j][c], s0); s1 = fmaf(v1[j][c], v1[j][c], s1); } }
              const float r0 = 1.0f / sqrtf(wave_sum(s0) * (1.f / D) + 1e-6f), r1 = 1.0f / sqrtf(wave_sum(s1) * (1.f / D) + 1e-6f);
              const size_t m0 = (size_t)(grp * 64 + 8 * F.wave + 2 * i2);
              unsigned* o0 = (unsigned*)(H2 + m0 * D) + lane; unsigned* o1 = (unsigned*)(H2 + (m0 + 1) * D) + lane;
#pragma unroll
              for (int j = 0; j < 4; ++j) { v0[j] = v0[j] * r0 * g[j]; v1[j] = v1[j] * r1 * g[j];
                  o0[64 * j] = pk4_fp8(v0[j].x, v0[j].y, v0[j].z, v0[j].w);
                  o1[64 * j] = pk4_fp8(v1[j].x, v1[j].y, v1[j].z, v1[j].w);
#pragma unroll
                  for (int c = 0; c < 4; ++c) vp[j][c] = (f32x2){v0[j][c], v1[j][c]}; } }
            f32x2 a2[32];
#pragma unroll
            for (int e4 = 0; e4 < 8; ++e4) {
#pragma unroll
                for (int ee = 0; ee < 4; ++ee) { const int e = 4 * e4 + ee; f32x2 t = {0.f, 0.f};
#pragma unroll
                    for (int j = 0; j < 4; ++j) { const f32x4 wv = *(const LAS f32x4*)(WrT + e * WRT_LD + 256 * j + 4 * lane);
#pragma unroll
                        for (int c = 0; c < 4; ++c) t = __builtin_elementwise_fma(vp[j][c], (f32x2){wv[c], wv[c]}, t); }
                    a2[e] = t; }
                asm volatile("" ::: "memory");
            }
            float a[32];
            { const bool up = (lane & 32) != 0;
#pragma unroll
              for (int q = 0; q < 32; ++q) { const float send = up ? a2[q].x : a2[q].y; const float keep = up ? a2[q].y : a2[q].x; a[q] = keep + __shfl_xor(send, 32); } }
#pragma unroll
            for (int q = 0; q < 16; ++q) { const bool up = (lane & 16) != 0; const float send = up ? a[q] : a[q + 16]; const float keep = up ? a[q + 16] : a[q]; a[q] = keep + __shfl_xor(send, 16); }
#pragma unroll
            for (int q = 0; q < 8; ++q) { const bool up = (lane & 8) != 0; const float send = up ? a[q] : a[q + 8]; const float keep = up ? a[q + 8] : a[q]; a[q] = keep + __shfl_xor(send, 8); }
#pragma unroll
            for (int q = 0; q < 4; ++q) { const bool up = (lane & 4) != 0; const float send = up ? a[q] : a[q + 4]; const float keep = up ? a[q + 4] : a[q]; a[q] = keep + __shfl_xor(send, 4); }
#pragma unroll
            for (int q = 0; q < 2; ++q) { const bool up = (lane & 2) != 0; const float send = up ? a[q] : a[q + 2]; const float keep = up ? a[q + 2] : a[q]; a[q] = keep + __shfl_xor(send, 2); }
            { const bool up = (lane & 1) != 0; const float send = up ? a[0] : a[1]; const float keep = up ? a[1] : a[0]; a[0] = keep + __shfl_xor(send, 1); }
            const int tl = 8 * F.wave + 2 * i2 + (lane >> 5);
            route_pair(a[0] + brl, lane, tl, (size_t)(grp * 64 + tl), hist, ple, gate);
        }
        __syncthreads();
        if (F.tid < 32) base[F.tid] = (int)__hip_atomic_fetch_add(cnt + F.tid, (unsigned)hist[F.tid], RLX_AGENT);
        __syncthreads();
        if (F.tid < 256) { const int pe = ple[F.tid], e = pe & 255, lr = pe >> 8; list[e * CAP + base[e] + lr] = (grp * 64) * 4 + F.tid; }
        __syncthreads();
    }
}

#ifndef MK_MAXU
#define MK_MAXU 12
#endif
constexpr int MAXU = MK_MAXU;
template <int NP>
struct MoeOrder {
    LAS const int* rt0;
    LAS const int* tokl;
    int nwg, G, c, reps;
    __device__ __forceinline__ bool next(int i, pg8::Unit& u) const {
        const long L = (long)i * G + c; if (L >= (long)nwg * reps) return false;
        int wgid = (int)(L % nwg); { const int q = nwg / 8, r = nwg % 8, xcd = wgid % 8, off = wgid / 8; wgid = (xcd < r ? xcd * (q + 1) : r * (q + 1) + (xcd - r) * q) + off; }
        int e = 0;
#pragma unroll 1
        for (int j = 1; j < 32; ++j) if (wgid >= NP * rt0[j]) e = j;
        const int l = wgid - NP * rt0[e], nte = rt0[e + 1] - rt0[e];
        const int pn = l / nte, rt = l - pn * nte;
        u.pm = __builtin_amdgcn_readfirstlane(rt0[e] + rt); u.pn = __builtin_amdgcn_readfirstlane(e * NP + pn); u.e = __builtin_amdgcn_readfirstlane(e); u.rt = __builtin_amdgcn_readfirstlane(rt); return true;
    }
};
struct MoeOrder1 : MoeOrder<8> {
    __device__ __forceinline__ void after_unit(int ui) const {}
    __device__ __forceinline__ unsigned arow(const pg8::Unit& u, int ui, int r) const { return (unsigned)tokl[ui * 256 + r] * 1024u; }
};
struct MoeOrder2 : MoeOrder<4> {
    __device__ __forceinline__ void after_unit(int ui) const {}
    __device__ __forceinline__ unsigned arow(const pg8::Unit& u, int ui, int r) const { return (unsigned)(u.pm * 256 + r) * 1024u; }
};
struct EpiAct {
    static constexpr bool PERM = true;
    const float* b_gu; unsigned char* ACT;
    __device__ __forceinline__ void operator()(const f32x4 (&acc)[2][2][4][2], const pg8::Unit& u, int wr, int wc, int fr, int fq) const {
        const int pn = u.pn & 7, cl = pn * 128 + wc * 32 + 8 * fq;
        const int row0 = u.pm * 256 + wr * 64 + fr;
        const f32x4 bg0 = *(const f32x4*)(b_gu + u.e * 2048 + cl), bg1 = *(const f32x4*)(b_gu + u.e * 2048 + cl + 4);
        const f32x4 bl0 = *(const f32x4*)(b_gu + u.e * 2048 + 1024 + cl), bl1 = *(const f32x4*)(b_gu + u.e * 2048 + 1024 + cl + 4);
#pragma unroll
        for (int ai = 0; ai < 2; ++ai)
#pragma unroll
            for (int m = 0; m < 4; ++m) {
                f32x4 g0 = acc[ai][0][m][0] + bg0, g1 = acc[ai][0][m][1] + bg1, l0 = acc[ai][1][m][0] + bl0, l1 = acc[ai][1][m][1] + bl1;
                float r0[4], r1[4];
#pragma unroll
                for (int j = 0; j < 4; ++j) {
                    const float ga = fminf(g0[j], 7.0f), gb = fminf(g1[j], 7.0f);
                    const float la = fminf(fmaxf(l0[j], -7.0f), 7.0f), lb = fminf(fmaxf(l1[j], -7.0f), 7.0f);
                    r0[j] = (la + 1.0f) * (ga * fast_sigmoid(1.702f * ga)); r1[j] = (lb + 1.0f) * (gb * fast_sigmoid(1.702f * gb));
                }
                u32x2 w; w.x = pk4_fp8(r0[0], r0[1], r0[2], r0[3]); w.y = pk4_fp8(r1[0], r1[1], r1[2], r1[3]);
                *(u32x2*)(ACT + (size_t)(row0 + ai * 128 + m * 16) * 1024 + cl) = w;
            }
    }
};
struct EpiYP {
    static constexpr bool PERM = true;
    const float* b_d; const unsigned* cnt; const int* list; const float* gate; unsigned char* YP;
    __device__ __forceinline__ void operator()(const f32x4 (&acc)[2][2][4][2], const pg8::Unit& u, int wr, int wc, int fr, int fq) const {
        const int pn = u.pn & 3, col0 = pn * 256 + wc * 32 + 8 * fq;
        const int ne = (int)cnt[u.e];
        f32x4 bv[2][2];
#pragma unroll
        for (int bj = 0; bj < 2; ++bj)
#pragma unroll
            for (int n = 0; n < 2; ++n) bv[bj][n] = *(const f32x4*)(b_d + u.e * 1024 + col0 + bj * 128 + 4 * n);
#pragma unroll
        for (int ai = 0; ai < 2; ++ai)
#pragma unroll
            for (int m = 0; m < 4; ++m) {
                const int slot = u.rt * 256 + ai * 128 + wr * 64 + m * 16 + fr;
                if (slot < ne) {
                    const int pid = list[u.e * CAP + slot]; const float gw = gate[pid] * 16.0f;
#pragma unroll
                    for (int bj = 0; bj < 2; ++bj) { const f32x4 v0 = (acc[ai][bj][m][0] + bv[bj][0]) * gw, v1 = (acc[ai][bj][m][1] + bv[bj][1]) * gw;
                        u32x2 w; w.x = pk4_fp8(v0[0], v0[1], v0[2], v0[3]); w.y = pk4_fp8(v1[0], v1[1], v1[2], v1[3]);
                        *(u32x2*)(YP + (size_t)pid * 1024 + col0 + bj * 128) = w; }
                }
            }
    }
};
__device__ __forceinline__ int moe_setup(Frame& F, LAS int* rt0) {
    if (F.tid == 0) { int acc = 0; for (int e = 0; e < 32; ++e) { rt0[e] = acc; acc += ((int)F.ctl[CW_CNT + e] + 255) >> 8; } rt0[32] = acc; }
    __syncthreads();
    return rt0[32];
}

__device__ __forceinline__ void p8_final(Frame& F, const int nrep) {
    const int gw = F.vcu * NWAVES + F.wave, NGW = F.G * NWAVES;
    const float* X1 = WSP(const float, WS_X1); const unsigned char* YP = WSP(const unsigned char, WS_YP);
    f32x4 g[4];
#pragma unroll
    for (int j = 0; j < 4; ++j) g[j] = *((const f32x4*)F.g_final + F.lane + 64 * j);
    float pscale = 1.0f;
#ifdef MK_TPROBE
    { const unsigned long long* st = (const unsigned long long*)(F.ctl + CW_STAMP); const float dt_us = (float)(st[MK_TPROBE_J] - st[MK_TPROBE_I]) * 0.01f; pscale = 1.0f + sqrtf(dt_us * 1e-5f); }
#endif
    for (int m0 = gw; m0 < M * nrep; m0 += NGW) {
        const int m = m0 % M;
        const f32x4* xr = (const f32x4*)(X1 + (size_t)m * D) + F.lane;
        f32x4 v[4]; float s = 0.f;
#pragma unroll
        for (int j = 0; j < 4; ++j) v[j] = xr[64 * j];
        f32x4 ys[4];
#pragma unroll
        for (int j = 0; j < 4; ++j) ys[j] = (f32x4){0.f, 0.f, 0.f, 0.f};
#pragma unroll
        for (int k = 0; k < 4; ++k) { const unsigned* yr = (const unsigned*)(YP + ((size_t)m * 4 + k) * 1024) + F.lane;
#pragma unroll
            for (int j = 0; j < 4; ++j) { const int y = (int)yr[64 * j]; const f32x2 lo = __builtin_amdgcn_cvt_pk_f32_fp8(y, false), hi = __builtin_amdgcn_cvt_pk_f32_fp8(y, true);
                ys[j].x += lo.x; ys[j].y += lo.y; ys[j].z += hi.x; ys[j].w += hi.y; } }
#pragma unroll
        for (int j = 0; j < 4; ++j) v[j] = v[j] + ys[j] * 0.0625f;
#pragma unroll
        for (int j = 0; j < 4; ++j) s += (v[j].x * v[j].x + v[j].y * v[j].y) + (v[j].z * v[j].z + v[j].w * v[j].w);
        const float rstd = 1.0f / sqrtf(wave_sum(s) * (1.f / D) + 1e-6f);
        f32x4* op = (f32x4*)(F.out + (size_t)m * D) + F.lane;
#pragma unroll
        for (int j = 0; j < 4; ++j) op[64 * j] = v[j] * (rstd * pscale) * g[j];
    }
}

struct Args { const float* in[18]; float* out; unsigned char* ws; int ph_lo, ph_hi, rep_k, rep_n; };
__global__ void __launch_bounds__(NWAVES * 64, 2) mk_fwd(Args args) {
    extern __shared__ __attribute__((aligned(16))) unsigned char lds[];
    Frame F;
    F.lds = (LAS unsigned char*)lds;
    F.MISC = (volatile LAS unsigned*)(F.lds + MISC_OFF);
    F.tid = threadIdx.x; F.lane = F.tid & 63; F.wave = __builtin_amdgcn_readfirstlane(F.tid >> 6);
    F.G = gridDim.x; { const int bx = blockIdx.x; F.vcu = (F.G % 8 == 0) ? (bx % 8) * (F.G / 8) + bx / 8 : bx; }
    F.ws = args.ws; F.ctl = (unsigned*)(args.ws + WS_CTL);
    F.x = args.in[0]; F.g_mix = args.in[1]; F.w_in = args.in[2]; F.w_up = args.in[3]; F.b_alpha = args.in[4]; F.g_gla = args.in[5]; F.w_conv = args.in[6];
    F.w_a = args.in[7]; F.w_b = args.in[8]; F.w_out = args.in[9]; F.g_ffn = args.in[10]; F.w_router = args.in[11]; F.b_router = args.in[12];
    F.w_gu = args.in[13]; F.b_gu = args.in[14]; F.w_d = args.in[15]; F.b_d = args.in[16]; F.g_final = args.in[17]; F.out = args.out;
    if (F.tid < 128) ((LAS unsigned*)(F.lds + MISC_OFF))[F.tid] = 0u;
    __syncthreads();
    XcdBarrier bar; bar.bar = F.ctl + CW_BAR; bar.x = 0; bar.st = nullptr;
    if (N_LAUNCHES == 1) bar = xcd_barrier_post(F.ctl + CW_BAR, F.MISC + 8);
    const int lo = args.ph_lo, hi = args.ph_hi;
#ifdef MK_ONLY
#define IN(k) ((k) == MK_ONLY && lo <= (k) && (k) < hi)
#else
#define IN(k) (lo <= (k) && (k) < hi)
#endif
#define REPS(k) (((k) == args.rep_k) ? 1 + args.rep_n : 1)
#if defined(MK_TPROBE) || defined(MK_DELAY_K)
#define STAMP(k) do { if (blockIdx.x == 0 && F.tid == 0) ((unsigned long long*)(F.ctl + CW_STAMP))[k] = __builtin_amdgcn_s_memrealtime(); } while (0)
#else
#define STAMP(k) do { } while (0)
#endif
#ifdef MK_DELAY_K
#define DELAY(k) do { if ((k) == MK_DELAY_K) { const unsigned long long dl = __hip_atomic_load((unsigned long long*)(F.ctl + CW_STAMP), RLX_AGENT) + (unsigned long long)(MK_DELAY_US) * 100ull; \
    while (__builtin_amdgcn_s_memrealtime() < dl) __builtin_amdgcn_s_sleep(8); } } while (0)
#else
#define DELAY(k) do { } while (0)
#endif
#define SEAM(k) do { if (IN(k) && IN((k) + 1)) xcd_barrier(bar); STAMP((k) + 1); DELAY(k); } while (0)

    STAMP(0);
    if (IN(0)) { p0_prologue(F, REPS(0), REPS(11)); SEAM(0); }
    if (IN(1)) { const int nrep = REPS(1);
        P1Order S; S.init(M, NZ, D, F.G, (int)blockIdx.x, nrep); S.w_gu = F.w_gu; S.w_d = F.w_d; S.ws = F.ws; S.lds = F.lds; S.slot = ((int)blockIdx.x >> 3) & 7; S.wave = F.wave; S.lane = F.lane;
        EpiZ E{WSP(bf16, WS_Z)};
        pg8::gemm_phase<EpiZ, P1Order, true>(F.lds, WSP(const bf16, WS_XN), WSP(const bf16, WS_WIN), D, S, E);
        SEAM(1);
    }
    if (IN(2)) { const int nrep = REPS(2); for (int it = F.vcu; it < 256 * nrep; it += F.G) gla_item<false>(F, it & 255); conv_rows(F, REPS(12)); SEAM(2); }
    if (IN(3)) { gla_scan(F, REPS(3)); SEAM(3); }
    if (IN(4)) { const int nrep = REPS(4); for (int it = F.vcu; it < 256 * nrep; it += F.G) gla_item<true>(F, it & 255); SEAM(4); }
    if (IN(5)) { const int nrep = REPS(5);
        static_assert(WS_PB == WS_OG + (size_t)M * 1024 * 2 && WS_WB == WS_WA + (size_t)1024 * 1024 * 2, "P3Order addresses PB / Wb from OG / Wa");
        P3Order S; S.init(M, D, D, F.G, (int)blockIdx.x, nrep);
        EpiBranch E{WSP(const bf16, WS_Z), WSP(bf16, WS_M1), WSP(bf16, WS_MIX)};
        pg8::gemm_phase<EpiBranch, P3Order, true>(F.lds, WSP(const bf16, WS_OG), WSP(const bf16, WS_WA), D, S, E);
        SEAM(5);
    }
    if (IN(6)) { const int nrep = REPS(6);
        pg8::StaticOrder S; S.init(M, D, D, F.G, (int)blockIdx.x, nrep);
        EpiX1 E{F.x, WSP(float, WS_X1)};
        pg8::gemm_phase<EpiX1, pg8::StaticOrder, false>(F.lds, WSP(const bf16, WS_MIX), WSP(const bf16, WS_WO), D, S, E);
        SEAM(6);
    }
    if (IN(7)) { p5_router(F); SEAM(7); }
    if (IN(8)) { const int nrep = REPS(8);
        LAS int* rt0 = (LAS int*)(F.lds + EXTRA_OFF); LAS int* tokl = (LAS int*)(F.lds + EXTRA_OFF + 256);
        const int R = moe_setup(F, rt0);
        MoeOrder1 S; S.rt0 = rt0; S.tokl = tokl; S.nwg = R * 8; S.G = F.G; S.c = (int)blockIdx.x; S.reps = nrep;
        const int* list = WSP(const int, WS_LIST);
        { pg8::Unit u; for (int ui = 0; ui < MAXU && S.next(ui, u); ++ui) if (F.tid < 256) { const int slot = u.rt * 256 + F.tid; tokl[ui * 256 + F.tid] = slot < (int)F.ctl[CW_CNT + u.e] ? (list[u.e * CAP + slot] >> 2) : 0; } }
        __syncthreads();
        EpiAct E{F.b_gu, WSP(unsigned char, WS_ACT)};
        pg8::gemm_phase<EpiAct, MoeOrder1, true, true, 122>(F.lds, WSP(const void, WS_XN), WSP(const void, WS_WGU), D, S, E);
        SEAM(8);
    }
    if (IN(9)) { const int nrep = REPS(9);
        LAS int* rt0 = (LAS int*)(F.lds + EXTRA_OFF);
        const int R = moe_setup(F, rt0);
        MoeOrder2 S; S.rt0 = rt0; S.tokl = nullptr; S.nwg = R * 4; S.G = F.G; S.c = (int)blockIdx.x; S.reps = nrep;
        EpiYP E{F.b_d, F.ctl + CW_CNT, WSP(const int, WS_LIST), WSP(const float, WS_GATE), WSP(unsigned char, WS_YP)};
        pg8::gemm_phase<EpiYP, MoeOrder2, true, true, 122>(F.lds, WSP(const void, WS_ACT), WSP(const void, WS_WD), D, S, E);
        SEAM(9);
    }
    if (IN(10)) { p8_final(F, REPS(10)); }
#undef IN
#undef SEAM
}

extern "C" void kernel_launch(void* const* d_in, const int* in_sizes, int n_in, void* d_out, int out_size, void* d_ws, size_t ws_size, hipStream_t stream) {
    static int grid = 0;
    if (grid == 0) {
        if (n_in != 18 || out_size != M * D || ws_size < WS_END) { fprintf(stderr, "kernel_launch: unexpected shapes (n_in %d, out %d, ws %zu < %zu)\n", n_in, out_size, ws_size, (size_t)WS_END); grid = -1; return; }
        int dev = 0, cus = 0, per_cu = 0;
        if (hipGetDevice(&dev) != hipSuccess || hipDeviceGetAttribute(&cus, hipDeviceAttributeMultiprocessorCount, dev) != hipSuccess) { grid = -1; return; }
        if (hipFuncSetAttribute((const void*)mk_fwd, hipFuncAttributeMaxDynamicSharedMemorySize, LDS_BYTES) != hipSuccess) { fprintf(stderr, "kernel_launch: hipFuncSetAttribute(%d B LDS) failed\n", LDS_BYTES); grid = -1; return; }
        if (hipOccupancyMaxActiveBlocksPerMultiprocessor(&per_cu, (const void*)mk_fwd, NWAVES * 64, LDS_BYTES) != hipSuccess || per_cu < 1) fprintf(stderr, "kernel_launch: occupancy query says %d\n", per_cu);
        (void)hipGetLastError();
        grid = cus;
        if (grid != 256) fprintf(stderr, "kernel_launch: %d CUs (built for 256)\n", grid);
    }
    if (grid < 0) return;
    (void)hipMemsetAsync((char*)d_ws + WS_CTL, 0, CTL_ZERO_BYTES, stream);
    Args a{};
    for (int i = 0; i < 18; ++i) a.in[i] = (const float*)d_in[i];
    a.out = (float*)d_out; a.ws = (unsigned char*)d_ws;
#ifdef MK_REPEAT
    a.rep_k = MK_REPEAT; a.rep_n = MK_REPEAT_N;
#else
    a.rep_k = -1; a.rep_n = 0;
#endif
    for (int li = 0; li < N_LAUNCHES; ++li) {
        a.ph_lo = (N_LAUNCHES == 1) ? 0 : li; a.ph_hi = (N_LAUNCHES == 1) ? NPH : li + 1;
        hipLaunchKernelGGL(mk_fwd, dim3(grid), dim3(NWAVES * 64), LDS_BYTES, stream, a);
    }
}
```

```cpp
#include <hip/hip_runtime.h>
#include <cstdio>
#include <cstdint>

#ifndef MK_N_LAUNCHES
#define MK_N_LAUNCHES 1
#endif

#define LAS __attribute__((address_space(3)))
#define GAS __attribute__((address_space(1)))
typedef unsigned short bf16;
typedef short bf16x8 __attribute__((ext_vector_type(8)));
typedef float f32x4 __attribute__((ext_vector_type(4)));
typedef float f32x2 __attribute__((ext_vector_type(2)));
typedef float f32x16 __attribute__((ext_vector_type(16)));
typedef unsigned u32x4 __attribute__((ext_vector_type(4)));
typedef unsigned u32x2 __attribute__((ext_vector_type(2)));
typedef __bf16 bf16x2_t __attribute__((ext_vector_type(2)));
typedef int v8i32 __attribute__((ext_vector_type(8)));

constexpr int NWAVES = 8;
constexpr int M = 16384, D = 1024, SEQ = 2048;
constexpr int NZS = 8208;
constexpr int NZ = 8192;
constexpr int NE = 32, CAP = 16384;
constexpr int NPH = 11;
constexpr int N_LAUNCHES = MK_N_LAUNCHES;
constexpr size_t ZQ = 0, ZK = ZQ + (size_t)4 * M * 128, ZV = ZK + (size_t)4 * M * 128, ZR = ZV + (size_t)4 * M * 256, ZCB = ZR + (size_t)4 * M * 256, ZCC = ZCB + (size_t)M * 1024, ZCX = ZCC + (size_t)M * 1024, ZGA = ZCX + (size_t)M * 1024, ZGB = ZGA + (size_t)M * 1024;

constexpr size_t MiB = 1u << 20;
constexpr size_t WS_CTL = 0, CTL_ZERO_BYTES = 65536;
constexpr size_t WS_LIST = 1 * MiB;
constexpr size_t WS_GATE = 3 * MiB;
constexpr size_t WS_DECS = 4 * MiB;
constexpr size_t WS_WIN = 16 * MiB;
constexpr size_t WS_WA = 32 * MiB, WS_WB = 34 * MiB, WS_WO = 36 * MiB;
constexpr size_t WS_WGU = 40 * MiB;
constexpr size_t WS_WD = 168 * MiB;
constexpr size_t WS_XN = 232 * MiB;
constexpr size_t WS_LA = 264 * MiB;
constexpr size_t WS_Z = 296 * MiB;
constexpr size_t WS_YP = WS_Z;
constexpr size_t WS_U = 552 * MiB;
constexpr size_t WS_SIN = 584 * MiB;
constexpr size_t WS_OG = 616 * MiB;
constexpr size_t WS_PB = 648 * MiB;
constexpr size_t WS_M1 = 680 * MiB;
constexpr size_t WS_MIX = 744 * MiB;
constexpr size_t WS_X1 = 776 * MiB;
constexpr size_t WS_ACT = 840 * MiB;
constexpr size_t WS_END = 984 * MiB;
constexpr int CW_TMO = 0;
constexpr int CW_BAR = 4096;
constexpr int CW_CNT = 8192;
constexpr int CW_STAMP = 12288;

constexpr int RING_BYTES = 131072;
constexpr int EXTRA_OFF = RING_BYTES;
constexpr int LDS_BYTES = 155648 + 512;
constexpr int MISC_OFF = 155648;

#define RLX_AGENT __ATOMIC_RELAXED, __HIP_MEMORY_SCOPE_AGENT
#define LDS_WAIT() asm volatile("s_waitcnt lgkmcnt(0)" ::: "memory")
#define VM_WAIT() asm volatile("s_waitcnt vmcnt(0)" ::: "memory")
__device__ __forceinline__ unsigned pk2(float lo, float hi) { f32x2 v = {lo, hi}; bf16x2_t b = __builtin_convertvector(v, bf16x2_t); return __builtin_bit_cast(unsigned, b); }
__device__ __forceinline__ unsigned pk4_fp8(float a, float b, float c, float d) { int w = 0; w = __builtin_amdgcn_cvt_pk_fp8_f32(a, b, w, false); w = __builtin_amdgcn_cvt_pk_fp8_f32(c, d, w, true); return (unsigned)w; }
__device__ __forceinline__ float bf_lo(unsigned w) { return __builtin_bit_cast(float, w << 16); }
__device__ __forceinline__ float bf_hi(unsigned w) { return __builtin_bit_cast(float, w & 0xffff0000u); }
__device__ __forceinline__ float bf1(bf16 b) { return __builtin_bit_cast(float, ((unsigned)b) << 16); }
__device__ __forceinline__ float fast_sigmoid(float x) { return __builtin_amdgcn_rcpf(1.0f + __expf(-x)); }
__device__ __forceinline__ float wave_sum(float v) {
#pragma unroll
    for (int o = 1; o < 64; o <<= 1) v += __shfl_xor(v, o);
    return v;
}

namespace pg8 {
constexpr int BM = 256, BK = 64, HALF = 128, HTB = HALF * BK * 2, STAGE_BYTES = 8 * HTB, NXCD = 8, WGM = 8;
__device__ __forceinline__ int lds_byte(int r, int c) { const int st = (r >> 4) * 2 + (c >> 5), rr = r & 15, cc = c & 31, ob = rr * 64 + cc * 2; return st * 1024 + (ob ^ (((ob >> 9) & 1) << 5)); }
__device__ __forceinline__ void stage_rc(int b, int& R, int& C) { const int st = b / 1024, sb = b % 1024, swz = sb ^ (((sb >> 9) & 1) << 5); R = (st >> 1) * 16 + swz / 64; C = (st & 1) * 32 + (swz % 64) / 2; }
__device__ __forceinline__ int perm32(int rho) { const int n = rho >> 4, i = rho & 15; return 8 * (i >> 2) + 4 * n + (i & 3); }

struct Unit { int pm, pn, e, rt; };

struct StaticOrder {
    int nM, nN, nwg, G, c, K, reps;
    __device__ __forceinline__ void init(int M_, int N_, int K_, int G_, int c_, int reps_) { nM = M_ / BM; nN = N_ / BM; nwg = nM * nN; G = G_; c = c_; K = K_; reps = reps_; }
    __device__ __forceinline__ bool next(int i, Unit& u) const {
        const long L = (long)i * G + c; if (L >= (long)nwg * reps) return false;
        int wgid = (int)(L % nwg); { const int q = nwg / NXCD, r = nwg % NXCD, xcd = wgid % NXCD, off = wgid / NXCD; wgid = (xcd < r ? xcd * (q + 1) : r * (q + 1) + (xcd - r) * q) + off; }
        const int nig = WGM * nN, gid = wgid / nig, fm = gid * WGM, gsz = (nM - fm) < WGM ? (nM - fm) : WGM;
        u.pm = fm + ((wgid % nig) % gsz); u.pn = (wgid % nig) / gsz; u.e = 0; u.rt = 0; return true;
    }
    __device__ __forceinline__ unsigned arow(const Unit& u, int ui, int r) const { return (unsigned)(u.pm * BM + r) * (unsigned)(K * 2); }
    __device__ __forceinline__ void after_unit(int ui) const {}
};

template <class Epi, class Sched, bool ALIGN_EPI, bool FP8 = false, int SCW = 127>
__device__ __forceinline__ void gemm_phase(LAS unsigned char* lds, const void* Ag, const void* Btg, const int K, const Sched& S, const Epi& E) {
    const int tid = threadIdx.x, wid = __builtin_amdgcn_readfirstlane(tid >> 6), lane = tid & 63, wr = wid >> 2, wc = wid & 3, fr = lane & 15, fq = lane >> 4;
    const int RB = FP8 ? K : 2 * K;
    const int nt = RB / 128;
    int RA[2], CA[2]; unsigned voffB[2];
#pragma unroll
    for (int i = 0; i < 2; ++i) { int R, C; stage_rc(tid * 16 + i * 8192, R, C); const int Rb = Epi::PERM ? ((R & ~31) + perm32(R & 31)) : R;
        RA[i] = R; CA[i] = C * 2; voffB[i] = (unsigned)(Rb * RB + C * 2); }
    const size_t kstep = (size_t)(BK * 2);
    const size_t hstep = (size_t)HALF * RB;
    const size_t tstep = 2 * hstep;
    const unsigned ldsw = (unsigned)wid * 1024u;
    const int aoff = lds_byte(wr * 64 + fr, fq * 8), boff = lds_byte(wc * 32 + fr, fq * 8);
#define PG8_SA(b, h) (((b) * 2 + (h)) * HTB)
#define PG8_SB(b, h) ((4 + (b) * 2 + (h)) * HTB)
#define PG8_STAGEB(bufoff, gbase) do { _Pragma("unroll") for (int _i = 0; _i < 2; ++_i) \
        __builtin_amdgcn_global_load_lds((const unsigned*)((const char*)(gbase) + voffB[_i]), (LAS unsigned*)(lds + (bufoff) + ldsw + _i * 8192), 16, 0, 0); } while (0)
#define PG8_STAGEA(bufoff, o0, o1) do { \
        __builtin_amdgcn_global_load_lds((const unsigned*)((const char*)Ag + (o0)), (LAS unsigned*)(lds + (bufoff) + ldsw), 16, 0, 0); \
        __builtin_amdgcn_global_load_lds((const unsigned*)((const char*)Ag + (o1)), (LAS unsigned*)(lds + (bufoff) + ldsw + 8192), 16, 0, 0); } while (0)
#define PG8_LDA(dst, b, h) do { if constexpr (FP8) { _Pragma("unroll") for (int m = 0; m < 4; ++m) { dst[m][0] = *(const LAS bf16x8*)(lds + PG8_SA(b, h) + aoff + m * 2048); dst[m][1] = *(const LAS bf16x8*)(lds + PG8_SA(b, h) + aoff + m * 2048 + 1024); } } \
        else { _Pragma("unroll") for (int m = 0; m < 4; ++m) _Pragma("unroll") for (int k = 0; k < 2; ++k) dst[m][k] = *(const LAS bf16x8*)(lds + PG8_SA(b, h) + aoff + m * 2048 + k * 1024); } } while (0)
#define PG8_LDB(dst, b, h) do { if constexpr (FP8) { _Pragma("unroll") for (int n = 0; n < 2; ++n) { dst[n][0] = *(const LAS bf16x8*)(lds + PG8_SB(b, h) + boff + n * 2048); dst[n][1] = *(const LAS bf16x8*)(lds + PG8_SB(b, h) + boff + n * 2048 + 1024); } } \
        else { _Pragma("unroll") for (int n = 0; n < 2; ++n) _Pragma("unroll") for (int k = 0; k < 2; ++k) dst[n][k] = *(const LAS bf16x8*)(lds + PG8_SB(b, h) + boff + n * 2048 + k * 1024); } } while (0)
#define PG8_F8(x) __builtin_bit_cast(v8i32, __builtin_shufflevector(__builtin_bit_cast(u32x4, (x)[0]), __builtin_bit_cast(u32x4, (x)[1]), 0, 1, 2, 3, 4, 5, 6, 7))
#define PG8_MMA(ai, bj, At, Bt) do { __builtin_amdgcn_s_setprio(1); if constexpr (FP8) { _Pragma("unroll") for (int m = 0; m < 4; ++m) _Pragma("unroll") for (int n = 0; n < 2; ++n) \
        asm volatile("v_mfma_scale_f32_16x16x128_f8f6f4 %0, %1, %2, %0, %3, %4 op_sel_hi:[0,0,0]" : "+v"(acc[ai][bj][m][n]) : "v"(PG8_F8(Bt[n])), "v"(PG8_F8(At[m])), "v"(scw_reg), "v"(sca_reg)); } \
        else { _Pragma("unroll") for (int m = 0; m < 4; ++m) _Pragma("unroll") for (int n = 0; n < 2; ++n) _Pragma("unroll") for (int k = 0; k < 2; ++k) \
        acc[ai][bj][m][n] = __builtin_amdgcn_mfma_f32_16x16x32_bf16(Bt[n][k], At[m][k], acc[ai][bj][m][n], 0, 0, 0); } __builtin_amdgcn_s_setprio(0); } while (0)
#define PG8_WAIT_V(n) asm volatile("s_waitcnt vmcnt(" #n ")" ::: "memory")
#define PG8_WAIT_L(n) asm volatile("s_waitcnt lgkmcnt(" #n ")" ::: "memory")
#define PG8_BAR __builtin_amdgcn_s_barrier()
#define PG8_SCHED __builtin_amdgcn_sched_barrier(0)
    Unit cur, nxt; int ui = 0;
    if (!S.next(0, cur)) return;
    int scw_reg = SCW, sca_reg = 127;
    asm volatile("" : "+v"(scw_reg), "+v"(sca_reg));
    f32x4 acc[2][2][4][2];
#pragma unroll
    for (int a = 0; a < 2; ++a)
#pragma unroll
        for (int b = 0; b < 2; ++b)
#pragma unroll
            for (int m = 0; m < 4; ++m)
#pragma unroll
                for (int n = 0; n < 2; ++n) acc[a][b][m][n] = (f32x4){0.f, 0.f, 0.f, 0.f};
#define PG8_ZPAD() do { if constexpr (FP8) { _Pragma("unroll") for (int a = 0; a < 2; ++a) _Pragma("unroll") for (int b = 0; b < 2; ++b) _Pragma("unroll") for (int m = 0; m < 4; ++m) asm volatile("s_nop 1" : "+v"(acc[a][b][m][0]), "+v"(acc[a][b][m][1])); } } while (0)
    PG8_ZPAD();
    bf16x8 At[4][2], B0[2][2], B1[2][2];
    unsigned ac00, ac01, ac10, ac11;
    ac00 = S.arow(cur, 0, RA[0]) + CA[0]; ac01 = S.arow(cur, 0, RA[1]) + CA[1]; ac10 = S.arow(cur, 0, HALF + RA[0]) + CA[0]; ac11 = S.arow(cur, 0, HALF + RA[1]) + CA[1];
    const char* cB = (const char*)Btg + (size_t)cur.pn * tstep;
    PG8_STAGEB(PG8_SB(0, 0), cB); PG8_STAGEB(PG8_SB(0, 1), cB + hstep); PG8_STAGEA(PG8_SA(0, 0), ac00, ac01); PG8_STAGEA(PG8_SA(0, 1), ac10, ac11);
    if (wr == 1) PG8_BAR;
    PG8_WAIT_V(2); PG8_BAR;
    PG8_STAGEB(PG8_SB(1, 0), cB + kstep); PG8_STAGEA(PG8_SA(1, 0), ac00 + 128u, ac01 + 128u); PG8_STAGEB(PG8_SB(1, 1), cB + hstep + kstep);
    PG8_WAIT_V(6); PG8_BAR;
    for (;;) {
        const bool has_next = S.next(ui + 1, nxt);
        const char* nB = has_next ? (const char*)Btg + (size_t)nxt.pn * tstep : cB;
#pragma unroll 1
        for (int t = 0; t < nt; t += 2) {
            const bool last = (t == nt - 2);
            const unsigned k1 = (unsigned)(t + 1) * 128u, k2 = (unsigned)(t + 2) * 128u;
            unsigned a200 = ac00 + k2, a201 = ac01 + k2, a210 = ac10 + k2, a211 = ac11 + k2;
            if (last) { if (has_next) { a200 = S.arow(nxt, ui + 1, RA[0]) + CA[0]; a201 = S.arow(nxt, ui + 1, RA[1]) + CA[1]; a210 = S.arow(nxt, ui + 1, HALF + RA[0]) + CA[0]; a211 = S.arow(nxt, ui + 1, HALF + RA[1]) + CA[1]; }
                        else { a200 = ac00; a201 = ac01; a210 = ac10; a211 = ac11; } }
            const char* b2 = last ? nB : cB + (size_t)k2; const char* b3 = b2 + kstep;
            PG8_LDB(B0, 0, 0); PG8_LDB(B1, 0, 1); PG8_SCHED; PG8_LDA(At, 0, 0); PG8_STAGEA(PG8_SA(1, 1), ac10 + k1, ac11 + k1);
            PG8_WAIT_V(8); PG8_WAIT_L(0); PG8_BAR; PG8_MMA(0, 0, At, B0); PG8_MMA(0, 1, At, B1); PG8_BAR; PG8_SCHED;
            PG8_LDA(At, 0, 1); PG8_STAGEB(PG8_SB(0, 0), b2); PG8_STAGEB(PG8_SB(0, 1), b2 + hstep); PG8_STAGEA(PG8_SA(0, 0), a200, a201);
            PG8_WAIT_V(8); PG8_WAIT_L(0); PG8_BAR; PG8_MMA(1, 0, At, B0); PG8_MMA(1, 1, At, B1); PG8_BAR; PG8_SCHED;
            PG8_LDB(B0, 1, 0); PG8_LDB(B1, 1, 1); PG8_SCHED; PG8_LDA(At, 1, 0); PG8_STAGEA(PG8_SA(0, 1), a210, a211);
            PG8_WAIT_V(8); PG8_WAIT_L(0); PG8_BAR; PG8_MMA(0, 0, At, B0); PG8_MMA(0, 1, At, B1); PG8_BAR; PG8_SCHED;
            PG8_LDA(At, 1, 1); PG8_STAGEB(PG8_SB(1, 0), b3); PG8_STAGEB(PG8_SB(1, 1), b3 + hstep); PG8_STAGEA(PG8_SA(1, 0), a200 + 128u, a201 + 128u);
            PG8_WAIT_V(8); PG8_WAIT_L(0); PG8_BAR; PG8_MMA(1, 0, At, B0); PG8_MMA(1, 1, At, B1); PG8_BAR; PG8_SCHED;
        }
        if constexpr (FP8) asm volatile("s_nop 15\n\ts_nop 15" ::: "memory");
#pragma unroll
        for (int a = 0; a < 2; ++a)
#pragma unroll
            for (int b = 0; b < 2; ++b)
#pragma unroll
                for (int m = 0; m < 4; ++m) asm volatile("" : "+v"(acc[a][b][m][0]), "+v"(acc[a][b][m][1]));
        if constexpr (ALIGN_EPI) { if (wr == 0) PG8_BAR; }
        E(acc, cur, wr, wc, fr, fq);
        S.after_unit(ui);
        if (!has_next) break;
#pragma unroll
        for (int a = 0; a < 2; ++a)
#pragma unroll
            for (int b = 0; b < 2; ++b)
#pragma unroll
                for (int m = 0; m < 4; ++m)
#pragma unroll
                    for (int n = 0; n < 2; ++n) acc[a][b][m][n] = (f32x4){0.f, 0.f, 0.f, 0.f};
        PG8_ZPAD();
        cur = nxt; cB = nB; ++ui;
        ac00 = S.arow(cur, ui, RA[0]) + CA[0]; ac01 = S.arow(cur, ui, RA[1]) + CA[1]; ac10 = S.arow(cur, ui, HALF + RA[0]) + CA[0]; ac11 = S.arow(cur, ui, HALF + RA[1]) + CA[1];
        if constexpr (ALIGN_EPI) { if (wr == 1) PG8_BAR; }
    }
    PG8_WAIT_V(0);
    if constexpr (!ALIGN_EPI) { if (wr == 0) PG8_BAR; }
    PG8_BAR;
#undef PG8_SA
#undef PG8_SB
#undef PG8_STAGEA
#undef PG8_STAGEB
#undef PG8_LDA
#undef PG8_LDB
#undef PG8_MMA
#undef PG8_F8
#undef PG8_ZPAD
#undef PG8_WAIT_V
#undef PG8_WAIT_L
#undef PG8_BAR
#undef PG8_SCHED
}
}

#define XB_TMO      128
#define XB_XCNT(j)  (256  + 64 * (j))
#define XB_XSUB(j)  (1280 + 64 * (j))
#define XB_XGEN(j)  (2304 + 64 * (j))
#define XB_TOP      3328
#define XB_TOPGEN   3392
#define XCD_BAR_WORDS 3456
#define XB_SPIN_CAP (1u << 18)
__device__ __forceinline__ unsigned xb_ld(unsigned* p)              { return __hip_atomic_load(p, __ATOMIC_RELAXED, __HIP_MEMORY_SCOPE_AGENT); }
__device__ __forceinline__ unsigned xb_add(unsigned* p, unsigned v) { return __hip_atomic_fetch_add(p, v, __ATOMIC_RELAXED, __HIP_MEMORY_SCOPE_AGENT); }
__device__ __forceinline__ unsigned xb_xcc_id() { return (unsigned)__builtin_amdgcn_s_getreg((3 << 11) | 20) & 0xFu; }
#define XB_SPIN(cond, bar) do { unsigned _sp = 0; while (cond) { __builtin_amdgcn_s_sleep(1); \
    if ((++_sp & 255u) == 0u) { if (xb_ld(&(bar)[XB_TMO])) break; if (_sp > XB_SPIN_CAP) { atomicAdd(&(bar)[XB_TMO], 1u); break; } } } } while (0)
struct XcdBarrier { unsigned* bar; unsigned x; volatile LAS unsigned* st; };
__device__ __forceinline__ XcdBarrier xcd_barrier_post(unsigned* bar, volatile LAS unsigned* st) {
    XcdBarrier b; b.bar = bar; b.x = xb_xcc_id(); b.st = st;
    if (threadIdx.x == 0) (void)xb_add(&bar[XB_XCNT(b.x)], 1u);
    return b;
}
__device__ __forceinline__ void xcd_barrier_complete(unsigned* bar, unsigned x, unsigned& nloc, unsigned& nx) {
    const unsigned G = gridDim.x * gridDim.y * gridDim.z;
    unsigned sum, cnt, mine, sp = 0u;
    for (;;) {
        sum = 0u; cnt = 0u; mine = 0u;
#pragma unroll
        for (unsigned j = 0; j < 16; ++j) { const unsigned c = xb_ld(&bar[XB_XCNT(j)]); sum += c; cnt += (c > 0u) ? 1u : 0u; mine = (j == x) ? c : mine; }
        if (sum == G) break;
        __builtin_amdgcn_s_sleep(1);
        if ((++sp & 255u) == 0u) { if (xb_ld(&bar[XB_TMO])) break; if (sp > XB_SPIN_CAP) { atomicAdd(&bar[XB_TMO], 1u); break; } }
    }
    nloc = mine > 0u ? mine : 1u; nx = cnt > 0u ? cnt : 1u;
}
__device__ __forceinline__ void xcd_barrier(const XcdBarrier& b) {
    asm volatile("s_waitcnt vmcnt(0)" ::: "memory");
    __syncthreads();
    if (threadIdx.x == 0) {
        unsigned* bar = b.bar;
        __builtin_amdgcn_s_waitcnt(0);
        unsigned nloc = b.st[0], nx = b.st[1];
        if (nloc == 0u) { xcd_barrier_complete(bar, b.x, nloc, nx); b.st[0] = nloc; b.st[1] = nx; }
        const unsigned old = xb_add(&bar[XB_XSUB(b.x)], 1u);
        const unsigned gen = old / nloc;
        if (old + 1u == (gen + 1u) * nloc) {
            __builtin_amdgcn_fence(__ATOMIC_RELEASE, "agent");
            asm volatile("s_waitcnt vmcnt(0)" ::: "memory");
            const unsigned og = xb_add(&bar[XB_TOP], 1u);
            const unsigned tg = og / nx;
            if (og + 1u == (tg + 1u) * nx) xb_add(&bar[XB_TOPGEN], 1u);
            else XB_SPIN(xb_ld(&bar[XB_TOPGEN]) == tg, bar);
            __builtin_amdgcn_fence(__ATOMIC_ACQUIRE, "agent");
            xb_add(&bar[XB_XGEN(b.x)], 1u);
            asm volatile("s_waitcnt vmcnt(0)" ::: "memory");
        } else {
            XB_SPIN(xb_ld(&bar[XB_XGEN(b.x)]) == gen, bar);
            __builtin_amdgcn_fence(__ATOMIC_ACQUIRE, "agent");
            asm volatile("s_waitcnt vmcnt(0)" ::: "memory");
        }
    }
    __syncthreads();
}

struct Frame {
    LAS unsigned char* lds;
    volatile LAS unsigned* MISC;
    unsigned* ctl;
    int tid, lane, wave, vcu, G;
    unsigned char* ws;
    const float *x, *g_mix, *w_in, *w_up, *b_alpha, *g_gla, *w_conv, *w_a, *w_b, *w_out, *g_ffn, *w_router, *b_router, *w_gu, *b_gu, *w_d, *b_d, *g_final;
    float* out;
};
#define WSP(T, off) ((T*)(F.ws + (off)))

__device__ __forceinline__ void tr_item64(const float* W, int ld, int k0, int n0, bf16* WT, size_t dst_row0, int K, LAS unsigned* T, int lane) {
    const int nq = lane & 15, kr = lane >> 4;
    const float* src = W + (size_t)(k0 + 2 * kr) * ld + n0 + 4 * nq;
    f32x4 a0[8], a1[8];
#pragma unroll
    for (int it = 0; it < 8; ++it) { a0[it] = *(const f32x4*)(src + (size_t)(8 * it) * ld); a1[it] = *(const f32x4*)(src + (size_t)(8 * it + 1) * ld); }
    const int c = lane & 7;
#pragma unroll
    for (int hf = 0; hf < 2; ++hf) {
        if ((nq >> 3) == hf) {
#pragma unroll
            for (int it = 0; it < 8; ++it)
#pragma unroll
                for (int q = 0; q < 4; ++q) T[(4 * (nq & 7) + q) * 33 + 4 * it + kr] = pk2(a0[it][q], a1[it][q]);
        }
        LDS_WAIT(); asm volatile("" ::: "memory");
#pragma unroll
        for (int j = 0; j < 4; ++j) { const int n = (lane >> 3) + 8 * j; const LAS unsigned* t = T + n * 33 + 4 * c;
            u32x4 o; o.x = t[0]; o.y = t[1]; o.z = t[2]; o.w = t[3];
            *(u32x4*)(WT + (dst_row0 + 32 * hf + n) * (size_t)K + k0 + 8 * c) = o; }
        LDS_WAIT(); asm volatile("" ::: "memory");
    }
}

__device__ __forceinline__ void tr_item8(const float* W, int ld, int k0, int n0, unsigned char* WT8, size_t dst_row0, int KB, float scale, LAS unsigned* T, int lane) {
    const int nq = lane & 7, kr = lane >> 3;
    const float* src = W + (size_t)(k0 + 4 * kr) * ld + n0 + 4 * nq;
    f32x4 a[4][4];
#pragma unroll
    for (int it = 0; it < 4; ++it)
#pragma unroll
        for (int j = 0; j < 4; ++j) a[it][j] = *(const f32x4*)(src + (size_t)(32 * it + j) * ld);
    const int c = lane & 7;
#pragma unroll
    for (int hf = 0; hf < 2; ++hf) {
        if ((nq >> 2) == hf) {
#pragma unroll
            for (int it = 0; it < 4; ++it)
#pragma unroll
                for (int q = 0; q < 4; ++q) T[(4 * (nq & 3) + q) * 33 + 8 * it + kr] = pk4_fp8(a[it][0][q] * scale, a[it][1][q] * scale, a[it][2][q] * scale, a[it][3][q] * scale);
        }
        LDS_WAIT(); asm volatile("" ::: "memory");
#pragma unroll
        for (int j = 0; j < 2; ++j) { const int n = (lane >> 3) + 8 * j; const LAS unsigned* t = T + n * 33 + 4 * c;
            u32x4 o; o.x = t[0]; o.y = t[1]; o.z = t[2]; o.w = t[3];
            *(u32x4*)(WT8 + (dst_row0 + 16 * hf + n) * (size_t)KB + k0 + 16 * c) = o; }
        LDS_WAIT(); asm volatile("" ::: "memory");
    }
}
__device__ __forceinline__ void moe_convert_share(const float* w_gu, const float* w_d, unsigned char* ws, LAS unsigned char* lds, int c, int G, int wave, int lane) {
    LAS unsigned* T = (LAS unsigned*)(lds + EXTRA_OFF + wave * 2176);
    constexpr int I_GU = NE * 64 * 8, I_D = NE * 32 * 8;
    for (int it = c * NWAVES + wave; it < I_GU + I_D; it += G * NWAVES) {
        int r = it;
        if (r < I_GU) { const int e = r >> 9, q = r & 511, kb = q >> 6, nb = q & 63, j0 = 32 * nb, pn = j0 >> 8, within = j0 & 255, half = within >> 7;
            tr_item8(w_gu + (size_t)e * 1024 * 2048, 2048, 128 * kb, half * 1024 + pn * 128 + (within & 127), ws + WS_WGU + (size_t)e * 2048 * 1024, j0, 1024, 32.0f, T, lane); continue; } r -= I_GU;
        { const int e = r >> 8, q = r & 255, kb = q >> 5, nb = q & 31;
            tr_item8(w_d + (size_t)e * 1024 * 1024, 1024, 128 * kb, 32 * nb, ws + WS_WD + (size_t)e * 1024 * 1024, 32 * nb, 1024, 32.0f, T, lane); }
    }
}
struct P1Order : pg8::StaticOrder {
    const float* w_gu; const float* w_d; unsigned char* ws; LAS unsigned char* lds; int slot, wave, lane;
    __device__ __forceinline__ void after_unit(int ui) const { if (ui == slot) { int ln = lane; asm volatile("" : "+v"(ln));
            moe_convert_share(w_gu, w_d, ws, lds, c, G, wave, ln); } }
};

constexpr int P0_T_BYTES = 4352;
constexpr int P0_WL = 8 * P0_T_BYTES;
constexpr int P0_WU = P0_WL + 65536;
constexpr int P0_BA = P0_WU + 32768;

__device__ __forceinline__ void p0_items(Frame& F, const int nrep) {
    LAS unsigned* scr = (LAS unsigned*)(F.lds + F.wave * P0_T_BYTES);
    const int gw = F.vcu * NWAVES + F.wave, NGW = F.G * NWAVES;
    constexpr int I_IN = 128 * 16, I_SQ = 16 * 16;
    constexpr int NITEMS = I_IN + 3 * I_SQ;
    bf16* Win_t = WSP(bf16, WS_WIN);
    for (int it0 = gw; it0 < NITEMS * nrep; it0 += NGW) {
        int r = it0 % NITEMS;
        if (r < I_IN) { const int kb = r >> 7, nb = r & 127, j0 = 64 * nb;
            int srcc = j0 < 3072 ? j0 : j0 + 16;
            if (j0 >= 4096 && j0 < 6144) { const int pn = j0 >> 8, within = j0 & 255; srcc = ((within >> 7) ? 5136 : 4112) + (pn - 16) * 128 + (within & 127); }
            tr_item64(F.w_in, NZS, 64 * kb, srcc, Win_t, j0, 1024, scr, F.lane); continue; } r -= I_IN;
        if (r < I_SQ) { tr_item64(F.w_a, 1024, 64 * (r >> 4), 64 * (r & 15), WSP(bf16, WS_WA), 64 * (r & 15), 1024, scr, F.lane); continue; } r -= I_SQ;
        if (r < I_SQ) { tr_item64(F.w_b, 1024, 64 * (r >> 4), 64 * (r & 15), WSP(bf16, WS_WB), 64 * (r & 15), 1024, scr, F.lane); continue; } r -= I_SQ;
        tr_item64(F.w_out, 1024, 64 * (r >> 4), 64 * (r & 15), WSP(bf16, WS_WO), 64 * (r & 15), 1024, scr, F.lane);
    }
}

__device__ __forceinline__ void p0_rows(Frame& F, const int nrep2) {
    const int gw = F.vcu * NWAVES + F.wave, NGW = F.G * NWAVES;
    LAS float* Wl = (LAS float*)(F.lds + P0_WL);
    LAS float* WU = (LAS float*)(F.lds + P0_WU);
    LAS float* BA = (LAS float*)(F.lds + P0_BA);
    f32x4 g[4];
#pragma unroll
    for (int j = 0; j < 4; ++j) g[j] = *((const f32x4*)F.g_mix + F.lane + 64 * j);
    bf16* XN = WSP(bf16, WS_XN); bf16* LA = WSP(bf16, WS_LA);
    f32x4 nx[4];
    if (gw < M * nrep2) { const f32x4* xr = (const f32x4*)(F.x + (size_t)(gw % M) * D) + F.lane;
#pragma unroll
        for (int j = 0; j < 4; ++j) nx[j] = xr[64 * j]; }
#pragma unroll 1
    for (int m0 = gw; m0 < M * nrep2; m0 += NGW) {
        const int m = m0 % M;
        f32x4 v[4]; float s = 0.f;
#pragma unroll
        for (int j = 0; j < 4; ++j) { v[j] = nx[j]; s += (v[j].x * v[j].x + v[j].y * v[j].y) + (v[j].z * v[j].z + v[j].w * v[j].w); }
        if (m0 + NGW < M * nrep2) { const f32x4* xr = (const f32x4*)(F.x + (size_t)((m0 + NGW) % M) * D) + F.lane;
#pragma unroll
            for (int j = 0; j < 4; ++j) nx[j] = xr[64 * j]; }
        const float rstd = 1.0f / sqrtf(wave_sum(s) * (1.f / D) + 1e-6f);
        unsigned long long* o8 = (unsigned long long*)(XN + (size_t)m * D) + F.lane;
#pragma unroll
        for (int j = 0; j < 4; ++j) { v[j] = v[j] * rstd * g[j]; o8[64 * j] = (unsigned long long)pk2(v[j].x, v[j].y) | ((unsigned long long)pk2(v[j].z, v[j].w) << 32); }
        float a[16];
#pragma unroll
        for (int r4 = 0; r4 < 4; ++r4) {
#pragma unroll
            for (int rr = 0; rr < 4; ++rr) { const int r = 4 * r4 + rr; float t = 0.f;
#pragma unroll
                for (int j = 0; j < 4; ++j) { const f32x4 w = *(const LAS f32x4*)(Wl + r * 1024 + 256 * j + 4 * F.lane); t = fmaf(v[j].x, w.x, t); t = fmaf(v[j].y, w.y, t); t = fmaf(v[j].z, w.z, t); t = fmaf(v[j].w, w.w, t); }
                a[r] = t; }
            asm volatile("" ::: "memory");
        }
#pragma unroll
        for (int q = 0; q < 8; ++q) { const bool up = (F.lane & 32) != 0; const float send = up ? a[q] : a[q + 8]; const float keep = up ? a[q + 8] : a[q]; a[q] = keep + __shfl_xor(send, 32); }
#pragma unroll
        for (int q = 0; q < 4; ++q) { const bool up = (F.lane & 16) != 0; const float send = up ? a[q] : a[q + 4]; const float keep = up ? a[q + 4] : a[q]; a[q] = keep + __shfl_xor(send, 16); }
#pragma unroll
        for (int q = 0; q < 2; ++q) { const bool up = (F.lane & 8) != 0; const float send = up ? a[q] : a[q + 2]; const float keep = up ? a[q + 2] : a[q]; a[q] = keep + __shfl_xor(send, 8); }
        { const bool up = (F.lane & 4) != 0; const float send = up ? a[0] : a[1]; const float keep = up ? a[1] : a[0]; a[0] = keep + __shfl_xor(send, 4); }
        float alv = a[0]; alv += __shfl_xor(alv, 2); alv += __shfl_xor(alv, 1);
        float al[16];
#pragma unroll
        for (int r = 0; r < 16; ++r) al[r] = __builtin_bit_cast(float, __builtin_amdgcn_readlane(__builtin_bit_cast(int, alv), 4 * r));
#pragma unroll
        for (int i = 0; i < 8; ++i) { const int j = F.lane + 64 * i; float pre = BA[j];
#pragma unroll
            for (int r = 0; r < 16; ++r) pre = fmaf(al[r], WU[r * 512 + j], pre);
            const float ls = fminf(pre, 0.f) - __logf(1.0f + __expf(-fabsf(pre)));
            LA[((size_t)(i >> 1) * M + m) * 128 + (j & 127)] = (bf16)(pk2(ls * (1.0f / 16.0f), 0.f) & 0xffffu);
            if (i & 1) asm volatile("" ::: "memory"); }
    }
}

__device__ __forceinline__ void p0_prologue(Frame& F, const int nrep, const int nrep2) {
    {
        LAS float* Wl = (LAS float*)(F.lds + P0_WL); LAS float* WU = (LAS float*)(F.lds + P0_WU); LAS float* BA = (LAS float*)(F.lds + P0_BA);
        for (int i = 0; i < 32; ++i) { const int idx = F.tid + 512 * i, k = idx >> 4, r = idx & 15; Wl[r * 1024 + k] = F.w_in[(size_t)k * NZS + 3072 + r]; }
        for (int i = 0; i < 16; ++i) { const int idx = F.tid + 512 * i; WU[idx] = F.w_up[idx]; }
        BA[F.tid] = F.b_alpha[F.tid];
        __syncthreads();
    }
#pragma unroll 1
    for (int pass = 0; pass < 2; ++pass) {
        if (((pass ^ F.wave) & 1) == 0) p0_items(F, nrep); else p0_rows(F, nrep2);
    }
}

struct EpiZ {
    static constexpr bool PERM = true;
    bf16* Z;
    __device__ __forceinline__ void operator()(const f32x4 (&acc)[2][2][4][2], const pg8::Unit& u, int wr, int wc, int fr, int fq) const {
        const int row0 = u.pm * 256 + wr * 64 + fr, c0 = wc * 32 + 8 * fq;
        const int pn = u.pn;
        const int kind = pn < 2 ? 1 : (pn < 8 ? 0 : (pn < 12 ? 2 : (pn < 24 ? 0 : 3)));
        bf16* base; int ld; size_t bjs;
        if (pn < 4) { base = Z + (pn < 2 ? ZQ : ZK) + (size_t)(2 * (pn & 1)) * M * 128; ld = 128; bjs = (size_t)M * 128; }
        else if (pn < 12) { base = Z + (pn < 8 ? ZV : ZR) + (size_t)(pn & 3) * M * 256; ld = 256; bjs = 128; }
        else { const int t = (pn - 12) >> 2; base = Z + ZCB + (size_t)t * M * 1024 + (size_t)((pn - 12) & 3) * 256; ld = 1024; bjs = 128; }
        if (pn >= 16 && pn < 24) {
            bf16* ub = Z + ZCC + (size_t)(pn - 16) * 128;
#pragma unroll
            for (int ai = 0; ai < 2; ++ai)
#pragma unroll
                for (int m = 0; m < 4; ++m) { const f32x4 v0 = acc[ai][0][m][0] * acc[ai][1][m][0], v1 = acc[ai][0][m][1] * acc[ai][1][m][1];
                    u32x4 w; w.x = pk2(v0[0], v0[1]); w.y = pk2(v0[2], v0[3]); w.z = pk2(v1[0], v1[1]); w.w = pk2(v1[2], v1[3]);
                    *(u32x4*)(ub + (size_t)(row0 + ai * 128 + m * 16) * 1024 + c0) = w; }
            return;
        }
#pragma unroll
        for (int ai = 0; ai < 2; ++ai)
#pragma unroll
            for (int m = 0; m < 4; ++m) { bf16* rowp = base + (size_t)(row0 + ai * 128 + m * 16) * ld + c0;
#pragma unroll
                for (int bj = 0; bj < 2; ++bj) { f32x4 v0 = acc[ai][bj][m][0], v1 = acc[ai][bj][m][1];
                    if (kind == 1) { v0 = v0 * 0.08838834764831845f; v1 = v1 * 0.08838834764831845f; }
                    else if (kind == 2) {
#pragma unroll
                        for (int j = 0; j < 4; ++j) { v0[j] = v0[j] * fast_sigmoid(v0[j]); v1[j] = v1[j] * fast_sigmoid(v1[j]); } }
                    else if (kind == 3) {
#pragma unroll
                        for (int j = 0; j < 4; ++j) { v0[j] = fast_sigmoid(v0[j]); v1[j] = fast_sigmoid(v1[j]); } }
                    u32x4 w; w.x = pk2(v0[0], v0[1]); w.y = pk2(v0[2], v0[3]); w.z = pk2(v1[0], v1[1]); w.w = pk2(v1[2], v1[3]);
                    *(u32x4*)(rowp + bj * bjs) = w; } }
    }
};

constexpr int QD_STRIDE = 272, KT_STRIDE = 144, SC_STRIDE = 144, OT_STRIDE = 1040;
constexpr int L_QD = 0, L_KI = 17408, L_KT = 34816, L_SC = 53248, L_DEC = 62464, L_SEG = 62976, L_OT = 67584;
__device__ __forceinline__ int crow(int reg, int h) { return (reg & 3) + 8 * (reg >> 2) + 4 * h; }

template <bool OUT>
__device__ __forceinline__ void gla_item(Frame& F, int item) {
    const int bh = item >> 3, sc = item & 7, b = bh >> 2, hd = bh & 3;
    const int t0 = b * SEQ + sc * 256;
    const int tid = F.tid, lane = F.lane, w = F.wave, r32 = lane & 31, h = lane >> 5;
    const bf16* Z = WSP(const bf16, WS_Z);
    const bf16* LA = WSP(const bf16, WS_LA);
    LAS unsigned char* L = F.lds;
    f32x16 S[4];
    unsigned* Sbuf = (OUT ? WSP(unsigned, WS_SIN) : WSP(unsigned, WS_U)) + (size_t)item * 16384 + (size_t)w * 2048;
    if (OUT) {
#pragma unroll
        for (int kb = 0; kb < 4; ++kb)
#pragma unroll
            for (int r = 0; r < 16; r += 2) { const unsigned pw = Sbuf[(kb * 8 + (r >> 1)) * 64 + lane]; S[kb][r] = bf_lo(pw); S[kb][r + 1] = bf_hi(pw); }
    } else {
#pragma unroll
        for (int kb = 0; kb < 4; ++kb)
#pragma unroll
            for (int r = 0; r < 16; ++r) S[kb][r] = 0.f;
    }
    float btot_run0 = 0.f, btot_run1 = 0.f;
    const int tok_n = tid >> 3, part = tid & 7;
    unsigned la2[8], kk[8], qq[8]; bf16x8 Bv[4]; u32x4 rc[4];
#define GLA_LOAD(tcx) do { \
        const size_t rb_ = ((size_t)hd * M + (tcx) + 8 * w) * 128 + 2 * lane; \
        _Pragma("unroll") for (int i = 0; i < 8; ++i) { la2[i] = *(const unsigned*)(LA + rb_ + (size_t)i * 128); kk[i] = *(const unsigned*)(Z + ZK + rb_ + (size_t)i * 128); if (OUT) qq[i] = *(const unsigned*)(Z + ZQ + rb_ + (size_t)i * 128); } \
    } while (0)
#define GLA_LOADV(tcx) do { \
        _Pragma("unroll") for (int ks = 0; ks < 4; ++ks) _Pragma("unroll") for (int j = 0; j < 8; ++j) Bv[ks][j] = (short)Z[ZV + ((size_t)hd * M + (tcx) + 16 * ks + 8 * h + j) * 256 + 32 * w + r32]; \
    } while (0)
#define GLA_LOADR(tcx) do { \
        if (OUT) { const u32x4* rp_ = (const u32x4*)(Z + ZR + ((size_t)hd * M + (tcx) + tok_n) * 256 + 32 * part); _Pragma("unroll") for (int i = 0; i < 4; ++i) rc[i] = rp_[i]; } \
    } while (0)
    GLA_LOAD(t0); GLA_LOADV(t0);
#pragma unroll 1
    for (int c = 0; c < 4; ++c) {
        const int tc = t0 + c * 64;
        float p0[8], p1[8];
        { float r0 = 0.f, r1 = 0.f;
#pragma unroll
          for (int i = 0; i < 8; ++i) { r0 += bf_lo(la2[i]); r1 += bf_hi(la2[i]); p0[i] = r0; p1[i] = r1; }
          *(LAS f32x2*)(L + L_SEG + (w * 128 + 2 * lane) * 4) = (f32x2){r0, r1}; }
        GLA_LOADR(tc);
        __syncthreads();
        float off0 = 0.f, off1 = 0.f, bt0 = 0.f, bt1 = 0.f;
#pragma unroll
        for (int sgi = 0; sgi < 8; ++sgi) { const f32x2 sv = *(const LAS f32x2*)(L + L_SEG + (sgi * 128 + 2 * lane) * 4); if (sgi < w) { off0 += sv.x; off1 += sv.y; } bt0 += sv.x; bt1 += sv.y; }
        if (w == 0) { *(LAS f32x2*)(L + L_DEC + 8 * lane) = (f32x2){__expf(bt0), __expf(bt1)}; btot_run0 += bt0; btot_run1 += bt1; }
        {
            unsigned kt0[4], kt1[4];
#pragma unroll
            for (int i = 0; i < 8; i += 2) {
                const float b00 = off0 + p0[i], b01 = off1 + p1[i], b10 = off0 + p0[i + 1], b11 = off1 + p1[i + 1];
                const float k00 = bf_lo(kk[i]), k01 = bf_hi(kk[i]), k10 = bf_lo(kk[i + 1]), k11 = bf_hi(kk[i + 1]);
                kt0[i >> 1] = pk2(k00 * __expf(bt0 - b00), k10 * __expf(bt0 - b10));
                kt1[i >> 1] = pk2(k01 * __expf(bt1 - b01), k11 * __expf(bt1 - b11));
                if (OUT) {
                    const float q00 = bf_lo(qq[i]), q01 = bf_hi(qq[i]), q10 = bf_lo(qq[i + 1]), q11 = bf_hi(qq[i + 1]);
                    *(LAS unsigned*)(L + L_QD + (8 * w + i) * QD_STRIDE + 4 * lane) = pk2(q00 * __expf(b00), q01 * __expf(b01));
                    *(LAS unsigned*)(L + L_QD + (8 * w + i + 1) * QD_STRIDE + 4 * lane) = pk2(q10 * __expf(b10), q11 * __expf(b11));
                    *(LAS unsigned*)(L + L_KI + (8 * w + i) * QD_STRIDE + 4 * lane) = pk2(k00 * __expf(-b00), k01 * __expf(-b01));
                    *(LAS unsigned*)(L + L_KI + (8 * w + i + 1) * QD_STRIDE + 4 * lane) = pk2(k10 * __expf(-b10), k11 * __expf(-b11));
                }
            }
            *(LAS u32x4*)(L + L_KT + (2 * lane) * KT_STRIDE + 16 * w) = (u32x4){kt0[0], kt0[1], kt0[2], kt0[3]};
            *(LAS u32x4*)(L + L_KT + (2 * lane + 1) * KT_STRIDE + 16 * w) = (u32x4){kt1[0], kt1[1], kt1[2], kt1[3]};
        }
        __syncthreads();
        if (c < 3) GLA_LOAD(tc + 64);
        f32x16 o[2];
        if (OUT) {
            if (w < 3) {
                const int ib = w == 0 ? 0 : 1, jb = w == 2 ? 1 : 0;
                f32x16 sacc;
#pragma unroll
                for (int r = 0; r < 16; ++r) sacc[r] = 0.f;
#pragma unroll
                for (int kb = 0; kb < 8; ++kb) {
                    const bf16x8 a = *(const LAS bf16x8*)(L + L_QD + (32 * ib + r32) * QD_STRIDE + 2 * (16 * kb + 8 * h));
                    const bf16x8 bb = *(const LAS bf16x8*)(L + L_KI + (32 * jb + r32) * QD_STRIDE + 2 * (16 * kb + 8 * h));
                    sacc = __builtin_amdgcn_mfma_f32_32x32x16_bf16(a, bb, sacc, 0, 0, 0);
                }
#pragma unroll
                for (int r = 0; r < 16; r += 1) {
                    const int i = 32 * ib + crow(r, h), j = 32 * jb + r32;
                    const float v = (j <= i) ? sacc[r] : 0.f;
                    *(LAS bf16*)(L + L_SC + i * SC_STRIDE + 2 * j) = (bf16)(pk2(v, 0.f) & 0xffffu);
                }
            }
#pragma unroll
            for (int ib = 0; ib < 2; ++ib)
#pragma unroll
                for (int r = 0; r < 16; ++r) o[ib][r] = 0.f;
#pragma unroll
            for (int kb = 0; kb < 4; ++kb)
#pragma unroll
                for (int s2 = 0; s2 < 2; ++s2) {
                    u32x4 pb; pb.x = pk2(S[kb][8 * s2 + 0], S[kb][8 * s2 + 1]); pb.y = pk2(S[kb][8 * s2 + 2], S[kb][8 * s2 + 3]); pb.z = pk2(S[kb][8 * s2 + 4], S[kb][8 * s2 + 5]); pb.w = pk2(S[kb][8 * s2 + 6], S[kb][8 * s2 + 7]);
                    const bf16x8 bfrag = __builtin_bit_cast(bf16x8, pb);
#pragma unroll
                    for (int ib = 0; ib < 2; ++ib) {
                        const LAS unsigned char* qp = L + L_QD + (32 * ib + r32) * QD_STRIDE + 2 * (32 * kb + 16 * s2 + 4 * h);
                        const u32x2 lo = *(const LAS u32x2*)qp, hi = *(const LAS u32x2*)(qp + 16);
                        const bf16x8 afrag = __builtin_bit_cast(bf16x8, (u32x4){lo.x, lo.y, hi.x, hi.y});
                        o[ib] = __builtin_amdgcn_mfma_f32_32x32x16_bf16(afrag, bfrag, o[ib], 0, 0, 0);
                    }
                }
            __syncthreads();
#pragma unroll
            for (int ks = 0; ks < 4; ++ks)
#pragma unroll
                for (int ib = 0; ib < 2; ++ib) {
                    if (ib == 0 && ks >= 2) continue;
                    const bf16x8 a = *(const LAS bf16x8*)(L + L_SC + (32 * ib + r32) * SC_STRIDE + 2 * (16 * ks + 8 * h));
                    o[ib] = __builtin_amdgcn_mfma_f32_32x32x16_bf16(a, Bv[ks], o[ib], 0, 0, 0);
                }
        }
#pragma unroll
        for (int kb = 0; kb < 4; ++kb) {
#pragma unroll
            for (int g4 = 0; g4 < 4; ++g4) { const f32x4 dc = *(const LAS f32x4*)(L + L_DEC + 4 * (32 * kb + 8 * g4 + 4 * h));
#pragma unroll
                for (int j = 0; j < 4; ++j) S[kb][4 * g4 + j] *= dc[j]; }
#pragma unroll
            for (int ks = 0; ks < 4; ++ks) {
                const bf16x8 a = *(const LAS bf16x8*)(L + L_KT + (32 * kb + r32) * KT_STRIDE + 2 * (16 * ks + 8 * h));
                S[kb] = __builtin_amdgcn_mfma_f32_32x32x16_bf16(a, Bv[ks], S[kb], 0, 0, 0);
            }
        }
        if (c < 3) GLA_LOADV(tc + 64);
        if (OUT) {
#pragma unroll
            for (int ib = 0; ib < 2; ++ib)
#pragma unroll
                for (int r = 0; r < 16; ++r) *(LAS float*)(L + L_OT + (32 * ib + crow(r, h)) * OT_STRIDE + 4 * (32 * w + r32)) = o[ib][r];
            __syncthreads();
            f32x4 ov[8]; float ss = 0.f;
#pragma unroll
            for (int i = 0; i < 8; ++i) { ov[i] = *(const LAS f32x4*)(L + L_OT + tok_n * OT_STRIDE + 4 * (32 * part + 4 * i)); ss += (ov[i].x * ov[i].x + ov[i].y * ov[i].y) + (ov[i].z * ov[i].z + ov[i].w * ov[i].w); }
            ss += __shfl_xor(ss, 1); ss += __shfl_xor(ss, 2); ss += __shfl_xor(ss, 4);
            const float rs = 1.0f / sqrtf(ss * (1.0f / 256.0f) + 1e-6f);
            const size_t trow = (size_t)(tc + tok_n);
            const f32x4* gp = (const f32x4*)(F.g_gla + hd * 256 + 32 * part);
            u32x4* op = (u32x4*)(WSP(bf16, WS_OG) + trow * 1024 + hd * 256 + 32 * part);
#pragma unroll
            for (int i = 0; i < 4; ++i) {
                const u32x4 rr = rc[i]; const f32x4 g0 = gp[2 * i], g1 = gp[2 * i + 1]; const f32x4 a0 = ov[2 * i], a1 = ov[2 * i + 1];
                u32x4 ow;
                ow.x = pk2(a0.x * rs * g0.x * bf_lo(rr.x), a0.y * rs * g0.y * bf_hi(rr.x));
                ow.y = pk2(a0.z * rs * g0.z * bf_lo(rr.y), a0.w * rs * g0.w * bf_hi(rr.y));
                ow.z = pk2(a1.x * rs * g1.x * bf_lo(rr.z), a1.y * rs * g1.y * bf_hi(rr.z));
                ow.w = pk2(a1.z * rs * g1.z * bf_lo(rr.w), a1.w * rs * g1.w * bf_hi(rr.w));
                op[i] = ow;
            }
        }
    }
#undef GLA_LOAD
#undef GLA_LOADV
#undef GLA_LOADR
    if (!OUT) {
#pragma unroll
        for (int kb = 0; kb < 4; ++kb)
#pragma unroll
            for (int r = 0; r < 16; r += 2) Sbuf[(kb * 8 + (r >> 1)) * 64 + lane] = pk2(S[kb][r], S[kb][r + 1]);
        if (w == 0) *(f32x2*)(WSP(float, WS_DECS) + item * 128 + 2 * lane) = (f32x2){__expf(btot_run0), __expf(btot_run1)};
    }
    __syncthreads();
}

__device__ __forceinline__ void conv_rows(Frame& F, const int nrep) {
    const int gw = F.vcu * NWAVES + F.wave, NGW = F.G * NWAVES;
    const bf16* Z = WSP(const bf16, WS_Z); bf16* PB = WSP(bf16, WS_PB);
    for (int blk0 = gw; blk0 < (M / 8) * nrep; blk0 += NGW) {
        const int blk = blk0 % (M / 8);
        const int m0 = blk * 8, s0 = m0 % SEQ;
#pragma unroll 1
        for (int j = 0; j < 2; ++j) {
            const int c = 8 * F.lane + 512 * j;
            const size_t rp = (size_t)(s0 > 0 ? m0 - 2 : m0);
            const u32x4 p2c = *(const u32x4*)(Z + ZCC + rp * 1024 + c);
            const u32x4 p1c = *(const u32x4*)(Z + ZCC + (rp + 1) * 1024 + c);
            float w0[8], w1[8], w2[8];
#pragma unroll
            for (int i = 0; i < 8; ++i) { w0[i] = F.w_conv[c + i]; w1[i] = F.w_conv[1024 + c + i]; w2[i] = F.w_conv[2048 + c + i]; }
            float u1[8], u2[8];
            const float keep = s0 > 0 ? 1.0f : 0.0f;
#pragma unroll
            for (int i = 0; i < 4; ++i) { u2[2 * i] = keep * bf_lo(p2c[i]); u2[2 * i + 1] = keep * bf_hi(p2c[i]); u1[2 * i] = keep * bf_lo(p1c[i]); u1[2 * i + 1] = keep * bf_hi(p1c[i]); }
#pragma unroll
            for (int hb = 0; hb < 2; ++hb) {
                u32x4 cc[4], cb[4];
#pragma unroll
                for (int rr = 0; rr < 4; ++rr) { const size_t row = (size_t)(m0 + 4 * hb + rr); cc[rr] = *(const u32x4*)(Z + ZCC + row * 1024 + c); cb[rr] = *(const u32x4*)(Z + ZCB + row * 1024 + c); }
#pragma unroll
                for (int rr = 0; rr < 4; ++rr) {
                    float u0[8], y[8];
#pragma unroll
                    for (int i = 0; i < 4; ++i) { u0[2 * i] = bf_lo(cc[rr][i]); u0[2 * i + 1] = bf_hi(cc[rr][i]); }
#pragma unroll
                    for (int i = 0; i < 8; ++i) y[i] = w0[i] * u2[i] + w1[i] * u1[i] + w2[i] * u0[i];
                    u32x4 ow;
#pragma unroll
                    for (int i = 0; i < 4; ++i) ow[i] = pk2(bf_lo(cb[rr][i]) * y[2 * i], bf_hi(cb[rr][i]) * y[2 * i + 1]);
                    *(u32x4*)(PB + (size_t)(m0 + 4 * hb + rr) * 1024 + c) = ow;
#pragma unroll
                    for (int i = 0; i < 8; ++i) { u2[i] = u1[i]; u1[i] = u0[i]; }
                }
                asm volatile("" ::: "memory");
            }
        }
    }
}

__device__ __forceinline__ void gla_scan(Frame& F, const int nrep) {
    const unsigned* U = WSP(const unsigned, WS_U); unsigned* SIN = WSP(unsigned, WS_SIN); const float* DECS = WSP(const float, WS_DECS);
    const int gt = F.vcu * 512 + F.tid, NT = F.G * 512;
    for (int idx0 = gt; idx0 < 32 * 16384 * nrep; idx0 += NT) {
        const int idx = idx0 & (32 * 16384 - 1);
        const int bh = idx >> 14, e = idx & 16383;
        const int ln = e & 63, rp = (e >> 6) & 7, kb = (e >> 9) & 3;
        const int dk = 32 * kb + crow(2 * rp, ln >> 5);
        float s0 = 0.f, s1 = 0.f;
        unsigned uw[8];
#pragma unroll
        for (int sc = 0; sc < 8; ++sc) uw[sc] = U[(size_t)(bh * 8 + sc) * 16384 + e];
#pragma unroll
        for (int sc = 0; sc < 8; ++sc) {
            const int item = bh * 8 + sc;
            SIN[(size_t)item * 16384 + e] = pk2(s0, s1);
            const f32x2 dc = *(const f32x2*)(DECS + item * 128 + dk);
            s0 = dc.x * s0 + bf_lo(uw[sc]); s1 = dc.y * s1 + bf_hi(uw[sc]);
        }
    }
}

struct P3Order : pg8::StaticOrder {
    __device__ __forceinline__ bool next(int i, pg8::Unit& u) const {
        if (!pg8::StaticOrder::next(i >> 1, u)) return false;
        u.e = i & 1; u.pn += 4 * u.e; return true;
    }
    __device__ __forceinline__ unsigned arow(const pg8::Unit& u, int ui, int r) const { return (unsigned)(u.e * M + u.pm * 256 + r) * 2048u; }
    __device__ __forceinline__ void after_unit(int ui) const {}
};
struct EpiBranch {
    static constexpr bool PERM = true;
    const bf16* Z; bf16* M1; bf16* MIX;
    __device__ __forceinline__ void operator()(const f32x4 (&acc)[2][2][4][2], const pg8::Unit& u, int wr, int wc, int fr, int fq) const {
        const int row0 = u.pm * 256 + wr * 64 + fr, col0 = (u.pn & 3) * 256 + wc * 32 + 8 * fq;
        const bf16* G = Z + (u.e ? ZGB : ZGA);
#pragma unroll
        for (int ai = 0; ai < 2; ++ai)
#pragma unroll
            for (int m = 0; m < 4; ++m) { const size_t row = (size_t)(row0 + ai * 128 + m * 16);
#pragma unroll
                for (int bj = 0; bj < 2; ++bj) { const u32x4 sg = *(const u32x4*)(G + row * 1024 + col0 + bj * 128);
                    const f32x4 v0 = acc[ai][bj][m][0], v1 = acc[ai][bj][m][1];
                    float r[8] = {v0[0] * bf_lo(sg.x), v0[1] * bf_hi(sg.x), v0[2] * bf_lo(sg.y), v0[3] * bf_hi(sg.y), v1[0] * bf_lo(sg.z), v1[1] * bf_hi(sg.z), v1[2] * bf_lo(sg.w), v1[3] * bf_hi(sg.w)};
                    if (u.e) { const u32x4 mm = *(const u32x4*)(M1 + row * 1024 + col0 + bj * 128);
                        r[0] += bf_lo(mm.x); r[1] += bf_hi(mm.x); r[2] += bf_lo(mm.y); r[3] += bf_hi(mm.y); r[4] += bf_lo(mm.z); r[5] += bf_hi(mm.z); r[6] += bf_lo(mm.w); r[7] += bf_hi(mm.w); }
                    u32x4 w; w.x = pk2(r[0], r[1]); w.y = pk2(r[2], r[3]); w.z = pk2(r[4], r[5]); w.w = pk2(r[6], r[7]);
                    *(u32x4*)((u.e ? MIX : M1) + row * 1024 + col0 + bj * 128) = w; } }
    }
};
struct EpiX1 {
    static constexpr bool PERM = true;
    const float* x; bf16* X1;
    __device__ __forceinline__ void operator()(const f32x4 (&acc)[2][2][4][2], const pg8::Unit& u, int wr, int wc, int fr, int fq) const {
        const int row0 = u.pm * 256 + wr * 64 + fr, col0 = u.pn * 256 + wc * 32 + 8 * fq;
#pragma unroll
        for (int ai = 0; ai < 2; ++ai)
#pragma unroll
            for (int m = 0; m < 4; ++m) { const size_t off = (size_t)(row0 + ai * 128 + m * 16) * 1024 + col0;
#pragma unroll
                for (int bj = 0; bj < 2; ++bj) { const f32x4 x0 = *(const f32x4*)(x + off + bj * 128), x1 = *(const f32x4*)(x + off + bj * 128 + 4);
                    const f32x4 v0 = x0 + acc[ai][bj][m][0], v1 = x1 + acc[ai][bj][m][1];
                    u32x4 w; w.x = pk2(v0[0], v0[1]); w.y = pk2(v0[2], v0[3]); w.z = pk2(v1[0], v1[1]); w.w = pk2(v1[2], v1[3]);
                    *(u32x4*)(X1 + off + bj * 128) = w; } }
    }
};

constexpr int WRT_LD = 1028;
__device__ __forceinline__ void route_pair(float lg, int lane, int tl, size_t m, LAS int* hist, LAS int* ple, float* gate) {
    const int myi = lane & 31;
    float tv[4]; int ti[4];
#pragma unroll
    for (int k = 0; k < 4; ++k) {
        float bv = lg; int bi = myi;
#pragma unroll
        for (int off = 16; off >= 1; off >>= 1) { const float ov = __shfl_xor(bv, off); const int oi = __shfl_xor(bi, off); if (ov > bv || (ov == bv && oi < bi)) { bv = ov; bi = oi; } }
        tv[k] = bv; ti[k] = bi;
        if (myi == bi) lg = -3.0e38f;
    }
    const float e1 = __expf(tv[1] - tv[0]), e2 = __expf(tv[2] - tv[0]), e3 = __expf(tv[3] - tv[0]);
    const float inv = 1.0f / (1.0f + e1 + e2 + e3);
    if (myi < 4) {
        const int ek = myi == 0 ? ti[0] : (myi == 1 ? ti[1] : (myi == 2 ? ti[2] : ti[3]));
        const float gk = (myi == 0 ? 1.0f : (myi == 1 ? e1 : (myi == 2 ? e2 : e3))) * inv;
        const int lr = __hip_atomic_fetch_add(&hist[ek], 1, __ATOMIC_RELAXED, __HIP_MEMORY_SCOPE_WORKGROUP);
        ple[tl * 4 + myi] = ek | (lr << 8);
        gate[m * 4 + myi] = gk;
    }
}
__device__ __forceinline__ void p5_router(Frame& F) {
    LAS float* WrT = (LAS float*)F.lds;
    LAS int* hist = (LAS int*)(F.lds + EXTRA_OFF + 1024);
    LAS int* base = (LAS int*)(F.lds + EXTRA_OFF + 1024 + 128);
    LAS int* ple = (LAS int*)(F.lds + EXTRA_OFF + 1024 + 256);
    for (int i = 0; i < 64; ++i) { const int idx = F.tid + 512 * i, k = idx >> 5, e = idx & 31; WrT[e * WRT_LD + k] = F.w_router[idx]; }
    f32x4 g[4];
#pragma unroll
    for (int j = 0; j < 4; ++j) g[j] = *((const f32x4*)F.g_ffn + F.lane + 64 * j);
    const float brl = F.b_router[F.lane & 31];
    const bf16* X1 = WSP(const bf16, WS_X1); unsigned char* H2 = WSP(unsigned char, WS_XN);
    unsigned* cnt = F.ctl + CW_CNT; int* list = WSP(int, WS_LIST); float* gate = WSP(float, WS_GATE);
    const int lane = F.lane;
    for (int grp = F.vcu; grp < M / 64; grp += F.G) {
        if (F.tid < 32) hist[F.tid] = 0;
        __syncthreads();
        u32x2 nx0[4], nx1[4];
        { const u32x2* xa = (const u32x2*)(X1 + (size_t)(grp * 64 + 8 * F.wave) * D) + lane;
#pragma unroll
          for (int j = 0; j < 4; ++j) { nx0[j] = xa[64 * j]; nx1[j] = xa[256 + 64 * j]; } }
#pragma unroll 1
        for (int i2 = 0; i2 < 4; ++i2) {
            f32x4 v0[4], v1[4];
#pragma unroll
            for (int j = 0; j < 4; ++j) { v0[j] = (f32x4){bf_lo(nx0[j].x), bf_hi(nx0[j].x), bf_lo(nx0[j].y), bf_hi(nx0[j].y)}; v1[j] = (f32x4){bf_lo(nx1[j].x), bf_hi(nx1[j].x), bf_lo(nx1[j].y), bf_hi(nx1[j].y)}; }
            if (i2 < 3) { const u32x2* xa = (const u32x2*)(X1 + (size_t)(grp * 64 + 8 * F.wave + 2 * i2 + 2) * D) + lane;
#pragma unroll
                for (int j = 0; j < 4; ++j) { nx0[j] = xa[64 * j]; nx1[j] = xa[256 + 64 * j]; } }
            f32x2 vp[4][4];
            { float s0 = 0.f, s1 = 0.f;
#pragma unroll
              for (int j = 0; j < 4; ++j) {
#pragma unroll
                  for (int c = 0; c < 4; ++c) { s0 = fmaf(v0[j][c], v0[j][c], s0); s1 = fmaf(v1[j][c], v1[j][c], s1); } }
              const float r0 = 1.0f / sqrtf(wave_sum(s0) * (1.f / D) + 1e-6f), r1 = 1.0f / sqrtf(wave_sum(s1) * (1.f / D) + 1e-6f);
              const size_t m0 = (size_t)(grp * 64 + 8 * F.wave + 2 * i2);
              unsigned* o0 = (unsigned*)(H2 + m0 * D) + lane; unsigned* o1 = (unsigned*)(H2 + (m0 + 1) * D) + lane;
#pragma unroll
              for (int j = 0; j < 4; ++j) { v0[j] = v0[j] * r0 * g[j]; v1[j] = v1[j] * r1 * g[j];
                  o0[64 * j] = pk4_fp8(v0[j].x, v0[j].y, v0[j].z, v0[j].w);
                  o1[64 * j] = pk4_fp8(v1[j].x, v1[j].y, v1[j].z, v1[j].w);
#pragma unroll
                  for (int c = 0; c < 4; ++c) vp[j][c] = (f32x2){v0[j][c], v1[j][c]}; } }
            f32x2 a2[32];
#pragma unroll
            for (int e4 = 0; e4 < 8; ++e4) {
#pragma unroll
                for (int ee = 0; ee < 4; ++ee) { const int e = 4 * e4 + ee; f32x2 t = {0.f, 0.f};
#pragma unroll
                    for (int j = 0; j < 4; ++j) { const f32x4 wv = *(const LAS f32x4*)(WrT + e * WRT_LD + 256 * j + 4 * lane);
#pragma unroll
                        for (int c = 0; c < 4; ++c) t = __builtin_elementwise_fma(vp[j][c], (f32x2){wv[c], wv[c]}, t); }
                    a2[e] = t; }
                asm volatile("" ::: "memory");
            }
            float a[32];
            { const bool up = (lane & 32) != 0;
#pragma unroll
              for (int q = 0; q < 32; ++q) { const float send = up ? a2[q].x : a2[q].y; const float keep = up ? a2[q].y : a2[q].x; a[q] = keep + __shfl_xor(send, 32); } }
#pragma unroll
            for (int q = 0; q < 16; ++q) { const bool up = (lane & 16) != 0; const float send = up ? a[q] : a[q + 16]; const float keep = up ? a[q + 16] : a[q]; a[q] = keep + __shfl_xor(send, 16); }
#pragma unroll
            for (int q = 0; q < 8; ++q) { const bool up = (lane & 8) != 0; const float send = up ? a[q] : a[q + 8]; const float keep = up ? a[q + 8] : a[q]; a[q] = keep + __shfl_xor(send, 8); }
#pragma unroll
            for (int q = 0; q < 4; ++q) { const bool up = (lane & 4) != 0; const float send = up ? a[q] : a[q + 4]; const float keep = up ? a[q + 4] : a[q]; a[q] = keep + __shfl_xor(send, 4); }
#pragma unroll
            for (int q = 0; q < 2; ++q) { const bool up = (lane & 2) != 0; const float send = up ? a[q] : a[q + 2]; const float keep = up ? a[q + 2] : a[q]; a[q] = keep + __shfl_xor(send, 2); }
            { const bool up = (lane & 1) != 0; const float send = up ? a[0] : a[1]; const float keep = up ? a[1] : a[0]; a[0] = keep + __shfl_xor(send, 1); }
            const int tl = 8 * F.wave + 2 * i2 + (lane >> 5);
            route_pair(a[0] + brl, lane, tl, (size_t)(grp * 64 + tl), hist, ple, gate);
        }
        __syncthreads();
        if (F.tid < 32) base[F.tid] = (int)__hip_atomic_fetch_add(cnt + F.tid, (unsigned)hist[F.tid], RLX_AGENT);
        __syncthreads();
        if (F.tid < 256) { const int pe = ple[F.tid], e = pe & 255, lr = pe >> 8; list[e * CAP + base[e] + lr] = (grp * 64) * 4 + F.tid; }
        __syncthreads();
    }
}

#ifndef MK_MAXU
#define MK_MAXU 12
#endif
constexpr int MAXU = MK_MAXU;
template <int NP>
struct MoeOrder {
    LAS const int* rt0;
    LAS const int* tokl;
    int nwg, G, c, reps;
    __device__ __forceinline__ bool next(int i, pg8::Unit& u) const {
        const long L = (long)i * G + c; if (L >= (long)nwg * reps) return false;
        int wgid = (int)(L % nwg); { const int q = nwg / 8, r = nwg % 8, xcd = wgid % 8, off = wgid / 8; wgid = (xcd < r ? xcd * (q + 1) : r * (q + 1) + (xcd - r) * q) + off; }
        int e = 0;
#pragma unroll 1
        for (int j = 1; j < 32; ++j) if (wgid >= NP * rt0[j]) e = j;
        const int l = wgid - NP * rt0[e], nte = rt0[e + 1] - rt0[e];
        const int pn = l / nte, rt = l - pn * nte;
        u.pm = __builtin_amdgcn_readfirstlane(rt0[e] + rt); u.pn = __builtin_amdgcn_readfirstlane(e * NP + pn); u.e = __builtin_amdgcn_readfirstlane(e); u.rt = __builtin_amdgcn_readfirstlane(rt); return true;
    }
};
struct MoeOrder1 : MoeOrder<8> {
    __device__ __forceinline__ void after_unit(int ui) const {}
    __device__ __forceinline__ unsigned arow(const pg8::Unit& u, int ui, int r) const { return (unsigned)tokl[ui * 256 + r] * 1024u; }
};
struct MoeOrder2 : MoeOrder<4> {
    __device__ __forceinline__ void after_unit(int ui) const {}
    __device__ __forceinline__ unsigned arow(const pg8::Unit& u, int ui, int r) const { return (unsigned)(u.pm * 256 + r) * 1024u; }
};
struct EpiAct {
    static constexpr bool PERM = true;
    const float* b_gu; unsigned char* ACT;
    __device__ __forceinline__ void operator()(const f32x4 (&acc)[2][2][4][2], const pg8::Unit& u, int wr, int wc, int fr, int fq) const {
        const int pn = u.pn & 7, cl = pn * 128 + wc * 32 + 8 * fq;
        const int row0 = u.pm * 256 + wr * 64 + fr;
        const f32x4 bg0 = *(const f32x4*)(b_gu + u.e * 2048 + cl), bg1 = *(const f32x4*)(b_gu + u.e * 2048 + cl + 4);
        const f32x4 bl0 = *(const f32x4*)(b_gu + u.e * 2048 + 1024 + cl), bl1 = *(const f32x4*)(b_gu + u.e * 2048 + 1024 + cl + 4);
#pragma unroll
        for (int ai = 0; ai < 2; ++ai)
#pragma unroll
            for (int m = 0; m < 4; ++m) {
                f32x4 g0 = acc[ai][0][m][0] + bg0, g1 = acc[ai][0][m][1] + bg1, l0 = acc[ai][1][m][0] + bl0, l1 = acc[ai][1][m][1] + bl1;
                float r0[4], r1[4];
#pragma unroll
                for (int j = 0; j < 4; ++j) {
                    const float ga = fminf(g0[j], 7.0f), gb = fminf(g1[j], 7.0f);
                    const float la = fminf(fmaxf(l0[j], -7.0f), 7.0f), lb = fminf(fmaxf(l1[j], -7.0f), 7.0f);
                    r0[j] = (la + 1.0f) * (ga * fast_sigmoid(1.702f * ga)); r1[j] = (lb + 1.0f) * (gb * fast_sigmoid(1.702f * gb));
                }
                u32x2 w; w.x = pk4_fp8(r0[0], r0[1], r0[2], r0[3]); w.y = pk4_fp8(r1[0], r1[1], r1[2], r1[3]);
                *(u32x2*)(ACT + (size_t)(row0 + ai * 128 + m * 16) * 1024 + cl) = w;
            }
    }
};
struct EpiYP {
    static constexpr bool PERM = true;
    const float* b_d; const unsigned* cnt; const int* list; const float* gate; unsigned char* YP;
    __device__ __forceinline__ void operator()(const f32x4 (&acc)[2][2][4][2], const pg8::Unit& u, int wr, int wc, int fr, int fq) const {
        const int pn = u.pn & 3, col0 = pn * 256 + wc * 32 + 8 * fq;
        const int ne = (int)cnt[u.e];
        f32x4 bv[2][2];
#pragma unroll
        for (int bj = 0; bj < 2; ++bj)
#pragma unroll
            for (int n = 0; n < 2; ++n) bv[bj][n] = *(const f32x4*)(b_d + u.e * 1024 + col0 + bj * 128 + 4 * n);
#pragma unroll
        for (int ai = 0; ai < 2; ++ai)
#pragma unroll
            for (int m = 0; m < 4; ++m) {
                const int slot = u.rt * 256 + ai * 128 + wr * 64 + m * 16 + fr;
                if (slot < ne) {
                    const int pid = list[u.e * CAP + slot]; const float gw = gate[pid] * 16.0f;
#pragma unroll
                    for (int bj = 0; bj < 2; ++bj) { const f32x4 v0 = (acc[ai][bj][m][0] + bv[bj][0]) * gw, v1 = (acc[ai][bj][m][1] + bv[bj][1]) * gw;
                        u32x2 w; w.x = pk4_fp8(v0[0], v0[1], v0[2], v0[3]); w.y = pk4_fp8(v1[0], v1[1], v1[2], v1[3]);
                        *(u32x2*)(YP + (size_t)pid * 1024 + col0 + bj * 128) = w; }
                }
            }
    }
};
__device__ __forceinline__ int moe_setup(Frame& F, LAS int* rt0) {
    if (F.tid == 0) { int acc = 0; for (int e = 0; e < 32; ++e) { rt0[e] = acc; acc += ((int)F.ctl[CW_CNT + e] + 255) >> 8; } rt0[32] = acc; }
    __syncthreads();
    return rt0[32];
}

__device__ __forceinline__ void p8_final(Frame& F, const int nrep) {
    const int gw = F.vcu * NWAVES + F.wave, NGW = F.G * NWAVES;
    const bf16* X1 = WSP(const bf16, WS_X1); const unsigned char* YP = WSP(const unsigned char, WS_YP);
    f32x4 g[4];
#pragma unroll
    for (int j = 0; j < 4; ++j) g[j] = *((const f32x4*)F.g_final + F.lane + 64 * j);
    float pscale = 1.0f;
#ifdef MK_TPROBE
    { const unsigned long long* st = (const unsigned long long*)(F.ctl + CW_STAMP); const float dt_us = (float)(st[MK_TPROBE_J] - st[MK_TPROBE_I]) * 0.01f; pscale = 1.0f + sqrtf(dt_us * 1e-5f); }
#endif
    for (int m0 = gw; m0 < M * nrep; m0 += NGW) {
        const int m = m0 % M;
        const u32x2* xr = (const u32x2*)(X1 + (size_t)m * D) + F.lane;
        f32x4 v[4]; float s = 0.f;
#pragma unroll
        for (int j = 0; j < 4; ++j) { const u32x2 xw = xr[64 * j]; v[j] = (f32x4){bf_lo(xw.x), bf_hi(xw.x), bf_lo(xw.y), bf_hi(xw.y)}; }
        f32x4 ys[4];
#pragma unroll
        for (int j = 0; j < 4; ++j) ys[j] = (f32x4){0.f, 0.f, 0.f, 0.f};
#pragma unroll
        for (int k = 0; k < 4; ++k) { const unsigned* yr = (const unsigned*)(YP + ((size_t)m * 4 + k) * 1024) + F.lane;
#pragma unroll
            for (int j = 0; j < 4; ++j) { const int y = (int)yr[64 * j]; const f32x2 lo = __builtin_amdgcn_cvt_pk_f32_fp8(y, false), hi = __builtin_amdgcn_cvt_pk_f32_fp8(y, true);
                ys[j].x += lo.x; ys[j].y += lo.y; ys[j].z += hi.x; ys[j].w += hi.y; } }
#pragma unroll
        for (int j = 0; j < 4; ++j) v[j] = v[j] + ys[j] * 0.0625f;
#pragma unroll
        for (int j = 0; j < 4; ++j) s += (v[j].x * v[j].x + v[j].y * v[j].y) + (v[j].z * v[j].z + v[j].w * v[j].w);
        const float rstd = 1.0f / sqrtf(wave_sum(s) * (1.f / D) + 1e-6f);
        f32x4* op = (f32x4*)(F.out + (size_t)m * D) + F.lane;
#pragma unroll
        for (int j = 0; j < 4; ++j) op[64 * j] = v[j] * (rstd * pscale) * g[j];
    }
}

struct Args { const float* in[18]; float* out; unsigned char* ws; int ph_lo, ph_hi, rep_k, rep_n; };
__global__ void __launch_bounds__(NWAVES * 64, 2) mk_fwd(Args args) {
    extern __shared__ __attribute__((aligned(16))) unsigned char lds[];
    Frame F;
    F.lds = (LAS unsigned char*)lds;
    F.MISC = (volatile LAS unsigned*)(F.lds + MISC_OFF);
    F.tid = threadIdx.x; F.lane = F.tid & 63; F.wave = __builtin_amdgcn_readfirstlane(F.tid >> 6);
    F.G = gridDim.x; { const int bx = blockIdx.x; F.vcu = (F.G % 8 == 0) ? (bx % 8) * (F.G / 8) + bx / 8 : bx; }
    F.ws = args.ws; F.ctl = (unsigned*)(args.ws + WS_CTL);
    F.x = args.in[0]; F.g_mix = args.in[1]; F.w_in = args.in[2]; F.w_up = args.in[3]; F.b_alpha = args.in[4]; F.g_gla = args.in[5]; F.w_conv = args.in[6];
    F.w_a = args.in[7]; F.w_b = args.in[8]; F.w_out = args.in[9]; F.g_ffn = args.in[10]; F.w_router = args.in[11]; F.b_router = args.in[12];
    F.w_gu = args.in[13]; F.b_gu = args.in[14]; F.w_d = args.in[15]; F.b_d = args.in[16]; F.g_final = args.in[17]; F.out = args.out;
    if (F.tid < 128) ((LAS unsigned*)(F.lds + MISC_OFF))[F.tid] = 0u;
    __syncthreads();
    XcdBarrier bar; bar.bar = F.ctl + CW_BAR; bar.x = 0; bar.st = nullptr;
    if (N_LAUNCHES == 1) bar = xcd_barrier_post(F.ctl + CW_BAR, F.MISC + 8);
    const int lo = args.ph_lo, hi = args.ph_hi;
#ifdef MK_ONLY
#define IN(k) ((k) == MK_ONLY && lo <= (k) && (k) < hi)
#else
#define IN(k) (lo <= (k) && (k) < hi)
#endif
#define REPS(k) (((k) == args.rep_k) ? 1 + args.rep_n : 1)
#if defined(MK_TPROBE) || defined(MK_DELAY_K)
#define STAMP(k) do { if (blockIdx.x == 0 && F.tid == 0) ((unsigned long long*)(F.ctl + CW_STAMP))[k] = __builtin_amdgcn_s_memrealtime(); } while (0)
#else
#define STAMP(k) do { } while (0)
#endif
#ifdef MK_DELAY_K
#define DELAY(k) do { if ((k) == MK_DELAY_K) { const unsigned long long dl = __hip_atomic_load((unsigned long long*)(F.ctl + CW_STAMP), RLX_AGENT) + (unsigned long long)(MK_DELAY_US) * 100ull; \
    while (__builtin_amdgcn_s_memrealtime() < dl) __builtin_amdgcn_s_sleep(8); } } while (0)
#else
#define DELAY(k) do { } while (0)
#endif
#define SEAM(k) do { if (IN(k) && IN((k) + 1)) xcd_barrier(bar); STAMP((k) + 1); DELAY(k); } while (0)

    STAMP(0);
    if (IN(0)) { p0_prologue(F, REPS(0), REPS(11)); SEAM(0); }
    if (IN(1)) { const int nrep = REPS(1);
        P1Order S; S.init(M, NZ, D, F.G, (int)blockIdx.x, nrep); S.w_gu = F.w_gu; S.w_d = F.w_d; S.ws = F.ws; S.lds = F.lds; S.slot = ((int)blockIdx.x >> 3) & 7; S.wave = F.wave; S.lane = F.lane;
        EpiZ E{WSP(bf16, WS_Z)};
        pg8::gemm_phase<EpiZ, P1Order, true>(F.lds, WSP(const bf16, WS_XN), WSP(const bf16, WS_WIN), D, S, E);
        SEAM(1);
    }
    if (IN(2)) { const int nrep = REPS(2); for (int it = F.vcu; it < 256 * nrep; it += F.G) gla_item<false>(F, it & 255); conv_rows(F, REPS(12)); SEAM(2); }
    if (IN(3)) { gla_scan(F, REPS(3)); SEAM(3); }
    if (IN(4)) { const int nrep = REPS(4); for (int it = F.vcu; it < 256 * nrep; it += F.G) gla_item<true>(F, it & 255); SEAM(4); }
    if (IN(5)) { const int nrep = REPS(5);
        static_assert(WS_PB == WS_OG + (size_t)M * 1024 * 2 && WS_WB == WS_WA + (size_t)1024 * 1024 * 2, "P3Order addresses PB / Wb from OG / Wa");
        P3Order S; S.init(M, D, D, F.G, (int)blockIdx.x, nrep);
        EpiBranch E{WSP(const bf16, WS_Z), WSP(bf16, WS_M1), WSP(bf16, WS_MIX)};
        pg8::gemm_phase<EpiBranch, P3Order, true>(F.lds, WSP(const bf16, WS_OG), WSP(const bf16, WS_WA), D, S, E);
        SEAM(5);
    }
    if (IN(6)) { const int nrep = REPS(6);
        pg8::StaticOrder S; S.init(M, D, D, F.G, (int)blockIdx.x, nrep);
        EpiX1 E{F.x, WSP(bf16, WS_X1)};
        pg8::gemm_phase<EpiX1, pg8::StaticOrder, false>(F.lds, WSP(const bf16, WS_MIX), WSP(const bf16, WS_WO), D, S, E);
        SEAM(6);
    }
    if (IN(7)) { p5_router(F); SEAM(7); }
    if (IN(8)) { const int nrep = REPS(8);
        LAS int* rt0 = (LAS int*)(F.lds + EXTRA_OFF); LAS int* tokl = (LAS int*)(F.lds + EXTRA_OFF + 256);
        const int R = moe_setup(F, rt0);
        MoeOrder1 S; S.rt0 = rt0; S.tokl = tokl; S.nwg = R * 8; S.G = F.G; S.c = (int)blockIdx.x; S.reps = nrep;
        const int* list = WSP(const int, WS_LIST);
        { pg8::Unit u; for (int ui = 0; ui < MAXU && S.next(ui, u); ++ui) if (F.tid < 256) { const int slot = u.rt * 256 + F.tid; tokl[ui * 256 + F.tid] = slot < (int)F.ctl[CW_CNT + u.e] ? (list[u.e * CAP + slot] >> 2) : 0; } }
        __syncthreads();
        EpiAct E{F.b_gu, WSP(unsigned char, WS_ACT)};
        pg8::gemm_phase<EpiAct, MoeOrder1, true, true, 122>(F.lds, WSP(const void, WS_XN), WSP(const void, WS_WGU), D, S, E);
        SEAM(8);
    }
    if (IN(9)) { const int nrep = REPS(9);
        LAS int* rt0 = (LAS int*)(F.lds + EXTRA_OFF);
        const int R = moe_setup(F, rt0);
        MoeOrder2 S; S.rt0 = rt0; S.tokl = nullptr; S.nwg = R * 4; S.G = F.G; S.c = (int)blockIdx.x; S.reps = nrep;
        EpiYP E{F.b_d, F.ctl + CW_CNT, WSP(const int, WS_LIST), WSP(const float, WS_GATE), WSP(unsigned char, WS_YP)};
        pg8::gemm_phase<EpiYP, MoeOrder2, true, true, 122>(F.lds, WSP(const void, WS_ACT), WSP(const void, WS_WD), D, S, E);
        SEAM(9);
    }
    if (IN(10)) { p8_final(F, REPS(10)); }
#undef IN
#undef SEAM
}

extern "C" void kernel_launch(void* const* d_in, const int* in_sizes, int n_in, void* d_out, int out_size, void* d_ws, size_t ws_size, hipStream_t stream) {
    static int grid = 0;
    if (grid == 0) {
        if (n_in != 18 || out_size != M * D || ws_size < WS_END) { fprintf(stderr, "kernel_launch: unexpected shapes (n_in %d, out %d, ws %zu < %zu)\n", n_in, out_size, ws_size, (size_t)WS_END); grid = -1; return; }
        int dev = 0, cus = 0, per_cu = 0;
        if (hipGetDevice(&dev) != hipSuccess || hipDeviceGetAttribute(&cus, hipDeviceAttributeMultiprocessorCount, dev) != hipSuccess) { grid = -1; return; }
        if (hipFuncSetAttribute((const void*)mk_fwd, hipFuncAttributeMaxDynamicSharedMemorySize, LDS_BYTES) != hipSuccess) { fprintf(stderr, "kernel_launch: hipFuncSetAttribute(%d B LDS) failed\n", LDS_BYTES); grid = -1; return; }
        if (hipOccupancyMaxActiveBlocksPerMultiprocessor(&per_cu, (const void*)mk_fwd, NWAVES * 64, LDS_BYTES) != hipSuccess || per_cu < 1) fprintf(stderr, "kernel_launch: occupancy query says %d\n", per_cu);
        (void)hipGetLastError();
        grid = cus;
        if (grid != 256) fprintf(stderr, "kernel_launch: %d CUs (built for 256)\n", grid);
    }
    if (grid < 0) return;
    (void)hipMemsetAsync((char*)d_ws + WS_CTL, 0, CTL_ZERO_BYTES, stream);
    Args a{};
    for (int i = 0; i < 18; ++i) a.in[i] = (const float*)d_in[i];
    a.out = (float*)d_out; a.ws = (unsigned char*)d_ws;
#ifdef MK_REPEAT
    a.rep_k = MK_REPEAT; a.rep_n = MK_REPEAT_N;
#else
    a.rep_k = -1; a.rep_n = 0;
#endif
    for (int li = 0; li < N_LAUNCHES; ++li) {
        a.ph_lo = (N_LAUNCHES == 1) ? 0 : li; a.ph_hi = (N_LAUNCHES == 1) ? NPH : li + 1;
        hipLaunchKernelGGL(mk_fwd, dim3(grid), dim3(NWAVES * 64), LDS_BYTES, stream, a);
    }
}
```

```cpp
#include <hip/hip_runtime.h>
#include <cstdio>
#include <cstdint>

#ifndef MK_N_LAUNCHES
#define MK_N_LAUNCHES 1
#endif

#define LAS __attribute__((address_space(3)))
#define GAS __attribute__((address_space(1)))
typedef unsigned short bf16;
typedef short bf16x8 __attribute__((ext_vector_type(8)));
typedef float f32x4 __attribute__((ext_vector_type(4)));
typedef float f32x2 __attribute__((ext_vector_type(2)));
typedef float f32x16 __attribute__((ext_vector_type(16)));
typedef unsigned u32x4 __attribute__((ext_vector_type(4)));
typedef unsigned u32x2 __attribute__((ext_vector_type(2)));
typedef __bf16 bf16x2_t __attribute__((ext_vector_type(2)));
typedef int v8i32 __attribute__((ext_vector_type(8)));

constexpr int NWAVES = 8;
constexpr int M = 16384, D = 1024, SEQ = 2048;
constexpr int NZS = 8208;
constexpr int NZ = 8192;
constexpr int NE = 32, CAP = 16384;
constexpr int NPH = 11;
constexpr int N_LAUNCHES = MK_N_LAUNCHES;
constexpr size_t ZQ = 0, ZK = ZQ + (size_t)4 * M * 128, ZV = ZK + (size_t)4 * M * 128, ZR = ZV + (size_t)4 * M * 256, ZCB = ZR + (size_t)4 * M * 256, ZCC = ZCB + (size_t)M * 1024, ZCX = ZCC + (size_t)M * 1024, ZGA = ZCX + (size_t)M * 1024, ZGB = ZGA + (size_t)M * 1024;

constexpr size_t MiB = 1u << 20;
constexpr size_t WS_CTL = 0, CTL_ZERO_BYTES = 65536;
constexpr size_t WS_LIST = 1 * MiB;
constexpr size_t WS_GATE = 3 * MiB;
constexpr size_t WS_DECS = 4 * MiB;
constexpr size_t WS_WIN = 16 * MiB;
constexpr size_t WS_WA = 32 * MiB, WS_WB = 34 * MiB, WS_WO = 36 * MiB;
constexpr size_t WS_WGU = 40 * MiB;
constexpr size_t WS_WD = 168 * MiB;
constexpr size_t WS_XN = 232 * MiB;
constexpr size_t WS_LA = 264 * MiB;
constexpr size_t WS_Z = 296 * MiB;
constexpr size_t WS_YP = WS_Z;
constexpr size_t WS_U = 552 * MiB;
constexpr size_t WS_SIN = 584 * MiB;
constexpr size_t WS_OG = 616 * MiB;
constexpr size_t WS_PB = 648 * MiB;
constexpr size_t WS_M1 = 680 * MiB;
constexpr size_t WS_MIX = 744 * MiB;
constexpr size_t WS_X1 = 776 * MiB;
constexpr size_t WS_ACT = 840 * MiB;
constexpr size_t WS_END = 984 * MiB;
constexpr int CW_TMO = 0;
constexpr int CW_BAR = 4096;
constexpr int CW_CNT = 8192;
constexpr int CW_STAMP = 12288;

constexpr int RING_BYTES = 131072;
constexpr int EXTRA_OFF = RING_BYTES;
constexpr int LDS_BYTES = 155648 + 512;
constexpr int MISC_OFF = 155648;

#define RLX_AGENT __ATOMIC_RELAXED, __HIP_MEMORY_SCOPE_AGENT
#define LDS_WAIT() asm volatile("s_waitcnt lgkmcnt(0)" ::: "memory")
#define VM_WAIT() asm volatile("s_waitcnt vmcnt(0)" ::: "memory")
__device__ __forceinline__ unsigned pk2(float lo, float hi) { f32x2 v = {lo, hi}; bf16x2_t b = __builtin_convertvector(v, bf16x2_t); return __builtin_bit_cast(unsigned, b); }
__device__ __forceinline__ unsigned pk4_fp8(float a, float b, float c, float d) { int w = 0; w = __builtin_amdgcn_cvt_pk_fp8_f32(a, b, w, false); w = __builtin_amdgcn_cvt_pk_fp8_f32(c, d, w, true); return (unsigned)w; }
__device__ __forceinline__ float bf_lo(unsigned w) { return __builtin_bit_cast(float, w << 16); }
__device__ __forceinline__ float bf_hi(unsigned w) { return __builtin_bit_cast(float, w & 0xffff0000u); }
__device__ __forceinline__ float bf1(bf16 b) { return __builtin_bit_cast(float, ((unsigned)b) << 16); }
__device__ __forceinline__ float fast_sigmoid(float x) { return __builtin_amdgcn_rcpf(1.0f + __expf(-x)); }
__device__ __forceinline__ float wave_sum(float v) {
#pragma unroll
    for (int o = 1; o < 64; o <<= 1) v += __shfl_xor(v, o);
    return v;
}

namespace pg8 {
constexpr int BM = 256, BK = 64, HALF = 128, HTB = HALF * BK * 2, STAGE_BYTES = 8 * HTB, NXCD = 8, WGM = 8;
__device__ __forceinline__ int lds_byte(int r, int c) { const int st = (r >> 4) * 2 + (c >> 5), rr = r & 15, cc = c & 31, ob = rr * 64 + cc * 2; return st * 1024 + (ob ^ (((ob >> 9) & 1) << 5)); }
__device__ __forceinline__ void stage_rc(int b, int& R, int& C) { const int st = b / 1024, sb = b % 1024, swz = sb ^ (((sb >> 9) & 1) << 5); R = (st >> 1) * 16 + swz / 64; C = (st & 1) * 32 + (swz % 64) / 2; }
__device__ __forceinline__ int perm32(int rho) { const int n = rho >> 4, i = rho & 15; return 8 * (i >> 2) + 4 * n + (i & 3); }

struct Unit { int pm, pn, e, rt; };

struct StaticOrder {
    int nM, nN, nwg, G, c, K, reps;
    __device__ __forceinline__ void init(int M_, int N_, int K_, int G_, int c_, int reps_) { nM = M_ / BM; nN = N_ / BM; nwg = nM * nN; G = G_; c = c_; K = K_; reps = reps_; }
    __device__ __forceinline__ bool next(int i, Unit& u) const {
        const long L = (long)i * G + c; if (L >= (long)nwg * reps) return false;
        int wgid = (int)(L % nwg); { const int q = nwg / NXCD, r = nwg % NXCD, xcd = wgid % NXCD, off = wgid / NXCD; wgid = (xcd < r ? xcd * (q + 1) : r * (q + 1) + (xcd - r) * q) + off; }
        const int nig = WGM * nN, gid = wgid / nig, fm = gid * WGM, gsz = (nM - fm) < WGM ? (nM - fm) : WGM;
        u.pm = fm + ((wgid % nig) % gsz); u.pn = (wgid % nig) / gsz; u.e = 0; u.rt = 0; return true;
    }
    __device__ __forceinline__ unsigned arow(const Unit& u, int ui, int r) const { return (unsigned)(u.pm * BM + r) * (unsigned)(K * 2); }
    __device__ __forceinline__ void after_unit(int ui) const {}
};

template <class Epi, class Sched, bool ALIGN_EPI, bool FP8 = false, int SCW = 127>
__device__ __forceinline__ void gemm_phase(LAS unsigned char* lds, const void* Ag, const void* Btg, const int K, const Sched& S, const Epi& E) {
    const int tid = threadIdx.x, wid = __builtin_amdgcn_readfirstlane(tid >> 6), lane = tid & 63, wr = wid >> 2, wc = wid & 3, fr = lane & 15, fq = lane >> 4;
    const int RB = FP8 ? K : 2 * K;
    const int nt = RB / 128;
    int RA[2], CA[2]; unsigned voffB[2];
#pragma unroll
    for (int i = 0; i < 2; ++i) { int R, C; stage_rc(tid * 16 + i * 8192, R, C); const int Rb = Epi::PERM ? ((R & ~31) + perm32(R & 31)) : R;
        RA[i] = R; CA[i] = C * 2; voffB[i] = (unsigned)(Rb * RB + C * 2); }
    const size_t kstep = (size_t)(BK * 2);
    const size_t hstep = (size_t)HALF * RB;
    const size_t tstep = 2 * hstep;
    const unsigned ldsw = (unsigned)wid * 1024u;
    const int aoff = lds_byte(wr * 64 + fr, fq * 8), boff = lds_byte(wc * 32 + fr, fq * 8);
#define PG8_SA(b, h) (((b) * 2 + (h)) * HTB)
#define PG8_SB(b, h) ((4 + (b) * 2 + (h)) * HTB)
#define PG8_STAGEB(bufoff, gbase) do { _Pragma("unroll") for (int _i = 0; _i < 2; ++_i) \
        __builtin_amdgcn_global_load_lds((const unsigned*)((const char*)(gbase) + voffB[_i]), (LAS unsigned*)(lds + (bufoff) + ldsw + _i * 8192), 16, 0, 0); } while (0)
#define PG8_STAGEA(bufoff, o0, o1) do { \
        __builtin_amdgcn_global_load_lds((const unsigned*)((const char*)Ag + (o0)), (LAS unsigned*)(lds + (bufoff) + ldsw), 16, 0, 0); \
        __builtin_amdgcn_global_load_lds((const unsigned*)((const char*)Ag + (o1)), (LAS unsigned*)(lds + (bufoff) + ldsw + 8192), 16, 0, 0); } while (0)
#define PG8_LDA(dst, b, h) do { if constexpr (FP8) { _Pragma("unroll") for (int m = 0; m < 4; ++m) { dst[m][0] = *(const LAS bf16x8*)(lds + PG8_SA(b, h) + aoff + m * 2048); dst[m][1] = *(const LAS bf16x8*)(lds + PG8_SA(b, h) + aoff + m * 2048 + 1024); } } \
        else { _Pragma("unroll") for (int m = 0; m < 4; ++m) _Pragma("unroll") for (int k = 0; k < 2; ++k) dst[m][k] = *(const LAS bf16x8*)(lds + PG8_SA(b, h) + aoff + m * 2048 + k * 1024); } } while (0)
#define PG8_LDB(dst, b, h) do { if constexpr (FP8) { _Pragma("unroll") for (int n = 0; n < 2; ++n) { dst[n][0] = *(const LAS bf16x8*)(lds + PG8_SB(b, h) + boff + n * 2048); dst[n][1] = *(const LAS bf16x8*)(lds + PG8_SB(b, h) + boff + n * 2048 + 1024); } } \
        else { _Pragma("unroll") for (int n = 0; n < 2; ++n) _Pragma("unroll") for (int k = 0; k < 2; ++k) dst[n][k] = *(const LAS bf16x8*)(lds + PG8_SB(b, h) + boff + n * 2048 + k * 1024); } } while (0)
#define PG8_F8(x) __builtin_bit_cast(v8i32, __builtin_shufflevector(__builtin_bit_cast(u32x4, (x)[0]), __builtin_bit_cast(u32x4, (x)[1]), 0, 1, 2, 3, 4, 5, 6, 7))
#define PG8_MMA(ai, bj, At, Bt) do { __builtin_amdgcn_s_setprio(1); if constexpr (FP8) { _Pragma("unroll") for (int m = 0; m < 4; ++m) _Pragma("unroll") for (int n = 0; n < 2; ++n) \
        asm volatile("v_mfma_scale_f32_16x16x128_f8f6f4 %0, %1, %2, %0, %3, %4 op_sel_hi:[0,0,0]" : "+v"(acc[ai][bj][m][n]) : "v"(PG8_F8(Bt[n])), "v"(PG8_F8(At[m])), "v"(scw_reg), "v"(sca_reg)); } \
        else { _Pragma("unroll") for (int m = 0; m < 4; ++m) _Pragma("unroll") for (int n = 0; n < 2; ++n) _Pragma("unroll") for (int k = 0; k < 2; ++k) \
        acc[ai][bj][m][n] = __builtin_amdgcn_mfma_f32_16x16x32_bf16(Bt[n][k], At[m][k], acc[ai][bj][m][n], 0, 0, 0); } __builtin_amdgcn_s_setprio(0); } while (0)
#define PG8_WAIT_V(n) asm volatile("s_waitcnt vmcnt(" #n ")" ::: "memory")
#define PG8_WAIT_L(n) asm volatile("s_waitcnt lgkmcnt(" #n ")" ::: "memory")
#define PG8_BAR __builtin_amdgcn_s_barrier()
#define PG8_SCHED __builtin_amdgcn_sched_barrier(0)
    Unit cur, nxt; int ui = 0;
    if (!S.next(0, cur)) return;
    int scw_reg = SCW, sca_reg = 127;
    asm volatile("" : "+v"(scw_reg), "+v"(sca_reg));
    f32x4 acc[2][2][4][2];
#pragma unroll
    for (int a = 0; a < 2; ++a)
#pragma unroll
        for (int b = 0; b < 2; ++b)
#pragma unroll
            for (int m = 0; m < 4; ++m)
#pragma unroll
                for (int n = 0; n < 2; ++n) acc[a][b][m][n] = (f32x4){0.f, 0.f, 0.f, 0.f};
#define PG8_ZPAD() do { if constexpr (FP8) { _Pragma("unroll") for (int a = 0; a < 2; ++a) _Pragma("unroll") for (int b = 0; b < 2; ++b) _Pragma("unroll") for (int m = 0; m < 4; ++m) asm volatile("s_nop 1" : "+v"(acc[a][b][m][0]), "+v"(acc[a][b][m][1])); } } while (0)
    PG8_ZPAD();
    bf16x8 At[4][2], B0[2][2], B1[2][2];
    unsigned ac00, ac01, ac10, ac11;
    ac00 = S.arow(cur, 0, RA[0]) + CA[0]; ac01 = S.arow(cur, 0, RA[1]) + CA[1]; ac10 = S.arow(cur, 0, HALF + RA[0]) + CA[0]; ac11 = S.arow(cur, 0, HALF + RA[1]) + CA[1];
    const char* cB = (const char*)Btg + (size_t)cur.pn * tstep;
    PG8_STAGEB(PG8_SB(0, 0), cB); PG8_STAGEB(PG8_SB(0, 1), cB + hstep); PG8_STAGEA(PG8_SA(0, 0), ac00, ac01); PG8_STAGEA(PG8_SA(0, 1), ac10, ac11);
    if (wr == 1) PG8_BAR;
    PG8_WAIT_V(2); PG8_BAR;
    PG8_STAGEB(PG8_SB(1, 0), cB + kstep); PG8_STAGEA(PG8_SA(1, 0), ac00 + 128u, ac01 + 128u); PG8_STAGEB(PG8_SB(1, 1), cB + hstep + kstep);
    PG8_WAIT_V(6); PG8_BAR;
    for (;;) {
        const bool has_next = S.next(ui + 1, nxt);
        const char* nB = has_next ? (const char*)Btg + (size_t)nxt.pn * tstep : cB;
#pragma unroll 1
        for (int t = 0; t < nt; t += 2) {
            const bool last = (t == nt - 2);
            const unsigned k1 = (unsigned)(t + 1) * 128u, k2 = (unsigned)(t + 2) * 128u;
            unsigned a200 = ac00 + k2, a201 = ac01 + k2, a210 = ac10 + k2, a211 = ac11 + k2;
            if (last) { if (has_next) { a200 = S.arow(nxt, ui + 1, RA[0]) + CA[0]; a201 = S.arow(nxt, ui + 1, RA[1]) + CA[1]; a210 = S.arow(nxt, ui + 1, HALF + RA[0]) + CA[0]; a211 = S.arow(nxt, ui + 1, HALF + RA[1]) + CA[1]; }
                        else { a200 = ac00; a201 = ac01; a210 = ac10; a211 = ac11; } }
            const char* b2 = last ? nB : cB + (size_t)k2; const char* b3 = b2 + kstep;
            PG8_LDB(B0, 0, 0); PG8_LDB(B1, 0, 1); PG8_SCHED; PG8_LDA(At, 0, 0); PG8_STAGEA(PG8_SA(1, 1), ac10 + k1, ac11 + k1);
            PG8_WAIT_V(8); PG8_WAIT_L(0); PG8_BAR; PG8_MMA(0, 0, At, B0); PG8_MMA(0, 1, At, B1); PG8_BAR; PG8_SCHED;
            PG8_LDA(At, 0, 1); PG8_STAGEB(PG8_SB(0, 0), b2); PG8_STAGEB(PG8_SB(0, 1), b2 + hstep); PG8_STAGEA(PG8_SA(0, 0), a200, a201);
            PG8_WAIT_V(8); PG8_WAIT_L(0); PG8_BAR; PG8_MMA(1, 0, At, B0); PG8_MMA(1, 1, At, B1); PG8_BAR; PG8_SCHED;
            PG8_LDB(B0, 1, 0); PG8_LDB(B1, 1, 1); PG8_SCHED; PG8_LDA(At, 1, 0); PG8_STAGEA(PG8_SA(0, 1), a210, a211);
            PG8_WAIT_V(8); PG8_WAIT_L(0); PG8_BAR; PG8_MMA(0, 0, At, B0); PG8_MMA(0, 1, At, B1); PG8_BAR; PG8_SCHED;
            PG8_LDA(At, 1, 1); PG8_STAGEB(PG8_SB(1, 0), b3); PG8_STAGEB(PG8_SB(1, 1), b3 + hstep); PG8_STAGEA(PG8_SA(1, 0), a200 + 128u, a201 + 128u);
            PG8_WAIT_V(8); PG8_WAIT_L(0); PG8_BAR; PG8_MMA(1, 0, At, B0); PG8_MMA(1, 1, At, B1); PG8_BAR; PG8_SCHED;
        }
        if constexpr (FP8) asm volatile("s_nop 15\n\ts_nop 15" ::: "memory");
#pragma unroll
        for (int a = 0; a < 2; ++a)
#pragma unroll
            for (int b = 0; b < 2; ++b)
#pragma unroll
                for (int m = 0; m < 4; ++m) asm volatile("" : "+v"(acc[a][b][m][0]), "+v"(acc[a][b][m][1]));
        if constexpr (ALIGN_EPI) { if (wr == 0) PG8_BAR; }
        E(acc, cur, wr, wc, fr, fq);
        S.after_unit(ui);
        if (!has_next) break;
#pragma unroll
        for (int a = 0; a < 2; ++a)
#pragma unroll
            for (int b = 0; b < 2; ++b)
#pragma unroll
                for (int m = 0; m < 4; ++m)
#pragma unroll
                    for (int n = 0; n < 2; ++n) acc[a][b][m][n] = (f32x4){0.f, 0.f, 0.f, 0.f};
        PG8_ZPAD();
        cur = nxt; cB = nB; ++ui;
        ac00 = S.arow(cur, ui, RA[0]) + CA[0]; ac01 = S.arow(cur, ui, RA[1]) + CA[1]; ac10 = S.arow(cur, ui, HALF + RA[0]) + CA[0]; ac11 = S.arow(cur, ui, HALF + RA[1]) + CA[1];
        if constexpr (ALIGN_EPI) { if (wr == 1) PG8_BAR; }
    }
    PG8_WAIT_V(0);
    if constexpr (!ALIGN_EPI) { if (wr == 0) PG8_BAR; }
    PG8_BAR;
#undef PG8_SA
#undef PG8_SB
#undef PG8_STAGEA
#undef PG8_STAGEB
#undef PG8_LDA
#undef PG8_LDB
#undef PG8_MMA
#undef PG8_F8
#undef PG8_ZPAD
#undef PG8_WAIT_V
#undef PG8_WAIT_L
#undef PG8_BAR
#undef PG8_SCHED
}
}

#define XB_TMO      128
#define XB_XCNT(j)  (256  + 64 * (j))
#define XB_XSUB(j)  (1280 + 64 * (j))
#define XB_XGEN(j)  (2304 + 64 * (j))
#define XB_TOP      3328
#define XB_TOPGEN   3392
#define XCD_BAR_WORDS 3456
#define XB_SPIN_CAP (1u << 18)
__device__ __forceinline__ unsigned xb_ld(unsigned* p)              { return __hip_atomic_load(p, __ATOMIC_RELAXED, __HIP_MEMORY_SCOPE_AGENT); }
__device__ __forceinline__ unsigned xb_add(unsigned* p, unsigned v) { return __hip_atomic_fetch_add(p, v, __ATOMIC_RELAXED, __HIP_MEMORY_SCOPE_AGENT); }
__device__ __forceinline__ unsigned xb_xcc_id() { return (unsigned)__builtin_amdgcn_s_getreg((3 << 11) | 20) & 0xFu; }
#define XB_SPIN(cond, bar) do { unsigned _sp = 0; while (cond) { __builtin_amdgcn_s_sleep(1); \
    if ((++_sp & 255u) == 0u) { if (xb_ld(&(bar)[XB_TMO])) break; if (_sp > XB_SPIN_CAP) { atomicAdd(&(bar)[XB_TMO], 1u); break; } } } } while (0)
struct XcdBarrier { unsigned* bar; unsigned x; volatile LAS unsigned* st; };
__device__ __forceinline__ XcdBarrier xcd_barrier_post(unsigned* bar, volatile LAS unsigned* st) {
    XcdBarrier b; b.bar = bar; b.x = xb_xcc_id(); b.st = st;
    if (threadIdx.x == 0) (void)xb_add(&bar[XB_XCNT(b.x)], 1u);
    return b;
}
__device__ __forceinline__ void xcd_barrier_complete(unsigned* bar, unsigned x, unsigned& nloc, unsigned& nx) {
    const unsigned G = gridDim.x * gridDim.y * gridDim.z;
    unsigned sum, cnt, mine, sp = 0u;
    for (;;) {
        sum = 0u; cnt = 0u; mine = 0u;
#pragma unroll
        for (unsigned j = 0; j < 16; ++j) { const unsigned c = xb_ld(&bar[XB_XCNT(j)]); sum += c; cnt += (c > 0u) ? 1u : 0u; mine = (j == x) ? c : mine; }
        if (sum == G) break;
        __builtin_amdgcn_s_sleep(1);
        if ((++sp & 255u) == 0u) { if (xb_ld(&bar[XB_TMO])) break; if (sp > XB_SPIN_CAP) { atomicAdd(&bar[XB_TMO], 1u); break; } }
    }
    nloc = mine > 0u ? mine : 1u; nx = cnt > 0u ? cnt : 1u;
}
__device__ __forceinline__ void xcd_barrier(const XcdBarrier& b) {
    asm volatile("s_waitcnt vmcnt(0)" ::: "memory");
    __syncthreads();
    if (threadIdx.x == 0) {
        unsigned* bar = b.bar;
        __builtin_amdgcn_s_waitcnt(0);
        unsigned nloc = b.st[0], nx = b.st[1];
        if (nloc == 0u) { xcd_barrier_complete(bar, b.x, nloc, nx); b.st[0] = nloc; b.st[1] = nx; }
        const unsigned old = xb_add(&bar[XB_XSUB(b.x)], 1u);
        const unsigned gen = old / nloc;
        if (old + 1u == (gen + 1u) * nloc) {
            __builtin_amdgcn_fence(__ATOMIC_RELEASE, "agent");
            asm volatile("s_waitcnt vmcnt(0)" ::: "memory");
            const unsigned og = xb_add(&bar[XB_TOP], 1u);
            const unsigned tg = og / nx;
            if (og + 1u == (tg + 1u) * nx) xb_add(&bar[XB_TOPGEN], 1u);
            else XB_SPIN(xb_ld(&bar[XB_TOPGEN]) == tg, bar);
            __builtin_amdgcn_fence(__ATOMIC_ACQUIRE, "agent");
            xb_add(&bar[XB_XGEN(b.x)], 1u);
            asm volatile("s_waitcnt vmcnt(0)" ::: "memory");
        } else {
            XB_SPIN(xb_ld(&bar[XB_XGEN(b.x)]) == gen, bar);
            __builtin_amdgcn_fence(__ATOMIC_ACQUIRE, "agent");
            asm volatile("s_waitcnt vmcnt(0)" ::: "memory");
        }
    }
    __syncthreads();
}

struct Frame {
    LAS unsigned char* lds;
    volatile LAS unsigned* MISC;
    unsigned* ctl;
    int tid, lane, wave, vcu, G;
    unsigned char* ws;
    const float *x, *g_mix, *w_in, *w_up, *b_alpha, *g_gla, *w_conv, *w_a, *w_b, *w_out, *g_ffn, *w_router, *b_router, *w_gu, *b_gu, *w_d, *b_d, *g_final;
    float* out;
};
#define WSP(T, off) ((T*)(F.ws + (off)))

__device__ __forceinline__ void tr_item64(const float* W, int ld, int k0, int n0, bf16* WT, size_t dst_row0, int K, LAS unsigned* T, int lane) {
    const int nq = lane & 15, kr = lane >> 4;
    const float* src = W + (size_t)(k0 + 2 * kr) * ld + n0 + 4 * nq;
    f32x4 a0[8], a1[8];
#pragma unroll
    for (int it = 0; it < 8; ++it) { a0[it] = *(const f32x4*)(src + (size_t)(8 * it) * ld); a1[it] = *(const f32x4*)(src + (size_t)(8 * it + 1) * ld); }
    const int c = lane & 7;
#pragma unroll
    for (int hf = 0; hf < 2; ++hf) {
        if ((nq >> 3) == hf) {
#pragma unroll
            for (int it = 0; it < 8; ++it)
#pragma unroll
                for (int q = 0; q < 4; ++q) T[(4 * (nq & 7) + q) * 33 + 4 * it + kr] = pk2(a0[it][q], a1[it][q]);
        }
        LDS_WAIT(); asm volatile("" ::: "memory");
#pragma unroll
        for (int j = 0; j < 4; ++j) { const int n = (lane >> 3) + 8 * j; const LAS unsigned* t = T + n * 33 + 4 * c;
            u32x4 o; o.x = t[0]; o.y = t[1]; o.z = t[2]; o.w = t[3];
            *(u32x4*)(WT + (dst_row0 + 32 * hf + n) * (size_t)K + k0 + 8 * c) = o; }
        LDS_WAIT(); asm volatile("" ::: "memory");
    }
}

__device__ __forceinline__ void tr_item8(const float* W, int ld, int k0, int n0, unsigned char* WT8, size_t dst_row0, int KB, float scale, LAS unsigned* T, int lane) {
    const int nq = lane & 7, kr = lane >> 3;
    const float* src = W + (size_t)(k0 + 4 * kr) * ld + n0 + 4 * nq;
    f32x4 a[4][4];
#pragma unroll
    for (int it = 0; it < 4; ++it)
#pragma unroll
        for (int j = 0; j < 4; ++j) a[it][j] = __builtin_nontemporal_load((const f32x4*)(src + (size_t)(32 * it + j) * ld));
    const int c = lane & 7;
#pragma unroll
    for (int hf = 0; hf < 2; ++hf) {
        if ((nq >> 2) == hf) {
#pragma unroll
            for (int it = 0; it < 4; ++it)
#pragma unroll
                for (int q = 0; q < 4; ++q) T[(4 * (nq & 3) + q) * 33 + 8 * it + kr] = pk4_fp8(a[it][0][q] * scale, a[it][1][q] * scale, a[it][2][q] * scale, a[it][3][q] * scale);
        }
        LDS_WAIT(); asm volatile("" ::: "memory");
#pragma unroll
        for (int j = 0; j < 2; ++j) { const int n = (lane >> 3) + 8 * j; const LAS unsigned* t = T + n * 33 + 4 * c;
            u32x4 o; o.x = t[0]; o.y = t[1]; o.z = t[2]; o.w = t[3];
            *(u32x4*)(WT8 + (dst_row0 + 16 * hf + n) * (size_t)KB + k0 + 16 * c) = o; }
        LDS_WAIT(); asm volatile("" ::: "memory");
    }
}
constexpr int MOE_NIT = NE * 64 * 8 + NE * 32 * 8;
#ifndef MK_MOE_SPLIT
#define MK_MOE_SPLIT 0
#endif
constexpr int MOE_SPLIT = MK_MOE_SPLIT;
__device__ __forceinline__ void moe_convert_range(const float* w_gu, const float* w_d, unsigned char* ws, LAS unsigned* T, int first, int step, int end, int lane) {
    constexpr int I_GU = NE * 64 * 8;
    for (int it = first; it < end; it += step) {
        int r = it;
        if (r < I_GU) { const int e = r >> 9, q = r & 511, kb = q >> 6, nb = q & 63, j0 = 32 * nb, pn = j0 >> 8, within = j0 & 255, half = within >> 7;
            tr_item8(w_gu + (size_t)e * 1024 * 2048, 2048, 128 * kb, half * 1024 + pn * 128 + (within & 127), ws + WS_WGU + (size_t)e * 2048 * 1024, j0, 1024, 32.0f, T, lane); continue; } r -= I_GU;
        { const int e = r >> 8, q = r & 255, kb = q >> 5, nb = q & 31;
            tr_item8(w_d + (size_t)e * 1024 * 1024, 1024, 128 * kb, 32 * nb, ws + WS_WD + (size_t)e * 1024 * 1024, 32 * nb, 1024, 32.0f, T, lane); }
    }
}
__device__ __forceinline__ void moe_convert_share(const float* w_gu, const float* w_d, unsigned char* ws, LAS unsigned char* lds, int c, int G, int wave, int lane) {
    moe_convert_range(w_gu, w_d, ws, (LAS unsigned*)(lds + EXTRA_OFF + wave * 2176), MOE_SPLIT + c * NWAVES + wave, G * NWAVES, MOE_NIT, lane);
}
struct P1Order : pg8::StaticOrder {
    const float* w_gu; const float* w_d; unsigned char* ws; LAS unsigned char* lds; int slot, wave, lane;
    __device__ __forceinline__ void after_unit(int ui) const { if (ui == slot) { int ln = lane; asm volatile("" : "+v"(ln));
            moe_convert_share(w_gu, w_d, ws, lds, c, G, wave, ln); } }
};

constexpr int P0_T_BYTES = 4352;
constexpr int P0_WLD = 2064;
constexpr int P0_WL = 8 * P0_T_BYTES;
constexpr int P0_WU = P0_WL + 16 * P0_WLD;
constexpr int P0_BA = P0_WU + 16384;
constexpr int P0_AS = P0_BA + 2048;

__device__ __forceinline__ void p0_items(Frame& F, const int nrep) {
    LAS unsigned* scr = (LAS unsigned*)(F.lds + F.wave * P0_T_BYTES);
    const int gw = F.vcu * NWAVES + F.wave, NGW = F.G * NWAVES;
    constexpr int I_IN = 128 * 16, I_SQ = 16 * 16;
    constexpr int NITEMS = I_IN + 3 * I_SQ;
    bf16* Win_t = WSP(bf16, WS_WIN);
    for (int it0 = gw; it0 < NITEMS * nrep; it0 += NGW) {
        int r = it0 % NITEMS;
        if (r < I_IN) { const int kb = r >> 7, nb = r & 127, j0 = 64 * nb;
            int srcc = j0 < 3072 ? j0 : j0 + 16;
            if (j0 >= 4096 && j0 < 6144) { const int pn = j0 >> 8, within = j0 & 255; srcc = ((within >> 7) ? 5136 : 4112) + (pn - 16) * 128 + (within & 127); }
            tr_item64(F.w_in, NZS, 64 * kb, srcc, Win_t, j0, 1024, scr, F.lane); continue; } r -= I_IN;
        if (r < I_SQ) { tr_item64(F.w_a, 1024, 64 * (r >> 4), 64 * (r & 15), WSP(bf16, WS_WA), 64 * (r & 15), 1024, scr, F.lane); continue; } r -= I_SQ;
        if (r < I_SQ) { tr_item64(F.w_b, 1024, 64 * (r >> 4), 64 * (r & 15), WSP(bf16, WS_WB), 64 * (r & 15), 1024, scr, F.lane); continue; } r -= I_SQ;
        tr_item64(F.w_out, 1024, 64 * (r >> 4), 64 * (r & 15), WSP(bf16, WS_WO), 64 * (r & 15), 1024, scr, F.lane);
    }
    moe_convert_range(F.w_gu, F.w_d, F.ws, scr, gw, NGW, MOE_SPLIT, F.lane);
}

__device__ __forceinline__ void p0_rows(Frame& F, const int nrep2) {
    const int gw = F.vcu * NWAVES + F.wave, NGW = F.G * NWAVES, lane = F.lane, r32 = lane & 31, h = lane >> 5;
    LAS unsigned char* L = F.lds;
    LAS float* BA = (LAS float*)(L + P0_BA);
    LAS float* AS = (LAS float*)(L + P0_AS + F.wave * 512);
    f32x4 g[4];
#pragma unroll
    for (int j = 0; j < 4; ++j) g[j] = *((const f32x4*)F.g_mix + lane + 64 * j);
    bf16* XN = WSP(bf16, WS_XN); bf16* LA = WSP(bf16, WS_LA);
#pragma unroll 1
    for (int b8 = 0; (b8 * 8) * NGW + gw < M * nrep2; ++b8) {
        f32x4 nx[4];
        { const f32x4* xr = (const f32x4*)(F.x + (size_t)(((b8 * 8) * NGW + gw) % M) * D) + lane;
#pragma unroll
          for (int j = 0; j < 4; ++j) nx[j] = xr[64 * j]; }
#pragma unroll 1
        for (int i = 0; i < 8; ++i) {
            const int m = ((b8 * 8 + i) * NGW + gw) % M;
            f32x4 v[4]; float s = 0.f;
#pragma unroll
            for (int j = 0; j < 4; ++j) { v[j] = nx[j]; s += (v[j].x * v[j].x + v[j].y * v[j].y) + (v[j].z * v[j].z + v[j].w * v[j].w); }
            if (i < 7) { const f32x4* xr = (const f32x4*)(F.x + (size_t)(((b8 * 8 + i + 1) * NGW + gw) % M) * D) + lane;
#pragma unroll
                for (int j = 0; j < 4; ++j) nx[j] = xr[64 * j]; }
            const float rstd = 1.0f / sqrtf(wave_sum(s) * (1.f / D) + 1e-6f);
            unsigned long long* o8 = (unsigned long long*)(XN + (size_t)m * D) + lane;
#pragma unroll
            for (int j = 0; j < 4; ++j) { v[j] = v[j] * rstd * g[j]; o8[64 * j] = (unsigned long long)pk2(v[j].x, v[j].y) | ((unsigned long long)pk2(v[j].z, v[j].w) << 32); }
        }
        asm volatile("s_waitcnt vmcnt(0)" ::: "memory");
        {
            const int tl = lane & 7, kg = lane >> 4, rr = lane & 15;
            const bf16* ap = XN + (size_t)(((b8 * 8 + tl) * NGW + gw) % M) * D + 8 * kg;
            const LAS unsigned char* bp = L + P0_WL + rr * P0_WLD + 16 * kg;
            f32x4 ac = {0.f, 0.f, 0.f, 0.f};
#pragma unroll
            for (int k8 = 0; k8 < 4; ++k8) {
                bf16x8 af[8];
#pragma unroll
                for (int q = 0; q < 8; ++q) af[q] = *(const bf16x8*)(ap + 32 * (8 * k8 + q));
#pragma unroll
                for (int q = 0; q < 8; ++q) ac = __builtin_amdgcn_mfma_f32_16x16x32_bf16(af[q], *(const LAS bf16x8*)(bp + 64 * (8 * k8 + q)), ac, 0, 0, 0);
            }
            if (lane < 32) {
#pragma unroll
                for (int q = 0; q < 4; ++q) AS[(4 * kg + q) * 16 + rr] = ac[q]; }
        }
        {
            f32x4 a0 = {0.f, 0.f, 0.f, 0.f}, a1 = a0;
            if (r32 < 8) { a0 = *(const LAS f32x4*)(AS + r32 * 16 + 8 * h); a1 = *(const LAS f32x4*)(AS + r32 * 16 + 8 * h + 4); }
            u32x4 hi, lo;
            hi.x = pk2(a0[0], a0[1]); hi.y = pk2(a0[2], a0[3]); hi.z = pk2(a1[0], a1[1]); hi.w = pk2(a1[2], a1[3]);
            lo.x = pk2(a0[0] - bf_lo(hi.x), a0[1] - bf_hi(hi.x)); lo.y = pk2(a0[2] - bf_lo(hi.y), a0[3] - bf_hi(hi.y)); lo.z = pk2(a1[0] - bf_lo(hi.z), a1[1] - bf_hi(hi.z)); lo.w = pk2(a1[2] - bf_lo(hi.w), a1[3] - bf_hi(hi.w));
            const bf16x8 ahi = __builtin_bit_cast(bf16x8, hi), alo = __builtin_bit_cast(bf16x8, lo);
            int mrow[4];
#pragma unroll
            for (int q = 0; q < 4; ++q) mrow[q] = ((b8 * 8 + q + 4 * h) * NGW + gw) % M;
#pragma unroll 4
            for (int nt = 0; nt < 16; ++nt) {
                const bf16x8 bw = *(const LAS bf16x8*)(L + P0_WU + (32 * nt + r32) * 32 + 16 * h);
                f32x16 c16;
#pragma unroll
                for (int q = 0; q < 16; ++q) c16[q] = 0.f;
                c16 = __builtin_amdgcn_mfma_f32_32x32x16_bf16(ahi, bw, c16, 0, 0, 0);
                c16 = __builtin_amdgcn_mfma_f32_32x32x16_bf16(alo, bw, c16, 0, 0, 0);
                const float bb = BA[32 * nt + r32];
#pragma unroll
                for (int q = 0; q < 4; ++q) { const float pre = c16[q] + bb;
                    const float ls = fminf(pre, 0.f) - __logf(1.0f + __expf(-fabsf(pre)));
                    LA[((size_t)(nt >> 2) * M + mrow[q]) * 128 + 32 * (nt & 3) + r32] = (bf16)(pk2(ls * (1.0f / 16.0f), 0.f) & 0xffffu); }
            }
        }
    }
}

__device__ __forceinline__ void p0_prologue(Frame& F, const int nrep, const int nrep2) {
    {
        LAS unsigned char* L = F.lds;
        for (int i = 0; i < 32; ++i) { const int idx = F.tid + 512 * i, k = idx >> 4, r = idx & 15; *(LAS bf16*)(L + P0_WL + r * P0_WLD + 2 * k) = (bf16)(pk2(F.w_in[(size_t)k * NZS + 3072 + r], 0.f) & 0xffffu); }
        for (int i = 0; i < 16; ++i) { const int idx = F.tid + 512 * i, r = idx >> 9, n = idx & 511; *(LAS bf16*)(L + P0_WU + n * 32 + 2 * r) = (bf16)(pk2(F.w_up[idx], 0.f) & 0xffffu); }
        ((LAS float*)(L + P0_BA))[F.tid] = F.b_alpha[F.tid];
        __syncthreads();
    }
#pragma unroll 1
    for (int pass = 0; pass < 2; ++pass) {
        if (((pass ^ F.wave) & 1) == 0) p0_items(F, nrep); else p0_rows(F, nrep2);
    }
}

struct EpiZ {
    static constexpr bool PERM = true;
    bf16* Z;
    __device__ __forceinline__ void operator()(const f32x4 (&acc)[2][2][4][2], const pg8::Unit& u, int wr, int wc, int fr, int fq) const {
        const int row0 = u.pm * 256 + wr * 64 + fr, c0 = wc * 32 + 8 * fq;
        const int pn = u.pn;
        const int kind = pn < 2 ? 1 : (pn < 8 ? 0 : (pn < 12 ? 2 : (pn < 24 ? 0 : 3)));
        bf16* base; int ld; size_t bjs;
        if (pn < 4) { base = Z + (pn < 2 ? ZQ : ZK) + (size_t)(2 * (pn & 1)) * M * 128; ld = 128; bjs = (size_t)M * 128; }
        else if (pn < 12) { base = Z + (pn < 8 ? ZV : ZR) + (size_t)(pn & 3) * M * 256; ld = 256; bjs = 128; }
        else { const int t = (pn - 12) >> 2; base = Z + ZCB + (size_t)t * M * 1024 + (size_t)((pn - 12) & 3) * 256; ld = 1024; bjs = 128; }
        if (pn >= 16 && pn < 24) {
            bf16* ub = Z + ZCC + (size_t)(pn - 16) * 128;
#pragma unroll
            for (int ai = 0; ai < 2; ++ai)
#pragma unroll
                for (int m = 0; m < 4; ++m) { const f32x4 v0 = acc[ai][0][m][0] * acc[ai][1][m][0], v1 = acc[ai][0][m][1] * acc[ai][1][m][1];
                    u32x4 w; w.x = pk2(v0[0], v0[1]); w.y = pk2(v0[2], v0[3]); w.z = pk2(v1[0], v1[1]); w.w = pk2(v1[2], v1[3]);
                    *(u32x4*)(ub + (size_t)(row0 + ai * 128 + m * 16) * 1024 + c0) = w; }
            return;
        }
#pragma unroll
        for (int ai = 0; ai < 2; ++ai)
#pragma unroll
            for (int m = 0; m < 4; ++m) { bf16* rowp = base + (size_t)(row0 + ai * 128 + m * 16) * ld + c0;
#pragma unroll
                for (int bj = 0; bj < 2; ++bj) { f32x4 v0 = acc[ai][bj][m][0], v1 = acc[ai][bj][m][1];
                    if (kind == 1) { v0 = v0 * 0.08838834764831845f; v1 = v1 * 0.08838834764831845f; }
                    else if (kind == 2) {
#pragma unroll
                        for (int j = 0; j < 4; ++j) { v0[j] = v0[j] * fast_sigmoid(v0[j]); v1[j] = v1[j] * fast_sigmoid(v1[j]); } }
                    else if (kind == 3) {
#pragma unroll
                        for (int j = 0; j < 4; ++j) { v0[j] = fast_sigmoid(v0[j]); v1[j] = fast_sigmoid(v1[j]); } }
                    u32x4 w; w.x = pk2(v0[0], v0[1]); w.y = pk2(v0[2], v0[3]); w.z = pk2(v1[0], v1[1]); w.w = pk2(v1[2], v1[3]);
                    *(u32x4*)(rowp + bj * bjs) = w; } }
    }
};

constexpr int QD_STRIDE = 272, KT_STRIDE = 144, SC_STRIDE = 144, OT_STRIDE = 1040;
constexpr int L_QD = 0, L_KI = 17408, L_KT = 34816, L_SC = 53248, L_DEC = 62464, L_SEG = 62976, L_OT = 67584;
__device__ __forceinline__ int crow(int reg, int h) { return (reg & 3) + 8 * (reg >> 2) + 4 * h; }

template <bool OUT>
__device__ __forceinline__ void gla_item(Frame& F, int item) {
    const int bh = item >> 3, sc = item & 7, b = bh >> 2, hd = bh & 3;
    const int t0 = b * SEQ + sc * 256;
    const int tid = F.tid, lane = F.lane, w = F.wave, r32 = lane & 31, h = lane >> 5;
    const bf16* Z = WSP(const bf16, WS_Z);
    const bf16* LA = WSP(const bf16, WS_LA);
    LAS unsigned char* L = F.lds;
    f32x16 S[4];
    unsigned* Sbuf = (OUT ? WSP(unsigned, WS_SIN) : WSP(unsigned, WS_U)) + (size_t)item * 16384 + (size_t)w * 2048;
    if (OUT) {
#pragma unroll
        for (int kb = 0; kb < 4; ++kb)
#pragma unroll
            for (int r = 0; r < 16; r += 2) { const unsigned pw = Sbuf[(kb * 8 + (r >> 1)) * 64 + lane]; S[kb][r] = bf_lo(pw); S[kb][r + 1] = bf_hi(pw); }
    } else {
#pragma unroll
        for (int kb = 0; kb < 4; ++kb)
#pragma unroll
            for (int r = 0; r < 16; ++r) S[kb][r] = 0.f;
    }
    float btot_run0 = 0.f, btot_run1 = 0.f;
    const int tok_n = tid >> 3, part = tid & 7;
    unsigned la2[8], kk[8], qq[8]; bf16x8 Bv[4]; u32x4 rc[4];
#define GLA_LOAD(tcx) do { \
        const size_t rb_ = ((size_t)hd * M + (tcx) + 8 * w) * 128 + 2 * lane; \
        _Pragma("unroll") for (int i = 0; i < 8; ++i) { la2[i] = *(const unsigned*)(LA + rb_ + (size_t)i * 128); kk[i] = *(const unsigned*)(Z + ZK + rb_ + (size_t)i * 128); if (OUT) qq[i] = *(const unsigned*)(Z + ZQ + rb_ + (size_t)i * 128); } \
    } while (0)
#define GLA_LOADV(tcx) do { \
        _Pragma("unroll") for (int ks = 0; ks < 4; ++ks) _Pragma("unroll") for (int j = 0; j < 8; ++j) Bv[ks][j] = (short)Z[ZV + ((size_t)hd * M + (tcx) + 16 * ks + 8 * h + j) * 256 + 32 * w + r32]; \
    } while (0)
#define GLA_LOADR(tcx) do { \
        if (OUT) { const u32x4* rp_ = (const u32x4*)(Z + ZR + ((size_t)hd * M + (tcx) + tok_n) * 256 + 32 * part); _Pragma("unroll") for (int i = 0; i < 4; ++i) rc[i] = rp_[i]; } \
    } while (0)
    GLA_LOAD(t0); GLA_LOADV(t0);
#pragma unroll 1
    for (int c = 0; c < 4; ++c) {
        const int tc = t0 + c * 64;
        float p0[8], p1[8];
        { float r0 = 0.f, r1 = 0.f;
#pragma unroll
          for (int i = 0; i < 8; ++i) { r0 += bf_lo(la2[i]); r1 += bf_hi(la2[i]); p0[i] = r0; p1[i] = r1; }
          *(LAS f32x2*)(L + L_SEG + (w * 128 + 2 * lane) * 4) = (f32x2){r0, r1}; }
        GLA_LOADR(tc);
        __syncthreads();
        float off0 = 0.f, off1 = 0.f, bt0 = 0.f, bt1 = 0.f;
#pragma unroll
        for (int sgi = 0; sgi < 8; ++sgi) { const f32x2 sv = *(const LAS f32x2*)(L + L_SEG + (sgi * 128 + 2 * lane) * 4); if (sgi < w) { off0 += sv.x; off1 += sv.y; } bt0 += sv.x; bt1 += sv.y; }
        if (w == 0) { *(LAS f32x2*)(L + L_DEC + 8 * lane) = (f32x2){__expf(bt0), __expf(bt1)}; btot_run0 += bt0; btot_run1 += bt1; }
        {
            unsigned kt0[4], kt1[4];
#pragma unroll
            for (int i = 0; i < 8; i += 2) {
                const float b00 = off0 + p0[i], b01 = off1 + p1[i], b10 = off0 + p0[i + 1], b11 = off1 + p1[i + 1];
                const float k00 = bf_lo(kk[i]), k01 = bf_hi(kk[i]), k10 = bf_lo(kk[i + 1]), k11 = bf_hi(kk[i + 1]);
                kt0[i >> 1] = pk2(k00 * __expf(bt0 - b00), k10 * __expf(bt0 - b10));
                kt1[i >> 1] = pk2(k01 * __expf(bt1 - b01), k11 * __expf(bt1 - b11));
                if (OUT) {
                    const float q00 = bf_lo(qq[i]), q01 = bf_hi(qq[i]), q10 = bf_lo(qq[i + 1]), q11 = bf_hi(qq[i + 1]);
                    *(LAS unsigned*)(L + L_QD + (8 * w + i) * QD_STRIDE + 4 * lane) = pk2(q00 * __expf(b00), q01 * __expf(b01));
                    *(LAS unsigned*)(L + L_QD + (8 * w + i + 1) * QD_STRIDE + 4 * lane) = pk2(q10 * __expf(b10), q11 * __expf(b11));
                    *(LAS unsigned*)(L + L_KI + (8 * w + i) * QD_STRIDE + 4 * lane) = pk2(k00 * __expf(-b00), k01 * __expf(-b01));
                    *(LAS unsigned*)(L + L_KI + (8 * w + i + 1) * QD_STRIDE + 4 * lane) = pk2(k10 * __expf(-b10), k11 * __expf(-b11));
                }
            }
            *(LAS u32x4*)(L + L_KT + (2 * lane) * KT_STRIDE + 16 * w) = (u32x4){kt0[0], kt0[1], kt0[2], kt0[3]};
            *(LAS u32x4*)(L + L_KT + (2 * lane + 1) * KT_STRIDE + 16 * w) = (u32x4){kt1[0], kt1[1], kt1[2], kt1[3]};
        }
        __syncthreads();
        if (c < 3) GLA_LOAD(tc + 64);
        f32x16 o[2];
        if (OUT) {
            if (w < 3) {
                const int ib = w == 0 ? 0 : 1, jb = w == 2 ? 1 : 0;
                f32x16 sacc;
#pragma unroll
                for (int r = 0; r < 16; ++r) sacc[r] = 0.f;
#pragma unroll
                for (int kb = 0; kb < 8; ++kb) {
                    const bf16x8 a = *(const LAS bf16x8*)(L + L_QD + (32 * ib + r32) * QD_STRIDE + 2 * (16 * kb + 8 * h));
                    const bf16x8 bb = *(const LAS bf16x8*)(L + L_KI + (32 * jb + r32) * QD_STRIDE + 2 * (16 * kb + 8 * h));
                    sacc = __builtin_amdgcn_mfma_f32_32x32x16_bf16(a, bb, sacc, 0, 0, 0);
                }
#pragma unroll
                for (int r = 0; r < 16; r += 1) {
                    const int i = 32 * ib + crow(r, h), j = 32 * jb + r32;
                    const float v = (j <= i) ? sacc[r] : 0.f;
                    *(LAS bf16*)(L + L_SC + i * SC_STRIDE + 2 * j) = (bf16)(pk2(v, 0.f) & 0xffffu);
                }
            }
#pragma unroll
            for (int ib = 0; ib < 2; ++ib)
#pragma unroll
                for (int r = 0; r < 16; ++r) o[ib][r] = 0.f;
#pragma unroll
            for (int kb = 0; kb < 4; ++kb)
#pragma unroll
                for (int s2 = 0; s2 < 2; ++s2) {
                    u32x4 pb; pb.x = pk2(S[kb][8 * s2 + 0], S[kb][8 * s2 + 1]); pb.y = pk2(S[kb][8 * s2 + 2], S[kb][8 * s2 + 3]); pb.z = pk2(S[kb][8 * s2 + 4], S[kb][8 * s2 + 5]); pb.w = pk2(S[kb][8 * s2 + 6], S[kb][8 * s2 + 7]);
                    const bf16x8 bfrag = __builtin_bit_cast(bf16x8, pb);
#pragma unroll
                    for (int ib = 0; ib < 2; ++ib) {
                        const LAS unsigned char* qp = L + L_QD + (32 * ib + r32) * QD_STRIDE + 2 * (32 * kb + 16 * s2 + 4 * h);
                        const u32x2 lo = *(const LAS u32x2*)qp, hi = *(const LAS u32x2*)(qp + 16);
                        const bf16x8 afrag = __builtin_bit_cast(bf16x8, (u32x4){lo.x, lo.y, hi.x, hi.y});
                        o[ib] = __builtin_amdgcn_mfma_f32_32x32x16_bf16(afrag, bfrag, o[ib], 0, 0, 0);
                    }
                }
            __syncthreads();
#pragma unroll
            for (int ks = 0; ks < 4; ++ks)
#pragma unroll
                for (int ib = 0; ib < 2; ++ib) {
                    if (ib == 0 && ks >= 2) continue;
                    const bf16x8 a = *(const LAS bf16x8*)(L + L_SC + (32 * ib + r32) * SC_STRIDE + 2 * (16 * ks + 8 * h));
                    o[ib] = __builtin_amdgcn_mfma_f32_32x32x16_bf16(a, Bv[ks], o[ib], 0, 0, 0);
                }
        }
#pragma unroll
        for (int kb = 0; kb < 4; ++kb) {
#pragma unroll
            for (int g4 = 0; g4 < 4; ++g4) { const f32x4 dc = *(const LAS f32x4*)(L + L_DEC + 4 * (32 * kb + 8 * g4 + 4 * h));
#pragma unroll
                for (int j = 0; j < 4; ++j) S[kb][4 * g4 + j] *= dc[j]; }
#pragma unroll
            for (int ks = 0; ks < 4; ++ks) {
                const bf16x8 a = *(const LAS bf16x8*)(L + L_KT + (32 * kb + r32) * KT_STRIDE + 2 * (16 * ks + 8 * h));
                S[kb] = __builtin_amdgcn_mfma_f32_32x32x16_bf16(a, Bv[ks], S[kb], 0, 0, 0);
            }
        }
        if (c < 3) GLA_LOADV(tc + 64);
        if (OUT) {
#pragma unroll
            for (int ib = 0; ib < 2; ++ib)
#pragma unroll
                for (int r = 0; r < 16; ++r) *(LAS float*)(L + L_OT + (32 * ib + crow(r, h)) * OT_STRIDE + 4 * (32 * w + r32)) = o[ib][r];
            __syncthreads();
            f32x4 ov[8]; float ss = 0.f;
#pragma unroll
            for (int i = 0; i < 8; ++i) { ov[i] = *(const LAS f32x4*)(L + L_OT + tok_n * OT_STRIDE + 4 * (32 * part + 4 * i)); ss += (ov[i].x * ov[i].x + ov[i].y * ov[i].y) + (ov[i].z * ov[i].z + ov[i].w * ov[i].w); }
            ss += __shfl_xor(ss, 1); ss += __shfl_xor(ss, 2); ss += __shfl_xor(ss, 4);
            const float rs = 1.0f / sqrtf(ss * (1.0f / 256.0f) + 1e-6f);
            const size_t trow = (size_t)(tc + tok_n);
            const f32x4* gp = (const f32x4*)(F.g_gla + hd * 256 + 32 * part);
            u32x4* op = (u32x4*)(WSP(bf16, WS_OG) + trow * 1024 + hd * 256 + 32 * part);
#pragma unroll
            for (int i = 0; i < 4; ++i) {
                const u32x4 rr = rc[i]; const f32x4 g0 = gp[2 * i], g1 = gp[2 * i + 1]; const f32x4 a0 = ov[2 * i], a1 = ov[2 * i + 1];
                u32x4 ow;
                ow.x = pk2(a0.x * rs * g0.x * bf_lo(rr.x), a0.y * rs * g0.y * bf_hi(rr.x));
                ow.y = pk2(a0.z * rs * g0.z * bf_lo(rr.y), a0.w * rs * g0.w * bf_hi(rr.y));
                ow.z = pk2(a1.x * rs * g1.x * bf_lo(rr.z), a1.y * rs * g1.y * bf_hi(rr.z));
                ow.w = pk2(a1.z * rs * g1.z * bf_lo(rr.w), a1.w * rs * g1.w * bf_hi(rr.w));
                op[i] = ow;
            }
        }
    }
#undef GLA_LOAD
#undef GLA_LOADV
#undef GLA_LOADR
    if (!OUT) {
#pragma unroll
        for (int kb = 0; kb < 4; ++kb)
#pragma unroll
            for (int r = 0; r < 16; r += 2) Sbuf[(kb * 8 + (r >> 1)) * 64 + lane] = pk2(S[kb][r], S[kb][r + 1]);
        if (w == 0) *(f32x2*)(WSP(float, WS_DECS) + item * 128 + 2 * lane) = (f32x2){__expf(btot_run0), __expf(btot_run1)};
    }
    __syncthreads();
}

__device__ __forceinline__ void conv_rows(Frame& F, const int nrep) {
    const int gw = F.vcu * NWAVES + F.wave, NGW = F.G * NWAVES;
    const bf16* Z = WSP(const bf16, WS_Z); bf16* PB = WSP(bf16, WS_PB);
    for (int blk0 = gw; blk0 < (M / 8) * nrep; blk0 += NGW) {
        const int blk = blk0 % (M / 8);
        const int m0 = blk * 8, s0 = m0 % SEQ;
#pragma unroll 1
        for (int j = 0; j < 2; ++j) {
            const int c = 8 * F.lane + 512 * j;
            const size_t rp = (size_t)(s0 > 0 ? m0 - 2 : m0);
            const u32x4 p2c = *(const u32x4*)(Z + ZCC + rp * 1024 + c);
            const u32x4 p1c = *(const u32x4*)(Z + ZCC + (rp + 1) * 1024 + c);
            float w0[8], w1[8], w2[8];
#pragma unroll
            for (int i = 0; i < 8; ++i) { w0[i] = F.w_conv[c + i]; w1[i] = F.w_conv[1024 + c + i]; w2[i] = F.w_conv[2048 + c + i]; }
            float u1[8], u2[8];
            const float keep = s0 > 0 ? 1.0f : 0.0f;
#pragma unroll
            for (int i = 0; i < 4; ++i) { u2[2 * i] = keep * bf_lo(p2c[i]); u2[2 * i + 1] = keep * bf_hi(p2c[i]); u1[2 * i] = keep * bf_lo(p1c[i]); u1[2 * i + 1] = keep * bf_hi(p1c[i]); }
#pragma unroll
            for (int hb = 0; hb < 2; ++hb) {
                u32x4 cc[4], cb[4];
#pragma unroll
                for (int rr = 0; rr < 4; ++rr) { const size_t row = (size_t)(m0 + 4 * hb + rr); cc[rr] = *(const u32x4*)(Z + ZCC + row * 1024 + c); cb[rr] = *(const u32x4*)(Z + ZCB + row * 1024 + c); }
#pragma unroll
                for (int rr = 0; rr < 4; ++rr) {
                    float u0[8], y[8];
#pragma unroll
                    for (int i = 0; i < 4; ++i) { u0[2 * i] = bf_lo(cc[rr][i]); u0[2 * i + 1] = bf_hi(cc[rr][i]); }
#pragma unroll
                    for (int i = 0; i < 8; ++i) y[i] = w0[i] * u2[i] + w1[i] * u1[i] + w2[i] * u0[i];
                    u32x4 ow;
#pragma unroll
                    for (int i = 0; i < 4; ++i) ow[i] = pk2(bf_lo(cb[rr][i]) * y[2 * i], bf_hi(cb[rr][i]) * y[2 * i + 1]);
                    *(u32x4*)(PB + (size_t)(m0 + 4 * hb + rr) * 1024 + c) = ow;
#pragma unroll
                    for (int i = 0; i < 8; ++i) { u2[i] = u1[i]; u1[i] = u0[i]; }
                }
                asm volatile("" ::: "memory");
            }
        }
    }
}

__device__ __forceinline__ void gla_scan(Frame& F, const int nrep) {
    const unsigned* U = WSP(const unsigned, WS_U); unsigned* SIN = WSP(unsigned, WS_SIN); const float* DECS = WSP(const float, WS_DECS);
    const int gt = F.vcu * 512 + F.tid, NT = F.G * 512;
    for (int idx0 = gt; idx0 < 32 * 16384 * nrep; idx0 += NT) {
        const int idx = idx0 & (32 * 16384 - 1);
        const int bh = idx >> 14, e = idx & 16383;
        const int ln = e & 63, rp = (e >> 6) & 7, kb = (e >> 9) & 3;
        const int dk = 32 * kb + crow(2 * rp, ln >> 5);
        float s0 = 0.f, s1 = 0.f;
        unsigned uw[8];
#pragma unroll
        for (int sc = 0; sc < 8; ++sc) uw[sc] = U[(size_t)(bh * 8 + sc) * 16384 + e];
#pragma unroll
        for (int sc = 0; sc < 8; ++sc) {
            const int item = bh * 8 + sc;
            SIN[(size_t)item * 16384 + e] = pk2(s0, s1);
            const f32x2 dc = *(const f32x2*)(DECS + item * 128 + dk);
            s0 = dc.x * s0 + bf_lo(uw[sc]); s1 = dc.y * s1 + bf_hi(uw[sc]);
        }
    }
}

struct P3Order : pg8::StaticOrder {
    __device__ __forceinline__ bool next(int i, pg8::Unit& u) const {
        if (!pg8::StaticOrder::next(i >> 1, u)) return false;
        u.e = i & 1; u.pn += 4 * u.e; return true;
    }
    __device__ __forceinline__ unsigned arow(const pg8::Unit& u, int ui, int r) const { return (unsigned)(u.e * M + u.pm * 256 + r) * 2048u; }
    __device__ __forceinline__ void after_unit(int ui) const {}
};
struct EpiBranch {
    static constexpr bool PERM = true;
    const bf16* Z; bf16* M1; bf16* MIX;
    __device__ __forceinline__ void operator()(const f32x4 (&acc)[2][2][4][2], const pg8::Unit& u, int wr, int wc, int fr, int fq) const {
        const int row0 = u.pm * 256 + wr * 64 + fr, col0 = (u.pn & 3) * 256 + wc * 32 + 8 * fq;
        const bf16* G = Z + (u.e ? ZGB : ZGA);
#pragma unroll
        for (int ai = 0; ai < 2; ++ai)
#pragma unroll
            for (int m = 0; m < 4; ++m) { const size_t row = (size_t)(row0 + ai * 128 + m * 16);
#pragma unroll
                for (int bj = 0; bj < 2; ++bj) { const u32x4 sg = *(const u32x4*)(G + row * 1024 + col0 + bj * 128);
                    const f32x4 v0 = acc[ai][bj][m][0], v1 = acc[ai][bj][m][1];
                    float r[8] = {v0[0] * bf_lo(sg.x), v0[1] * bf_hi(sg.x), v0[2] * bf_lo(sg.y), v0[3] * bf_hi(sg.y), v1[0] * bf_lo(sg.z), v1[1] * bf_hi(sg.z), v1[2] * bf_lo(sg.w), v1[3] * bf_hi(sg.w)};
                    if (u.e) { const u32x4 mm = *(const u32x4*)(M1 + row * 1024 + col0 + bj * 128);
                        r[0] += bf_lo(mm.x); r[1] += bf_hi(mm.x); r[2] += bf_lo(mm.y); r[3] += bf_hi(mm.y); r[4] += bf_lo(mm.z); r[5] += bf_hi(mm.z); r[6] += bf_lo(mm.w); r[7] += bf_hi(mm.w); }
                    u32x4 w; w.x = pk2(r[0], r[1]); w.y = pk2(r[2], r[3]); w.z = pk2(r[4], r[5]); w.w = pk2(r[6], r[7]);
                    *(u32x4*)((u.e ? MIX : M1) + row * 1024 + col0 + bj * 128) = w; } }
    }
};
struct EpiX1 {
    static constexpr bool PERM = true;
    const float* x; bf16* X1;
    __device__ __forceinline__ void operator()(const f32x4 (&acc)[2][2][4][2], const pg8::Unit& u, int wr, int wc, int fr, int fq) const {
        const int row0 = u.pm * 256 + wr * 64 + fr, col0 = u.pn * 256 + wc * 32 + 8 * fq;
#pragma unroll
        for (int ai = 0; ai < 2; ++ai)
#pragma unroll
            for (int m = 0; m < 4; ++m) { const size_t off = (size_t)(row0 + ai * 128 + m * 16) * 1024 + col0;
#pragma unroll
                for (int bj = 0; bj < 2; ++bj) { const f32x4 x0 = *(const f32x4*)(x + off + bj * 128), x1 = *(const f32x4*)(x + off + bj * 128 + 4);
                    const f32x4 v0 = x0 + acc[ai][bj][m][0], v1 = x1 + acc[ai][bj][m][1];
                    u32x4 w; w.x = pk2(v0[0], v0[1]); w.y = pk2(v0[2], v0[3]); w.z = pk2(v1[0], v1[1]); w.w = pk2(v1[2], v1[3]);
                    *(u32x4*)(X1 + off + bj * 128) = w; } }
    }
};

constexpr int P5_WLD = 2064;
constexpr int P5_WH = 0, P5_WL = 32 * P5_WLD;
constexpr int P5_RSTD = 133120, P5_LOGT = 133376;
constexpr int P5_HIST = 141824, P5_BASE = P5_HIST + 128, P5_PLE = P5_HIST + 256;
__device__ __forceinline__ void p5_router(Frame& F) {
    LAS unsigned char* L = F.lds;
    LAS float* RSTD = (LAS float*)(L + P5_RSTD); LAS float* LOGT = (LAS float*)(L + P5_LOGT);
    LAS int* hist = (LAS int*)(L + P5_HIST); LAS int* base = (LAS int*)(L + P5_BASE); LAS int* ple = (LAS int*)(L + P5_PLE);
    const bf16* X1 = WSP(const bf16, WS_X1); unsigned char* H2 = WSP(unsigned char, WS_XN);
    unsigned* cnt = F.ctl + CW_CNT; int* list = WSP(int, WS_LIST); float* gate = WSP(float, WS_GATE);
    const int lane = F.lane, w = F.wave, r32 = lane & 31, h = lane >> 5;
    f32x4 g[4];
#pragma unroll
    for (int j = 0; j < 4; ++j) g[j] = *((const f32x4*)F.g_ffn + lane + 64 * j);
    for (int grp = F.vcu; grp < M / 64; grp += F.G) {
        for (int i = 0; i < 64; ++i) { const int idx = F.tid + 512 * i, k = idx >> 5, e = idx & 31; const float wv = F.w_router[idx] * F.g_ffn[k];
            const unsigned hi = pk2(wv, 0.f) & 0xffffu; const float rem = wv - __builtin_bit_cast(float, hi << 16);
            *(LAS bf16*)(L + P5_WH + e * P5_WLD + 2 * k) = (bf16)hi; *(LAS bf16*)(L + P5_WL + e * P5_WLD + 2 * k) = (bf16)(pk2(rem, 0.f) & 0xffffu); }
        if (F.tid < 32) hist[F.tid] = 0;
        const size_t tok0 = (size_t)grp * 64;
        { u32x2 xv[8][4];
#pragma unroll
          for (int i = 0; i < 8; ++i) { const u32x2* xa = (const u32x2*)(X1 + (tok0 + 8 * w + i) * D) + lane;
#pragma unroll
              for (int j = 0; j < 4; ++j) xv[i][j] = xa[64 * j]; }
#pragma unroll
          for (int i = 0; i < 8; ++i) { f32x4 v[4]; float ss = 0.f;
#pragma unroll
              for (int j = 0; j < 4; ++j) { v[j] = (f32x4){bf_lo(xv[i][j].x), bf_hi(xv[i][j].x), bf_lo(xv[i][j].y), bf_hi(xv[i][j].y)};
#pragma unroll
                  for (int c = 0; c < 4; ++c) ss = fmaf(v[j][c], v[j][c], ss); }
              const float rs = 1.0f / sqrtf(wave_sum(ss) * (1.f / D) + 1e-6f);
              if (lane == 0) RSTD[8 * w + i] = rs;
              unsigned* o4 = (unsigned*)(H2 + (tok0 + 8 * w + i) * D) + lane;
#pragma unroll
              for (int j = 0; j < 4; ++j) { const f32x4 hv = v[j] * rs * g[j]; o4[64 * j] = pk4_fp8(hv.x, hv.y, hv.z, hv.w); } } }
        bf16x8 af[2][8];
        { const bf16* xa = X1 + (tok0 + r32) * D + 128 * w + 8 * h;
#pragma unroll
          for (int mt = 0; mt < 2; ++mt)
#pragma unroll
              for (int ks = 0; ks < 8; ++ks) af[mt][ks] = *(const bf16x8*)(xa + (size_t)mt * 32 * D + 16 * ks); }
        __syncthreads();
        f32x16 acc[2];
#pragma unroll
        for (int mt = 0; mt < 2; ++mt)
#pragma unroll
            for (int r = 0; r < 16; ++r) acc[mt][r] = 0.f;
#pragma unroll
        for (int ks = 0; ks < 8; ++ks) {
            const bf16x8 bh = *(const LAS bf16x8*)(L + P5_WH + r32 * P5_WLD + 2 * (128 * w + 16 * ks + 8 * h));
            const bf16x8 bl = *(const LAS bf16x8*)(L + P5_WL + r32 * P5_WLD + 2 * (128 * w + 16 * ks + 8 * h));
#pragma unroll
            for (int mt = 0; mt < 2; ++mt) { acc[mt] = __builtin_amdgcn_mfma_f32_32x32x16_bf16(af[mt][ks], bh, acc[mt], 0, 0, 0); acc[mt] = __builtin_amdgcn_mfma_f32_32x32x16_bf16(af[mt][ks], bl, acc[mt], 0, 0, 0); }
        }
        __syncthreads();
#pragma unroll
        for (int mt = 0; mt < 2; ++mt)
#pragma unroll
            for (int r = 0; r < 16; ++r) *(LAS float*)(L + ((w * 64 + 32 * mt + crow(r, h)) * 32 + r32) * 4) = acc[mt][r];
        __syncthreads();
        { const int tk = F.tid >> 3, eq = F.tid & 7;
          f32x4 sum = *(const LAS f32x4*)(L + ((0 * 64 + tk) * 32 + 4 * eq) * 4);
#pragma unroll
          for (int ww = 1; ww < 8; ++ww) sum = sum + *(const LAS f32x4*)(L + ((ww * 64 + tk) * 32 + 4 * eq) * 4);
          const float rs = RSTD[tk]; const f32x4 bb = *(const f32x4*)(F.b_router + 4 * eq);
#pragma unroll
          for (int c = 0; c < 4; ++c) LOGT[tk * 33 + 4 * eq + c] = sum[c] * rs + bb[c]; }
        __syncthreads();
        if (F.tid < 64) {
            const int tk = F.tid; float tv[4]; int ti[4];
#pragma unroll
            for (int k = 0; k < 4; ++k) { float bv = -3.0e38f; int bi = 0;
                for (int e = 0; e < 32; ++e) { const float v = LOGT[tk * 33 + e]; if (v > bv) { bv = v; bi = e; } }
                tv[k] = bv; ti[k] = bi; LOGT[tk * 33 + bi] = -3.0e38f; }
            const float e1 = __expf(tv[1] - tv[0]), e2 = __expf(tv[2] - tv[0]), e3 = __expf(tv[3] - tv[0]);
            const float inv = 1.0f / (1.0f + e1 + e2 + e3);
            const float gk[4] = {inv, e1 * inv, e2 * inv, e3 * inv};
#pragma unroll
            for (int k = 0; k < 4; ++k) { const int lr = __hip_atomic_fetch_add(&hist[ti[k]], 1, __ATOMIC_RELAXED, __HIP_MEMORY_SCOPE_WORKGROUP);
                ple[tk * 4 + k] = ti[k] | (lr << 8); gate[(tok0 + tk) * 4 + k] = gk[k]; }
        }
        __syncthreads();
        if (F.tid < 32) base[F.tid] = (int)__hip_atomic_fetch_add(cnt + F.tid, (unsigned)hist[F.tid], RLX_AGENT);
        __syncthreads();
        if (F.tid < 256) { const int pe = ple[F.tid], e = pe & 255, lr = pe >> 8; list[e * CAP + base[e] + lr] = (grp * 64) * 4 + F.tid; }
        __syncthreads();
    }
}

#ifndef MK_MAXU
#define MK_MAXU 12
#endif
constexpr int MAXU = MK_MAXU;
template <int NP>
struct MoeOrder {
    LAS const int* rt0;
    LAS const int* tokl;
    int nwg, G, c, reps;
    __device__ __forceinline__ bool next(int i, pg8::Unit& u) const {
        const long L = (long)i * G + c; if (L >= (long)nwg * reps) return false;
        int wgid = (int)(L % nwg); { const int q = nwg / 8, r = nwg % 8, xcd = wgid % 8, off = wgid / 8; wgid = (xcd < r ? xcd * (q + 1) : r * (q + 1) + (xcd - r) * q) + off; }
        int e = 0;
#pragma unroll 1
        for (int j = 1; j < 32; ++j) if (wgid >= NP * rt0[j]) e = j;
        const int l = wgid - NP * rt0[e], nte = rt0[e + 1] - rt0[e];
        const int pn = l / nte, rt = l - pn * nte;
        u.pm = __builtin_amdgcn_readfirstlane(rt0[e] + rt); u.pn = __builtin_amdgcn_readfirstlane(e * NP + pn); u.e = __builtin_amdgcn_readfirstlane(e); u.rt = __builtin_amdgcn_readfirstlane(rt); return true;
    }
};
struct MoeOrder1 : MoeOrder<8> {
    __device__ __forceinline__ void after_unit(int ui) const {}
    __device__ __forceinline__ unsigned arow(const pg8::Unit& u, int ui, int r) const { return (unsigned)tokl[ui * 256 + r] * 1024u; }
};
struct MoeOrder2 : MoeOrder<4> {
    __device__ __forceinline__ void after_unit(int ui) const {}
    __device__ __forceinline__ unsigned arow(const pg8::Unit& u, int ui, int r) const { return (unsigned)(u.pm * 256 + r) * 1024u; }
};
struct EpiAct {
    static constexpr bool PERM = true;
    const float* b_gu; unsigned char* ACT;
    __device__ __forceinline__ void operator()(const f32x4 (&acc)[2][2][4][2], const pg8::Unit& u, int wr, int wc, int fr, int fq) const {
        const int pn = u.pn & 7, cl = pn * 128 + wc * 32 + 8 * fq;
        const int row0 = u.pm * 256 + wr * 64 + fr;
        const f32x4 bg0 = *(const f32x4*)(b_gu + u.e * 2048 + cl), bg1 = *(const f32x4*)(b_gu + u.e * 2048 + cl + 4);
        const f32x4 bl0 = *(const f32x4*)(b_gu + u.e * 2048 + 1024 + cl), bl1 = *(const f32x4*)(b_gu + u.e * 2048 + 1024 + cl + 4);
#pragma unroll
        for (int ai = 0; ai < 2; ++ai)
#pragma unroll
            for (int m = 0; m < 4; ++m) {
                f32x4 g0 = acc[ai][0][m][0] + bg0, g1 = acc[ai][0][m][1] + bg1, l0 = acc[ai][1][m][0] + bl0, l1 = acc[ai][1][m][1] + bl1;
                float r0[4], r1[4];
#pragma unroll
                for (int j = 0; j < 4; ++j) {
                    const float ga = fminf(g0[j], 7.0f), gb = fminf(g1[j], 7.0f);
                    const float la = fminf(fmaxf(l0[j], -7.0f), 7.0f), lb = fminf(fmaxf(l1[j], -7.0f), 7.0f);
                    r0[j] = (la + 1.0f) * (ga * fast_sigmoid(1.702f * ga)); r1[j] = (lb + 1.0f) * (gb * fast_sigmoid(1.702f * gb));
                }
                u32x2 w; w.x = pk4_fp8(r0[0], r0[1], r0[2], r0[3]); w.y = pk4_fp8(r1[0], r1[1], r1[2], r1[3]);
                *(u32x2*)(ACT + (size_t)(row0 + ai * 128 + m * 16) * 1024 + cl) = w;
            }
    }
};
struct EpiYP {
    static constexpr bool PERM = true;
    const float* b_d; const unsigned* cnt; const int* list; const float* gate; unsigned char* YP;
    __device__ __forceinline__ void operator()(const f32x4 (&acc)[2][2][4][2], const pg8::Unit& u, int wr, int wc, int fr, int fq) const {
        const int pn = u.pn & 3, col0 = pn * 256 + wc * 32 + 8 * fq;
        const int ne = (int)cnt[u.e];
        f32x4 bv[2][2];
#pragma unroll
        for (int bj = 0; bj < 2; ++bj)
#pragma unroll
            for (int n = 0; n < 2; ++n) bv[bj][n] = *(const f32x4*)(b_d + u.e * 1024 + col0 + bj * 128 + 4 * n);
#pragma unroll
        for (int ai = 0; ai < 2; ++ai)
#pragma unroll
            for (int m = 0; m < 4; ++m) {
                const int slot = u.rt * 256 + ai * 128 + wr * 64 + m * 16 + fr;
                if (slot < ne) {
                    const int pid = list[u.e * CAP + slot]; const float gw = gate[pid] * 16.0f;
#pragma unroll
                    for (int bj = 0; bj < 2; ++bj) { const f32x4 v0 = (acc[ai][bj][m][0] + bv[bj][0]) * gw, v1 = (acc[ai][bj][m][1] + bv[bj][1]) * gw;
                        u32x2 w; w.x = pk4_fp8(v0[0], v0[1], v0[2], v0[3]); w.y = pk4_fp8(v1[0], v1[1], v1[2], v1[3]);
                        *(u32x2*)(YP + (size_t)pid * 1024 + col0 + bj * 128) = w; }
                }
            }
    }
};
__device__ __forceinline__ int moe_setup(Frame& F, LAS int* rt0) {
    if (F.tid == 0) { int acc = 0; for (int e = 0; e < 32; ++e) { rt0[e] = acc; acc += ((int)F.ctl[CW_CNT + e] + 255) >> 8; } rt0[32] = acc; }
    __syncthreads();
    return rt0[32];
}

__device__ __forceinline__ void p8_final(Frame& F, const int nrep) {
    const int gw = F.vcu * NWAVES + F.wave, NGW = F.G * NWAVES;
    const bf16* X1 = WSP(const bf16, WS_X1); const unsigned char* YP = WSP(const unsigned char, WS_YP);
    f32x4 g[4];
#pragma unroll
    for (int j = 0; j < 4; ++j) g[j] = *((const f32x4*)F.g_final + F.lane + 64 * j);
    float pscale = 1.0f;
#ifdef MK_TPROBE
    { const unsigned long long* st = (const unsigned long long*)(F.ctl + CW_STAMP); const float dt_us = (float)(st[MK_TPROBE_J] - st[MK_TPROBE_I]) * 0.01f; pscale = 1.0f + sqrtf(dt_us * 1e-5f); }
#endif
    for (int m0 = gw; m0 < M * nrep; m0 += NGW) {
        const int m = m0 % M;
        const u32x2* xr = (const u32x2*)(X1 + (size_t)m * D) + F.lane;
        f32x4 v[4]; float s = 0.f;
#pragma unroll
        for (int j = 0; j < 4; ++j) { const u32x2 xw = xr[64 * j]; v[j] = (f32x4){bf_lo(xw.x), bf_hi(xw.x), bf_lo(xw.y), bf_hi(xw.y)}; }
        f32x4 ys[4];
#pragma unroll
        for (int j = 0; j < 4; ++j) ys[j] = (f32x4){0.f, 0.f, 0.f, 0.f};
#pragma unroll
        for (int k = 0; k < 4; ++k) { const unsigned* yr = (const unsigned*)(YP + ((size_t)m * 4 + k) * 1024) + F.lane;
#pragma unroll
            for (int j = 0; j < 4; ++j) { const int y = (int)yr[64 * j]; const f32x2 lo = __builtin_amdgcn_cvt_pk_f32_fp8(y, false), hi = __builtin_amdgcn_cvt_pk_f32_fp8(y, true);
                ys[j].x += lo.x; ys[j].y += lo.y; ys[j].z += hi.x; ys[j].w += hi.y; } }
#pragma unroll
        for (int j = 0; j < 4; ++j) v[j] = v[j] + ys[j] * 0.0625f;
#pragma unroll
        for (int j = 0; j < 4; ++j) s += (v[j].x * v[j].x + v[j].y * v[j].y) + (v[j].z * v[j].z + v[j].w * v[j].w);
        const float rstd = 1.0f / sqrtf(wave_sum(s) * (1.f / D) + 1e-6f);
        f32x4* op = (f32x4*)(F.out + (size_t)m * D) + F.lane;
#pragma unroll
        for (int j = 0; j < 4; ++j) op[64 * j] = v[j] * (rstd * pscale) * g[j];
    }
}

struct Args { const float* in[18]; float* out; unsigned char* ws; int ph_lo, ph_hi, rep_k, rep_n; };
__global__ void __launch_bounds__(NWAVES * 64, 2) mk_fwd(Args args) {
    extern __shared__ __attribute__((aligned(16))) unsigned char lds[];
    Frame F;
    F.lds = (LAS unsigned char*)lds;
    F.MISC = (volatile LAS unsigned*)(F.lds + MISC_OFF);
    F.tid = threadIdx.x; F.lane = F.tid & 63; F.wave = __builtin_amdgcn_readfirstlane(F.tid >> 6);
    F.G = gridDim.x; { const int bx = blockIdx.x; F.vcu = (F.G % 8 == 0) ? (bx % 8) * (F.G / 8) + bx / 8 : bx; }
    F.ws = args.ws; F.ctl = (unsigned*)(args.ws + WS_CTL);
    F.x = args.in[0]; F.g_mix = args.in[1]; F.w_in = args.in[2]; F.w_up = args.in[3]; F.b_alpha = args.in[4]; F.g_gla = args.in[5]; F.w_conv = args.in[6];
    F.w_a = args.in[7]; F.w_b = args.in[8]; F.w_out = args.in[9]; F.g_ffn = args.in[10]; F.w_router = args.in[11]; F.b_router = args.in[12];
    F.w_gu = args.in[13]; F.b_gu = args.in[14]; F.w_d = args.in[15]; F.b_d = args.in[16]; F.g_final = args.in[17]; F.out = args.out;
    if (F.tid < 128) ((LAS unsigned*)(F.lds + MISC_OFF))[F.tid] = 0u;
    __syncthreads();
    XcdBarrier bar; bar.bar = F.ctl + CW_BAR; bar.x = 0; bar.st = nullptr;
    if (N_LAUNCHES == 1) bar = xcd_barrier_post(F.ctl + CW_BAR, F.MISC + 8);
    const int lo = args.ph_lo, hi = args.ph_hi;
#ifdef MK_ONLY
#define IN(k) ((k) == MK_ONLY && lo <= (k) && (k) < hi)
#else
#define IN(k) (lo <= (k) && (k) < hi)
#endif
#define REPS(k) (((k) == args.rep_k) ? 1 + args.rep_n : 1)
#if defined(MK_TPROBE) || defined(MK_DELAY_K)
#define STAMP(k) do { if (blockIdx.x == 0 && F.tid == 0) ((unsigned long long*)(F.ctl + CW_STAMP))[k] = __builtin_amdgcn_s_memrealtime(); } while (0)
#else
#define STAMP(k) do { } while (0)
#endif
#ifdef MK_DELAY_K
#define DELAY(k) do { if ((k) == MK_DELAY_K) { const unsigned long long dl = __hip_atomic_load((unsigned long long*)(F.ctl + CW_STAMP), RLX_AGENT) + (unsigned long long)(MK_DELAY_US) * 100ull; \
    while (__builtin_amdgcn_s_memrealtime() < dl) __builtin_amdgcn_s_sleep(8); } } while (0)
#else
#define DELAY(k) do { } while (0)
#endif
#define SEAM(k) do { if (IN(k) && IN((k) + 1)) xcd_barrier(bar); STAMP((k) + 1); DELAY(k); } while (0)

    STAMP(0);
    if (IN(0)) { p0_prologue(F, REPS(0), REPS(11)); SEAM(0); }
    if (IN(1)) { const int nrep = REPS(1);
        P1Order S; S.init(M, NZ, D, F.G, (int)blockIdx.x, nrep); S.w_gu = F.w_gu; S.w_d = F.w_d; S.ws = F.ws; S.lds = F.lds; S.slot = ((int)blockIdx.x >> 3) & 7; S.wave = F.wave; S.lane = F.lane;
        EpiZ E{WSP(bf16, WS_Z)};
        pg8::gemm_phase<EpiZ, P1Order, true>(F.lds, WSP(const bf16, WS_XN), WSP(const bf16, WS_WIN), D, S, E);
        SEAM(1);
    }
    if (IN(2)) { const int nrep = REPS(2); for (int it = F.vcu; it < 256 * nrep; it += F.G) gla_item<false>(F, it & 255); conv_rows(F, REPS(12)); SEAM(2); }
    if (IN(3)) { gla_scan(F, REPS(3)); SEAM(3); }
    if (IN(4)) { const int nrep = REPS(4); for (int it = F.vcu; it < 256 * nrep; it += F.G) gla_item<true>(F, it & 255); SEAM(4); }
    if (IN(5)) { const int nrep = REPS(5);
        static_assert(WS_PB == WS_OG + (size_t)M * 1024 * 2 && WS_WB == WS_WA + (size_t)1024 * 1024 * 2, "P3Order addresses PB / Wb from OG / Wa");
        P3Order S; S.init(M, D, D, F.G, (int)blockIdx.x, nrep);
        EpiBranch E{WSP(const bf16, WS_Z), WSP(bf16, WS_M1), WSP(bf16, WS_MIX)};
        pg8::gemm_phase<EpiBranch, P3Order, true>(F.lds, WSP(const bf16, WS_OG), WSP(const bf16, WS_WA), D, S, E);
        SEAM(5);
    }
    if (IN(6)) { const int nrep = REPS(6);
        pg8::StaticOrder S; S.init(M, D, D, F.G, (int)blockIdx.x, nrep);
        EpiX1 E{F.x, WSP(bf16, WS_X1)};
        pg8::gemm_phase<EpiX1, pg8::StaticOrder, false>(F.lds, WSP(const bf16, WS_MIX), WSP(const bf16, WS_WO), D, S, E);
        SEAM(6);
    }
    if (IN(7)) { p5_router(F); SEAM(7); }
    if (IN(8)) { const int nrep = REPS(8);
        LAS int* rt0 = (LAS int*)(F.lds + EXTRA_OFF); LAS int* tokl = (LAS int*)(F.lds + EXTRA_OFF + 256);
        const int R = moe_setup(F, rt0);
        MoeOrder1 S; S.rt0 = rt0; S.tokl = tokl; S.nwg = R * 8; S.G = F.G; S.c = (int)blockIdx.x; S.reps = nrep;
        const int* list = WSP(const int, WS_LIST);
        { pg8::Unit u; for (int ui = 0; ui < MAXU && S.next(ui, u); ++ui) if (F.tid < 256) { const int slot = u.rt * 256 + F.tid; tokl[ui * 256 + F.tid] = slot < (int)F.ctl[CW_CNT + u.e] ? (list[u.e * CAP + slot] >> 2) : 0; } }
        __syncthreads();
        EpiAct E{F.b_gu, WSP(unsigned char, WS_ACT)};
        pg8::gemm_phase<EpiAct, MoeOrder1, true, true, 122>(F.lds, WSP(const void, WS_XN), WSP(const void, WS_WGU), D, S, E);
        SEAM(8);
    }
    if (IN(9)) { const int nrep = REPS(9);
        LAS int* rt0 = (LAS int*)(F.lds + EXTRA_OFF);
        const int R = moe_setup(F, rt0);
        MoeOrder2 S; S.rt0 = rt0; S.tokl = nullptr; S.nwg = R * 4; S.G = F.G; S.c = (int)blockIdx.x; S.reps = nrep;
        EpiYP E{F.b_d, F.ctl + CW_CNT, WSP(const int, WS_LIST), WSP(const float, WS_GATE), WSP(unsigned char, WS_YP)};
        pg8::gemm_phase<EpiYP, MoeOrder2, true, true, 122>(F.lds, WSP(const void, WS_ACT), WSP(const void, WS_WD), D, S, E);
        SEAM(9);
    }
    if (IN(10)) { p8_final(F, REPS(10)); }
#undef IN
#undef SEAM
}

extern "C" void kernel_launch(void* const* d_in, const int* in_sizes, int n_in, void* d_out, int out_size, void* d_ws, size_t ws_size, hipStream_t stream) {
    static int grid = 0;
    if (grid == 0) {
        if (n_in != 18 || out_size != M * D || ws_size < WS_END) { fprintf(stderr, "kernel_launch: unexpected shapes (n_in %d, out %d, ws %zu < %zu)\n", n_in, out_size, ws_size, (size_t)WS_END); grid = -1; return; }
        int dev = 0, cus = 0, per_cu = 0;
        if (hipGetDevice(&dev) != hipSuccess || hipDeviceGetAttribute(&cus, hipDeviceAttributeMultiprocessorCount, dev) != hipSuccess) { grid = -1; return; }
        if (hipFuncSetAttribute((const void*)mk_fwd, hipFuncAttributeMaxDynamicSharedMemorySize, LDS_BYTES) != hipSuccess) { fprintf(stderr, "kernel_launch: hipFuncSetAttribute(%d B LDS) failed\n", LDS_BYTES); grid = -1; return; }
        if (hipOccupancyMaxActiveBlocksPerMultiprocessor(&per_cu, (const void*)mk_fwd, NWAVES * 64, LDS_BYTES) != hipSuccess || per_cu < 1) fprintf(stderr, "kernel_launch: occupancy query says %d\n", per_cu);
        (void)hipGetLastError();
        grid = cus;
        if (grid != 256) fprintf(stderr, "kernel_launch: %d CUs (built for 256)\n", grid);
    }
    if (grid < 0) return;
    (void)hipMemsetAsync((char*)d_ws + WS_CTL, 0, CTL_ZERO_BYTES, stream);
    Args a{};
    for (int i = 0; i < 18; ++i) a.in[i] = (const float*)d_in[i];
    a.out = (float*)d_out; a.ws = (unsigned char*)d_ws;
#ifdef MK_REPEAT
    a.rep_k = MK_REPEAT; a.rep_n = MK_REPEAT_N;
#else
    a.rep_k = -1; a.rep_n = 0;
#endif
    for (int li = 0; li < N_LAUNCHES; ++li) {
        a.ph_lo = (N_LAUNCHES == 1) ? 0 : li; a.ph_hi = (N_LAUNCHES == 1) ? NPH : li + 1;
        hipLaunchKernelGGL(mk_fwd, dim3(grid), dim3(NWAVES * 64), LDS_BYTES, stream, a);
    }
}
```

```cpp
#include <hip/hip_runtime.h>
#include <cstdio>
#include <cstdint>

#ifndef MK_N_LAUNCHES
#define MK_N_LAUNCHES 1
#endif

#define LAS __attribute__((address_space(3)))
#define GAS __attribute__((address_space(1)))
typedef unsigned short bf16;
typedef short bf16x8 __attribute__((ext_vector_type(8)));
typedef float f32x4 __attribute__((ext_vector_type(4)));
typedef float f32x2 __attribute__((ext_vector_type(2)));
typedef float f32x16 __attribute__((ext_vector_type(16)));
typedef unsigned u32x4 __attribute__((ext_vector_type(4)));
typedef unsigned u32x2 __attribute__((ext_vector_type(2)));
typedef __bf16 bf16x2_t __attribute__((ext_vector_type(2)));
typedef int v8i32 __attribute__((ext_vector_type(8)));

constexpr int NWAVES = 8;
constexpr int M = 16384, D = 1024, SEQ = 2048;
constexpr int NZS = 8208;
constexpr int NZ = 8192;
constexpr int NE = 32, CAP = 16384;
constexpr int NPH = 11;
constexpr int N_LAUNCHES = MK_N_LAUNCHES;
constexpr size_t ZQ = 0, ZK = ZQ + (size_t)4 * M * 128, ZV = ZK + (size_t)4 * M * 128, ZR = ZV + (size_t)4 * M * 256, ZCB = ZR + (size_t)4 * M * 256, ZCC = ZCB + (size_t)M * 1024, ZCX = ZCC + (size_t)M * 1024, ZGA = ZCX + (size_t)M * 1024, ZGB = ZGA + (size_t)M * 1024;

constexpr size_t MiB = 1u << 20;
constexpr size_t WS_CTL = 0, CTL_ZERO_BYTES = 65536;
constexpr size_t WS_LIST = 1 * MiB;
constexpr size_t WS_GATE = 3 * MiB;
constexpr size_t WS_DECS = 4 * MiB;
constexpr size_t WS_WIN = 16 * MiB;
constexpr size_t WS_WA = 32 * MiB, WS_WB = 34 * MiB, WS_WO = 36 * MiB;
constexpr size_t WS_WGU = 40 * MiB;
constexpr size_t WS_WD = 168 * MiB;
constexpr size_t WS_XN = 232 * MiB;
constexpr size_t WS_LA = 264 * MiB;
constexpr size_t WS_Z = 296 * MiB;
constexpr size_t WS_YP = WS_Z;
constexpr size_t WS_U = 552 * MiB;
constexpr size_t WS_SIN = 584 * MiB;
constexpr size_t WS_OG = 616 * MiB;
constexpr size_t WS_PB = 648 * MiB;
constexpr size_t WS_M1 = 680 * MiB;
constexpr size_t WS_MIX = 744 * MiB;
constexpr size_t WS_X1 = 776 * MiB;
constexpr size_t WS_ACT = 840 * MiB;
constexpr size_t WS_END = 984 * MiB;
constexpr int CW_TMO = 0;
constexpr int CW_BAR = 4096;
constexpr int CW_CNT = 8192;
constexpr int CW_STAMP = 12288;

constexpr int RING_BYTES = 131072;
constexpr int EXTRA_OFF = RING_BYTES;
constexpr int LDS_BYTES = 155648 + 512;
constexpr int MISC_OFF = 155648;

#define RLX_AGENT __ATOMIC_RELAXED, __HIP_MEMORY_SCOPE_AGENT
#define LDS_WAIT() asm volatile("s_waitcnt lgkmcnt(0)" ::: "memory")
#define VM_WAIT() asm volatile("s_waitcnt vmcnt(0)" ::: "memory")
__device__ __forceinline__ unsigned pk2(float lo, float hi) { f32x2 v = {lo, hi}; bf16x2_t b = __builtin_convertvector(v, bf16x2_t); return __builtin_bit_cast(unsigned, b); }
__device__ __forceinline__ unsigned pk4_fp8(float a, float b, float c, float d) { int w = 0; w = __builtin_amdgcn_cvt_pk_fp8_f32(a, b, w, false); w = __builtin_amdgcn_cvt_pk_fp8_f32(c, d, w, true); return (unsigned)w; }
__device__ __forceinline__ float bf_lo(unsigned w) { return __builtin_bit_cast(float, w << 16); }
__device__ __forceinline__ float bf_hi(unsigned w) { return __builtin_bit_cast(float, w & 0xffff0000u); }
__device__ __forceinline__ float bf1(bf16 b) { return __builtin_bit_cast(float, ((unsigned)b) << 16); }
__device__ __forceinline__ float fast_sigmoid(float x) { return __builtin_amdgcn_rcpf(1.0f + __expf(-x)); }
__device__ __forceinline__ float wave_sum(float v) {
#pragma unroll
    for (int o = 1; o < 64; o <<= 1) v += __shfl_xor(v, o);
    return v;
}

namespace pg8 {
constexpr int BM = 256, BK = 64, HALF = 128, HTB = HALF * BK * 2, STAGE_BYTES = 8 * HTB, NXCD = 8, WGM = 8;
__device__ __forceinline__ int lds_byte(int r, int c) { const int st = (r >> 4) * 2 + (c >> 5), rr = r & 15, cc = c & 31, ob = rr * 64 + cc * 2; return st * 1024 + (ob ^ (((ob >> 9) & 1) << 5)); }
__device__ __forceinline__ void stage_rc(int b, int& R, int& C) { const int st = b / 1024, sb = b % 1024, swz = sb ^ (((sb >> 9) & 1) << 5); R = (st >> 1) * 16 + swz / 64; C = (st & 1) * 32 + (swz % 64) / 2; }
__device__ __forceinline__ int perm32(int rho) { const int n = rho >> 4, i = rho & 15; return 8 * (i >> 2) + 4 * n + (i & 3); }

struct Unit { int pm, pn, e, rt; };

struct StaticOrder {
    int nM, nN, nwg, G, c, K, reps;
    __device__ __forceinline__ void init(int M_, int N_, int K_, int G_, int c_, int reps_) { nM = M_ / BM; nN = N_ / BM; nwg = nM * nN; G = G_; c = c_; K = K_; reps = reps_; }
    __device__ __forceinline__ bool next(int i, Unit& u) const {
        const long L = (long)i * G + c; if (L >= (long)nwg * reps) return false;
        int wgid = (int)(L % nwg); { const int q = nwg / NXCD, r = nwg % NXCD, xcd = wgid % NXCD, off = wgid / NXCD; wgid = (xcd < r ? xcd * (q + 1) : r * (q + 1) + (xcd - r) * q) + off; }
        const int nig = WGM * nN, gid = wgid / nig, fm = gid * WGM, gsz = (nM - fm) < WGM ? (nM - fm) : WGM;
        u.pm = fm + ((wgid % nig) % gsz); u.pn = (wgid % nig) / gsz; u.e = 0; u.rt = 0; return true;
    }
    __device__ __forceinline__ unsigned arow(const Unit& u, int ui, int r) const { return (unsigned)(u.pm * BM + r) * (unsigned)(K * 2); }
    __device__ __forceinline__ void after_unit(int ui) const {}
};

template <class Epi, class Sched, bool ALIGN_EPI, bool FP8 = false, int SCW = 127>
__device__ __forceinline__ void gemm_phase(LAS unsigned char* lds, const void* Ag, const void* Btg, const int K, const Sched& S, const Epi& E) {
    const int tid = threadIdx.x, wid = __builtin_amdgcn_readfirstlane(tid >> 6), lane = tid & 63, wr = wid >> 2, wc = wid & 3, fr = lane & 15, fq = lane >> 4;
    const int RB = FP8 ? K : 2 * K;
    const int nt = RB / 128;
    int RA[2], CA[2]; unsigned voffB[2];
#pragma unroll
    for (int i = 0; i < 2; ++i) { int R, C; stage_rc(tid * 16 + i * 8192, R, C); const int Rb = Epi::PERM ? ((R & ~31) + perm32(R & 31)) : R;
        RA[i] = R; CA[i] = C * 2; voffB[i] = (unsigned)(Rb * RB + C * 2); }
    const size_t kstep = (size_t)(BK * 2);
    const size_t hstep = (size_t)HALF * RB;
    const size_t tstep = 2 * hstep;
    const unsigned ldsw = (unsigned)wid * 1024u;
    const int aoff = lds_byte(wr * 64 + fr, fq * 8), boff = lds_byte(wc * 32 + fr, fq * 8);
#define PG8_SA(b, h) (((b) * 2 + (h)) * HTB)
#define PG8_SB(b, h) ((4 + (b) * 2 + (h)) * HTB)
#define PG8_STAGEB(bufoff, gbase) do { _Pragma("unroll") for (int _i = 0; _i < 2; ++_i) \
        __builtin_amdgcn_global_load_lds((const unsigned*)((const char*)(gbase) + voffB[_i]), (LAS unsigned*)(lds + (bufoff) + ldsw + _i * 8192), 16, 0, 0); } while (0)
#define PG8_STAGEA(bufoff, o0, o1) do { \
        __builtin_amdgcn_global_load_lds((const unsigned*)((const char*)Ag + (o0)), (LAS unsigned*)(lds + (bufoff) + ldsw), 16, 0, 0); \
        __builtin_amdgcn_global_load_lds((const unsigned*)((const char*)Ag + (o1)), (LAS unsigned*)(lds + (bufoff) + ldsw + 8192), 16, 0, 0); } while (0)
#define PG8_LDA(dst, b, h) do { if constexpr (FP8) { _Pragma("unroll") for (int m = 0; m < 4; ++m) { dst[m][0] = *(const LAS bf16x8*)(lds + PG8_SA(b, h) + aoff + m * 2048); dst[m][1] = *(const LAS bf16x8*)(lds + PG8_SA(b, h) + aoff + m * 2048 + 1024); } } \
        else { _Pragma("unroll") for (int m = 0; m < 4; ++m) _Pragma("unroll") for (int k = 0; k < 2; ++k) dst[m][k] = *(const LAS bf16x8*)(lds + PG8_SA(b, h) + aoff + m * 2048 + k * 1024); } } while (0)
#define PG8_LDB(dst, b, h) do { if constexpr (FP8) { _Pragma("unroll") for (int n = 0; n < 2; ++n) { dst[n][0] = *(const LAS bf16x8*)(lds + PG8_SB(b, h) + boff + n * 2048); dst[n][1] = *(const LAS bf16x8*)(lds + PG8_SB(b, h) + boff + n * 2048 + 1024); } } \
        else { _Pragma("unroll") for (int n = 0; n < 2; ++n) _Pragma("unroll") for (int k = 0; k < 2; ++k) dst[n][k] = *(const LAS bf16x8*)(lds + PG8_SB(b, h) + boff + n * 2048 + k * 1024); } } while (0)
#define PG8_F8(x) __builtin_bit_cast(v8i32, __builtin_shufflevector(__builtin_bit_cast(u32x4, (x)[0]), __builtin_bit_cast(u32x4, (x)[1]), 0, 1, 2, 3, 4, 5, 6, 7))
#define PG8_MMA(ai, bj, At, Bt) do { __builtin_amdgcn_s_setprio(1); if constexpr (FP8) { _Pragma("unroll") for (int m = 0; m < 4; ++m) _Pragma("unroll") for (int n = 0; n < 2; ++n) \
        asm volatile("v_mfma_scale_f32_16x16x128_f8f6f4 %0, %1, %2, %0, %3, %4 op_sel_hi:[0,0,0]" : "+v"(acc[ai][bj][m][n]) : "v"(PG8_F8(Bt[n])), "v"(PG8_F8(At[m])), "v"(scw_reg), "v"(sca_reg)); } \
        else { _Pragma("unroll") for (int m = 0; m < 4; ++m) _Pragma("unroll") for (int n = 0; n < 2; ++n) _Pragma("unroll") for (int k = 0; k < 2; ++k) \
        acc[ai][bj][m][n] = __builtin_amdgcn_mfma_f32_16x16x32_bf16(Bt[n][k], At[m][k], acc[ai][bj][m][n], 0, 0, 0); } __builtin_amdgcn_s_setprio(0); } while (0)
#define PG8_WAIT_V(n) asm volatile("s_waitcnt vmcnt(" #n ")" ::: "memory")
#define PG8_WAIT_L(n) asm volatile("s_waitcnt lgkmcnt(" #n ")" ::: "memory")
#define PG8_BAR __builtin_amdgcn_s_barrier()
#define PG8_SCHED __builtin_amdgcn_sched_barrier(0)
    Unit cur, nxt; int ui = 0;
    if (!S.next(0, cur)) return;
    int scw_reg = SCW, sca_reg = 127;
    asm volatile("" : "+v"(scw_reg), "+v"(sca_reg));
    f32x4 acc[2][2][4][2];
#pragma unroll
    for (int a = 0; a < 2; ++a)
#pragma unroll
        for (int b = 0; b < 2; ++b)
#pragma unroll
            for (int m = 0; m < 4; ++m)
#pragma unroll
                for (int n = 0; n < 2; ++n) acc[a][b][m][n] = (f32x4){0.f, 0.f, 0.f, 0.f};
#define PG8_ZPAD() do { if constexpr (FP8) { _Pragma("unroll") for (int a = 0; a < 2; ++a) _Pragma("unroll") for (int b = 0; b < 2; ++b) _Pragma("unroll") for (int m = 0; m < 4; ++m) asm volatile("s_nop 1" : "+v"(acc[a][b][m][0]), "+v"(acc[a][b][m][1])); } } while (0)
    PG8_ZPAD();
    bf16x8 At[4][2], B0[2][2], B1[2][2];
    unsigned ac00, ac01, ac10, ac11;
    ac00 = S.arow(cur, 0, RA[0]) + CA[0]; ac01 = S.arow(cur, 0, RA[1]) + CA[1]; ac10 = S.arow(cur, 0, HALF + RA[0]) + CA[0]; ac11 = S.arow(cur, 0, HALF + RA[1]) + CA[1];
    const char* cB = (const char*)Btg + (size_t)cur.pn * tstep;
    PG8_STAGEB(PG8_SB(0, 0), cB); PG8_STAGEB(PG8_SB(0, 1), cB + hstep); PG8_STAGEA(PG8_SA(0, 0), ac00, ac01); PG8_STAGEA(PG8_SA(0, 1), ac10, ac11);
    if (wr == 1) PG8_BAR;
    PG8_WAIT_V(2); PG8_BAR;
    PG8_STAGEB(PG8_SB(1, 0), cB + kstep); PG8_STAGEA(PG8_SA(1, 0), ac00 + 128u, ac01 + 128u); PG8_STAGEB(PG8_SB(1, 1), cB + hstep + kstep);
    PG8_WAIT_V(6); PG8_BAR;
    for (;;) {
        const bool has_next = S.next(ui + 1, nxt);
        const char* nB = has_next ? (const char*)Btg + (size_t)nxt.pn * tstep : cB;
#pragma unroll 1
        for (int t = 0; t < nt; t += 2) {
            const bool last = (t == nt - 2);
            const unsigned k1 = (unsigned)(t + 1) * 128u, k2 = (unsigned)(t + 2) * 128u;
            unsigned a200 = ac00 + k2, a201 = ac01 + k2, a210 = ac10 + k2, a211 = ac11 + k2;
            if (last) { if (has_next) { a200 = S.arow(nxt, ui + 1, RA[0]) + CA[0]; a201 = S.arow(nxt, ui + 1, RA[1]) + CA[1]; a210 = S.arow(nxt, ui + 1, HALF + RA[0]) + CA[0]; a211 = S.arow(nxt, ui + 1, HALF + RA[1]) + CA[1]; }
                        else { a200 = ac00; a201 = ac01; a210 = ac10; a211 = ac11; } }
            const char* b2 = last ? nB : cB + (size_t)k2; const char* b3 = b2 + kstep;
            PG8_LDB(B0, 0, 0); PG8_LDB(B1, 0, 1); PG8_SCHED; PG8_LDA(At, 0, 0); PG8_STAGEA(PG8_SA(1, 1), ac10 + k1, ac11 + k1);
            PG8_WAIT_V(8); PG8_WAIT_L(0); PG8_BAR; PG8_MMA(0, 0, At, B0); PG8_MMA(0, 1, At, B1); PG8_BAR; PG8_SCHED;
            PG8_LDA(At, 0, 1); PG8_STAGEB(PG8_SB(0, 0), b2); PG8_STAGEB(PG8_SB(0, 1), b2 + hstep); PG8_STAGEA(PG8_SA(0, 0), a200, a201);
            PG8_WAIT_V(8); PG8_WAIT_L(0); PG8_BAR; PG8_MMA(1, 0, At, B0); PG8_MMA(1, 1, At, B1); PG8_BAR; PG8_SCHED;
            PG8_LDB(B0, 1, 0); PG8_LDB(B1, 1, 1); PG8_SCHED; PG8_LDA(At, 1, 0); PG8_STAGEA(PG8_SA(0, 1), a210, a211);
            PG8_WAIT_V(8); PG8_WAIT_L(0); PG8_BAR; PG8_MMA(0, 0, At, B0); PG8_MMA(0, 1, At, B1); PG8_BAR; PG8_SCHED;
            PG8_LDA(At, 1, 1); PG8_STAGEB(PG8_SB(1, 0), b3); PG8_STAGEB(PG8_SB(1, 1), b3 + hstep); PG8_STAGEA(PG8_SA(1, 0), a200 + 128u, a201 + 128u);
            PG8_WAIT_V(8); PG8_WAIT_L(0); PG8_BAR; PG8_MMA(1, 0, At, B0); PG8_MMA(1, 1, At, B1); PG8_BAR; PG8_SCHED;
        }
        if constexpr (FP8) asm volatile("s_nop 15\n\ts_nop 15" ::: "memory");
#pragma unroll
        for (int a = 0; a < 2; ++a)
#pragma unroll
            for (int b = 0; b < 2; ++b)
#pragma unroll
                for (int m = 0; m < 4; ++m) asm volatile("" : "+v"(acc[a][b][m][0]), "+v"(acc[a][b][m][1]));
        if constexpr (ALIGN_EPI) { if (wr == 0) PG8_BAR; }
        E(acc, cur, wr, wc, fr, fq);
        S.after_unit(ui);
        if (!has_next) break;
#pragma unroll
        for (int a = 0; a < 2; ++a)
#pragma unroll
            for (int b = 0; b < 2; ++b)
#pragma unroll
                for (int m = 0; m < 4; ++m)
#pragma unroll
                    for (int n = 0; n < 2; ++n) acc[a][b][m][n] = (f32x4){0.f, 0.f, 0.f, 0.f};
        PG8_ZPAD();
        cur = nxt; cB = nB; ++ui;
        ac00 = S.arow(cur, ui, RA[0]) + CA[0]; ac01 = S.arow(cur, ui, RA[1]) + CA[1]; ac10 = S.arow(cur, ui, HALF + RA[0]) + CA[0]; ac11 = S.arow(cur, ui, HALF + RA[1]) + CA[1];
        if constexpr (ALIGN_EPI) { if (wr == 1) PG8_BAR; }
    }
    PG8_WAIT_V(0);
    if constexpr (!ALIGN_EPI) { if (wr == 0) PG8_BAR; }
    PG8_BAR;
#undef PG8_SA
#undef PG8_SB
#undef PG8_STAGEA
#undef PG8_STAGEB
#undef PG8_LDA
#undef PG8_LDB
#undef PG8_MMA
#undef PG8_F8
#undef PG8_ZPAD
#undef PG8_WAIT_V
#undef PG8_WAIT_L
#undef PG8_BAR
#undef PG8_SCHED
}
}

#define XB_TMO      128
#define XB_XCNT(j)  (256  + 64 * (j))
#define XB_XSUB(j)  (1280 + 64 * (j))
#define XB_XGEN(j)  (2304 + 64 * (j))
#define XB_TOP      3328
#define XB_TOPGEN   3392
#define XCD_BAR_WORDS 3456
#define XB_SPIN_CAP (1u << 18)
__device__ __forceinline__ unsigned xb_ld(unsigned* p)              { return __hip_atomic_load(p, __ATOMIC_RELAXED, __HIP_MEMORY_SCOPE_AGENT); }
__device__ __forceinline__ unsigned xb_add(unsigned* p, unsigned v) { return __hip_atomic_fetch_add(p, v, __ATOMIC_RELAXED, __HIP_MEMORY_SCOPE_AGENT); }
__device__ __forceinline__ unsigned xb_xcc_id() { return (unsigned)__builtin_amdgcn_s_getreg((3 << 11) | 20) & 0xFu; }
#define XB_SPIN(cond, bar) do { unsigned _sp = 0; while (cond) { __builtin_amdgcn_s_sleep(1); \
    if ((++_sp & 255u) == 0u) { if (xb_ld(&(bar)[XB_TMO])) break; if (_sp > XB_SPIN_CAP) { atomicAdd(&(bar)[XB_TMO], 1u); break; } } } } while (0)
struct XcdBarrier { unsigned* bar; unsigned x; volatile LAS unsigned* st; };
__device__ __forceinline__ XcdBarrier xcd_barrier_post(unsigned* bar, volatile LAS unsigned* st) {
    XcdBarrier b; b.bar = bar; b.x = xb_xcc_id(); b.st = st;
    if (threadIdx.x == 0) (void)xb_add(&bar[XB_XCNT(b.x)], 1u);
    return b;
}
__device__ __forceinline__ void xcd_barrier_complete(unsigned* bar, unsigned x, unsigned& nloc, unsigned& nx) {
    const unsigned G = gridDim.x * gridDim.y * gridDim.z;
    unsigned sum, cnt, mine, sp = 0u;
    for (;;) {
        sum = 0u; cnt = 0u; mine = 0u;
#pragma unroll
        for (unsigned j = 0; j < 16; ++j) { const unsigned c = xb_ld(&bar[XB_XCNT(j)]); sum += c; cnt += (c > 0u) ? 1u : 0u; mine = (j == x) ? c : mine; }
        if (sum == G) break;
        __builtin_amdgcn_s_sleep(1);
        if ((++sp & 255u) == 0u) { if (xb_ld(&bar[XB_TMO])) break; if (sp > XB_SPIN_CAP) { atomicAdd(&bar[XB_TMO], 1u); break; } }
    }
    nloc = mine > 0u ? mine : 1u; nx = cnt > 0u ? cnt : 1u;
}
__device__ __forceinline__ void xcd_barrier(const XcdBarrier& b) {
    asm volatile("s_waitcnt vmcnt(0)" ::: "memory");
    __syncthreads();
    if (threadIdx.x == 0) {
        unsigned* bar = b.bar;
        __builtin_amdgcn_s_waitcnt(0);
        unsigned nloc = b.st[0], nx = b.st[1];
        if (nloc == 0u) { xcd_barrier_complete(bar, b.x, nloc, nx); b.st[0] = nloc; b.st[1] = nx; }
        const unsigned old = xb_add(&bar[XB_XSUB(b.x)], 1u);
        const unsigned gen = old / nloc;
        if (old + 1u == (gen + 1u) * nloc) {
            __builtin_amdgcn_fence(__ATOMIC_RELEASE, "agent");
            asm volatile("s_waitcnt vmcnt(0)" ::: "memory");
            const unsigned og = xb_add(&bar[XB_TOP], 1u);
            const unsigned tg = og / nx;
            if (og + 1u == (tg + 1u) * nx) xb_add(&bar[XB_TOPGEN], 1u);
            else XB_SPIN(xb_ld(&bar[XB_TOPGEN]) == tg, bar);
            __builtin_amdgcn_fence(__ATOMIC_ACQUIRE, "agent");
            xb_add(&bar[XB_XGEN(b.x)], 1u);
            asm volatile("s_waitcnt vmcnt(0)" ::: "memory");
        } else {
            XB_SPIN(xb_ld(&bar[XB_XGEN(b.x)]) == gen, bar);
            __builtin_amdgcn_fence(__ATOMIC_ACQUIRE, "agent");
            asm volatile("s_waitcnt vmcnt(0)" ::: "memory");
        }
    }
    __syncthreads();
}

struct Frame {
    LAS unsigned char* lds;
    volatile LAS unsigned* MISC;
    unsigned* ctl;
    int tid, lane, wave, vcu, G;
    unsigned char* ws;
    const float *x, *g_mix, *w_in, *w_up, *b_alpha, *g_gla, *w_conv, *w_a, *w_b, *w_out, *g_ffn, *w_router, *b_router, *w_gu, *b_gu, *w_d, *b_d, *g_final;
    float* out;
};
#define WSP(T, off) ((T*)(F.ws + (off)))

__device__ __forceinline__ void tr_item64(const float* W, int ld, int k0, int n0, bf16* WT, size_t dst_row0, int K, LAS unsigned* T, int lane) {
    const int nq = lane & 15, kr = lane >> 4;
    const float* src = W + (size_t)(k0 + 2 * kr) * ld + n0 + 4 * nq;
    f32x4 a0[8], a1[8];
#pragma unroll
    for (int it = 0; it < 8; ++it) { a0[it] = __builtin_nontemporal_load((const f32x4*)(src + (size_t)(8 * it) * ld)); a1[it] = __builtin_nontemporal_load((const f32x4*)(src + (size_t)(8 * it + 1) * ld)); }
    const int c = lane & 7;
#pragma unroll
    for (int hf = 0; hf < 2; ++hf) {
        if ((nq >> 3) == hf) {
#pragma unroll
            for (int it = 0; it < 8; ++it)
#pragma unroll
                for (int q = 0; q < 4; ++q) T[(4 * (nq & 7) + q) * 33 + 4 * it + kr] = pk2(a0[it][q], a1[it][q]);
        }
        LDS_WAIT(); asm volatile("" ::: "memory");
#pragma unroll
        for (int j = 0; j < 4; ++j) { const int n = (lane >> 3) + 8 * j; const LAS unsigned* t = T + n * 33 + 4 * c;
            u32x4 o; o.x = t[0]; o.y = t[1]; o.z = t[2]; o.w = t[3];
            *(u32x4*)(WT + (dst_row0 + 32 * hf + n) * (size_t)K + k0 + 8 * c) = o; }
        LDS_WAIT(); asm volatile("" ::: "memory");
    }
}

__device__ __forceinline__ void tr_item8(const float* W, int ld, int k0, int n0, unsigned char* WT8, size_t dst_row0, int KB, float scale, LAS unsigned* T, int lane) {
    const int nq = lane & 7, kr = lane >> 3;
    const float* src = W + (size_t)(k0 + 4 * kr) * ld + n0 + 4 * nq;
    f32x4 a[4][4];
#pragma unroll
    for (int it = 0; it < 4; ++it)
#pragma unroll
        for (int j = 0; j < 4; ++j) a[it][j] = __builtin_nontemporal_load((const f32x4*)(src + (size_t)(32 * it + j) * ld));
    const int c = lane & 7;
#pragma unroll
    for (int hf = 0; hf < 2; ++hf) {
        if ((nq >> 2) == hf) {
#pragma unroll
            for (int it = 0; it < 4; ++it)
#pragma unroll
                for (int q = 0; q < 4; ++q) T[(4 * (nq & 3) + q) * 33 + 8 * it + kr] = pk4_fp8(a[it][0][q] * scale, a[it][1][q] * scale, a[it][2][q] * scale, a[it][3][q] * scale);
        }
        LDS_WAIT(); asm volatile("" ::: "memory");
#pragma unroll
        for (int j = 0; j < 2; ++j) { const int n = (lane >> 3) + 8 * j; const LAS unsigned* t = T + n * 33 + 4 * c;
            u32x4 o; o.x = t[0]; o.y = t[1]; o.z = t[2]; o.w = t[3];
            *(u32x4*)(WT8 + (dst_row0 + 16 * hf + n) * (size_t)KB + k0 + 16 * c) = o; }
        LDS_WAIT(); asm volatile("" ::: "memory");
    }
}
constexpr int MOE_NIT = NE * 64 * 8 + NE * 32 * 8;
#ifndef MK_MOE_SPLIT
#define MK_MOE_SPLIT 0
#endif
constexpr int MOE_SPLIT = MK_MOE_SPLIT;
__device__ __forceinline__ void moe_convert_range(const float* w_gu, const float* w_d, unsigned char* ws, LAS unsigned* T, int first, int step, int end, int lane) {
    constexpr int I_GU = NE * 64 * 8;
    for (int it = first; it < end; it += step) {
        int r = it;
        if (r < I_GU) { const int e = r >> 9, q = r & 511, kb = q >> 6, nb = q & 63, j0 = 32 * nb, pn = j0 >> 8, within = j0 & 255, half = within >> 7;
            tr_item8(w_gu + (size_t)e * 1024 * 2048, 2048, 128 * kb, half * 1024 + pn * 128 + (within & 127), ws + WS_WGU + (size_t)e * 2048 * 1024, j0, 1024, 32.0f, T, lane); continue; } r -= I_GU;
        { const int e = r >> 8, q = r & 255, kb = q >> 5, nb = q & 31;
            tr_item8(w_d + (size_t)e * 1024 * 1024, 1024, 128 * kb, 32 * nb, ws + WS_WD + (size_t)e * 1024 * 1024, 32 * nb, 1024, 32.0f, T, lane); }
    }
}
__device__ __forceinline__ void moe_convert_share(const float* w_gu, const float* w_d, unsigned char* ws, LAS unsigned char* lds, int c, int G, int wave, int lane) {
    moe_convert_range(w_gu, w_d, ws, (LAS unsigned*)(lds + EXTRA_OFF + wave * 2176), MOE_SPLIT + c * NWAVES + wave, G * NWAVES, MOE_NIT, lane);
}
struct P1Order : pg8::StaticOrder {
    const float* w_gu; const float* w_d; unsigned char* ws; LAS unsigned char* lds; int slot, wave, lane;
    __device__ __forceinline__ void after_unit(int ui) const { if (ui == slot) { int ln = lane; asm volatile("" : "+v"(ln));
            moe_convert_share(w_gu, w_d, ws, lds, c, G, wave, ln); } }
};

constexpr int P0_T_BYTES = 4352;
constexpr int P0_WLD = 2064;
constexpr int P0_WL = 8 * P0_T_BYTES;
constexpr int P0_WU = P0_WL + 16 * P0_WLD;
constexpr int P0_BA = P0_WU + 16384;
constexpr int P0_AS = P0_BA + 2048;

__device__ __forceinline__ void p0_items(Frame& F, const int nrep) {
    LAS unsigned* scr = (LAS unsigned*)(F.lds + F.wave * P0_T_BYTES);
    const int gw = F.vcu * NWAVES + F.wave, NGW = F.G * NWAVES;
    constexpr int I_IN = 128 * 16, I_SQ = 16 * 16;
    constexpr int NITEMS = I_IN + 3 * I_SQ;
    bf16* Win_t = WSP(bf16, WS_WIN);
    for (int it0 = gw; it0 < NITEMS * nrep; it0 += NGW) {
        int r = it0 % NITEMS;
        if (r < I_IN) { const int kb = r >> 7, nb = r & 127, j0 = 64 * nb;
            int srcc = j0 < 3072 ? j0 : j0 + 16;
            if (j0 >= 4096 && j0 < 6144) { const int pn = j0 >> 8, within = j0 & 255; srcc = ((within >> 7) ? 5136 : 4112) + (pn - 16) * 128 + (within & 127); }
            tr_item64(F.w_in, NZS, 64 * kb, srcc, Win_t, j0, 1024, scr, F.lane); continue; } r -= I_IN;
        if (r < I_SQ) { tr_item64(F.w_a, 1024, 64 * (r >> 4), 64 * (r & 15), WSP(bf16, WS_WA), 64 * (r & 15), 1024, scr, F.lane); continue; } r -= I_SQ;
        if (r < I_SQ) { tr_item64(F.w_b, 1024, 64 * (r >> 4), 64 * (r & 15), WSP(bf16, WS_WB), 64 * (r & 15), 1024, scr, F.lane); continue; } r -= I_SQ;
        tr_item64(F.w_out, 1024, 64 * (r >> 4), 64 * (r & 15), WSP(bf16, WS_WO), 64 * (r & 15), 1024, scr, F.lane);
    }
    moe_convert_range(F.w_gu, F.w_d, F.ws, scr, gw, NGW, MOE_SPLIT, F.lane);
}

__device__ __forceinline__ void p0_rows(Frame& F, const int nrep2) {
    const int gw = F.vcu * NWAVES + F.wave, NGW = F.G * NWAVES, lane = F.lane, r32 = lane & 31, h = lane >> 5;
    LAS unsigned char* L = F.lds;
    LAS float* BA = (LAS float*)(L + P0_BA);
    LAS float* AS = (LAS float*)(L + P0_AS + F.wave * 512);
    f32x4 g[4];
#pragma unroll
    for (int j = 0; j < 4; ++j) g[j] = *((const f32x4*)F.g_mix + lane + 64 * j);
    bf16* XN = WSP(bf16, WS_XN); bf16* LA = WSP(bf16, WS_LA);
#pragma unroll 1
    for (int b8 = 0; (b8 * 8) * NGW + gw < M * nrep2; ++b8) {
        f32x4 nx[4];
        { const f32x4* xr = (const f32x4*)(F.x + (size_t)(((b8 * 8) * NGW + gw) % M) * D) + lane;
#pragma unroll
          for (int j = 0; j < 4; ++j) nx[j] = __builtin_nontemporal_load(xr + 64 * j); }
#pragma unroll 1
        for (int i = 0; i < 8; ++i) {
            const int m = ((b8 * 8 + i) * NGW + gw) % M;
            f32x4 v[4]; float s = 0.f;
#pragma unroll
            for (int j = 0; j < 4; ++j) { v[j] = nx[j]; s += (v[j].x * v[j].x + v[j].y * v[j].y) + (v[j].z * v[j].z + v[j].w * v[j].w); }
            if (i < 7) { const f32x4* xr = (const f32x4*)(F.x + (size_t)(((b8 * 8 + i + 1) * NGW + gw) % M) * D) + lane;
#pragma unroll
                for (int j = 0; j < 4; ++j) nx[j] = __builtin_nontemporal_load(xr + 64 * j); }
            const float rstd = 1.0f / sqrtf(wave_sum(s) * (1.f / D) + 1e-6f);
            unsigned long long* o8 = (unsigned long long*)(XN + (size_t)m * D) + lane;
#pragma unroll
            for (int j = 0; j < 4; ++j) { v[j] = v[j] * rstd * g[j]; o8[64 * j] = (unsigned long long)pk2(v[j].x, v[j].y) | ((unsigned long long)pk2(v[j].z, v[j].w) << 32); }
        }
        asm volatile("s_waitcnt vmcnt(0)" ::: "memory");
        {
            const int tl = lane & 7, kg = lane >> 4, rr = lane & 15;
            const bf16* ap = XN + (size_t)(((b8 * 8 + tl) * NGW + gw) % M) * D + 8 * kg;
            const LAS unsigned char* bp = L + P0_WL + rr * P0_WLD + 16 * kg;
            f32x4 ac = {0.f, 0.f, 0.f, 0.f};
#pragma unroll
            for (int k8 = 0; k8 < 4; ++k8) {
                bf16x8 af[8];
#pragma unroll
                for (int q = 0; q < 8; ++q) af[q] = *(const bf16x8*)(ap + 32 * (8 * k8 + q));
#pragma unroll
                for (int q = 0; q < 8; ++q) ac = __builtin_amdgcn_mfma_f32_16x16x32_bf16(af[q], *(const LAS bf16x8*)(bp + 64 * (8 * k8 + q)), ac, 0, 0, 0);
            }
            if (lane < 32) {
#pragma unroll
                for (int q = 0; q < 4; ++q) AS[(4 * kg + q) * 16 + rr] = ac[q]; }
        }
        {
            f32x4 a0 = {0.f, 0.f, 0.f, 0.f}, a1 = a0;
            if (r32 < 8) { a0 = *(const LAS f32x4*)(AS + r32 * 16 + 8 * h); a1 = *(const LAS f32x4*)(AS + r32 * 16 + 8 * h + 4); }
            u32x4 hi, lo;
            hi.x = pk2(a0[0], a0[1]); hi.y = pk2(a0[2], a0[3]); hi.z = pk2(a1[0], a1[1]); hi.w = pk2(a1[2], a1[3]);
            lo.x = pk2(a0[0] - bf_lo(hi.x), a0[1] - bf_hi(hi.x)); lo.y = pk2(a0[2] - bf_lo(hi.y), a0[3] - bf_hi(hi.y)); lo.z = pk2(a1[0] - bf_lo(hi.z), a1[1] - bf_hi(hi.z)); lo.w = pk2(a1[2] - bf_lo(hi.w), a1[3] - bf_hi(hi.w));
            const bf16x8 ahi = __builtin_bit_cast(bf16x8, hi), alo = __builtin_bit_cast(bf16x8, lo);
            int mrow[4];
#pragma unroll
            for (int q = 0; q < 4; ++q) mrow[q] = ((b8 * 8 + q + 4 * h) * NGW + gw) % M;
#pragma unroll 4
            for (int nt = 0; nt < 16; ++nt) {
                const bf16x8 bw = *(const LAS bf16x8*)(L + P0_WU + (32 * nt + r32) * 32 + 16 * h);
                f32x16 c16;
#pragma unroll
                for (int q = 0; q < 16; ++q) c16[q] = 0.f;
                c16 = __builtin_amdgcn_mfma_f32_32x32x16_bf16(ahi, bw, c16, 0, 0, 0);
                c16 = __builtin_amdgcn_mfma_f32_32x32x16_bf16(alo, bw, c16, 0, 0, 0);
                const float bb = BA[32 * nt + r32];
#pragma unroll
                for (int q = 0; q < 4; ++q) { const float pre = c16[q] + bb;
                    const float ls = fminf(pre, 0.f) - __logf(1.0f + __expf(-fabsf(pre)));
                    LA[((size_t)(nt >> 2) * M + mrow[q]) * 128 + 32 * (nt & 3) + r32] = (bf16)(pk2(ls * (1.0f / 16.0f), 0.f) & 0xffffu); }
            }
        }
    }
}

__device__ __forceinline__ void p0_prologue(Frame& F, const int nrep, const int nrep2) {
    {
        LAS unsigned char* L = F.lds;
        for (int i = 0; i < 32; ++i) { const int idx = F.tid + 512 * i, k = idx >> 4, r = idx & 15; *(LAS bf16*)(L + P0_WL + r * P0_WLD + 2 * k) = (bf16)(pk2(F.w_in[(size_t)k * NZS + 3072 + r], 0.f) & 0xffffu); }
        for (int i = 0; i < 16; ++i) { const int idx = F.tid + 512 * i, r = idx >> 9, n = idx & 511; *(LAS bf16*)(L + P0_WU + n * 32 + 2 * r) = (bf16)(pk2(F.w_up[idx], 0.f) & 0xffffu); }
        ((LAS float*)(L + P0_BA))[F.tid] = F.b_alpha[F.tid];
        __syncthreads();
    }
#pragma unroll 1
    for (int pass = 0; pass < 2; ++pass) {
        if (((pass ^ F.wave) & 1) == 0) p0_items(F, nrep); else p0_rows(F, nrep2);
    }
}

struct EpiZ {
    static constexpr bool PERM = true;
    bf16* Z;
    __device__ __forceinline__ void operator()(const f32x4 (&acc)[2][2][4][2], const pg8::Unit& u, int wr, int wc, int fr, int fq) const {
        const int row0 = u.pm * 256 + wr * 64 + fr, c0 = wc * 32 + 8 * fq;
        const int pn = u.pn;
        const int kind = pn < 2 ? 1 : (pn < 8 ? 0 : (pn < 12 ? 2 : (pn < 24 ? 0 : 3)));
        bf16* base; int ld; size_t bjs;
        if (pn < 4) { base = Z + (pn < 2 ? ZQ : ZK) + (size_t)(2 * (pn & 1)) * M * 128; ld = 128; bjs = (size_t)M * 128; }
        else if (pn < 12) { base = Z + (pn < 8 ? ZV : ZR) + (size_t)(pn & 3) * M * 256; ld = 256; bjs = 128; }
        else { const int t = (pn - 12) >> 2; base = Z + ZCB + (size_t)t * M * 1024 + (size_t)((pn - 12) & 3) * 256; ld = 1024; bjs = 128; }
        if (pn >= 16 && pn < 24) {
            bf16* ub = Z + ZCC + (size_t)(pn - 16) * 128;
#pragma unroll
            for (int ai = 0; ai < 2; ++ai)
#pragma unroll
                for (int m = 0; m < 4; ++m) { const f32x4 v0 = acc[ai][0][m][0] * acc[ai][1][m][0], v1 = acc[ai][0][m][1] * acc[ai][1][m][1];
                    u32x4 w; w.x = pk2(v0[0], v0[1]); w.y = pk2(v0[2], v0[3]); w.z = pk2(v1[0], v1[1]); w.w = pk2(v1[2], v1[3]);
                    *(u32x4*)(ub + (size_t)(row0 + ai * 128 + m * 16) * 1024 + c0) = w; }
            return;
        }
#pragma unroll
        for (int ai = 0; ai < 2; ++ai)
#pragma unroll
            for (int m = 0; m < 4; ++m) { bf16* rowp = base + (size_t)(row0 + ai * 128 + m * 16) * ld + c0;
#pragma unroll
                for (int bj = 0; bj < 2; ++bj) { f32x4 v0 = acc[ai][bj][m][0], v1 = acc[ai][bj][m][1];
                    if (kind == 1) { v0 = v0 * 0.08838834764831845f; v1 = v1 * 0.08838834764831845f; }
                    else if (kind == 2) {
#pragma unroll
                        for (int j = 0; j < 4; ++j) { v0[j] = v0[j] * fast_sigmoid(v0[j]); v1[j] = v1[j] * fast_sigmoid(v1[j]); } }
                    else if (kind == 3) {
#pragma unroll
                        for (int j = 0; j < 4; ++j) { v0[j] = fast_sigmoid(v0[j]); v1[j] = fast_sigmoid(v1[j]); } }
                    u32x4 w; w.x = pk2(v0[0], v0[1]); w.y = pk2(v0[2], v0[3]); w.z = pk2(v1[0], v1[1]); w.w = pk2(v1[2], v1[3]);
                    *(u32x4*)(rowp + bj * bjs) = w; } }
    }
};

constexpr int QD_STRIDE = 272, KT_STRIDE = 144, SC_STRIDE = 144, OT_STRIDE = 1040;
constexpr int L_QD = 0, L_KI = 17408, L_KT = 34816, L_SC = 53248, L_DEC = 62464, L_SEG = 62976, L_OT = 67584;
__device__ __forceinline__ int crow(int reg, int h) { return (reg & 3) + 8 * (reg >> 2) + 4 * h; }

template <bool OUT>
__device__ __forceinline__ void gla_item(Frame& F, int item) {
    const int bh = item >> 3, sc = item & 7, b = bh >> 2, hd = bh & 3;
    const int t0 = b * SEQ + sc * 256;
    const int tid = F.tid, lane = F.lane, w = F.wave, r32 = lane & 31, h = lane >> 5;
    const bf16* Z = WSP(const bf16, WS_Z);
    const bf16* LA = WSP(const bf16, WS_LA);
    LAS unsigned char* L = F.lds;
    f32x16 S[4];
    unsigned* Sbuf = (OUT ? WSP(unsigned, WS_SIN) : WSP(unsigned, WS_U)) + (size_t)item * 16384 + (size_t)w * 2048;
    if (OUT) {
#pragma unroll
        for (int kb = 0; kb < 4; ++kb)
#pragma unroll
            for (int r = 0; r < 16; r += 2) { const unsigned pw = Sbuf[(kb * 8 + (r >> 1)) * 64 + lane]; S[kb][r] = bf_lo(pw); S[kb][r + 1] = bf_hi(pw); }
    } else {
#pragma unroll
        for (int kb = 0; kb < 4; ++kb)
#pragma unroll
            for (int r = 0; r < 16; ++r) S[kb][r] = 0.f;
    }
    float btot_run0 = 0.f, btot_run1 = 0.f;
    const int tok_n = tid >> 3, part = tid & 7;
    unsigned la2[8], kk[8], qq[8]; bf16x8 Bv[4]; u32x4 rc[4];
#define GLA_LOAD(tcx) do { \
        const size_t rb_ = ((size_t)hd * M + (tcx) + 8 * w) * 128 + 2 * lane; \
        _Pragma("unroll") for (int i = 0; i < 8; ++i) { la2[i] = *(const unsigned*)(LA + rb_ + (size_t)i * 128); kk[i] = *(const unsigned*)(Z + ZK + rb_ + (size_t)i * 128); if (OUT) qq[i] = *(const unsigned*)(Z + ZQ + rb_ + (size_t)i * 128); } \
    } while (0)
#define GLA_LOADV(tcx) do { \
        _Pragma("unroll") for (int ks = 0; ks < 4; ++ks) _Pragma("unroll") for (int j = 0; j < 8; ++j) Bv[ks][j] = (short)Z[ZV + ((size_t)hd * M + (tcx) + 16 * ks + 8 * h + j) * 256 + 32 * w + r32]; \
    } while (0)
#define GLA_LOADR(tcx) do { \
        if (OUT) { const u32x4* rp_ = (const u32x4*)(Z + ZR + ((size_t)hd * M + (tcx) + tok_n) * 256 + 32 * part); _Pragma("unroll") for (int i = 0; i < 4; ++i) rc[i] = __builtin_nontemporal_load(rp_ + i); } \
    } while (0)
    GLA_LOAD(t0); GLA_LOADV(t0);
#pragma unroll 1
    for (int c = 0; c < 4; ++c) {
        const int tc = t0 + c * 64;
        float p0[8], p1[8];
        { float r0 = 0.f, r1 = 0.f;
#pragma unroll
          for (int i = 0; i < 8; ++i) { r0 += bf_lo(la2[i]); r1 += bf_hi(la2[i]); p0[i] = r0; p1[i] = r1; }
          *(LAS f32x2*)(L + L_SEG + (w * 128 + 2 * lane) * 4) = (f32x2){r0, r1}; }
        GLA_LOADR(tc);
        __syncthreads();
        float off0 = 0.f, off1 = 0.f, bt0 = 0.f, bt1 = 0.f;
#pragma unroll
        for (int sgi = 0; sgi < 8; ++sgi) { const f32x2 sv = *(const LAS f32x2*)(L + L_SEG + (sgi * 128 + 2 * lane) * 4); if (sgi < w) { off0 += sv.x; off1 += sv.y; } bt0 += sv.x; bt1 += sv.y; }
        if (w == 0) { *(LAS f32x2*)(L + L_DEC + 8 * lane) = (f32x2){__expf(bt0), __expf(bt1)}; btot_run0 += bt0; btot_run1 += bt1; }
        {
            unsigned kt0[4], kt1[4];
#pragma unroll
            for (int i = 0; i < 8; i += 2) {
                const float b00 = off0 + p0[i], b01 = off1 + p1[i], b10 = off0 + p0[i + 1], b11 = off1 + p1[i + 1];
                const float k00 = bf_lo(kk[i]), k01 = bf_hi(kk[i]), k10 = bf_lo(kk[i + 1]), k11 = bf_hi(kk[i + 1]);
                kt0[i >> 1] = pk2(k00 * __expf(bt0 - b00), k10 * __expf(bt0 - b10));
                kt1[i >> 1] = pk2(k01 * __expf(bt1 - b01), k11 * __expf(bt1 - b11));
                if (OUT) {
                    const float q00 = bf_lo(qq[i]), q01 = bf_hi(qq[i]), q10 = bf_lo(qq[i + 1]), q11 = bf_hi(qq[i + 1]);
                    *(LAS unsigned*)(L + L_QD + (8 * w + i) * QD_STRIDE + 4 * lane) = pk2(q00 * __expf(b00), q01 * __expf(b01));
                    *(LAS unsigned*)(L + L_QD + (8 * w + i + 1) * QD_STRIDE + 4 * lane) = pk2(q10 * __expf(b10), q11 * __expf(b11));
                    *(LAS unsigned*)(L + L_KI + (8 * w + i) * QD_STRIDE + 4 * lane) = pk2(k00 * __expf(-b00), k01 * __expf(-b01));
                    *(LAS unsigned*)(L + L_KI + (8 * w + i + 1) * QD_STRIDE + 4 * lane) = pk2(k10 * __expf(-b10), k11 * __expf(-b11));
                }
            }
            *(LAS u32x4*)(L + L_KT + (2 * lane) * KT_STRIDE + 16 * w) = (u32x4){kt0[0], kt0[1], kt0[2], kt0[3]};
            *(LAS u32x4*)(L + L_KT + (2 * lane + 1) * KT_STRIDE + 16 * w) = (u32x4){kt1[0], kt1[1], kt1[2], kt1[3]};
        }
        __syncthreads();
        if (c < 3) GLA_LOAD(tc + 64);
        f32x16 o[2];
        if (OUT) {
            if (w < 3) {
                const int ib = w == 0 ? 0 : 1, jb = w == 2 ? 1 : 0;
                f32x16 sacc;
#pragma unroll
                for (int r = 0; r < 16; ++r) sacc[r] = 0.f;
#pragma unroll
                for (int kb = 0; kb < 8; ++kb) {
                    const bf16x8 a = *(const LAS bf16x8*)(L + L_QD + (32 * ib + r32) * QD_STRIDE + 2 * (16 * kb + 8 * h));
                    const bf16x8 bb = *(const LAS bf16x8*)(L + L_KI + (32 * jb + r32) * QD_STRIDE + 2 * (16 * kb + 8 * h));
                    sacc = __builtin_amdgcn_mfma_f32_32x32x16_bf16(a, bb, sacc, 0, 0, 0);
                }
#pragma unroll
                for (int r = 0; r < 16; r += 1) {
                    const int i = 32 * ib + crow(r, h), j = 32 * jb + r32;
                    const float v = (j <= i) ? sacc[r] : 0.f;
                    *(LAS bf16*)(L + L_SC + i * SC_STRIDE + 2 * j) = (bf16)(pk2(v, 0.f) & 0xffffu);
                }
            }
#pragma unroll
            for (int ib = 0; ib < 2; ++ib)
#pragma unroll
                for (int r = 0; r < 16; ++r) o[ib][r] = 0.f;
#pragma unroll
            for (int kb = 0; kb < 4; ++kb)
#pragma unroll
                for (int s2 = 0; s2 < 2; ++s2) {
                    u32x4 pb; pb.x = pk2(S[kb][8 * s2 + 0], S[kb][8 * s2 + 1]); pb.y = pk2(S[kb][8 * s2 + 2], S[kb][8 * s2 + 3]); pb.z = pk2(S[kb][8 * s2 + 4], S[kb][8 * s2 + 5]); pb.w = pk2(S[kb][8 * s2 + 6], S[kb][8 * s2 + 7]);
                    const bf16x8 bfrag = __builtin_bit_cast(bf16x8, pb);
#pragma unroll
                    for (int ib = 0; ib < 2; ++ib) {
                        const LAS unsigned char* qp = L + L_QD + (32 * ib + r32) * QD_STRIDE + 2 * (32 * kb + 16 * s2 + 4 * h);
                        const u32x2 lo = *(const LAS u32x2*)qp, hi = *(const LAS u32x2*)(qp + 16);
                        const bf16x8 afrag = __builtin_bit_cast(bf16x8, (u32x4){lo.x, lo.y, hi.x, hi.y});
                        o[ib] = __builtin_amdgcn_mfma_f32_32x32x16_bf16(afrag, bfrag, o[ib], 0, 0, 0);
                    }
                }
            __syncthreads();
#pragma unroll
            for (int ks = 0; ks < 4; ++ks)
#pragma unroll
                for (int ib = 0; ib < 2; ++ib) {
                    if (ib == 0 && ks >= 2) continue;
                    const bf16x8 a = *(const LAS bf16x8*)(L + L_SC + (32 * ib + r32) * SC_STRIDE + 2 * (16 * ks + 8 * h));
                    o[ib] = __builtin_amdgcn_mfma_f32_32x32x16_bf16(a, Bv[ks], o[ib], 0, 0, 0);
                }
        }
#pragma unroll
        for (int kb = 0; kb < 4; ++kb) {
#pragma unroll
            for (int g4 = 0; g4 < 4; ++g4) { const f32x4 dc = *(const LAS f32x4*)(L + L_DEC + 4 * (32 * kb + 8 * g4 + 4 * h));
#pragma unroll
                for (int j = 0; j < 4; ++j) S[kb][4 * g4 + j] *= dc[j]; }
#pragma unroll
            for (int ks = 0; ks < 4; ++ks) {
                const bf16x8 a = *(const LAS bf16x8*)(L + L_KT + (32 * kb + r32) * KT_STRIDE + 2 * (16 * ks + 8 * h));
                S[kb] = __builtin_amdgcn_mfma_f32_32x32x16_bf16(a, Bv[ks], S[kb], 0, 0, 0);
            }
        }
        if (c < 3) GLA_LOADV(tc + 64);
        if (OUT) {
#pragma unroll
            for (int ib = 0; ib < 2; ++ib)
#pragma unroll
                for (int r = 0; r < 16; ++r) *(LAS float*)(L + L_OT + (32 * ib + crow(r, h)) * OT_STRIDE + 4 * (32 * w + r32)) = o[ib][r];
            __syncthreads();
            f32x4 ov[8]; float ss = 0.f;
#pragma unroll
            for (int i = 0; i < 8; ++i) { ov[i] = *(const LAS f32x4*)(L + L_OT + tok_n * OT_STRIDE + 4 * (32 * part + 4 * i)); ss += (ov[i].x * ov[i].x + ov[i].y * ov[i].y) + (ov[i].z * ov[i].z + ov[i].w * ov[i].w); }
            ss += __shfl_xor(ss, 1); ss += __shfl_xor(ss, 2); ss += __shfl_xor(ss, 4);
            const float rs = 1.0f / sqrtf(ss * (1.0f / 256.0f) + 1e-6f);
            const size_t trow = (size_t)(tc + tok_n);
            const f32x4* gp = (const f32x4*)(F.g_gla + hd * 256 + 32 * part);
            u32x4* op = (u32x4*)(WSP(bf16, WS_OG) + trow * 1024 + hd * 256 + 32 * part);
#pragma unroll
            for (int i = 0; i < 4; ++i) {
                const u32x4 rr = rc[i]; const f32x4 g0 = gp[2 * i], g1 = gp[2 * i + 1]; const f32x4 a0 = ov[2 * i], a1 = ov[2 * i + 1];
                u32x4 ow;
                ow.x = pk2(a0.x * rs * g0.x * bf_lo(rr.x), a0.y * rs * g0.y * bf_hi(rr.x));
                ow.y = pk2(a0.z * rs * g0.z * bf_lo(rr.y), a0.w * rs * g0.w * bf_hi(rr.y));
                ow.z = pk2(a1.x * rs * g1.x * bf_lo(rr.z), a1.y * rs * g1.y * bf_hi(rr.z));
                ow.w = pk2(a1.z * rs * g1.z * bf_lo(rr.w), a1.w * rs * g1.w * bf_hi(rr.w));
                op[i] = ow;
            }
        }
    }
#undef GLA_LOAD
#undef GLA_LOADV
#undef GLA_LOADR
    if (!OUT) {
#pragma unroll
        for (int kb = 0; kb < 4; ++kb)
#pragma unroll
            for (int r = 0; r < 16; r += 2) Sbuf[(kb * 8 + (r >> 1)) * 64 + lane] = pk2(S[kb][r], S[kb][r + 1]);
        if (w == 0) *(f32x2*)(WSP(float, WS_DECS) + item * 128 + 2 * lane) = (f32x2){__expf(btot_run0), __expf(btot_run1)};
    }
    __syncthreads();
}

__device__ __forceinline__ void conv_rows(Frame& F, const int nrep) {
    const int gw = F.vcu * NWAVES + F.wave, NGW = F.G * NWAVES;
    const bf16* Z = WSP(const bf16, WS_Z); bf16* PB = WSP(bf16, WS_PB);
    for (int blk0 = gw; blk0 < (M / 8) * nrep; blk0 += NGW) {
        const int blk = blk0 % (M / 8);
        const int m0 = blk * 8, s0 = m0 % SEQ;
#pragma unroll 1
        for (int j = 0; j < 2; ++j) {
            const int c = 8 * F.lane + 512 * j;
            const size_t rp = (size_t)(s0 > 0 ? m0 - 2 : m0);
            const u32x4 p2c = *(const u32x4*)(Z + ZCC + rp * 1024 + c);
            const u32x4 p1c = *(const u32x4*)(Z + ZCC + (rp + 1) * 1024 + c);
            float w0[8], w1[8], w2[8];
#pragma unroll
            for (int i = 0; i < 8; ++i) { w0[i] = F.w_conv[c + i]; w1[i] = F.w_conv[1024 + c + i]; w2[i] = F.w_conv[2048 + c + i]; }
            float u1[8], u2[8];
            const float keep = s0 > 0 ? 1.0f : 0.0f;
#pragma unroll
            for (int i = 0; i < 4; ++i) { u2[2 * i] = keep * bf_lo(p2c[i]); u2[2 * i + 1] = keep * bf_hi(p2c[i]); u1[2 * i] = keep * bf_lo(p1c[i]); u1[2 * i + 1] = keep * bf_hi(p1c[i]); }
#pragma unroll
            for (int hb = 0; hb < 2; ++hb) {
                u32x4 cc[4], cb[4];
#pragma unroll
                for (int rr = 0; rr < 4; ++rr) { const size_t row = (size_t)(m0 + 4 * hb + rr); cc[rr] = __builtin_nontemporal_load((const u32x4*)(Z + ZCC + row * 1024 + c)); cb[rr] = __builtin_nontemporal_load((const u32x4*)(Z + ZCB + row * 1024 + c)); }
#pragma unroll
                for (int rr = 0; rr < 4; ++rr) {
                    float u0[8], y[8];
#pragma unroll
                    for (int i = 0; i < 4; ++i) { u0[2 * i] = bf_lo(cc[rr][i]); u0[2 * i + 1] = bf_hi(cc[rr][i]); }
#pragma unroll
                    for (int i = 0; i < 8; ++i) y[i] = w0[i] * u2[i] + w1[i] * u1[i] + w2[i] * u0[i];
                    u32x4 ow;
#pragma unroll
                    for (int i = 0; i < 4; ++i) ow[i] = pk2(bf_lo(cb[rr][i]) * y[2 * i], bf_hi(cb[rr][i]) * y[2 * i + 1]);
                    *(u32x4*)(PB + (size_t)(m0 + 4 * hb + rr) * 1024 + c) = ow;
#pragma unroll
                    for (int i = 0; i < 8; ++i) { u2[i] = u1[i]; u1[i] = u0[i]; }
                }
                asm volatile("" ::: "memory");
            }
        }
    }
}

__device__ __forceinline__ void gla_scan(Frame& F, const int nrep) {
    const unsigned* U = WSP(const unsigned, WS_U); unsigned* SIN = WSP(unsigned, WS_SIN); const float* DECS = WSP(const float, WS_DECS);
    const int gt = F.vcu * 512 + F.tid, NT = F.G * 512;
    for (int idx0 = gt; idx0 < 32 * 16384 * nrep; idx0 += NT) {
        const int idx = idx0 & (32 * 16384 - 1);
        const int bh = idx >> 14, e = idx & 16383;
        const int ln = e & 63, rp = (e >> 6) & 7, kb = (e >> 9) & 3;
        const int dk = 32 * kb + crow(2 * rp, ln >> 5);
        float s0 = 0.f, s1 = 0.f;
        unsigned uw[8];
#pragma unroll
        for (int sc = 0; sc < 8; ++sc) uw[sc] = U[(size_t)(bh * 8 + sc) * 16384 + e];
#pragma unroll
        for (int sc = 0; sc < 8; ++sc) {
            const int item = bh * 8 + sc;
            SIN[(size_t)item * 16384 + e] = pk2(s0, s1);
            const f32x2 dc = *(const f32x2*)(DECS + item * 128 + dk);
            s0 = dc.x * s0 + bf_lo(uw[sc]); s1 = dc.y * s1 + bf_hi(uw[sc]);
        }
    }
}

struct P3Order : pg8::StaticOrder {
    __device__ __forceinline__ bool next(int i, pg8::Unit& u) const {
        if (!pg8::StaticOrder::next(i >> 1, u)) return false;
        u.e = i & 1; u.pn += 4 * u.e; return true;
    }
    __device__ __forceinline__ unsigned arow(const pg8::Unit& u, int ui, int r) const { return (unsigned)(u.e * M + u.pm * 256 + r) * 2048u; }
    __device__ __forceinline__ void after_unit(int ui) const {}
};
struct EpiBranch {
    static constexpr bool PERM = true;
    const bf16* Z; bf16* M1; bf16* MIX;
    __device__ __forceinline__ void operator()(const f32x4 (&acc)[2][2][4][2], const pg8::Unit& u, int wr, int wc, int fr, int fq) const {
        const int row0 = u.pm * 256 + wr * 64 + fr, col0 = (u.pn & 3) * 256 + wc * 32 + 8 * fq;
        const bf16* G = Z + (u.e ? ZGB : ZGA);
#pragma unroll
        for (int ai = 0; ai < 2; ++ai)
#pragma unroll
            for (int m = 0; m < 4; ++m) { const size_t row = (size_t)(row0 + ai * 128 + m * 16);
#pragma unroll
                for (int bj = 0; bj < 2; ++bj) { const u32x4 sg = *(const u32x4*)(G + row * 1024 + col0 + bj * 128);
                    const f32x4 v0 = acc[ai][bj][m][0], v1 = acc[ai][bj][m][1];
                    float r[8] = {v0[0] * bf_lo(sg.x), v0[1] * bf_hi(sg.x), v0[2] * bf_lo(sg.y), v0[3] * bf_hi(sg.y), v1[0] * bf_lo(sg.z), v1[1] * bf_hi(sg.z), v1[2] * bf_lo(sg.w), v1[3] * bf_hi(sg.w)};
                    if (u.e) { const u32x4 mm = *(const u32x4*)(M1 + row * 1024 + col0 + bj * 128);
                        r[0] += bf_lo(mm.x); r[1] += bf_hi(mm.x); r[2] += bf_lo(mm.y); r[3] += bf_hi(mm.y); r[4] += bf_lo(mm.z); r[5] += bf_hi(mm.z); r[6] += bf_lo(mm.w); r[7] += bf_hi(mm.w); }
                    u32x4 w; w.x = pk2(r[0], r[1]); w.y = pk2(r[2], r[3]); w.z = pk2(r[4], r[5]); w.w = pk2(r[6], r[7]);
                    *(u32x4*)((u.e ? MIX : M1) + row * 1024 + col0 + bj * 128) = w; } }
    }
};
struct EpiX1 {
    static constexpr bool PERM = true;
    const float* x; bf16* X1;
    __device__ __forceinline__ void operator()(const f32x4 (&acc)[2][2][4][2], const pg8::Unit& u, int wr, int wc, int fr, int fq) const {
        const int row0 = u.pm * 256 + wr * 64 + fr, col0 = u.pn * 256 + wc * 32 + 8 * fq;
#pragma unroll
        for (int ai = 0; ai < 2; ++ai)
#pragma unroll
            for (int m = 0; m < 4; ++m) { const size_t off = (size_t)(row0 + ai * 128 + m * 16) * 1024 + col0;
#pragma unroll
                for (int bj = 0; bj < 2; ++bj) { const f32x4 x0 = __builtin_nontemporal_load((const f32x4*)(x + off + bj * 128)), x1 = __builtin_nontemporal_load((const f32x4*)(x + off + bj * 128 + 4));
                    const f32x4 v0 = x0 + acc[ai][bj][m][0], v1 = x1 + acc[ai][bj][m][1];
                    u32x4 w; w.x = pk2(v0[0], v0[1]); w.y = pk2(v0[2], v0[3]); w.z = pk2(v1[0], v1[1]); w.w = pk2(v1[2], v1[3]);
                    *(u32x4*)(X1 + off + bj * 128) = w; } }
    }
};

constexpr int P5_WLD = 2064;
constexpr int P5_WH = 0, P5_WL = 32 * P5_WLD;
constexpr int P5_RSTD = 133120, P5_LOGT = 133376;
constexpr int P5_HIST = 141824, P5_BASE = P5_HIST + 128, P5_PLE = P5_HIST + 256;
__device__ __forceinline__ void p5_router(Frame& F) {
    LAS unsigned char* L = F.lds;
    LAS float* RSTD = (LAS float*)(L + P5_RSTD); LAS float* LOGT = (LAS float*)(L + P5_LOGT);
    LAS int* hist = (LAS int*)(L + P5_HIST); LAS int* base = (LAS int*)(L + P5_BASE); LAS int* ple = (LAS int*)(L + P5_PLE);
    const bf16* X1 = WSP(const bf16, WS_X1); unsigned char* H2 = WSP(unsigned char, WS_XN);
    unsigned* cnt = F.ctl + CW_CNT; int* list = WSP(int, WS_LIST); float* gate = WSP(float, WS_GATE);
    const int lane = F.lane, w = F.wave, r32 = lane & 31, h = lane >> 5;
    f32x4 g[4];
#pragma unroll
    for (int j = 0; j < 4; ++j) g[j] = *((const f32x4*)F.g_ffn + lane + 64 * j);
    for (int grp = F.vcu; grp < M / 64; grp += F.G) {
        for (int i = 0; i < 64; ++i) { const int idx = F.tid + 512 * i, k = idx >> 5, e = idx & 31; const float wv = F.w_router[idx] * F.g_ffn[k];
            const unsigned hi = pk2(wv, 0.f) & 0xffffu; const float rem = wv - __builtin_bit_cast(float, hi << 16);
            *(LAS bf16*)(L + P5_WH + e * P5_WLD + 2 * k) = (bf16)hi; *(LAS bf16*)(L + P5_WL + e * P5_WLD + 2 * k) = (bf16)(pk2(rem, 0.f) & 0xffffu); }
        if (F.tid < 32) hist[F.tid] = 0;
        const size_t tok0 = (size_t)grp * 64;
        { u32x2 xv[8][4];
#pragma unroll
          for (int i = 0; i < 8; ++i) { const u32x2* xa = (const u32x2*)(X1 + (tok0 + 8 * w + i) * D) + lane;
#pragma unroll
              for (int j = 0; j < 4; ++j) xv[i][j] = xa[64 * j]; }
#pragma unroll
          for (int i = 0; i < 8; ++i) { f32x4 v[4]; float ss = 0.f;
#pragma unroll
              for (int j = 0; j < 4; ++j) { v[j] = (f32x4){bf_lo(xv[i][j].x), bf_hi(xv[i][j].x), bf_lo(xv[i][j].y), bf_hi(xv[i][j].y)};
#pragma unroll
                  for (int c = 0; c < 4; ++c) ss = fmaf(v[j][c], v[j][c], ss); }
              const float rs = 1.0f / sqrtf(wave_sum(ss) * (1.f / D) + 1e-6f);
              if (lane == 0) RSTD[8 * w + i] = rs;
              unsigned* o4 = (unsigned*)(H2 + (tok0 + 8 * w + i) * D) + lane;
#pragma unroll
              for (int j = 0; j < 4; ++j) { const f32x4 hv = v[j] * rs * g[j]; o4[64 * j] = pk4_fp8(hv.x, hv.y, hv.z, hv.w); } } }
        bf16x8 af[2][8];
        { const bf16* xa = X1 + (tok0 + r32) * D + 128 * w + 8 * h;
#pragma unroll
          for (int mt = 0; mt < 2; ++mt)
#pragma unroll
              for (int ks = 0; ks < 8; ++ks) af[mt][ks] = *(const bf16x8*)(xa + (size_t)mt * 32 * D + 16 * ks); }
        __syncthreads();
        f32x16 acc[2];
#pragma unroll
        for (int mt = 0; mt < 2; ++mt)
#pragma unroll
            for (int r = 0; r < 16; ++r) acc[mt][r] = 0.f;
#pragma unroll
        for (int ks = 0; ks < 8; ++ks) {
            const bf16x8 bh = *(const LAS bf16x8*)(L + P5_WH + r32 * P5_WLD + 2 * (128 * w + 16 * ks + 8 * h));
            const bf16x8 bl = *(const LAS bf16x8*)(L + P5_WL + r32 * P5_WLD + 2 * (128 * w + 16 * ks + 8 * h));
#pragma unroll
            for (int mt = 0; mt < 2; ++mt) { acc[mt] = __builtin_amdgcn_mfma_f32_32x32x16_bf16(af[mt][ks], bh, acc[mt], 0, 0, 0); acc[mt] = __builtin_amdgcn_mfma_f32_32x32x16_bf16(af[mt][ks], bl, acc[mt], 0, 0, 0); }
        }
        __syncthreads();
#pragma unroll
        for (int mt = 0; mt < 2; ++mt)
#pragma unroll
            for (int r = 0; r < 16; ++r) *(LAS float*)(L + ((w * 64 + 32 * mt + crow(r, h)) * 32 + r32) * 4) = acc[mt][r];
        __syncthreads();
        { const int tk = F.tid >> 3, eq = F.tid & 7;
          f32x4 sum = *(const LAS f32x4*)(L + ((0 * 64 + tk) * 32 + 4 * eq) * 4);
#pragma unroll
          for (int ww = 1; ww < 8; ++ww) sum = sum + *(const LAS f32x4*)(L + ((ww * 64 + tk) * 32 + 4 * eq) * 4);
          const float rs = RSTD[tk]; const f32x4 bb = *(const f32x4*)(F.b_router + 4 * eq);
#pragma unroll
          for (int c = 0; c < 4; ++c) LOGT[tk * 33 + 4 * eq + c] = sum[c] * rs + bb[c]; }
        __syncthreads();
        if (F.tid < 64) {
            const int tk = F.tid; float tv[4]; int ti[4];
#pragma unroll
            for (int k = 0; k < 4; ++k) { float bv = -3.0e38f; int bi = 0;
                for (int e = 0; e < 32; ++e) { const float v = LOGT[tk * 33 + e]; if (v > bv) { bv = v; bi = e; } }
                tv[k] = bv; ti[k] = bi; LOGT[tk * 33 + bi] = -3.0e38f; }
            const float e1 = __expf(tv[1] - tv[0]), e2 = __expf(tv[2] - tv[0]), e3 = __expf(tv[3] - tv[0]);
            const float inv = 1.0f / (1.0f + e1 + e2 + e3);
            const float gk[4] = {inv, e1 * inv, e2 * inv, e3 * inv};
#pragma unroll
            for (int k = 0; k < 4; ++k) { const int lr = __hip_atomic_fetch_add(&hist[ti[k]], 1, __ATOMIC_RELAXED, __HIP_MEMORY_SCOPE_WORKGROUP);
                ple[tk * 4 + k] = ti[k] | (lr << 8); gate[(tok0 + tk) * 4 + k] = gk[k]; }
        }
        __syncthreads();
        if (F.tid < 32) base[F.tid] = (int)__hip_atomic_fetch_add(cnt + F.tid, (unsigned)hist[F.tid], RLX_AGENT);
        __syncthreads();
        if (F.tid < 256) { const int pe = ple[F.tid], e = pe & 255, lr = pe >> 8; list[e * CAP + base[e] + lr] = (grp * 64) * 4 + F.tid; }
        __syncthreads();
    }
}

#ifndef MK_MAXU
#define MK_MAXU 12
#endif
constexpr int MAXU = MK_MAXU;
template <int NP>
struct MoeOrder {
    LAS const int* rt0;
    LAS const int* tokl;
    int nwg, G, c, reps;
    __device__ __forceinline__ bool next(int i, pg8::Unit& u) const {
        const long L = (long)i * G + c; if (L >= (long)nwg * reps) return false;
        int wgid = (int)(L % nwg); { const int q = nwg / 8, r = nwg % 8, xcd = wgid % 8, off = wgid / 8; wgid = (xcd < r ? xcd * (q + 1) : r * (q + 1) + (xcd - r) * q) + off; }
        int e = 0;
#pragma unroll 1
        for (int j = 1; j < 32; ++j) if (wgid >= NP * rt0[j]) e = j;
        const int l = wgid - NP * rt0[e], nte = rt0[e + 1] - rt0[e];
        const int pn = l / nte, rt = l - pn * nte;
        u.pm = __builtin_amdgcn_readfirstlane(rt0[e] + rt); u.pn = __builtin_amdgcn_readfirstlane(e * NP + pn); u.e = __builtin_amdgcn_readfirstlane(e); u.rt = __builtin_amdgcn_readfirstlane(rt); return true;
    }
};
struct MoeOrder1 : MoeOrder<8> {
    __device__ __forceinline__ void after_unit(int ui) const {}
    __device__ __forceinline__ unsigned arow(const pg8::Unit& u, int ui, int r) const { return (unsigned)tokl[ui * 256 + r] * 1024u; }
};
struct MoeOrder2 : MoeOrder<4> {
    __device__ __forceinline__ void after_unit(int ui) const {}
    __device__ __forceinline__ unsigned arow(const pg8::Unit& u, int ui, int r) const { return (unsigned)(u.pm * 256 + r) * 1024u; }
};
struct EpiAct {
    static constexpr bool PERM = true;
    const float* b_gu; unsigned char* ACT;
    __device__ __forceinline__ void operator()(const f32x4 (&acc)[2][2][4][2], const pg8::Unit& u, int wr, int wc, int fr, int fq) const {
        const int pn = u.pn & 7, cl = pn * 128 + wc * 32 + 8 * fq;
        const int row0 = u.pm * 256 + wr * 64 + fr;
        const f32x4 bg0 = *(const f32x4*)(b_gu + u.e * 2048 + cl), bg1 = *(const f32x4*)(b_gu + u.e * 2048 + cl + 4);
        const f32x4 bl0 = *(const f32x4*)(b_gu + u.e * 2048 + 1024 + cl), bl1 = *(const f32x4*)(b_gu + u.e * 2048 + 1024 + cl + 4);
#pragma unroll
        for (int ai = 0; ai < 2; ++ai)
#pragma unroll
            for (int m = 0; m < 4; ++m) {
                f32x4 g0 = acc[ai][0][m][0] + bg0, g1 = acc[ai][0][m][1] + bg1, l0 = acc[ai][1][m][0] + bl0, l1 = acc[ai][1][m][1] + bl1;
                float r0[4], r1[4];
#pragma unroll
                for (int j = 0; j < 4; ++j) {
                    const float ga = fminf(g0[j], 7.0f), gb = fminf(g1[j], 7.0f);
                    const float la = fminf(fmaxf(l0[j], -7.0f), 7.0f), lb = fminf(fmaxf(l1[j], -7.0f), 7.0f);
                    r0[j] = (la + 1.0f) * (ga * fast_sigmoid(1.702f * ga)); r1[j] = (lb + 1.0f) * (gb * fast_sigmoid(1.702f * gb));
                }
                u32x2 w; w.x = pk4_fp8(r0[0], r0[1], r0[2], r0[3]); w.y = pk4_fp8(r1[0], r1[1], r1[2], r1[3]);
                *(u32x2*)(ACT + (size_t)(row0 + ai * 128 + m * 16) * 1024 + cl) = w;
            }
    }
};
struct EpiYP {
    static constexpr bool PERM = true;
    const float* b_d; const unsigned* cnt; const int* list; const float* gate; unsigned char* YP;
    __device__ __forceinline__ void operator()(const f32x4 (&acc)[2][2][4][2], const pg8::Unit& u, int wr, int wc, int fr, int fq) const {
        const int pn = u.pn & 3, col0 = pn * 256 + wc * 32 + 8 * fq;
        const int ne = (int)cnt[u.e];
        f32x4 bv[2][2];
#pragma unroll
        for (int bj = 0; bj < 2; ++bj)
#pragma unroll
            for (int n = 0; n < 2; ++n) bv[bj][n] = *(const f32x4*)(b_d + u.e * 1024 + col0 + bj * 128 + 4 * n);
#pragma unroll
        for (int ai = 0; ai < 2; ++ai)
#pragma unroll
            for (int m = 0; m < 4; ++m) {
                const int slot = u.rt * 256 + ai * 128 + wr * 64 + m * 16 + fr;
                if (slot < ne) {
                    const int pid = list[u.e * CAP + slot]; const float gw = gate[pid] * 16.0f;
#pragma unroll
                    for (int bj = 0; bj < 2; ++bj) { const f32x4 v0 = (acc[ai][bj][m][0] + bv[bj][0]) * gw, v1 = (acc[ai][bj][m][1] + bv[bj][1]) * gw;
                        u32x2 w; w.x = pk4_fp8(v0[0], v0[1], v0[2], v0[3]); w.y = pk4_fp8(v1[0], v1[1], v1[2], v1[3]);
                        *(u32x2*)(YP + (size_t)pid * 1024 + col0 + bj * 128) = w; }
                }
            }
    }
};
__device__ __forceinline__ int moe_setup(Frame& F, LAS int* rt0) {
    if (F.tid == 0) { int acc = 0; for (int e = 0; e < 32; ++e) { rt0[e] = acc; acc += ((int)F.ctl[CW_CNT + e] + 255) >> 8; } rt0[32] = acc; }
    __syncthreads();
    return rt0[32];
}

__device__ __forceinline__ void p8_final(Frame& F, const int nrep) {
    const int gw = F.vcu * NWAVES + F.wave, NGW = F.G * NWAVES;
    const bf16* X1 = WSP(const bf16, WS_X1); const unsigned char* YP = WSP(const unsigned char, WS_YP);
    f32x4 g[4];
#pragma unroll
    for (int j = 0; j < 4; ++j) g[j] = *((const f32x4*)F.g_final + F.lane + 64 * j);
    float pscale = 1.0f;
#ifdef MK_TPROBE
    { const unsigned long long* st = (const unsigned long long*)(F.ctl + CW_STAMP); const float dt_us = (float)(st[MK_TPROBE_J] - st[MK_TPROBE_I]) * 0.01f; pscale = 1.0f + sqrtf(dt_us * 1e-5f); }
#endif
    for (int m0 = gw; m0 < M * nrep; m0 += NGW) {
        const int m = m0 % M;
        const u32x2* xr = (const u32x2*)(X1 + (size_t)m * D) + F.lane;
        f32x4 v[4]; float s = 0.f;
#pragma unroll
        for (int j = 0; j < 4; ++j) { const u32x2 xw = __builtin_nontemporal_load(xr + 64 * j); v[j] = (f32x4){bf_lo(xw.x), bf_hi(xw.x), bf_lo(xw.y), bf_hi(xw.y)}; }
        f32x4 ys[4];
#pragma unroll
        for (int j = 0; j < 4; ++j) ys[j] = (f32x4){0.f, 0.f, 0.f, 0.f};
#pragma unroll
        for (int k = 0; k < 4; ++k) { const unsigned* yr = (const unsigned*)(YP + ((size_t)m * 4 + k) * 1024) + F.lane;
#pragma unroll
            for (int j = 0; j < 4; ++j) { const int y = (int)__builtin_nontemporal_load(yr + 64 * j); const f32x2 lo = __builtin_amdgcn_cvt_pk_f32_fp8(y, false), hi = __builtin_amdgcn_cvt_pk_f32_fp8(y, true);
                ys[j].x += lo.x; ys[j].y += lo.y; ys[j].z += hi.x; ys[j].w += hi.y; } }
#pragma unroll
        for (int j = 0; j < 4; ++j) v[j] = v[j] + ys[j] * 0.0625f;
#pragma unroll
        for (int j = 0; j < 4; ++j) s += (v[j].x * v[j].x + v[j].y * v[j].y) + (v[j].z * v[j].z + v[j].w * v[j].w);
        const float rstd = 1.0f / sqrtf(wave_sum(s) * (1.f / D) + 1e-6f);
        f32x4* op = (f32x4*)(F.out + (size_t)m * D) + F.lane;
#pragma unroll
        for (int j = 0; j < 4; ++j) __builtin_nontemporal_store(v[j] * (rstd * pscale) * g[j], op + 64 * j);
    }
}

struct Args { const float* in[18]; float* out; unsigned char* ws; int ph_lo, ph_hi, rep_k, rep_n; };
__global__ void __launch_bounds__(NWAVES * 64, 2) mk_fwd(Args args) {
    extern __shared__ __attribute__((aligned(16))) unsigned char lds[];
    Frame F;
    F.lds = (LAS unsigned char*)lds;
    F.MISC = (volatile LAS unsigned*)(F.lds + MISC_OFF);
    F.tid = threadIdx.x; F.lane = F.tid & 63; F.wave = __builtin_amdgcn_readfirstlane(F.tid >> 6);
    F.G = gridDim.x; { const int bx = blockIdx.x; F.vcu = (F.G % 8 == 0) ? (bx % 8) * (F.G / 8) + bx / 8 : bx; }
    F.ws = args.ws; F.ctl = (unsigned*)(args.ws + WS_CTL);
    F.x = args.in[0]; F.g_mix = args.in[1]; F.w_in = args.in[2]; F.w_up = args.in[3]; F.b_alpha = args.in[4]; F.g_gla = args.in[5]; F.w_conv = args.in[6];
    F.w_a = args.in[7]; F.w_b = args.in[8]; F.w_out = args.in[9]; F.g_ffn = args.in[10]; F.w_router = args.in[11]; F.b_router = args.in[12];
    F.w_gu = args.in[13]; F.b_gu = args.in[14]; F.w_d = args.in[15]; F.b_d = args.in[16]; F.g_final = args.in[17]; F.out = args.out;
    if (F.tid < 128) ((LAS unsigned*)(F.lds + MISC_OFF))[F.tid] = 0u;
    __syncthreads();
    XcdBarrier bar; bar.bar = F.ctl + CW_BAR; bar.x = 0; bar.st = nullptr;
    if (N_LAUNCHES == 1) bar = xcd_barrier_post(F.ctl + CW_BAR, F.MISC + 8);
    const int lo = args.ph_lo, hi = args.ph_hi;
#ifdef MK_ONLY
#define IN(k) ((k) == MK_ONLY && lo <= (k) && (k) < hi)
#else
#define IN(k) (lo <= (k) && (k) < hi)
#endif
#define REPS(k) (((k) == args.rep_k) ? 1 + args.rep_n : 1)
#if defined(MK_TPROBE) || defined(MK_DELAY_K)
#define STAMP(k) do { if (blockIdx.x == 0 && F.tid == 0) ((unsigned long long*)(F.ctl + CW_STAMP))[k] = __builtin_amdgcn_s_memrealtime(); } while (0)
#else
#define STAMP(k) do { } while (0)
#endif
#ifdef MK_DELAY_K
#define DELAY(k) do { if ((k) == MK_DELAY_K) { const unsigned long long dl = __hip_atomic_load((unsigned long long*)(F.ctl + CW_STAMP), RLX_AGENT) + (unsigned long long)(MK_DELAY_US) * 100ull; \
    while (__builtin_amdgcn_s_memrealtime() < dl) __builtin_amdgcn_s_sleep(8); } } while (0)
#else
#define DELAY(k) do { } while (0)
#endif
#define SEAM(k) do { if (IN(k) && IN((k) + 1)) xcd_barrier(bar); STAMP((k) + 1); DELAY(k); } while (0)

    STAMP(0);
    if (IN(0)) { p0_prologue(F, REPS(0), REPS(11)); SEAM(0); }
    if (IN(1)) { const int nrep = REPS(1);
        P1Order S; S.init(M, NZ, D, F.G, (int)blockIdx.x, nrep); S.w_gu = F.w_gu; S.w_d = F.w_d; S.ws = F.ws; S.lds = F.lds; S.slot = ((int)blockIdx.x >> 3) & 7; S.wave = F.wave; S.lane = F.lane;
        EpiZ E{WSP(bf16, WS_Z)};
        pg8::gemm_phase<EpiZ, P1Order, true>(F.lds, WSP(const bf16, WS_XN), WSP(const bf16, WS_WIN), D, S, E);
        SEAM(1);
    }
    if (IN(2)) { const int nrep = REPS(2); for (int it = F.vcu; it < 256 * nrep; it += F.G) gla_item<false>(F, it & 255); conv_rows(F, REPS(12)); SEAM(2); }
    if (IN(3)) { gla_scan(F, REPS(3)); SEAM(3); }
    if (IN(4)) { const int nrep = REPS(4); for (int it = F.vcu; it < 256 * nrep; it += F.G) gla_item<true>(F, it & 255); SEAM(4); }
    if (IN(5)) { const int nrep = REPS(5);
        static_assert(WS_PB == WS_OG + (size_t)M * 1024 * 2 && WS_WB == WS_WA + (size_t)1024 * 1024 * 2, "P3Order addresses PB / Wb from OG / Wa");
        P3Order S; S.init(M, D, D, F.G, (int)blockIdx.x, nrep);
        EpiBranch E{WSP(const bf16, WS_Z), WSP(bf16, WS_M1), WSP(bf16, WS_MIX)};
        pg8::gemm_phase<EpiBranch, P3Order, true>(F.lds, WSP(const bf16, WS_OG), WSP(const bf16, WS_WA), D, S, E);
        SEAM(5);
    }
    if (IN(6)) { const int nrep = REPS(6);
        pg8::StaticOrder S; S.init(M, D, D, F.G, (int)blockIdx.x, nrep);
        EpiX1 E{F.x, WSP(bf16, WS_X1)};
        pg8::gemm_phase<EpiX1, pg8::StaticOrder, false>(F.lds, WSP(const bf16, WS_MIX), WSP(const bf16, WS_WO), D, S, E);
        SEAM(6);
    }
    if (IN(7)) { p5_router(F); SEAM(7); }
    if (IN(8)) { const int nrep = REPS(8);
        LAS int* rt0 = (LAS int*)(F.lds + EXTRA_OFF); LAS int* tokl = (LAS int*)(F.lds + EXTRA_OFF + 256);
        const int R = moe_setup(F, rt0);
        MoeOrder1 S; S.rt0 = rt0; S.tokl = tokl; S.nwg = R * 8; S.G = F.G; S.c = (int)blockIdx.x; S.reps = nrep;
        const int* list = WSP(const int, WS_LIST);
        { pg8::Unit u; for (int ui = 0; ui < MAXU && S.next(ui, u); ++ui) if (F.tid < 256) { const int slot = u.rt * 256 + F.tid; tokl[ui * 256 + F.tid] = slot < (int)F.ctl[CW_CNT + u.e] ? (list[u.e * CAP + slot] >> 2) : 0; } }
        __syncthreads();
        EpiAct E{F.b_gu, WSP(unsigned char, WS_ACT)};
        pg8::gemm_phase<EpiAct, MoeOrder1, true, true, 122>(F.lds, WSP(const void, WS_XN), WSP(const void, WS_WGU), D, S, E);
        SEAM(8);
    }
    if (IN(9)) { const int nrep = REPS(9);
        LAS int* rt0 = (LAS int*)(F.lds + EXTRA_OFF);
        const int R = moe_setup(F, rt0);
        MoeOrder2 S; S.rt0 = rt0; S.tokl = nullptr; S.nwg = R * 4; S.G = F.G; S.c = (int)blockIdx.x; S.reps = nrep;
        EpiYP E{F.b_d, F.ctl + CW_CNT, WSP(const int, WS_LIST), WSP(const float, WS_GATE), WSP(unsigned char, WS_YP)};
        pg8::gemm_phase<EpiYP, MoeOrder2, true, true, 122>(F.lds, WSP(const void, WS_ACT), WSP(const void, WS_WD), D, S, E);
        SEAM(9);
    }
    if (IN(10)) { p8_final(F, REPS(10)); }
#undef IN
#undef SEAM
}

extern "C" void kernel_launch(void* const* d_in, const int* in_sizes, int n_in, void* d_out, int out_size, void* d_ws, size_t ws_size, hipStream_t stream) {
    static int grid = 0;
    if (grid == 0) {
        if (n_in != 18 || out_size != M * D || ws_size < WS_END) { fprintf(stderr, "kernel_launch: unexpected shapes (n_in %d, out %d, ws %zu < %zu)\n", n_in, out_size, ws_size, (size_t)WS_END); grid = -1; return; }
        int dev = 0, cus = 0, per_cu = 0;
        if (hipGetDevice(&dev) != hipSuccess || hipDeviceGetAttribute(&cus, hipDeviceAttributeMultiprocessorCount, dev) != hipSuccess) { grid = -1; return; }
        if (hipFuncSetAttribute((const void*)mk_fwd, hipFuncAttributeMaxDynamicSharedMemorySize, LDS_BYTES) != hipSuccess) { fprintf(stderr, "kernel_launch: hipFuncSetAttribute(%d B LDS) failed\n", LDS_BYTES); grid = -1; return; }
        if (hipOccupancyMaxActiveBlocksPerMultiprocessor(&per_cu, (const void*)mk_fwd, NWAVES * 64, LDS_BYTES) != hipSuccess || per_cu < 1) fprintf(stderr, "kernel_launch: occupancy query says %d\n", per_cu);
        (void)hipGetLastError();
        grid = cus;
        if (grid != 256) fprintf(stderr, "kernel_launch: %d CUs (built for 256)\n", grid);
    }
    if (grid < 0) return;
    (void)hipMemsetAsync((char*)d_ws + WS_CTL, 0, CTL_ZERO_BYTES, stream);
    Args a{};
    for (int i = 0; i < 18; ++i) a.in[i] = (const float*)d_in[i];
    a.out = (float*)d_out; a.ws = (unsigned char*)d_ws;
#ifdef MK_REPEAT
    a.rep_k = MK_REPEAT; a.rep_n = MK_REPEAT_N;
#else
    a.rep_k = -1; a.rep_n = 0;
#endif
    for (int li = 0; li < N_LAUNCHES; ++li) {
        a.ph_lo = (N_LAUNCHES == 1) ? 0 : li; a.ph_hi = (N_LAUNCHES == 1) ? NPH : li + 1;
        hipLaunchKernelGGL(mk_fwd, dim3(grid), dim3(NWAVES * 64), LDS_BYTES, stream, a);
    }
}
```

```cpp
#include <hip/hip_runtime.h>
#include <cstdio>
#include <cstdint>

#ifndef MK_N_LAUNCHES
#define MK_N_LAUNCHES 1
#endif

#define LAS __attribute__((address_space(3)))
#define GAS __attribute__((address_space(1)))
typedef unsigned short bf16;
typedef short bf16x8 __attribute__((ext_vector_type(8)));
typedef float f32x4 __attribute__((ext_vector_type(4)));
typedef float f32x2 __attribute__((ext_vector_type(2)));
typedef float f32x16 __attribute__((ext_vector_type(16)));
typedef unsigned u32x4 __attribute__((ext_vector_type(4)));
typedef unsigned u32x2 __attribute__((ext_vector_type(2)));
typedef __bf16 bf16x2_t __attribute__((ext_vector_type(2)));
typedef int v8i32 __attribute__((ext_vector_type(8)));

constexpr int NWAVES = 8;
constexpr int M = 16384, D = 1024, SEQ = 2048;
constexpr int NZS = 8208;
constexpr int NZ = 8192;
constexpr int NE = 32, CAP = 16384;
constexpr int NPH = 11;
constexpr int N_LAUNCHES = MK_N_LAUNCHES;
constexpr size_t ZQ = 0, ZK = ZQ + (size_t)4 * M * 128, ZV = ZK + (size_t)4 * M * 128, ZR = ZV + (size_t)4 * M * 256, ZCB = ZR + (size_t)4 * M * 256, ZCC = ZCB + (size_t)M * 1024, ZCX = ZCC + (size_t)M * 1024, ZGA = ZCX + (size_t)M * 1024, ZGB = ZGA + (size_t)M * 1024;

constexpr size_t MiB = 1u << 20;
constexpr size_t WS_CTL = 0, CTL_ZERO_BYTES = 65536;
constexpr size_t WS_LIST = 1 * MiB;
constexpr size_t WS_GATE = 3 * MiB;
constexpr size_t WS_DECS = 4 * MiB;
constexpr size_t WS_WIN = 16 * MiB;
constexpr size_t WS_WA = 32 * MiB, WS_WB = 34 * MiB, WS_WO = 36 * MiB;
constexpr size_t WS_WGU = 40 * MiB;
constexpr size_t WS_WD = 168 * MiB;
constexpr size_t WS_XN = 232 * MiB;
constexpr size_t WS_LA = 264 * MiB;
constexpr size_t WS_Z = 296 * MiB;
constexpr size_t WS_YP = WS_Z;
constexpr size_t WS_U = 552 * MiB;
constexpr size_t WS_SIN = 584 * MiB;
constexpr size_t WS_OG = 616 * MiB;
constexpr size_t WS_PB = 648 * MiB;
constexpr size_t WS_M1 = 680 * MiB;
constexpr size_t WS_MIX = 744 * MiB;
constexpr size_t WS_X1 = 776 * MiB;
constexpr size_t WS_ACT = 840 * MiB;
constexpr size_t WS_END = 984 * MiB;
constexpr int CW_TMO = 0;
constexpr int CW_BAR = 4096;
constexpr int CW_CNT = 8192;
constexpr int CW_STAMP = 12288;

constexpr int RING_BYTES = 131072;
constexpr int EXTRA_OFF = RING_BYTES;
constexpr int LDS_BYTES = 155648 + 512;
constexpr int MISC_OFF = 155648;

#define RLX_AGENT __ATOMIC_RELAXED, __HIP_MEMORY_SCOPE_AGENT
#define LDS_WAIT() asm volatile("s_waitcnt lgkmcnt(0)" ::: "memory")
#define VM_WAIT() asm volatile("s_waitcnt vmcnt(0)" ::: "memory")
__device__ __forceinline__ unsigned pk2(float lo, float hi) { f32x2 v = {lo, hi}; bf16x2_t b = __builtin_convertvector(v, bf16x2_t); return __builtin_bit_cast(unsigned, b); }
__device__ __forceinline__ unsigned pk4_fp8(float a, float b, float c, float d) { int w = 0; w = __builtin_amdgcn_cvt_pk_fp8_f32(a, b, w, false); w = __builtin_amdgcn_cvt_pk_fp8_f32(c, d, w, true); return (unsigned)w; }
__device__ __forceinline__ float bf_lo(unsigned w) { return __builtin_bit_cast(float, w << 16); }
__device__ __forceinline__ float bf_hi(unsigned w) { return __builtin_bit_cast(float, w & 0xffff0000u); }
__device__ __forceinline__ float bf1(bf16 b) { return __builtin_bit_cast(float, ((unsigned)b) << 16); }
__device__ __forceinline__ float fast_sigmoid(float x) { return __builtin_amdgcn_rcpf(1.0f + __expf(-x)); }
__device__ __forceinline__ float wave_sum(float v) {
#pragma unroll
    for (int o = 1; o < 64; o <<= 1) v += __shfl_xor(v, o);
    return v;
}

namespace pg8 {
constexpr int BM = 256, BK = 64, HALF = 128, HTB = HALF * BK * 2, STAGE_BYTES = 8 * HTB, NXCD = 8, WGM = 8;
__device__ __forceinline__ int lds_byte(int r, int c) { const int st = (r >> 4) * 2 + (c >> 5), rr = r & 15, cc = c & 31, ob = rr * 64 + cc * 2; return st * 1024 + (ob ^ (((ob >> 9) & 1) << 5)); }
__device__ __forceinline__ void stage_rc(int b, int& R, int& C) { const int st = b / 1024, sb = b % 1024, swz = sb ^ (((sb >> 9) & 1) << 5); R = (st >> 1) * 16 + swz / 64; C = (st & 1) * 32 + (swz % 64) / 2; }
__device__ __forceinline__ int perm32(int rho) { const int n = rho >> 4, i = rho & 15; return 8 * (i >> 2) + 4 * n + (i & 3); }

struct Unit { int pm, pn, e, rt, ui; };

struct StaticOrder {
    int nM, nN, nwg, G, c, K, reps;
    __device__ __forceinline__ void init(int M_, int N_, int K_, int G_, int c_, int reps_) { nM = M_ / BM; nN = N_ / BM; nwg = nM * nN; G = G_; c = c_; K = K_; reps = reps_; }
    __device__ __forceinline__ bool next(int i, Unit& u) const {
        const long L = (long)i * G + c; if (L >= (long)nwg * reps) return false;
        int wgid = (int)(L % nwg); { const int q = nwg / NXCD, r = nwg % NXCD, xcd = wgid % NXCD, off = wgid / NXCD; wgid = (xcd < r ? xcd * (q + 1) : r * (q + 1) + (xcd - r) * q) + off; }
        const int nig = WGM * nN, gid = wgid / nig, fm = gid * WGM, gsz = (nM - fm) < WGM ? (nM - fm) : WGM;
        u.pm = fm + ((wgid % nig) % gsz); u.pn = (wgid % nig) / gsz; u.e = 0; u.rt = 0; u.ui = i; return true;
    }
    __device__ __forceinline__ unsigned arow(const Unit& u, int ui, int r) const { return (unsigned)(u.pm * BM + r) * (unsigned)(K * 2); }
    __device__ __forceinline__ void after_unit(int ui) const {}
    __device__ __forceinline__ bool keep_acc(int ui) const { return false; }
};

template <class Epi, class Sched, bool ALIGN_EPI, bool FP8 = false, int SCW = 127>
__device__ __forceinline__ void gemm_phase(LAS unsigned char* lds, const void* Ag, const void* Btg, const int K, const Sched& S, const Epi& E) {
    const int tid = threadIdx.x, wid = __builtin_amdgcn_readfirstlane(tid >> 6), lane = tid & 63, wr = wid >> 2, wc = wid & 3, fr = lane & 15, fq = lane >> 4;
    const int RB = FP8 ? K : 2 * K;
    const int nt = RB / 128;
    int RA[2], CA[2]; unsigned voffB[2];
#pragma unroll
    for (int i = 0; i < 2; ++i) { int R, C; stage_rc(tid * 16 + i * 8192, R, C); const int Rb = Epi::PERM ? ((R & ~31) + perm32(R & 31)) : R;
        RA[i] = R; CA[i] = C * 2; voffB[i] = (unsigned)(Rb * RB + C * 2); }
    const size_t kstep = (size_t)(BK * 2);
    const size_t hstep = (size_t)HALF * RB;
    const size_t tstep = 2 * hstep;
    const unsigned ldsw = (unsigned)wid * 1024u;
    const int aoff = lds_byte(wr * 64 + fr, fq * 8), boff = lds_byte(wc * 32 + fr, fq * 8);
#define PG8_SA(b, h) (((b) * 2 + (h)) * HTB)
#define PG8_SB(b, h) ((4 + (b) * 2 + (h)) * HTB)
#define PG8_STAGEB(bufoff, gbase) do { _Pragma("unroll") for (int _i = 0; _i < 2; ++_i) \
        __builtin_amdgcn_global_load_lds((const unsigned*)((const char*)(gbase) + voffB[_i]), (LAS unsigned*)(lds + (bufoff) + ldsw + _i * 8192), 16, 0, 0); } while (0)
#define PG8_STAGEA(bufoff, o0, o1) do { \
        __builtin_amdgcn_global_load_lds((const unsigned*)((const char*)Ag + (o0)), (LAS unsigned*)(lds + (bufoff) + ldsw), 16, 0, 0); \
        __builtin_amdgcn_global_load_lds((const unsigned*)((const char*)Ag + (o1)), (LAS unsigned*)(lds + (bufoff) + ldsw + 8192), 16, 0, 0); } while (0)
#define PG8_LDA(dst, b, h) do { if constexpr (FP8) { _Pragma("unroll") for (int m = 0; m < 4; ++m) { dst[m][0] = *(const LAS bf16x8*)(lds + PG8_SA(b, h) + aoff + m * 2048); dst[m][1] = *(const LAS bf16x8*)(lds + PG8_SA(b, h) + aoff + m * 2048 + 1024); } } \
        else { _Pragma("unroll") for (int m = 0; m < 4; ++m) _Pragma("unroll") for (int k = 0; k < 2; ++k) dst[m][k] = *(const LAS bf16x8*)(lds + PG8_SA(b, h) + aoff + m * 2048 + k * 1024); } } while (0)
#define PG8_LDB(dst, b, h) do { if constexpr (FP8) { _Pragma("unroll") for (int n = 0; n < 2; ++n) { dst[n][0] = *(const LAS bf16x8*)(lds + PG8_SB(b, h) + boff + n * 2048); dst[n][1] = *(const LAS bf16x8*)(lds + PG8_SB(b, h) + boff + n * 2048 + 1024); } } \
        else { _Pragma("unroll") for (int n = 0; n < 2; ++n) _Pragma("unroll") for (int k = 0; k < 2; ++k) dst[n][k] = *(const LAS bf16x8*)(lds + PG8_SB(b, h) + boff + n * 2048 + k * 1024); } } while (0)
#define PG8_F8(x) __builtin_bit_cast(v8i32, __builtin_shufflevector(__builtin_bit_cast(u32x4, (x)[0]), __builtin_bit_cast(u32x4, (x)[1]), 0, 1, 2, 3, 4, 5, 6, 7))
#define PG8_MMA(ai, bj, At, Bt) do { __builtin_amdgcn_s_setprio(1); if constexpr (FP8) { _Pragma("unroll") for (int m = 0; m < 4; ++m) _Pragma("unroll") for (int n = 0; n < 2; ++n) \
        asm volatile("v_mfma_scale_f32_16x16x128_f8f6f4 %0, %1, %2, %0, %3, %4 op_sel_hi:[0,0,0]" : "+v"(acc[ai][bj][m][n]) : "v"(PG8_F8(Bt[n])), "v"(PG8_F8(At[m])), "v"(scw_reg), "v"(sca_reg)); } \
        else { _Pragma("unroll") for (int m = 0; m < 4; ++m) _Pragma("unroll") for (int n = 0; n < 2; ++n) _Pragma("unroll") for (int k = 0; k < 2; ++k) \
        acc[ai][bj][m][n] = __builtin_amdgcn_mfma_f32_16x16x32_bf16(Bt[n][k], At[m][k], acc[ai][bj][m][n], 0, 0, 0); } __builtin_amdgcn_s_setprio(0); } while (0)
#define PG8_WAIT_V(n) asm volatile("s_waitcnt vmcnt(" #n ")" ::: "memory")
#define PG8_WAIT_L(n) asm volatile("s_waitcnt lgkmcnt(" #n ")" ::: "memory")
#define PG8_BAR __builtin_amdgcn_s_barrier()
#define PG8_SCHED __builtin_amdgcn_sched_barrier(0)
    Unit cur, nxt; int ui = 0;
    if (!S.next(0, cur)) return;
    int scw_reg = SCW, sca_reg = 127;
    asm volatile("" : "+v"(scw_reg), "+v"(sca_reg));
    f32x4 acc[2][2][4][2];
#pragma unroll
    for (int a = 0; a < 2; ++a)
#pragma unroll
        for (int b = 0; b < 2; ++b)
#pragma unroll
            for (int m = 0; m < 4; ++m)
#pragma unroll
                for (int n = 0; n < 2; ++n) acc[a][b][m][n] = (f32x4){0.f, 0.f, 0.f, 0.f};
#define PG8_ZPAD() do { if constexpr (FP8) { _Pragma("unroll") for (int a = 0; a < 2; ++a) _Pragma("unroll") for (int b = 0; b < 2; ++b) _Pragma("unroll") for (int m = 0; m < 4; ++m) asm volatile("s_nop 1" : "+v"(acc[a][b][m][0]), "+v"(acc[a][b][m][1])); } } while (0)
    PG8_ZPAD();
    bf16x8 At[4][2], B0[2][2], B1[2][2];
    unsigned ac00, ac01, ac10, ac11;
    ac00 = S.arow(cur, 0, RA[0]) + CA[0]; ac01 = S.arow(cur, 0, RA[1]) + CA[1]; ac10 = S.arow(cur, 0, HALF + RA[0]) + CA[0]; ac11 = S.arow(cur, 0, HALF + RA[1]) + CA[1];
    const char* cB = (const char*)Btg + (size_t)cur.pn * tstep;
    PG8_STAGEB(PG8_SB(0, 0), cB); PG8_STAGEB(PG8_SB(0, 1), cB + hstep); PG8_STAGEA(PG8_SA(0, 0), ac00, ac01); PG8_STAGEA(PG8_SA(0, 1), ac10, ac11);
    if (wr == 1) PG8_BAR;
    PG8_WAIT_V(2); PG8_BAR;
    PG8_STAGEB(PG8_SB(1, 0), cB + kstep); PG8_STAGEA(PG8_SA(1, 0), ac00 + 128u, ac01 + 128u); PG8_STAGEB(PG8_SB(1, 1), cB + hstep + kstep);
    PG8_WAIT_V(6); PG8_BAR;
    for (;;) {
        const bool has_next = S.next(ui + 1, nxt);
        const char* nB = has_next ? (const char*)Btg + (size_t)nxt.pn * tstep : cB;
#pragma unroll 1
        for (int t = 0; t < nt; t += 2) {
            const bool last = (t == nt - 2);
            const unsigned k1 = (unsigned)(t + 1) * 128u, k2 = (unsigned)(t + 2) * 128u;
            unsigned a200 = ac00 + k2, a201 = ac01 + k2, a210 = ac10 + k2, a211 = ac11 + k2;
            if (last) { if (has_next) { a200 = S.arow(nxt, ui + 1, RA[0]) + CA[0]; a201 = S.arow(nxt, ui + 1, RA[1]) + CA[1]; a210 = S.arow(nxt, ui + 1, HALF + RA[0]) + CA[0]; a211 = S.arow(nxt, ui + 1, HALF + RA[1]) + CA[1]; }
                        else { a200 = ac00; a201 = ac01; a210 = ac10; a211 = ac11; } }
            const char* b2 = last ? nB : cB + (size_t)k2; const char* b3 = b2 + kstep;
            PG8_LDB(B0, 0, 0); PG8_LDB(B1, 0, 1); PG8_SCHED; PG8_LDA(At, 0, 0); PG8_STAGEA(PG8_SA(1, 1), ac10 + k1, ac11 + k1);
            PG8_WAIT_V(8); PG8_WAIT_L(0); PG8_BAR; PG8_MMA(0, 0, At, B0); PG8_MMA(0, 1, At, B1); PG8_BAR; PG8_SCHED;
            PG8_LDA(At, 0, 1); PG8_STAGEB(PG8_SB(0, 0), b2); PG8_STAGEB(PG8_SB(0, 1), b2 + hstep); PG8_STAGEA(PG8_SA(0, 0), a200, a201);
            PG8_WAIT_V(8); PG8_WAIT_L(0); PG8_BAR; PG8_MMA(1, 0, At, B0); PG8_MMA(1, 1, At, B1); PG8_BAR; PG8_SCHED;
            PG8_LDB(B0, 1, 0); PG8_LDB(B1, 1, 1); PG8_SCHED; PG8_LDA(At, 1, 0); PG8_STAGEA(PG8_SA(0, 1), a210, a211);
            PG8_WAIT_V(8); PG8_WAIT_L(0); PG8_BAR; PG8_MMA(0, 0, At, B0); PG8_MMA(0, 1, At, B1); PG8_BAR; PG8_SCHED;
            PG8_LDA(At, 1, 1); PG8_STAGEB(PG8_SB(1, 0), b3); PG8_STAGEB(PG8_SB(1, 1), b3 + hstep); PG8_STAGEA(PG8_SA(1, 0), a200 + 128u, a201 + 128u);
            PG8_WAIT_V(8); PG8_WAIT_L(0); PG8_BAR; PG8_MMA(1, 0, At, B0); PG8_MMA(1, 1, At, B1); PG8_BAR; PG8_SCHED;
        }
        if constexpr (FP8) asm volatile("s_nop 15\n\ts_nop 15" ::: "memory");
#pragma unroll
        for (int a = 0; a < 2; ++a)
#pragma unroll
            for (int b = 0; b < 2; ++b)
#pragma unroll
                for (int m = 0; m < 4; ++m) asm volatile("" : "+v"(acc[a][b][m][0]), "+v"(acc[a][b][m][1]));
        if constexpr (ALIGN_EPI) { if (wr == 0) PG8_BAR; }
        E(acc, cur, wr, wc, fr, fq);
        S.after_unit(ui);
        if (!has_next) break;
        if (!S.keep_acc(ui)) {
#pragma unroll
        for (int a = 0; a < 2; ++a)
#pragma unroll
            for (int b = 0; b < 2; ++b)
#pragma unroll
                for (int m = 0; m < 4; ++m)
#pragma unroll
                    for (int n = 0; n < 2; ++n) acc[a][b][m][n] = (f32x4){0.f, 0.f, 0.f, 0.f};
        }
        PG8_ZPAD();
        cur = nxt; cB = nB; ++ui;
        ac00 = S.arow(cur, ui, RA[0]) + CA[0]; ac01 = S.arow(cur, ui, RA[1]) + CA[1]; ac10 = S.arow(cur, ui, HALF + RA[0]) + CA[0]; ac11 = S.arow(cur, ui, HALF + RA[1]) + CA[1];
        if constexpr (ALIGN_EPI) { if (wr == 1) PG8_BAR; }
    }
    PG8_WAIT_V(0);
    if constexpr (!ALIGN_EPI) { if (wr == 0) PG8_BAR; }
    PG8_BAR;
#undef PG8_SA
#undef PG8_SB
#undef PG8_STAGEA
#undef PG8_STAGEB
#undef PG8_LDA
#undef PG8_LDB
#undef PG8_MMA
#undef PG8_F8
#undef PG8_ZPAD
#undef PG8_WAIT_V
#undef PG8_WAIT_L
#undef PG8_BAR
#undef PG8_SCHED
}
}

#define XB_TMO      128
#define XB_XCNT(j)  (256  + 64 * (j))
#define XB_XSUB(j)  (1280 + 64 * (j))
#define XB_XGEN(j)  (2304 + 64 * (j))
#define XB_TOP      3328
#define XB_TOPGEN   3392
#define XCD_BAR_WORDS 3456
#define XB_SPIN_CAP (1u << 18)
__device__ __forceinline__ unsigned xb_ld(unsigned* p)              { return __hip_atomic_load(p, __ATOMIC_RELAXED, __HIP_MEMORY_SCOPE_AGENT); }
__device__ __forceinline__ unsigned xb_add(unsigned* p, unsigned v) { return __hip_atomic_fetch_add(p, v, __ATOMIC_RELAXED, __HIP_MEMORY_SCOPE_AGENT); }
__device__ __forceinline__ unsigned xb_xcc_id() { return (unsigned)__builtin_amdgcn_s_getreg((3 << 11) | 20) & 0xFu; }
#define XB_SPIN(cond, bar) do { unsigned _sp = 0; while (cond) { __builtin_amdgcn_s_sleep(1); \
    if ((++_sp & 255u) == 0u) { if (xb_ld(&(bar)[XB_TMO])) break; if (_sp > XB_SPIN_CAP) { atomicAdd(&(bar)[XB_TMO], 1u); break; } } } } while (0)
struct XcdBarrier { unsigned* bar; unsigned x; volatile LAS unsigned* st; };
__device__ __forceinline__ XcdBarrier xcd_barrier_post(unsigned* bar, volatile LAS unsigned* st) {
    XcdBarrier b; b.bar = bar; b.x = xb_xcc_id(); b.st = st;
    if (threadIdx.x == 0) (void)xb_add(&bar[XB_XCNT(b.x)], 1u);
    return b;
}
__device__ __forceinline__ void xcd_barrier_complete(unsigned* bar, unsigned x, unsigned& nloc, unsigned& nx) {
    const unsigned G = gridDim.x * gridDim.y * gridDim.z;
    unsigned sum, cnt, mine, sp = 0u;
    for (;;) {
        sum = 0u; cnt = 0u; mine = 0u;
#pragma unroll
        for (unsigned j = 0; j < 16; ++j) { const unsigned c = xb_ld(&bar[XB_XCNT(j)]); sum += c; cnt += (c > 0u) ? 1u : 0u; mine = (j == x) ? c : mine; }
        if (sum == G) break;
        __builtin_amdgcn_s_sleep(1);
        if ((++sp & 255u) == 0u) { if (xb_ld(&bar[XB_TMO])) break; if (sp > XB_SPIN_CAP) { atomicAdd(&bar[XB_TMO], 1u); break; } }
    }
    nloc = mine > 0u ? mine : 1u; nx = cnt > 0u ? cnt : 1u;
}
__device__ __forceinline__ void xcd_barrier(const XcdBarrier& b) {
    asm volatile("s_waitcnt vmcnt(0)" ::: "memory");
    __syncthreads();
    if (threadIdx.x == 0) {
        unsigned* bar = b.bar;
        __builtin_amdgcn_s_waitcnt(0);
        unsigned nloc = b.st[0], nx = b.st[1];
        if (nloc == 0u) { xcd_barrier_complete(bar, b.x, nloc, nx); b.st[0] = nloc; b.st[1] = nx; }
        const unsigned old = xb_add(&bar[XB_XSUB(b.x)], 1u);
        const unsigned gen = old / nloc;
        if (old + 1u == (gen + 1u) * nloc) {
            __builtin_amdgcn_fence(__ATOMIC_RELEASE, "agent");
            asm volatile("s_waitcnt vmcnt(0)" ::: "memory");
            const unsigned og = xb_add(&bar[XB_TOP], 1u);
            const unsigned tg = og / nx;
            if (og + 1u == (tg + 1u) * nx) xb_add(&bar[XB_TOPGEN], 1u);
            else XB_SPIN(xb_ld(&bar[XB_TOPGEN]) == tg, bar);
            __builtin_amdgcn_fence(__ATOMIC_ACQUIRE, "agent");
            xb_add(&bar[XB_XGEN(b.x)], 1u);
            asm volatile("s_waitcnt vmcnt(0)" ::: "memory");
        } else {
            XB_SPIN(xb_ld(&bar[XB_XGEN(b.x)]) == gen, bar);
            __builtin_amdgcn_fence(__ATOMIC_ACQUIRE, "agent");
            asm volatile("s_waitcnt vmcnt(0)" ::: "memory");
        }
    }
    __syncthreads();
}

struct Frame {
    LAS unsigned char* lds;
    volatile LAS unsigned* MISC;
    unsigned* ctl;
    int tid, lane, wave, vcu, G;
    unsigned char* ws;
    const float *x, *g_mix, *w_in, *w_up, *b_alpha, *g_gla, *w_conv, *w_a, *w_b, *w_out, *g_ffn, *w_router, *b_router, *w_gu, *b_gu, *w_d, *b_d, *g_final;
    float* out;
};
#define WSP(T, off) ((T*)(F.ws + (off)))

__device__ __forceinline__ void tr_item64(const float* W, int ld, int k0, int n0, bf16* WT, size_t dst_row0, int K, LAS unsigned* T, int lane) {
    const int nq = lane & 15, kr = lane >> 4;
    const float* src = W + (size_t)(k0 + 2 * kr) * ld + n0 + 4 * nq;
    f32x4 a0[8], a1[8];
#pragma unroll
    for (int it = 0; it < 8; ++it) { a0[it] = __builtin_nontemporal_load((const f32x4*)(src + (size_t)(8 * it) * ld)); a1[it] = __builtin_nontemporal_load((const f32x4*)(src + (size_t)(8 * it + 1) * ld)); }
    const int c = lane & 7;
#pragma unroll
    for (int hf = 0; hf < 2; ++hf) {
        if ((nq >> 3) == hf) {
#pragma unroll
            for (int it = 0; it < 8; ++it)
#pragma unroll
                for (int q = 0; q < 4; ++q) T[(4 * (nq & 7) + q) * 33 + 4 * it + kr] = pk2(a0[it][q], a1[it][q]);
        }
        LDS_WAIT(); asm volatile("" ::: "memory");
#pragma unroll
        for (int j = 0; j < 4; ++j) { const int n = (lane >> 3) + 8 * j; const LAS unsigned* t = T + n * 33 + 4 * c;
            u32x4 o; o.x = t[0]; o.y = t[1]; o.z = t[2]; o.w = t[3];
            *(u32x4*)(WT + (dst_row0 + 32 * hf + n) * (size_t)K + k0 + 8 * c) = o; }
        LDS_WAIT(); asm volatile("" ::: "memory");
    }
}

__device__ __forceinline__ void tr_item8(const float* W, int ld, int k0, int n0, unsigned char* WT8, size_t dst_row0, int KB, float scale, LAS unsigned* T, int lane) {
    const int nq = lane & 7, kr = lane >> 3;
    const float* src = W + (size_t)(k0 + 4 * kr) * ld + n0 + 4 * nq;
    f32x4 a[4][4];
#pragma unroll
    for (int it = 0; it < 4; ++it)
#pragma unroll
        for (int j = 0; j < 4; ++j) a[it][j] = __builtin_nontemporal_load((const f32x4*)(src + (size_t)(32 * it + j) * ld));
    const int c = lane & 7;
#pragma unroll
    for (int hf = 0; hf < 2; ++hf) {
        if ((nq >> 2) == hf) {
#pragma unroll
            for (int it = 0; it < 4; ++it)
#pragma unroll
                for (int q = 0; q < 4; ++q) T[(4 * (nq & 3) + q) * 33 + 8 * it + kr] = pk4_fp8(a[it][0][q] * scale, a[it][1][q] * scale, a[it][2][q] * scale, a[it][3][q] * scale);
        }
        LDS_WAIT(); asm volatile("" ::: "memory");
#pragma unroll
        for (int j = 0; j < 2; ++j) { const int n = (lane >> 3) + 8 * j; const LAS unsigned* t = T + n * 33 + 4 * c;
            u32x4 o; o.x = t[0]; o.y = t[1]; o.z = t[2]; o.w = t[3];
            *(u32x4*)(WT8 + (dst_row0 + 16 * hf + n) * (size_t)KB + k0 + 16 * c) = o; }
        LDS_WAIT(); asm volatile("" ::: "memory");
    }
}
constexpr int MOE_NIT = NE * 64 * 8 + NE * 32 * 8;
#ifndef MK_MOE_SPLIT
#define MK_MOE_SPLIT 0
#endif
constexpr int MOE_SPLIT = MK_MOE_SPLIT;
__device__ __forceinline__ void moe_convert_range(const float* w_gu, const float* w_d, unsigned char* ws, LAS unsigned* T, int first, int step, int end, int lane) {
    constexpr int I_GU = NE * 64 * 8;
    for (int it = first; it < end; it += step) {
        int r = it;
        if (r < I_GU) { const int e = r >> 9, q = r & 511, kb = q >> 6, nb = q & 63, j0 = 32 * nb, pn = j0 >> 8, within = j0 & 255, half = within >> 7;
            tr_item8(w_gu + (size_t)e * 1024 * 2048, 2048, 128 * kb, half * 1024 + pn * 128 + (within & 127), ws + WS_WGU + (size_t)e * 2048 * 1024, j0, 1024, 32.0f, T, lane); continue; } r -= I_GU;
        { const int e = r >> 8, q = r & 255, kb = q >> 5, nb = q & 31;
            tr_item8(w_d + (size_t)e * 1024 * 1024, 1024, 128 * kb, 32 * nb, ws + WS_WD + (size_t)e * 1024 * 1024, 32 * nb, 1024, 32.0f, T, lane); }
    }
}
__device__ __forceinline__ void moe_convert_share(const float* w_gu, const float* w_d, unsigned char* ws, LAS unsigned char* lds, int c, int G, int wave, int lane) {
    moe_convert_range(w_gu, w_d, ws, (LAS unsigned*)(lds + EXTRA_OFF + wave * 2176), MOE_SPLIT + c * NWAVES + wave, G * NWAVES, MOE_NIT, lane);
}
struct P1Order : pg8::StaticOrder {
    const float* w_gu; const float* w_d; unsigned char* ws; LAS unsigned char* lds; int slot, wave, lane;
    __device__ __forceinline__ void after_unit(int ui) const { if (ui == slot) { int ln = lane; asm volatile("" : "+v"(ln));
            moe_convert_share(w_gu, w_d, ws, lds, c, G, wave, ln); } }
};

constexpr int P0_T_BYTES = 4352;
constexpr int P0_WLD = 2064;
constexpr int P0_WL = 8 * P0_T_BYTES;
constexpr int P0_WU = P0_WL + 16 * P0_WLD;
constexpr int P0_BA = P0_WU + 16384;
constexpr int P0_AS = P0_BA + 2048;

__device__ __forceinline__ void p0_items(Frame& F, const int nrep) {
    LAS unsigned* scr = (LAS unsigned*)(F.lds + F.wave * P0_T_BYTES);
    const int gw = F.vcu * NWAVES + F.wave, NGW = F.G * NWAVES;
    constexpr int I_IN = 128 * 16, I_SQ = 16 * 16;
    constexpr int NITEMS = I_IN + 3 * I_SQ;
    bf16* Win_t = WSP(bf16, WS_WIN);
    for (int it0 = gw; it0 < NITEMS * nrep; it0 += NGW) {
        int r = it0 % NITEMS;
        if (r < I_IN) { const int kb = r >> 7, nb = r & 127, j0 = 64 * nb;
            int srcc = j0 < 3072 ? j0 : j0 + 16;
            if (j0 >= 4096 && j0 < 6144) { const int pn = j0 >> 8, within = j0 & 255; srcc = ((within >> 7) ? 5136 : 4112) + (pn - 16) * 128 + (within & 127); }
            tr_item64(F.w_in, NZS, 64 * kb, srcc, Win_t, j0, 1024, scr, F.lane); continue; } r -= I_IN;
        if (r < I_SQ) { tr_item64(F.w_a, 1024, 64 * (r >> 4), 64 * (r & 15), WSP(bf16, WS_WA), 64 * (r & 15), 1024, scr, F.lane); continue; } r -= I_SQ;
        if (r < I_SQ) { tr_item64(F.w_b, 1024, 64 * (r >> 4), 64 * (r & 15), WSP(bf16, WS_WB), 64 * (r & 15), 1024, scr, F.lane); continue; } r -= I_SQ;
        tr_item64(F.w_out, 1024, 64 * (r >> 4), 64 * (r & 15), WSP(bf16, WS_WO), 64 * (r & 15), 1024, scr, F.lane);
    }
    moe_convert_range(F.w_gu, F.w_d, F.ws, scr, gw, NGW, MOE_SPLIT, F.lane);
}

__device__ __forceinline__ void p0_rows(Frame& F, const int nrep2) {
    const int gw = F.vcu * NWAVES + F.wave, NGW = F.G * NWAVES, lane = F.lane, r32 = lane & 31, h = lane >> 5;
    LAS unsigned char* L = F.lds;
    LAS float* BA = (LAS float*)(L + P0_BA);
    LAS float* AS = (LAS float*)(L + P0_AS + F.wave * 512);
    f32x4 g[4];
#pragma unroll
    for (int j = 0; j < 4; ++j) g[j] = *((const f32x4*)F.g_mix + lane + 64 * j);
    bf16* XN = WSP(bf16, WS_XN); bf16* LA = WSP(bf16, WS_LA);
#pragma unroll 1
    for (int b8 = 0; (b8 * 8) * NGW + gw < M * nrep2; ++b8) {
        f32x4 nx[4];
        { const f32x4* xr = (const f32x4*)(F.x + (size_t)(((b8 * 8) * NGW + gw) % M) * D) + lane;
#pragma unroll
          for (int j = 0; j < 4; ++j) nx[j] = __builtin_nontemporal_load(xr + 64 * j); }
#pragma unroll 1
        for (int i = 0; i < 8; ++i) {
            const int m = ((b8 * 8 + i) * NGW + gw) % M;
            f32x4 v[4]; float s = 0.f;
#pragma unroll
            for (int j = 0; j < 4; ++j) { v[j] = nx[j]; s += (v[j].x * v[j].x + v[j].y * v[j].y) + (v[j].z * v[j].z + v[j].w * v[j].w); }
            if (i < 7) { const f32x4* xr = (const f32x4*)(F.x + (size_t)(((b8 * 8 + i + 1) * NGW + gw) % M) * D) + lane;
#pragma unroll
                for (int j = 0; j < 4; ++j) nx[j] = __builtin_nontemporal_load(xr + 64 * j); }
            const float rstd = 1.0f / sqrtf(wave_sum(s) * (1.f / D) + 1e-6f);
            unsigned long long* o8 = (unsigned long long*)(XN + (size_t)m * D) + lane;
#pragma unroll
            for (int j = 0; j < 4; ++j) { v[j] = v[j] * rstd * g[j]; o8[64 * j] = (unsigned long long)pk2(v[j].x, v[j].y) | ((unsigned long long)pk2(v[j].z, v[j].w) << 32); }
        }
        asm volatile("s_waitcnt vmcnt(0)" ::: "memory");
        {
            const int tl = lane & 7, kg = lane >> 4, rr = lane & 15;
            const bf16* ap = XN + (size_t)(((b8 * 8 + tl) * NGW + gw) % M) * D + 8 * kg;
            const LAS unsigned char* bp = L + P0_WL + rr * P0_WLD + 16 * kg;
            f32x4 ac = {0.f, 0.f, 0.f, 0.f};
#pragma unroll
            for (int k8 = 0; k8 < 4; ++k8) {
                bf16x8 af[8];
#pragma unroll
                for (int q = 0; q < 8; ++q) af[q] = *(const bf16x8*)(ap + 32 * (8 * k8 + q));
#pragma unroll
                for (int q = 0; q < 8; ++q) ac = __builtin_amdgcn_mfma_f32_16x16x32_bf16(af[q], *(const LAS bf16x8*)(bp + 64 * (8 * k8 + q)), ac, 0, 0, 0);
            }
            if (lane < 32) {
#pragma unroll
                for (int q = 0; q < 4; ++q) AS[(4 * kg + q) * 16 + rr] = ac[q]; }
        }
        {
            f32x4 a0 = {0.f, 0.f, 0.f, 0.f}, a1 = a0;
            if (r32 < 8) { a0 = *(const LAS f32x4*)(AS + r32 * 16 + 8 * h); a1 = *(const LAS f32x4*)(AS + r32 * 16 + 8 * h + 4); }
            u32x4 hi, lo;
            hi.x = pk2(a0[0], a0[1]); hi.y = pk2(a0[2], a0[3]); hi.z = pk2(a1[0], a1[1]); hi.w = pk2(a1[2], a1[3]);
            lo.x = pk2(a0[0] - bf_lo(hi.x), a0[1] - bf_hi(hi.x)); lo.y = pk2(a0[2] - bf_lo(hi.y), a0[3] - bf_hi(hi.y)); lo.z = pk2(a1[0] - bf_lo(hi.z), a1[1] - bf_hi(hi.z)); lo.w = pk2(a1[2] - bf_lo(hi.w), a1[3] - bf_hi(hi.w));
            const bf16x8 ahi = __builtin_bit_cast(bf16x8, hi), alo = __builtin_bit_cast(bf16x8, lo);
            int mrow[4];
#pragma unroll
            for (int q = 0; q < 4; ++q) mrow[q] = ((b8 * 8 + q + 4 * h) * NGW + gw) % M;
#pragma unroll 4
            for (int nt = 0; nt < 16; ++nt) {
                const bf16x8 bw = *(const LAS bf16x8*)(L + P0_WU + (32 * nt + r32) * 32 + 16 * h);
                f32x16 c16;
#pragma unroll
                for (int q = 0; q < 16; ++q) c16[q] = 0.f;
                c16 = __builtin_amdgcn_mfma_f32_32x32x16_bf16(ahi, bw, c16, 0, 0, 0);
                c16 = __builtin_amdgcn_mfma_f32_32x32x16_bf16(alo, bw, c16, 0, 0, 0);
                const float bb = BA[32 * nt + r32];
#pragma unroll
                for (int q = 0; q < 4; ++q) { const float pre = c16[q] + bb;
                    const float ls = fminf(pre, 0.f) - __logf(1.0f + __expf(-fabsf(pre)));
                    LA[((size_t)(nt >> 2) * M + mrow[q]) * 128 + 32 * (nt & 3) + r32] = (bf16)(pk2(ls * (1.0f / 16.0f), 0.f) & 0xffffu); }
            }
        }
    }
}

__device__ __forceinline__ void p0_prologue(Frame& F, const int nrep, const int nrep2) {
    {
        LAS unsigned char* L = F.lds;
        for (int i = 0; i < 32; ++i) { const int idx = F.tid + 512 * i, k = idx >> 4, r = idx & 15; *(LAS bf16*)(L + P0_WL + r * P0_WLD + 2 * k) = (bf16)(pk2(F.w_in[(size_t)k * NZS + 3072 + r], 0.f) & 0xffffu); }
        for (int i = 0; i < 16; ++i) { const int idx = F.tid + 512 * i, r = idx >> 9, n = idx & 511; *(LAS bf16*)(L + P0_WU + n * 32 + 2 * r) = (bf16)(pk2(F.w_up[idx], 0.f) & 0xffffu); }
        ((LAS float*)(L + P0_BA))[F.tid] = F.b_alpha[F.tid];
        __syncthreads();
    }
#pragma unroll 1
    for (int pass = 0; pass < 2; ++pass) {
        if (((pass ^ F.wave) & 1) == 0) p0_items(F, nrep); else p0_rows(F, nrep2);
    }
}

struct EpiZ {
    static constexpr bool PERM = true;
    bf16* Z;
    __device__ __forceinline__ void operator()(const f32x4 (&acc)[2][2][4][2], const pg8::Unit& u, int wr, int wc, int fr, int fq) const {
        const int row0 = u.pm * 256 + wr * 64 + fr, c0 = wc * 32 + 8 * fq;
        const int pn = u.pn;
        const int kind = pn < 2 ? 1 : (pn < 8 ? 0 : (pn < 12 ? 2 : (pn < 24 ? 0 : 3)));
        bf16* base; int ld; size_t bjs;
        if (pn < 4) { base = Z + (pn < 2 ? ZQ : ZK) + (size_t)(2 * (pn & 1)) * M * 128; ld = 128; bjs = (size_t)M * 128; }
        else if (pn < 12) { base = Z + (pn < 8 ? ZV : ZR) + (size_t)(pn & 3) * M * 256; ld = 256; bjs = 128; }
        else { const int t = (pn - 12) >> 2; base = Z + ZCB + (size_t)t * M * 1024 + (size_t)((pn - 12) & 3) * 256; ld = 1024; bjs = 128; }
        if (pn >= 16 && pn < 24) {
            bf16* ub = Z + ZCC + (size_t)(pn - 16) * 128;
#pragma unroll
            for (int ai = 0; ai < 2; ++ai)
#pragma unroll
                for (int m = 0; m < 4; ++m) { const f32x4 v0 = acc[ai][0][m][0] * acc[ai][1][m][0], v1 = acc[ai][0][m][1] * acc[ai][1][m][1];
                    u32x4 w; w.x = pk2(v0[0], v0[1]); w.y = pk2(v0[2], v0[3]); w.z = pk2(v1[0], v1[1]); w.w = pk2(v1[2], v1[3]);
                    *(u32x4*)(ub + (size_t)(row0 + ai * 128 + m * 16) * 1024 + c0) = w; }
            return;
        }
#pragma unroll
        for (int ai = 0; ai < 2; ++ai)
#pragma unroll
            for (int m = 0; m < 4; ++m) { bf16* rowp = base + (size_t)(row0 + ai * 128 + m * 16) * ld + c0;
#pragma unroll
                for (int bj = 0; bj < 2; ++bj) { f32x4 v0 = acc[ai][bj][m][0], v1 = acc[ai][bj][m][1];
                    if (kind == 1) { v0 = v0 * 0.08838834764831845f; v1 = v1 * 0.08838834764831845f; }
                    else if (kind == 2) {
#pragma unroll
                        for (int j = 0; j < 4; ++j) { v0[j] = v0[j] * fast_sigmoid(v0[j]); v1[j] = v1[j] * fast_sigmoid(v1[j]); } }
                    else if (kind == 3) {
                        unsigned q[8];
#pragma unroll
                        for (int j = 0; j < 4; ++j) { q[j] = (unsigned)__builtin_rintf(fast_sigmoid(v0[j]) * 255.0f); q[4 + j] = (unsigned)__builtin_rintf(fast_sigmoid(v1[j]) * 255.0f); }
                        u32x2 wq; wq.x = q[0] | (q[1] << 8) | (q[2] << 16) | (q[3] << 24); wq.y = q[4] | (q[5] << 8) | (q[6] << 16) | (q[7] << 24);
                        unsigned char* gbase = (unsigned char*)(Z + (pn < 28 ? ZGA : ZGB)) + (size_t)((pn - 24) & 3) * 256;
                        *(u32x2*)(gbase + (size_t)(row0 + ai * 128 + m * 16) * 1024 + c0 + bj * 128) = wq;
                        continue; }
                    u32x4 w; w.x = pk2(v0[0], v0[1]); w.y = pk2(v0[2], v0[3]); w.z = pk2(v1[0], v1[1]); w.w = pk2(v1[2], v1[3]);
                    *(u32x4*)(rowp + bj * bjs) = w; } }
    }
};

constexpr int QD_STRIDE = 272, KT_STRIDE = 144, SC_STRIDE = 144, OT_STRIDE = 1040;
constexpr int L_GG = 134144, L_WC = 135168;
constexpr int L_QD = 0, L_KI = 17408, L_KT = 34816, L_SC = 53248, L_DEC = 62464, L_SEG = 62976, L_OT = 67584;
__device__ __forceinline__ int crow(int reg, int h) { return (reg & 3) + 8 * (reg >> 2) + 4 * h; }

template <bool OUT>
__device__ __forceinline__ void gla_item(Frame& F, int item, const int cblk = -1) {
    const int bh = item >> 3, sc = item & 7, b = bh >> 2, hd = bh & 3;
    const int t0 = b * SEQ + sc * 256;
    const int tid = F.tid, lane = F.lane, w = F.wave, r32 = lane & 31, h = lane >> 5;
    const bf16* Z = WSP(const bf16, WS_Z);
    const bf16* LA = WSP(const bf16, WS_LA);
    LAS unsigned char* L = F.lds;
    f32x16 S[4];
    unsigned* Sbuf = (OUT ? WSP(unsigned, WS_SIN) : WSP(unsigned, WS_U)) + (size_t)item * 16384 + (size_t)w * 2048;
    if (OUT) {
#pragma unroll
        for (int kb = 0; kb < 4; ++kb)
#pragma unroll
            for (int r = 0; r < 16; r += 2) { const unsigned pw = Sbuf[(kb * 8 + (r >> 1)) * 64 + lane]; S[kb][r] = bf_lo(pw); S[kb][r + 1] = bf_hi(pw); }
    } else {
#pragma unroll
        for (int kb = 0; kb < 4; ++kb)
#pragma unroll
            for (int r = 0; r < 16; ++r) S[kb][r] = 0.f;
    }
    float btot_run0 = 0.f, btot_run1 = 0.f;
    const int tok_n = tid >> 3, part = tid & 7;
    unsigned la2[8], kk[8], qq[8]; bf16x8 Bv[4]; u32x4 rc[4];
#define GLA_LOAD(tcx) do { \
        const size_t rb_ = ((size_t)hd * M + (tcx) + 8 * w) * 128 + 2 * lane; \
        _Pragma("unroll") for (int i = 0; i < 8; ++i) { la2[i] = *(const unsigned*)(LA + rb_ + (size_t)i * 128); kk[i] = *(const unsigned*)(Z + ZK + rb_ + (size_t)i * 128); if (OUT) qq[i] = *(const unsigned*)(Z + ZQ + rb_ + (size_t)i * 128); } \
    } while (0)
#define GLA_LOADV(tcx) do { \
        _Pragma("unroll") for (int ks = 0; ks < 4; ++ks) _Pragma("unroll") for (int j = 0; j < 8; ++j) Bv[ks][j] = (short)Z[ZV + ((size_t)hd * M + (tcx) + 16 * ks + 8 * h + j) * 256 + 32 * w + r32]; \
    } while (0)
#define GLA_LOADR(tcx) do { \
        if (OUT) { const u32x4* rp_ = (const u32x4*)(Z + ZR + ((size_t)hd * M + (tcx) + tok_n) * 256 + 32 * part); _Pragma("unroll") for (int i = 0; i < 4; ++i) rc[i] = __builtin_nontemporal_load(rp_ + i); } \
    } while (0)
    u32x4 cv_c[4], cv_b[4], cv_p2, cv_p1; float cu1[8], cu2[8];
    const bool do_conv = !OUT && cblk >= 0;
    const int cm0 = cblk * 8, cs0 = do_conv ? cm0 % SEQ : 0;
#define CONV_ISSUE(sub) do { if (do_conv) { const int cj_ = (sub) >> 1, chb_ = (sub) & 1, cc_ = 8 * lane + 512 * cj_; \
        if (chb_ == 0) { const size_t rp_ = (size_t)(cs0 > 0 ? cm0 - 2 : cm0); \
            cv_p2 = __builtin_nontemporal_load((const u32x4*)(Z + ZCC + rp_ * 1024 + cc_)); cv_p1 = __builtin_nontemporal_load((const u32x4*)(Z + ZCC + (rp_ + 1) * 1024 + cc_)); \
 } \
        _Pragma("unroll") for (int rr = 0; rr < 4; ++rr) { const size_t row_ = (size_t)(cm0 + 4 * chb_ + rr); \
            cv_c[rr] = __builtin_nontemporal_load((const u32x4*)(Z + ZCC + row_ * 1024 + cc_)); cv_b[rr] = __builtin_nontemporal_load((const u32x4*)(Z + ZCB + row_ * 1024 + cc_)); } } } while (0)
#define CONV_FINISH(sub) do { if (do_conv) { const int cj_ = (sub) >> 1, chb_ = (sub) & 1, cc_ = 8 * lane + 512 * cj_; float cw0[8], cw1[8], cw2[8]; \
        { const LAS f32x4* wp_ = (const LAS f32x4*)(L + L_WC + 4 * cc_); _Pragma("unroll") for (int i = 0; i < 2; ++i) { const f32x4 t0_ = wp_[i], t1_ = wp_[256 + i], t2_ = wp_[512 + i]; \
            _Pragma("unroll") for (int q = 0; q < 4; ++q) { cw0[4 * i + q] = t0_[q]; cw1[4 * i + q] = t1_[q]; cw2[4 * i + q] = t2_[q]; } } } \
        if (chb_ == 0) { const float keep_ = cs0 > 0 ? 1.0f : 0.0f; \
            _Pragma("unroll") for (int i = 0; i < 4; ++i) { cu2[2 * i] = keep_ * bf_lo(cv_p2[i]); cu2[2 * i + 1] = keep_ * bf_hi(cv_p2[i]); cu1[2 * i] = keep_ * bf_lo(cv_p1[i]); cu1[2 * i + 1] = keep_ * bf_hi(cv_p1[i]); } } \
        _Pragma("unroll") for (int rr = 0; rr < 4; ++rr) { float u0_[8], y_[8]; \
            _Pragma("unroll") for (int i = 0; i < 4; ++i) { u0_[2 * i] = bf_lo(cv_c[rr][i]); u0_[2 * i + 1] = bf_hi(cv_c[rr][i]); } \
            _Pragma("unroll") for (int i = 0; i < 8; ++i) y_[i] = cw0[i] * cu2[i] + cw1[i] * cu1[i] + cw2[i] * u0_[i]; \
            u32x4 ow_; _Pragma("unroll") for (int i = 0; i < 4; ++i) ow_[i] = pk2(bf_lo(cv_b[rr][i]) * y_[2 * i], bf_hi(cv_b[rr][i]) * y_[2 * i + 1]); \
            *(u32x4*)(WSP(bf16, WS_PB) + (size_t)(cm0 + 4 * chb_ + rr) * 1024 + cc_) = ow_; \
            _Pragma("unroll") for (int i = 0; i < 8; ++i) { cu2[i] = cu1[i]; cu1[i] = u0_[i]; } } } } while (0)
    if (OUT) { if (tid < 256) ((LAS float*)(L + L_GG))[tid] = F.g_gla[hd * 256 + tid]; }
    else if (do_conv) {
#pragma unroll
        for (int i = 0; i < 6; ++i) ((LAS float*)(L + L_WC))[tid + 512 * i] = F.w_conv[tid + 512 * i]; }
    GLA_LOAD(t0); GLA_LOADV(t0);
#pragma unroll 1
    for (int c = 0; c < 4; ++c) {
        const int tc = t0 + c * 64;
        float p0[8], p1[8];
        { float r0 = 0.f, r1 = 0.f;
#pragma unroll
          for (int i = 0; i < 8; ++i) { r0 += bf_lo(la2[i]); r1 += bf_hi(la2[i]); p0[i] = r0; p1[i] = r1; }
          *(LAS f32x2*)(L + L_SEG + (w * 128 + 2 * lane) * 4) = (f32x2){r0, r1}; }
        GLA_LOADR(tc);
        CONV_ISSUE(c);
        __syncthreads();
        float off0 = 0.f, off1 = 0.f, bt0 = 0.f, bt1 = 0.f;
#pragma unroll
        for (int sgi = 0; sgi < 8; ++sgi) { const f32x2 sv = *(const LAS f32x2*)(L + L_SEG + (sgi * 128 + 2 * lane) * 4); if (sgi < w) { off0 += sv.x; off1 += sv.y; } bt0 += sv.x; bt1 += sv.y; }
        if (w == 0) { *(LAS f32x2*)(L + L_DEC + 8 * lane) = (f32x2){__expf(bt0), __expf(bt1)}; btot_run0 += bt0; btot_run1 += bt1; }
        {
            unsigned kt0[4], kt1[4];
#pragma unroll
            for (int i = 0; i < 8; i += 2) {
                const float b00 = off0 + p0[i], b01 = off1 + p1[i], b10 = off0 + p0[i + 1], b11 = off1 + p1[i + 1];
                const float k00 = bf_lo(kk[i]), k01 = bf_hi(kk[i]), k10 = bf_lo(kk[i + 1]), k11 = bf_hi(kk[i + 1]);
                kt0[i >> 1] = pk2(k00 * __expf(bt0 - b00), k10 * __expf(bt0 - b10));
                kt1[i >> 1] = pk2(k01 * __expf(bt1 - b01), k11 * __expf(bt1 - b11));
                if (OUT) {
                    const float q00 = bf_lo(qq[i]), q01 = bf_hi(qq[i]), q10 = bf_lo(qq[i + 1]), q11 = bf_hi(qq[i + 1]);
                    *(LAS unsigned*)(L + L_QD + (8 * w + i) * QD_STRIDE + 4 * lane) = pk2(q00 * __expf(b00), q01 * __expf(b01));
                    *(LAS unsigned*)(L + L_QD + (8 * w + i + 1) * QD_STRIDE + 4 * lane) = pk2(q10 * __expf(b10), q11 * __expf(b11));
                    *(LAS unsigned*)(L + L_KI + (8 * w + i) * QD_STRIDE + 4 * lane) = pk2(k00 * __expf(-b00), k01 * __expf(-b01));
                    *(LAS unsigned*)(L + L_KI + (8 * w + i + 1) * QD_STRIDE + 4 * lane) = pk2(k10 * __expf(-b10), k11 * __expf(-b11));
                }
            }
            *(LAS u32x4*)(L + L_KT + (2 * lane) * KT_STRIDE + 16 * w) = (u32x4){kt0[0], kt0[1], kt0[2], kt0[3]};
            *(LAS u32x4*)(L + L_KT + (2 * lane + 1) * KT_STRIDE + 16 * w) = (u32x4){kt1[0], kt1[1], kt1[2], kt1[3]};
        }
        __syncthreads();
        if (c < 3) GLA_LOAD(tc + 64);
        f32x16 o[2];
        if (OUT) {
            if (w < 3) {
                const int ib = w == 0 ? 0 : 1, jb = w == 2 ? 1 : 0;
                f32x16 sacc;
#pragma unroll
                for (int r = 0; r < 16; ++r) sacc[r] = 0.f;
#pragma unroll
                for (int kb = 0; kb < 8; ++kb) {
                    const bf16x8 a = *(const LAS bf16x8*)(L + L_QD + (32 * ib + r32) * QD_STRIDE + 2 * (16 * kb + 8 * h));
                    const bf16x8 bb = *(const LAS bf16x8*)(L + L_KI + (32 * jb + r32) * QD_STRIDE + 2 * (16 * kb + 8 * h));
                    sacc = __builtin_amdgcn_mfma_f32_32x32x16_bf16(a, bb, sacc, 0, 0, 0);
                }
#pragma unroll
                for (int r = 0; r < 16; r += 1) {
                    const int i = 32 * ib + crow(r, h), j = 32 * jb + r32;
                    const float v = (j <= i) ? sacc[r] : 0.f;
                    *(LAS bf16*)(L + L_SC + i * SC_STRIDE + 2 * j) = (bf16)(pk2(v, 0.f) & 0xffffu);
                }
            }
#pragma unroll
            for (int ib = 0; ib < 2; ++ib)
#pragma unroll
                for (int r = 0; r < 16; ++r) o[ib][r] = 0.f;
#pragma unroll
            for (int kb = 0; kb < 4; ++kb)
#pragma unroll
                for (int s2 = 0; s2 < 2; ++s2) {
                    u32x4 pb; pb.x = pk2(S[kb][8 * s2 + 0], S[kb][8 * s2 + 1]); pb.y = pk2(S[kb][8 * s2 + 2], S[kb][8 * s2 + 3]); pb.z = pk2(S[kb][8 * s2 + 4], S[kb][8 * s2 + 5]); pb.w = pk2(S[kb][8 * s2 + 6], S[kb][8 * s2 + 7]);
                    const bf16x8 bfrag = __builtin_bit_cast(bf16x8, pb);
#pragma unroll
                    for (int ib = 0; ib < 2; ++ib) {
                        const LAS unsigned char* qp = L + L_QD + (32 * ib + r32) * QD_STRIDE + 2 * (32 * kb + 16 * s2 + 4 * h);
                        const u32x2 lo = *(const LAS u32x2*)qp, hi = *(const LAS u32x2*)(qp + 16);
                        const bf16x8 afrag = __builtin_bit_cast(bf16x8, (u32x4){lo.x, lo.y, hi.x, hi.y});
                        o[ib] = __builtin_amdgcn_mfma_f32_32x32x16_bf16(afrag, bfrag, o[ib], 0, 0, 0);
                    }
                }
            __syncthreads();
#pragma unroll
            for (int ks = 0; ks < 4; ++ks)
#pragma unroll
                for (int ib = 0; ib < 2; ++ib) {
                    if (ib == 0 && ks >= 2) continue;
                    const bf16x8 a = *(const LAS bf16x8*)(L + L_SC + (32 * ib + r32) * SC_STRIDE + 2 * (16 * ks + 8 * h));
                    o[ib] = __builtin_amdgcn_mfma_f32_32x32x16_bf16(a, Bv[ks], o[ib], 0, 0, 0);
                }
        }
#pragma unroll
        for (int kb = 0; kb < 4; ++kb) {
#pragma unroll
            for (int g4 = 0; g4 < 4; ++g4) { const f32x4 dc = *(const LAS f32x4*)(L + L_DEC + 4 * (32 * kb + 8 * g4 + 4 * h));
#pragma unroll
                for (int j = 0; j < 4; ++j) S[kb][4 * g4 + j] *= dc[j]; }
#pragma unroll
            for (int ks = 0; ks < 4; ++ks) {
                const bf16x8 a = *(const LAS bf16x8*)(L + L_KT + (32 * kb + r32) * KT_STRIDE + 2 * (16 * ks + 8 * h));
                S[kb] = __builtin_amdgcn_mfma_f32_32x32x16_bf16(a, Bv[ks], S[kb], 0, 0, 0);
            }
        }
        if (c < 3) GLA_LOADV(tc + 64);
        CONV_FINISH(c);
        if (OUT) {
#pragma unroll
            for (int ib = 0; ib < 2; ++ib)
#pragma unroll
                for (int r = 0; r < 16; ++r) *(LAS float*)(L + L_OT + (32 * ib + crow(r, h)) * OT_STRIDE + 4 * (32 * w + r32)) = o[ib][r];
            __syncthreads();
            f32x4 ov[8]; float ss = 0.f;
#pragma unroll
            for (int i = 0; i < 8; ++i) { ov[i] = *(const LAS f32x4*)(L + L_OT + tok_n * OT_STRIDE + 4 * (32 * part + 4 * i)); ss += (ov[i].x * ov[i].x + ov[i].y * ov[i].y) + (ov[i].z * ov[i].z + ov[i].w * ov[i].w); }
            ss += __shfl_xor(ss, 1); ss += __shfl_xor(ss, 2); ss += __shfl_xor(ss, 4);
            const float rs = 1.0f / sqrtf(ss * (1.0f / 256.0f) + 1e-6f);
            const size_t trow = (size_t)(tc + tok_n);
            const LAS f32x4* gp = (const LAS f32x4*)(L + L_GG + 4 * (32 * part));
            u32x4* op = (u32x4*)(WSP(bf16, WS_OG) + trow * 1024 + hd * 256 + 32 * part);
#pragma unroll
            for (int i = 0; i < 4; ++i) {
                const u32x4 rr = rc[i]; const f32x4 g0 = gp[2 * i], g1 = gp[2 * i + 1]; const f32x4 a0 = ov[2 * i], a1 = ov[2 * i + 1];
                u32x4 ow;
                ow.x = pk2(a0.x * rs * g0.x * bf_lo(rr.x), a0.y * rs * g0.y * bf_hi(rr.x));
                ow.y = pk2(a0.z * rs * g0.z * bf_lo(rr.y), a0.w * rs * g0.w * bf_hi(rr.y));
                ow.z = pk2(a1.x * rs * g1.x * bf_lo(rr.z), a1.y * rs * g1.y * bf_hi(rr.z));
                ow.w = pk2(a1.z * rs * g1.z * bf_lo(rr.w), a1.w * rs * g1.w * bf_hi(rr.w));
                op[i] = ow;
            }
        }
    }
#undef GLA_LOAD
#undef GLA_LOADV
#undef GLA_LOADR
#undef CONV_ISSUE
#undef CONV_FINISH
    if (!OUT) {
#pragma unroll
        for (int kb = 0; kb < 4; ++kb)
#pragma unroll
            for (int r = 0; r < 16; r += 2) Sbuf[(kb * 8 + (r >> 1)) * 64 + lane] = pk2(S[kb][r], S[kb][r + 1]);
        if (w == 0) *(f32x2*)(WSP(float, WS_DECS) + item * 128 + 2 * lane) = (f32x2){__expf(btot_run0), __expf(btot_run1)};
    }
    __syncthreads();
}

__device__ __forceinline__ void conv_rows(Frame& F, const int nrep, const int first_skip) {
    const int gw = F.vcu * NWAVES + F.wave, NGW = F.G * NWAVES;
    const bf16* Z = WSP(const bf16, WS_Z); bf16* PB = WSP(bf16, WS_PB);
    for (int blk0 = gw + first_skip * NGW; blk0 < (M / 8) * nrep; blk0 += NGW) {
        const int blk = blk0 % (M / 8);
        const int m0 = blk * 8, s0 = m0 % SEQ;
#pragma unroll 1
        for (int j = 0; j < 2; ++j) {
            const int c = 8 * F.lane + 512 * j;
            const size_t rp = (size_t)(s0 > 0 ? m0 - 2 : m0);
            const u32x4 p2c = *(const u32x4*)(Z + ZCC + rp * 1024 + c);
            const u32x4 p1c = *(const u32x4*)(Z + ZCC + (rp + 1) * 1024 + c);
            float w0[8], w1[8], w2[8];
#pragma unroll
            for (int i = 0; i < 8; ++i) { w0[i] = F.w_conv[c + i]; w1[i] = F.w_conv[1024 + c + i]; w2[i] = F.w_conv[2048 + c + i]; }
            float u1[8], u2[8];
            const float keep = s0 > 0 ? 1.0f : 0.0f;
#pragma unroll
            for (int i = 0; i < 4; ++i) { u2[2 * i] = keep * bf_lo(p2c[i]); u2[2 * i + 1] = keep * bf_hi(p2c[i]); u1[2 * i] = keep * bf_lo(p1c[i]); u1[2 * i + 1] = keep * bf_hi(p1c[i]); }
#pragma unroll
            for (int hb = 0; hb < 2; ++hb) {
                u32x4 cc[4], cb[4];
#pragma unroll
                for (int rr = 0; rr < 4; ++rr) { const size_t row = (size_t)(m0 + 4 * hb + rr); cc[rr] = __builtin_nontemporal_load((const u32x4*)(Z + ZCC + row * 1024 + c)); cb[rr] = __builtin_nontemporal_load((const u32x4*)(Z + ZCB + row * 1024 + c)); }
#pragma unroll
                for (int rr = 0; rr < 4; ++rr) {
                    float u0[8], y[8];
#pragma unroll
                    for (int i = 0; i < 4; ++i) { u0[2 * i] = bf_lo(cc[rr][i]); u0[2 * i + 1] = bf_hi(cc[rr][i]); }
#pragma unroll
                    for (int i = 0; i < 8; ++i) y[i] = w0[i] * u2[i] + w1[i] * u1[i] + w2[i] * u0[i];
                    u32x4 ow;
#pragma unroll
                    for (int i = 0; i < 4; ++i) ow[i] = pk2(bf_lo(cb[rr][i]) * y[2 * i], bf_hi(cb[rr][i]) * y[2 * i + 1]);
                    *(u32x4*)(PB + (size_t)(m0 + 4 * hb + rr) * 1024 + c) = ow;
#pragma unroll
                    for (int i = 0; i < 8; ++i) { u2[i] = u1[i]; u1[i] = u0[i]; }
                }
                asm volatile("" ::: "memory");
            }
        }
    }
}

__device__ __forceinline__ void gla_scan(Frame& F, const int nrep) {
    const unsigned* U = WSP(const unsigned, WS_U); unsigned* SIN = WSP(unsigned, WS_SIN); const float* DECS = WSP(const float, WS_DECS);
    const int gt = F.vcu * 512 + F.tid, NT = F.G * 512;
    for (int idx0 = gt; idx0 < 32 * 16384 * nrep; idx0 += NT) {
        const int idx = idx0 & (32 * 16384 - 1);
        const int bh = idx >> 14, e = idx & 16383;
        const int ln = e & 63, rp = (e >> 6) & 7, kb = (e >> 9) & 3;
        const int dk = 32 * kb + crow(2 * rp, ln >> 5);
        float s0 = 0.f, s1 = 0.f;
        unsigned uw[8];
#pragma unroll
        for (int sc = 0; sc < 8; ++sc) uw[sc] = U[(size_t)(bh * 8 + sc) * 16384 + e];
#pragma unroll
        for (int sc = 0; sc < 8; ++sc) {
            const int item = bh * 8 + sc;
            SIN[(size_t)item * 16384 + e] = pk2(s0, s1);
            const f32x2 dc = *(const f32x2*)(DECS + item * 128 + dk);
            s0 = dc.x * s0 + bf_lo(uw[sc]); s1 = dc.y * s1 + bf_hi(uw[sc]);
        }
    }
}

struct P3Order : pg8::StaticOrder {
    __device__ __forceinline__ bool next(int i, pg8::Unit& u) const {
        if (!pg8::StaticOrder::next(i >> 1, u)) return false;
        u.e = i & 1; u.pn += 4 * u.e; return true;
    }
    __device__ __forceinline__ unsigned arow(const pg8::Unit& u, int ui, int r) const { return (unsigned)(u.e * M + u.pm * 256 + r) * 2048u; }
    __device__ __forceinline__ void after_unit(int ui) const {}
    __device__ __forceinline__ bool keep_acc(int ui) const { return (ui & 1) == 0; }
};
struct EpiBranch {
    static constexpr bool PERM = true;
    const bf16* Z; bf16* MIX;
    __device__ __forceinline__ void operator()(f32x4 (&acc)[2][2][4][2], const pg8::Unit& u, int wr, int wc, int fr, int fq) const {
        const int row0 = u.pm * 256 + wr * 64 + fr, col0 = (u.pn & 3) * 256 + wc * 32 + 8 * fq;
#pragma unroll
        for (int ai = 0; ai < 2; ++ai)
#pragma unroll
            for (int m = 0; m < 4; ++m) { const size_t row = (size_t)(row0 + ai * 128 + m * 16);
#pragma unroll
                for (int bj = 0; bj < 2; ++bj) {
                    const u32x2 gb = __builtin_nontemporal_load((const u32x2*)((const unsigned char*)(Z + ZGB) + row * 1024 + col0 + bj * 128));
                    float sb[8];
#pragma unroll
                    for (int j = 0; j < 4; ++j) { sb[j] = (float)((gb.x >> (8 * j)) & 255u); sb[4 + j] = (float)((gb.y >> (8 * j)) & 255u); }
#pragma unroll
                    for (int j = 0; j < 8; ++j) sb[j] = fmaxf(sb[j], 1.0f) * (1.0f / 255.0f);
                    if (u.e == 0) {
                        const u32x2 ga = __builtin_nontemporal_load((const u32x2*)((const unsigned char*)(Z + ZGA) + row * 1024 + col0 + bj * 128));
                        float sa[8];
#pragma unroll
                        for (int j = 0; j < 4; ++j) { sa[j] = (float)((ga.x >> (8 * j)) & 255u) * (1.0f / 255.0f); sa[4 + j] = (float)((ga.y >> (8 * j)) & 255u) * (1.0f / 255.0f); }
#pragma unroll
                        for (int j = 0; j < 4; ++j) { acc[ai][bj][m][0][j] *= sa[j] * __builtin_amdgcn_rcpf(sb[j]); acc[ai][bj][m][1][j] *= sa[4 + j] * __builtin_amdgcn_rcpf(sb[4 + j]); }
                    } else {
                        const f32x4 v0 = acc[ai][bj][m][0], v1 = acc[ai][bj][m][1];
                        u32x4 w; w.x = pk2(v0[0] * sb[0], v0[1] * sb[1]); w.y = pk2(v0[2] * sb[2], v0[3] * sb[3]); w.z = pk2(v1[0] * sb[4], v1[1] * sb[5]); w.w = pk2(v1[2] * sb[6], v1[3] * sb[7]);
                        *(u32x4*)(MIX + row * 1024 + col0 + bj * 128) = w; }
                } }
    }
};
struct EpiX1 {
    static constexpr bool PERM = true;
    const float* x; bf16* X1;
    __device__ __forceinline__ void operator()(const f32x4 (&acc)[2][2][4][2], const pg8::Unit& u, int wr, int wc, int fr, int fq) const {
        const int row0 = u.pm * 256 + wr * 64 + fr, col0 = u.pn * 256 + wc * 32 + 8 * fq;
#pragma unroll
        for (int ai = 0; ai < 2; ++ai)
#pragma unroll
            for (int m = 0; m < 4; ++m) { const size_t off = (size_t)(row0 + ai * 128 + m * 16) * 1024 + col0;
#pragma unroll
                for (int bj = 0; bj < 2; ++bj) { const f32x4 x0 = __builtin_nontemporal_load((const f32x4*)(x + off + bj * 128)), x1 = __builtin_nontemporal_load((const f32x4*)(x + off + bj * 128 + 4));
                    const f32x4 v0 = x0 + acc[ai][bj][m][0], v1 = x1 + acc[ai][bj][m][1];
                    u32x4 w; w.x = pk2(v0[0], v0[1]); w.y = pk2(v0[2], v0[3]); w.z = pk2(v1[0], v1[1]); w.w = pk2(v1[2], v1[3]);
                    *(u32x4*)(X1 + off + bj * 128) = w; } }
    }
};

constexpr int P5_WLD = 2064;
constexpr int P5_WH = 0, P5_WL = 32 * P5_WLD;
constexpr int P5_RSTD = 133120, P5_LOGT = 133376;
constexpr int P5_HIST = 141824, P5_BASE = P5_HIST + 128, P5_PLE = P5_HIST + 256;
__device__ __forceinline__ void p5_router(Frame& F) {
    LAS unsigned char* L = F.lds;
    LAS float* RSTD = (LAS float*)(L + P5_RSTD); LAS float* LOGT = (LAS float*)(L + P5_LOGT);
    LAS int* hist = (LAS int*)(L + P5_HIST); LAS int* base = (LAS int*)(L + P5_BASE); LAS int* ple = (LAS int*)(L + P5_PLE);
    const bf16* X1 = WSP(const bf16, WS_X1); unsigned char* H2 = WSP(unsigned char, WS_XN);
    unsigned* cnt = F.ctl + CW_CNT; int* list = WSP(int, WS_LIST); float* gate = WSP(float, WS_GATE);
    const int lane = F.lane, w = F.wave, r32 = lane & 31, h = lane >> 5;
    f32x4 g[4];
#pragma unroll
    for (int j = 0; j < 4; ++j) g[j] = *((const f32x4*)F.g_ffn + lane + 64 * j);
    for (int grp = F.vcu; grp < M / 64; grp += F.G) {
        for (int i = 0; i < 64; ++i) { const int idx = F.tid + 512 * i, k = idx >> 5, e = idx & 31; const float wv = F.w_router[idx] * F.g_ffn[k];
            const unsigned hi = pk2(wv, 0.f) & 0xffffu; const float rem = wv - __builtin_bit_cast(float, hi << 16);
            *(LAS bf16*)(L + P5_WH + e * P5_WLD + 2 * k) = (bf16)hi; *(LAS bf16*)(L + P5_WL + e * P5_WLD + 2 * k) = (bf16)(pk2(rem, 0.f) & 0xffffu); }
        if (F.tid < 32) hist[F.tid] = 0;
        const size_t tok0 = (size_t)grp * 64;
        { u32x2 xv[8][4];
#pragma unroll
          for (int i = 0; i < 8; ++i) { const u32x2* xa = (const u32x2*)(X1 + (tok0 + 8 * w + i) * D) + lane;
#pragma unroll
              for (int j = 0; j < 4; ++j) xv[i][j] = xa[64 * j]; }
#pragma unroll
          for (int i = 0; i < 8; ++i) { f32x4 v[4]; float ss = 0.f;
#pragma unroll
              for (int j = 0; j < 4; ++j) { v[j] = (f32x4){bf_lo(xv[i][j].x), bf_hi(xv[i][j].x), bf_lo(xv[i][j].y), bf_hi(xv[i][j].y)};
#pragma unroll
                  for (int c = 0; c < 4; ++c) ss = fmaf(v[j][c], v[j][c], ss); }
              const float rs = 1.0f / sqrtf(wave_sum(ss) * (1.f / D) + 1e-6f);
              if (lane == 0) RSTD[8 * w + i] = rs;
              unsigned* o4 = (unsigned*)(H2 + (tok0 + 8 * w + i) * D) + lane;
#pragma unroll
              for (int j = 0; j < 4; ++j) { const f32x4 hv = v[j] * rs * g[j]; o4[64 * j] = pk4_fp8(hv.x, hv.y, hv.z, hv.w); } } }
        bf16x8 af[2][8];
        { const bf16* xa = X1 + (tok0 + r32) * D + 128 * w + 8 * h;
#pragma unroll
          for (int mt = 0; mt < 2; ++mt)
#pragma unroll
              for (int ks = 0; ks < 8; ++ks) af[mt][ks] = *(const bf16x8*)(xa + (size_t)mt * 32 * D + 16 * ks); }
        __syncthreads();
        f32x16 acc[2];
#pragma unroll
        for (int mt = 0; mt < 2; ++mt)
#pragma unroll
            for (int r = 0; r < 16; ++r) acc[mt][r] = 0.f;
#pragma unroll
        for (int ks = 0; ks < 8; ++ks) {
            const bf16x8 bh = *(const LAS bf16x8*)(L + P5_WH + r32 * P5_WLD + 2 * (128 * w + 16 * ks + 8 * h));
            const bf16x8 bl = *(const LAS bf16x8*)(L + P5_WL + r32 * P5_WLD + 2 * (128 * w + 16 * ks + 8 * h));
#pragma unroll
            for (int mt = 0; mt < 2; ++mt) { acc[mt] = __builtin_amdgcn_mfma_f32_32x32x16_bf16(af[mt][ks], bh, acc[mt], 0, 0, 0); acc[mt] = __builtin_amdgcn_mfma_f32_32x32x16_bf16(af[mt][ks], bl, acc[mt], 0, 0, 0); }
        }
        __syncthreads();
#pragma unroll
        for (int mt = 0; mt < 2; ++mt)
#pragma unroll
            for (int r = 0; r < 16; ++r) *(LAS float*)(L + ((w * 64 + 32 * mt + crow(r, h)) * 32 + r32) * 4) = acc[mt][r];
        __syncthreads();
        { const int tk = F.tid >> 3, eq = F.tid & 7;
          f32x4 sum = *(const LAS f32x4*)(L + ((0 * 64 + tk) * 32 + 4 * eq) * 4);
#pragma unroll
          for (int ww = 1; ww < 8; ++ww) sum = sum + *(const LAS f32x4*)(L + ((ww * 64 + tk) * 32 + 4 * eq) * 4);
          const float rs = RSTD[tk]; const f32x4 bb = *(const f32x4*)(F.b_router + 4 * eq);
#pragma unroll
          for (int c = 0; c < 4; ++c) LOGT[tk * 33 + 4 * eq + c] = sum[c] * rs + bb[c]; }
        __syncthreads();
        if (F.tid < 64) {
            const int tk = F.tid; float tv[4]; int ti[4];
#pragma unroll
            for (int k = 0; k < 4; ++k) { float bv = -3.0e38f; int bi = 0;
                for (int e = 0; e < 32; ++e) { const float v = LOGT[tk * 33 + e]; if (v > bv) { bv = v; bi = e; } }
                tv[k] = bv; ti[k] = bi; LOGT[tk * 33 + bi] = -3.0e38f; }
            const float e1 = __expf(tv[1] - tv[0]), e2 = __expf(tv[2] - tv[0]), e3 = __expf(tv[3] - tv[0]);
            const float inv = 1.0f / (1.0f + e1 + e2 + e3);
            const float gk[4] = {inv, e1 * inv, e2 * inv, e3 * inv};
#pragma unroll
            for (int k = 0; k < 4; ++k) { const int lr = __hip_atomic_fetch_add(&hist[ti[k]], 1, __ATOMIC_RELAXED, __HIP_MEMORY_SCOPE_WORKGROUP);
                ple[tk * 4 + k] = ti[k] | (lr << 8); gate[(tok0 + tk) * 4 + k] = gk[k]; }
        }
        __syncthreads();
        if (F.tid < 32) base[F.tid] = (int)__hip_atomic_fetch_add(cnt + F.tid, (unsigned)hist[F.tid], RLX_AGENT);
        __syncthreads();
        if (F.tid < 256) { const int pe = ple[F.tid], e = pe & 255, lr = pe >> 8; list[e * CAP + base[e] + lr] = (grp * 64) * 4 + F.tid; }
        __syncthreads();
    }
}

#ifndef MK_MAXU
#define MK_MAXU 12
#endif
constexpr int MAXU = MK_MAXU;
template <int NP>
struct MoeOrder {
    LAS const int* rt0;
    LAS const int* tokl;
    int nwg, G, c, reps;
    __device__ __forceinline__ bool next(int i, pg8::Unit& u) const {
        const long L = (long)i * G + c; if (L >= (long)nwg * reps) return false;
        int wgid = (int)(L % nwg); { const int q = nwg / 8, r = nwg % 8, xcd = wgid % 8, off = wgid / 8; wgid = (xcd < r ? xcd * (q + 1) : r * (q + 1) + (xcd - r) * q) + off; }
        int e = 0;
#pragma unroll 1
        for (int j = 1; j < 32; ++j) if (wgid >= NP * rt0[j]) e = j;
        const int l = wgid - NP * rt0[e], nte = rt0[e + 1] - rt0[e];
        const int pn = l / nte, rt = l - pn * nte;
        u.pm = __builtin_amdgcn_readfirstlane(rt0[e] + rt); u.pn = __builtin_amdgcn_readfirstlane(e * NP + pn); u.e = __builtin_amdgcn_readfirstlane(e); u.rt = __builtin_amdgcn_readfirstlane(rt); u.ui = i; return true;
    }
};
struct MoeOrder1 : MoeOrder<8> {
    __device__ __forceinline__ void after_unit(int ui) const {}
    __device__ __forceinline__ bool keep_acc(int ui) const { return false; }
    __device__ __forceinline__ unsigned arow(const pg8::Unit& u, int ui, int r) const { return (unsigned)tokl[ui * 256 + r] * 1024u; }
};
struct MoeOrder2 : MoeOrder<4> {
    __device__ __forceinline__ void after_unit(int ui) const {}
    __device__ __forceinline__ bool keep_acc(int ui) const { return false; }
    __device__ __forceinline__ unsigned arow(const pg8::Unit& u, int ui, int r) const { return (unsigned)(u.pm * 256 + r) * 1024u; }
};
struct EpiAct {
    static constexpr bool PERM = true;
    const float* b_gu; unsigned char* ACT;
    __device__ __forceinline__ void operator()(const f32x4 (&acc)[2][2][4][2], const pg8::Unit& u, int wr, int wc, int fr, int fq) const {
        const int pn = u.pn & 7, cl = pn * 128 + wc * 32 + 8 * fq;
        const int row0 = u.pm * 256 + wr * 64 + fr;
        const f32x4 bg0 = *(const f32x4*)(b_gu + u.e * 2048 + cl), bg1 = *(const f32x4*)(b_gu + u.e * 2048 + cl + 4);
        const f32x4 bl0 = *(const f32x4*)(b_gu + u.e * 2048 + 1024 + cl), bl1 = *(const f32x4*)(b_gu + u.e * 2048 + 1024 + cl + 4);
#pragma unroll
        for (int ai = 0; ai < 2; ++ai)
#pragma unroll
            for (int m = 0; m < 4; ++m) {
                f32x4 g0 = acc[ai][0][m][0] + bg0, g1 = acc[ai][0][m][1] + bg1, l0 = acc[ai][1][m][0] + bl0, l1 = acc[ai][1][m][1] + bl1;
                float r0[4], r1[4];
#pragma unroll
                for (int j = 0; j < 4; ++j) {
                    const float ga = fminf(g0[j], 7.0f), gb = fminf(g1[j], 7.0f);
                    const float la = fminf(fmaxf(l0[j], -7.0f), 7.0f), lb = fminf(fmaxf(l1[j], -7.0f), 7.0f);
                    r0[j] = (la + 1.0f) * (ga * fast_sigmoid(1.702f * ga)); r1[j] = (lb + 1.0f) * (gb * fast_sigmoid(1.702f * gb));
                }
                u32x2 w; w.x = pk4_fp8(r0[0], r0[1], r0[2], r0[3]); w.y = pk4_fp8(r1[0], r1[1], r1[2], r1[3]);
                *(u32x2*)(ACT + (size_t)(row0 + ai * 128 + m * 16) * 1024 + cl) = w;
            }
    }
};
constexpr int MAXU2 = 8;
struct EpiYP {
    static constexpr bool PERM = true;
    const float* b_d; LAS const int* pidl; LAS const float* gatel; unsigned char* YP;
    __device__ __forceinline__ void operator()(const f32x4 (&acc)[2][2][4][2], const pg8::Unit& u, int wr, int wc, int fr, int fq) const {
        const int pn = u.pn & 3, col0 = pn * 256 + wc * 32 + 8 * fq;
        f32x4 bv[2][2];
#pragma unroll
        for (int bj = 0; bj < 2; ++bj)
#pragma unroll
            for (int n = 0; n < 2; ++n) bv[bj][n] = *(const f32x4*)(b_d + u.e * 1024 + col0 + bj * 128 + 4 * n);
#pragma unroll
        for (int ai = 0; ai < 2; ++ai)
#pragma unroll
            for (int m = 0; m < 4; ++m) {
                const int rl = ai * 128 + wr * 64 + m * 16 + fr;
                const int pid = pidl[u.ui * 256 + rl];
                if (pid >= 0) {
                    const float gw = gatel[u.ui * 256 + rl];
#pragma unroll
                    for (int bj = 0; bj < 2; ++bj) { const f32x4 v0 = (acc[ai][bj][m][0] + bv[bj][0]) * gw, v1 = (acc[ai][bj][m][1] + bv[bj][1]) * gw;
                        u32x2 w; w.x = pk4_fp8(v0[0], v0[1], v0[2], v0[3]); w.y = pk4_fp8(v1[0], v1[1], v1[2], v1[3]);
                        *(u32x2*)(YP + (size_t)pid * 1024 + col0 + bj * 128) = w; }
                }
            }
    }
};
__device__ __forceinline__ int moe_setup(Frame& F, LAS int* rt0) {
    if (F.tid == 0) { int acc = 0; for (int e = 0; e < 32; ++e) { rt0[e] = acc; acc += ((int)F.ctl[CW_CNT + e] + 255) >> 8; } rt0[32] = acc; }
    __syncthreads();
    return rt0[32];
}

__device__ __forceinline__ void p8_final(Frame& F, const int nrep) {
    const int gw = F.vcu * NWAVES + F.wave, NGW = F.G * NWAVES;
    const bf16* X1 = WSP(const bf16, WS_X1); const unsigned char* YP = WSP(const unsigned char, WS_YP);
    f32x4 g[4];
#pragma unroll
    for (int j = 0; j < 4; ++j) g[j] = *((const f32x4*)F.g_final + F.lane + 64 * j);
    float pscale = 1.0f;
#ifdef MK_TPROBE
    { const unsigned long long* st = (const unsigned long long*)(F.ctl + CW_STAMP); const float dt_us = (float)(st[MK_TPROBE_J] - st[MK_TPROBE_I]) * 0.01f; pscale = 1.0f + sqrtf(dt_us * 1e-5f); }
#endif
    for (int m0 = gw; m0 < M * nrep; m0 += NGW) {
        const int m = m0 % M;
        const u32x2* xr = (const u32x2*)(X1 + (size_t)m * D) + F.lane;
        f32x4 v[4]; float s = 0.f;
#pragma unroll
        for (int j = 0; j < 4; ++j) { const u32x2 xw = __builtin_nontemporal_load(xr + 64 * j); v[j] = (f32x4){bf_lo(xw.x), bf_hi(xw.x), bf_lo(xw.y), bf_hi(xw.y)}; }
        f32x4 ys[4];
#pragma unroll
        for (int j = 0; j < 4; ++j) ys[j] = (f32x4){0.f, 0.f, 0.f, 0.f};
#pragma unroll
        for (int k = 0; k < 4; ++k) { const unsigned* yr = (const unsigned*)(YP + ((size_t)m * 4 + k) * 1024) + F.lane;
#pragma unroll
            for (int j = 0; j < 4; ++j) { const int y = (int)__builtin_nontemporal_load(yr + 64 * j); const f32x2 lo = __builtin_amdgcn_cvt_pk_f32_fp8(y, false), hi = __builtin_amdgcn_cvt_pk_f32_fp8(y, true);
                ys[j].x += lo.x; ys[j].y += lo.y; ys[j].z += hi.x; ys[j].w += hi.y; } }
#pragma unroll
        for (int j = 0; j < 4; ++j) v[j] = v[j] + ys[j] * 0.0625f;
#pragma unroll
        for (int j = 0; j < 4; ++j) s += (v[j].x * v[j].x + v[j].y * v[j].y) + (v[j].z * v[j].z + v[j].w * v[j].w);
        const float rstd = 1.0f / sqrtf(wave_sum(s) * (1.f / D) + 1e-6f);
        f32x4* op = (f32x4*)(F.out + (size_t)m * D) + F.lane;
#pragma unroll
        for (int j = 0; j < 4; ++j) __builtin_nontemporal_store(v[j] * (rstd * pscale) * g[j], op + 64 * j);
    }
}

struct Args { const float* in[18]; float* out; unsigned char* ws; int ph_lo, ph_hi, rep_k, rep_n; };
__global__ void __launch_bounds__(NWAVES * 64, 2) mk_fwd(Args args) {
    extern __shared__ __attribute__((aligned(16))) unsigned char lds[];
    Frame F;
    F.lds = (LAS unsigned char*)lds;
    F.MISC = (volatile LAS unsigned*)(F.lds + MISC_OFF);
    F.tid = threadIdx.x; F.lane = F.tid & 63; F.wave = __builtin_amdgcn_readfirstlane(F.tid >> 6);
    F.G = gridDim.x; { const int bx = blockIdx.x; F.vcu = (F.G % 8 == 0) ? (bx % 8) * (F.G / 8) + bx / 8 : bx; }
    F.ws = args.ws; F.ctl = (unsigned*)(args.ws + WS_CTL);
    F.x = args.in[0]; F.g_mix = args.in[1]; F.w_in = args.in[2]; F.w_up = args.in[3]; F.b_alpha = args.in[4]; F.g_gla = args.in[5]; F.w_conv = args.in[6];
    F.w_a = args.in[7]; F.w_b = args.in[8]; F.w_out = args.in[9]; F.g_ffn = args.in[10]; F.w_router = args.in[11]; F.b_router = args.in[12];
    F.w_gu = args.in[13]; F.b_gu = args.in[14]; F.w_d = args.in[15]; F.b_d = args.in[16]; F.g_final = args.in[17]; F.out = args.out;
    if (F.tid < 128) ((LAS unsigned*)(F.lds + MISC_OFF))[F.tid] = 0u;
    __syncthreads();
    XcdBarrier bar; bar.bar = F.ctl + CW_BAR; bar.x = 0; bar.st = nullptr;
    if (N_LAUNCHES == 1) bar = xcd_barrier_post(F.ctl + CW_BAR, F.MISC + 8);
    const int lo = args.ph_lo, hi = args.ph_hi;
#ifdef MK_ONLY
#define IN(k) ((k) == MK_ONLY && lo <= (k) && (k) < hi)
#else
#define IN(k) (lo <= (k) && (k) < hi)
#endif
#define REPS(k) (((k) == args.rep_k) ? 1 + args.rep_n : 1)
#if defined(MK_TPROBE) || defined(MK_DELAY_K)
#define STAMP(k) do { if (blockIdx.x == 0 && F.tid == 0) ((unsigned long long*)(F.ctl + CW_STAMP))[k] = __builtin_amdgcn_s_memrealtime(); } while (0)
#else
#define STAMP(k) do { } while (0)
#endif
#ifdef MK_DELAY_K
#define DELAY(k) do { if ((k) == MK_DELAY_K) { const unsigned long long dl = __hip_atomic_load((unsigned long long*)(F.ctl + CW_STAMP), RLX_AGENT) + (unsigned long long)(MK_DELAY_US) * 100ull; \
    while (__builtin_amdgcn_s_memrealtime() < dl) __builtin_amdgcn_s_sleep(8); } } while (0)
#else
#define DELAY(k) do { } while (0)
#endif
#define SEAM(k) do { if (IN(k) && IN((k) + 1)) xcd_barrier(bar); STAMP((k) + 1); DELAY(k); } while (0)

    STAMP(0);
    if (IN(0)) { p0_prologue(F, REPS(0), REPS(11)); SEAM(0); }
    if (IN(1)) { const int nrep = REPS(1);
        P1Order S; S.init(M, NZ, D, F.G, (int)blockIdx.x, nrep); S.w_gu = F.w_gu; S.w_d = F.w_d; S.ws = F.ws; S.lds = F.lds; S.slot = ((int)blockIdx.x >> 3) & 7; S.wave = F.wave; S.lane = F.lane;
        EpiZ E{WSP(bf16, WS_Z)};
        pg8::gemm_phase<EpiZ, P1Order, true>(F.lds, WSP(const bf16, WS_XN), WSP(const bf16, WS_WIN), D, S, E);
        SEAM(1);
    }
    if (IN(2)) { const int nrep = REPS(2); const int gwc = F.vcu * NWAVES + F.wave;
        for (int it = F.vcu; it < 256 * nrep; it += F.G) gla_item<false>(F, it & 255, (it == F.vcu && gwc < M / 8) ? gwc : -1);
        conv_rows(F, REPS(12), (F.vcu < 256) ? 1 : 0); SEAM(2); }
    if (IN(3)) { gla_scan(F, REPS(3)); SEAM(3); }
    if (IN(4)) { const int nrep = REPS(4); for (int it = F.vcu; it < 256 * nrep; it += F.G) gla_item<true>(F, it & 255); SEAM(4); }
    if (IN(5)) { const int nrep = REPS(5);
        static_assert(WS_PB == WS_OG + (size_t)M * 1024 * 2 && WS_WB == WS_WA + (size_t)1024 * 1024 * 2, "P3Order addresses PB / Wb from OG / Wa");
        P3Order S; S.init(M, D, D, F.G, (int)blockIdx.x, nrep);
        EpiBranch E{WSP(const bf16, WS_Z), WSP(bf16, WS_MIX)};
        pg8::gemm_phase<EpiBranch, P3Order, true>(F.lds, WSP(const bf16, WS_OG), WSP(const bf16, WS_WA), D, S, E);
        SEAM(5);
    }
    if (IN(6)) { const int nrep = REPS(6);
        pg8::StaticOrder S; S.init(M, D, D, F.G, (int)blockIdx.x, nrep);
        EpiX1 E{F.x, WSP(bf16, WS_X1)};
        pg8::gemm_phase<EpiX1, pg8::StaticOrder, false>(F.lds, WSP(const bf16, WS_MIX), WSP(const bf16, WS_WO), D, S, E);
        SEAM(6);
    }
    if (IN(7)) { p5_router(F); SEAM(7); }
    if (IN(8)) { const int nrep = REPS(8);
        LAS int* rt0 = (LAS int*)(F.lds + EXTRA_OFF); LAS int* tokl = (LAS int*)(F.lds + EXTRA_OFF + 256);
        const int R = moe_setup(F, rt0);
        MoeOrder1 S; S.rt0 = rt0; S.tokl = tokl; S.nwg = R * 8; S.G = F.G; S.c = (int)blockIdx.x; S.reps = nrep;
        const int* list = WSP(const int, WS_LIST);
        { pg8::Unit u; for (int ui = 0; ui < MAXU && S.next(ui, u); ++ui) if (F.tid < 256) { const int slot = u.rt * 256 + F.tid; tokl[ui * 256 + F.tid] = slot < (int)F.ctl[CW_CNT + u.e] ? (list[u.e * CAP + slot] >> 2) : 0; } }
        __syncthreads();
        EpiAct E{F.b_gu, WSP(unsigned char, WS_ACT)};
        pg8::gemm_phase<EpiAct, MoeOrder1, true, true, 122>(F.lds, WSP(const void, WS_XN), WSP(const void, WS_WGU), D, S, E);
        SEAM(8);
    }
    if (IN(9)) { const int nrep = REPS(9);
        LAS int* rt0 = (LAS int*)(F.lds + EXTRA_OFF);
        const int R = moe_setup(F, rt0);
        MoeOrder2 S; S.rt0 = rt0; S.tokl = nullptr; S.nwg = R * 4; S.G = F.G; S.c = (int)blockIdx.x; S.reps = nrep;
        LAS int* pidl = (LAS int*)(F.lds + EXTRA_OFF + 256); LAS float* gatel = (LAS float*)(F.lds + EXTRA_OFF + 256 + MAXU2 * 1024);
        { const int* list = WSP(const int, WS_LIST); const float* gate = WSP(const float, WS_GATE);
          pg8::Unit u; for (int ui = 0; ui < MAXU2 && S.next(ui, u); ++ui) if (F.tid < 256) { const int slot = u.rt * 256 + F.tid; int pid = -1; float gw = 0.f;
              if (slot < (int)F.ctl[CW_CNT + u.e]) { pid = list[u.e * CAP + slot]; gw = gate[pid] * 16.0f; }
              pidl[ui * 256 + F.tid] = pid; gatel[ui * 256 + F.tid] = gw; } }
        __syncthreads();
        EpiYP E{F.b_d, pidl, gatel, WSP(unsigned char, WS_YP)};
        pg8::gemm_phase<EpiYP, MoeOrder2, true, true, 122>(F.lds, WSP(const void, WS_ACT), WSP(const void, WS_WD), D, S, E);
        SEAM(9);
    }
    if (IN(10)) { p8_final(F, REPS(10)); }
#undef IN
#undef SEAM
}

extern "C" void kernel_launch(void* const* d_in, const int* in_sizes, int n_in, void* d_out, int out_size, void* d_ws, size_t ws_size, hipStream_t stream) {
    static int grid = 0;
    if (grid == 0) {
        if (n_in != 18 || out_size != M * D || ws_size < WS_END) { fprintf(stderr, "kernel_launch: unexpected shapes (n_in %d, out %d, ws %zu < %zu)\n", n_in, out_size, ws_size, (size_t)WS_END); grid = -1; return; }
        int dev = 0, cus = 0, per_cu = 0;
        if (hipGetDevice(&dev) != hipSuccess || hipDeviceGetAttribute(&cus, hipDeviceAttributeMultiprocessorCount, dev) != hipSuccess) { grid = -1; return; }
        if (hipFuncSetAttribute((const void*)mk_fwd, hipFuncAttributeMaxDynamicSharedMemorySize, LDS_BYTES) != hipSuccess) { fprintf(stderr, "kernel_launch: hipFuncSetAttribute(%d B LDS) failed\n", LDS_BYTES); grid = -1; return; }
        if (hipOccupancyMaxActiveBlocksPerMultiprocessor(&per_cu, (const void*)mk_fwd, NWAVES * 64, LDS_BYTES) != hipSuccess || per_cu < 1) fprintf(stderr, "kernel_launch: occupancy query says %d\n", per_cu);
        (void)hipGetLastError();
        grid = cus;
        if (grid != 256) fprintf(stderr, "kernel_launch: %d CUs (built for 256)\n", grid);
    }
    if (grid < 0) return;
    (void)hipMemsetAsync((char*)d_ws + WS_CTL, 0, CTL_ZERO_BYTES, stream);
    Args a{};
    for (int i = 0; i < 18; ++i) a.in[i] = (const float*)d_in[i];
    a.out = (float*)d_out; a.ws = (unsigned char*)d_ws;
#ifdef MK_REPEAT
    a.rep_k = MK_REPEAT; a.rep_n = MK_REPEAT_N;
#else
    a.rep_k = -1; a.rep_n = 0;
#endif
    for (int li = 0; li < N_LAUNCHES; ++li) {
        a.ph_lo = (N_LAUNCHES == 1) ? 0 : li; a.ph_hi = (N_LAUNCHES == 1) ? NPH : li + 1;
        hipLaunchKernelGGL(mk_fwd, dim3(grid), dim3(NWAVES * 64), LDS_BYTES, stream, a);
    }
}
```

```cpp
#include <hip/hip_runtime.h>
#include <cstdio>
#include <cstdint>

#ifndef MK_N_LAUNCHES
#define MK_N_LAUNCHES 1
#endif

#define LAS __attribute__((address_space(3)))
#define GAS __attribute__((address_space(1)))
typedef unsigned short bf16;
typedef short bf16x8 __attribute__((ext_vector_type(8)));
typedef float f32x4 __attribute__((ext_vector_type(4)));
typedef float f32x2 __attribute__((ext_vector_type(2)));
typedef float f32x16 __attribute__((ext_vector_type(16)));
typedef unsigned u32x4 __attribute__((ext_vector_type(4)));
typedef unsigned u32x2 __attribute__((ext_vector_type(2)));
typedef __bf16 bf16x2_t __attribute__((ext_vector_type(2)));
typedef int v8i32 __attribute__((ext_vector_type(8)));
typedef int i32x4 __attribute__((ext_vector_type(4)));

constexpr int NWAVES = 8;
constexpr int M = 16384, D = 1024, SEQ = 2048;
constexpr int NZS = 8208;
constexpr int NZ = 8192;
constexpr int NE = 32, CAP = 16384;
constexpr int NPH = 11;
constexpr int N_LAUNCHES = MK_N_LAUNCHES;
constexpr size_t ZQ = 0, ZK = ZQ + (size_t)4 * M * 128, ZV = ZK + (size_t)4 * M * 128, ZR = ZV + (size_t)4 * M * 256, ZCB = ZR + (size_t)4 * M * 256, ZCC = ZCB + (size_t)M * 1024, ZCX = ZCC + (size_t)M * 1024, ZGA = ZCX + (size_t)M * 1024, ZGB = ZGA + (size_t)M * 1024;

constexpr size_t MiB = 1u << 20;
constexpr size_t WS_CTL = 0, CTL_ZERO_BYTES = 65536;
constexpr size_t WS_LIST = 1 * MiB;
constexpr size_t WS_GATE = 3 * MiB;
constexpr size_t WS_DECS = 4 * MiB;
constexpr size_t WS_WIN = 16 * MiB;
constexpr size_t WS_WA = 32 * MiB, WS_WB = 34 * MiB, WS_WO = 36 * MiB;
constexpr size_t WS_WGU = 40 * MiB;
constexpr size_t WS_WD = 168 * MiB;
constexpr size_t WS_XN = 232 * MiB;
constexpr size_t WS_LA = 264 * MiB;
constexpr size_t WS_Z = 296 * MiB;
constexpr size_t WS_YP = WS_Z;
constexpr size_t WS_U = 552 * MiB;
constexpr size_t WS_SIN = 584 * MiB;
constexpr size_t WS_OG = 616 * MiB;
constexpr size_t WS_PB = 648 * MiB;
constexpr size_t WS_M1 = 680 * MiB;
constexpr size_t WS_MIX = 744 * MiB;
constexpr size_t WS_X1 = 776 * MiB;
constexpr size_t WS_ACT = 840 * MiB;
constexpr size_t WS_END = 984 * MiB;
constexpr int CW_TMO = 0;
constexpr int CW_BAR = 4096;
constexpr int CW_CNT = 8192;
constexpr int CW_STAMP = 12288;

constexpr int RING_BYTES = 131072;
constexpr int EXTRA_OFF = RING_BYTES;
constexpr int LDS_BYTES = 155648 + 512;
constexpr int MISC_OFF = 155648;

#define RLX_AGENT __ATOMIC_RELAXED, __HIP_MEMORY_SCOPE_AGENT
#define LDS_WAIT() asm volatile("s_waitcnt lgkmcnt(0)" ::: "memory")
#define VM_WAIT() asm volatile("s_waitcnt vmcnt(0)" ::: "memory")
__device__ __forceinline__ unsigned pk2(float lo, float hi) { f32x2 v = {lo, hi}; bf16x2_t b = __builtin_convertvector(v, bf16x2_t); return __builtin_bit_cast(unsigned, b); }
__device__ __forceinline__ unsigned pk4_fp8(float a, float b, float c, float d) { int w = 0; w = __builtin_amdgcn_cvt_pk_fp8_f32(a, b, w, false); w = __builtin_amdgcn_cvt_pk_fp8_f32(c, d, w, true); return (unsigned)w; }
__device__ __forceinline__ float bf_lo(unsigned w) { return __builtin_bit_cast(float, w << 16); }
__device__ __forceinline__ float bf_hi(unsigned w) { return __builtin_bit_cast(float, w & 0xffff0000u); }
__device__ __forceinline__ float bf1(bf16 b) { return __builtin_bit_cast(float, ((unsigned)b) << 16); }
__device__ __forceinline__ float fast_sigmoid(float x) { return __builtin_amdgcn_rcpf(1.0f + __expf(-x)); }
__device__ __forceinline__ float wave_sum(float v) {
#pragma unroll
    for (int o = 1; o < 64; o <<= 1) v += __shfl_xor(v, o);
    return v;
}

namespace pg8 {
constexpr int BM = 256, BK = 64, HALF = 128, HTB = HALF * BK * 2, STAGE_BYTES = 8 * HTB, NXCD = 8, WGM = 8;
__device__ __forceinline__ int lds_byte(int r, int c) { const int st = (r >> 4) * 2 + (c >> 5), rr = r & 15, cc = c & 31, ob = rr * 64 + cc * 2; return st * 1024 + (ob ^ (((ob >> 9) & 1) << 5)); }
__device__ __forceinline__ void stage_rc(int b, int& R, int& C) { const int st = b / 1024, sb = b % 1024, swz = sb ^ (((sb >> 9) & 1) << 5); R = (st >> 1) * 16 + swz / 64; C = (st & 1) * 32 + (swz % 64) / 2; }
__device__ __forceinline__ int perm32(int rho) { const int n = rho >> 4, i = rho & 15; return 8 * (i >> 2) + 4 * n + (i & 3); }

struct Unit { int pm, pn, e, rt, ui; };

struct StaticOrder {
    int nM, nN, nwg, G, c, K, reps;
    __device__ __forceinline__ void init(int M_, int N_, int K_, int G_, int c_, int reps_) { nM = M_ / BM; nN = N_ / BM; nwg = nM * nN; G = G_; c = c_; K = K_; reps = reps_; }
    __device__ __forceinline__ bool next(int i, Unit& u) const {
        const long L = (long)i * G + c; if (L >= (long)nwg * reps) return false;
        int wgid = (int)(L % nwg); { const int q = nwg / NXCD, r = nwg % NXCD, xcd = wgid % NXCD, off = wgid / NXCD; wgid = (xcd < r ? xcd * (q + 1) : r * (q + 1) + (xcd - r) * q) + off; }
        const int nig = WGM * nN, gid = wgid / nig, fm = gid * WGM, gsz = (nM - fm) < WGM ? (nM - fm) : WGM;
        u.pm = fm + ((wgid % nig) % gsz); u.pn = (wgid % nig) / gsz; u.e = 0; u.rt = 0; u.ui = i; return true;
    }
    __device__ __forceinline__ unsigned arow(const Unit& u, int ui, int r) const { return (unsigned)(u.pm * BM + r) * (unsigned)(K * 2); }
    __device__ __forceinline__ void after_unit(int ui) const {}
    __device__ __forceinline__ bool keep_acc(int ui) const { return false; }
};

template <class Epi, class Sched, bool ALIGN_EPI, bool FP8 = false, int SCW = 127>
__device__ __forceinline__ void gemm_phase(LAS unsigned char* lds, const void* Ag, const void* Btg, const int K, const Sched& S, const Epi& E) {
    const int tid = threadIdx.x, wid = __builtin_amdgcn_readfirstlane(tid >> 6), lane = tid & 63, wr = wid >> 2, wc = wid & 3, fr = lane & 15, fq = lane >> 4;
    const int RB = FP8 ? K : 2 * K;
    const int nt = RB / 128;
    int RA[2], CA[2]; unsigned voffB[2];
#pragma unroll
    for (int i = 0; i < 2; ++i) { int R, C; stage_rc(tid * 16 + i * 8192, R, C); const int Rb = Epi::PERM ? ((R & ~31) + perm32(R & 31)) : R;
        RA[i] = R; CA[i] = C * 2; voffB[i] = (unsigned)(Rb * RB + C * 2); }
    const size_t kstep = (size_t)(BK * 2);
    const size_t hstep = (size_t)HALF * RB;
    const size_t tstep = 2 * hstep;
    const unsigned ldsw = (unsigned)wid * 1024u;
    const int aoff = lds_byte(wr * 64 + fr, fq * 8), boff = lds_byte(wc * 32 + fr, fq * 8);
#define PG8_SA(b, h) (((b) * 2 + (h)) * HTB)
#define PG8_SB(b, h) ((4 + (b) * 2 + (h)) * HTB)
#define PG8_STAGEB(bufoff, gbase) do { _Pragma("unroll") for (int _i = 0; _i < 2; ++_i) \
        __builtin_amdgcn_global_load_lds((const unsigned*)((const char*)(gbase) + voffB[_i]), (LAS unsigned*)(lds + (bufoff) + ldsw + _i * 8192), 16, 0, 0); } while (0)
#define PG8_STAGEA(bufoff, o0, o1) do { \
        __builtin_amdgcn_global_load_lds((const unsigned*)((const char*)Ag + (o0)), (LAS unsigned*)(lds + (bufoff) + ldsw), 16, 0, 0); \
        __builtin_amdgcn_global_load_lds((const unsigned*)((const char*)Ag + (o1)), (LAS unsigned*)(lds + (bufoff) + ldsw + 8192), 16, 0, 0); } while (0)
#define PG8_LDA(dst, b, h) do { if constexpr (FP8) { _Pragma("unroll") for (int m = 0; m < 4; ++m) { dst[m][0] = *(const LAS bf16x8*)(lds + PG8_SA(b, h) + aoff + m * 2048); dst[m][1] = *(const LAS bf16x8*)(lds + PG8_SA(b, h) + aoff + m * 2048 + 1024); } } \
        else { _Pragma("unroll") for (int m = 0; m < 4; ++m) _Pragma("unroll") for (int k = 0; k < 2; ++k) dst[m][k] = *(const LAS bf16x8*)(lds + PG8_SA(b, h) + aoff + m * 2048 + k * 1024); } } while (0)
#define PG8_LDB(dst, b, h) do { if constexpr (FP8) { _Pragma("unroll") for (int n = 0; n < 2; ++n) { dst[n][0] = *(const LAS bf16x8*)(lds + PG8_SB(b, h) + boff + n * 2048); dst[n][1] = *(const LAS bf16x8*)(lds + PG8_SB(b, h) + boff + n * 2048 + 1024); } } \
        else { _Pragma("unroll") for (int n = 0; n < 2; ++n) _Pragma("unroll") for (int k = 0; k < 2; ++k) dst[n][k] = *(const LAS bf16x8*)(lds + PG8_SB(b, h) + boff + n * 2048 + k * 1024); } } while (0)
#define PG8_F8(x) __builtin_bit_cast(v8i32, __builtin_shufflevector(__builtin_bit_cast(u32x4, (x)[0]), __builtin_bit_cast(u32x4, (x)[1]), 0, 1, 2, 3, 4, 5, 6, 7))
#define PG8_MMA(ai, bj, At, Bt) do { __builtin_amdgcn_s_setprio(1); if constexpr (FP8) { _Pragma("unroll") for (int m = 0; m < 4; ++m) _Pragma("unroll") for (int n = 0; n < 2; ++n) \
        asm volatile("v_mfma_scale_f32_16x16x128_f8f6f4 %0, %1, %2, %0, %3, %4 op_sel_hi:[0,0,0]" : "+v"(acc[ai][bj][m][n]) : "v"(PG8_F8(Bt[n])), "v"(PG8_F8(At[m])), "v"(scw_reg), "v"(sca_reg)); } \
        else { _Pragma("unroll") for (int m = 0; m < 4; ++m) _Pragma("unroll") for (int n = 0; n < 2; ++n) _Pragma("unroll") for (int k = 0; k < 2; ++k) \
        acc[ai][bj][m][n] = __builtin_amdgcn_mfma_f32_16x16x32_bf16(Bt[n][k], At[m][k], acc[ai][bj][m][n], 0, 0, 0); } __builtin_amdgcn_s_setprio(0); } while (0)
#define PG8_WAIT_V(n) asm volatile("s_waitcnt vmcnt(" #n ")" ::: "memory")
#define PG8_WAIT_L(n) asm volatile("s_waitcnt lgkmcnt(" #n ")" ::: "memory")
#define PG8_BAR __builtin_amdgcn_s_barrier()
#define PG8_SCHED __builtin_amdgcn_sched_barrier(0)
    Unit cur, nxt; int ui = 0;
    if (!S.next(0, cur)) return;
    int scw_reg = SCW, sca_reg = 127;
    asm volatile("" : "+v"(scw_reg), "+v"(sca_reg));
    f32x4 acc[2][2][4][2];
#pragma unroll
    for (int a = 0; a < 2; ++a)
#pragma unroll
        for (int b = 0; b < 2; ++b)
#pragma unroll
            for (int m = 0; m < 4; ++m)
#pragma unroll
                for (int n = 0; n < 2; ++n) acc[a][b][m][n] = (f32x4){0.f, 0.f, 0.f, 0.f};
#define PG8_ZPAD() do { if constexpr (FP8) { _Pragma("unroll") for (int a = 0; a < 2; ++a) _Pragma("unroll") for (int b = 0; b < 2; ++b) _Pragma("unroll") for (int m = 0; m < 4; ++m) asm volatile("s_nop 1" : "+v"(acc[a][b][m][0]), "+v"(acc[a][b][m][1])); } } while (0)
    PG8_ZPAD();
    bf16x8 At[4][2], B0[2][2], B1[2][2];
    unsigned ac00, ac01, ac10, ac11;
    ac00 = S.arow(cur, 0, RA[0]) + CA[0]; ac01 = S.arow(cur, 0, RA[1]) + CA[1]; ac10 = S.arow(cur, 0, HALF + RA[0]) + CA[0]; ac11 = S.arow(cur, 0, HALF + RA[1]) + CA[1];
    const char* cB = (const char*)Btg + (size_t)cur.pn * tstep;
    PG8_STAGEB(PG8_SB(0, 0), cB); PG8_STAGEB(PG8_SB(0, 1), cB + hstep); PG8_STAGEA(PG8_SA(0, 0), ac00, ac01); PG8_STAGEA(PG8_SA(0, 1), ac10, ac11);
    if (wr == 1) PG8_BAR;
    PG8_WAIT_V(2); PG8_BAR;
    PG8_STAGEB(PG8_SB(1, 0), cB + kstep); PG8_STAGEA(PG8_SA(1, 0), ac00 + 128u, ac01 + 128u); PG8_STAGEB(PG8_SB(1, 1), cB + hstep + kstep);
    PG8_WAIT_V(6); PG8_BAR;
    for (;;) {
        const bool has_next = S.next(ui + 1, nxt);
        const char* nB = has_next ? (const char*)Btg + (size_t)nxt.pn * tstep : cB;
#pragma unroll 1
        for (int t = 0; t < nt; t += 2) {
            const bool last = (t == nt - 2);
            const unsigned k1 = (unsigned)(t + 1) * 128u, k2 = (unsigned)(t + 2) * 128u;
            unsigned a200 = ac00 + k2, a201 = ac01 + k2, a210 = ac10 + k2, a211 = ac11 + k2;
            if (last) { if (has_next) { a200 = S.arow(nxt, ui + 1, RA[0]) + CA[0]; a201 = S.arow(nxt, ui + 1, RA[1]) + CA[1]; a210 = S.arow(nxt, ui + 1, HALF + RA[0]) + CA[0]; a211 = S.arow(nxt, ui + 1, HALF + RA[1]) + CA[1]; }
                        else { a200 = ac00; a201 = ac01; a210 = ac10; a211 = ac11; } }
            const char* b2 = last ? nB : cB + (size_t)k2; const char* b3 = b2 + kstep;
            PG8_LDB(B0, 0, 0); PG8_LDB(B1, 0, 1); PG8_SCHED; PG8_LDA(At, 0, 0); PG8_STAGEA(PG8_SA(1, 1), ac10 + k1, ac11 + k1);
            PG8_WAIT_V(8); PG8_WAIT_L(0); PG8_BAR; PG8_MMA(0, 0, At, B0); PG8_MMA(0, 1, At, B1); PG8_BAR; PG8_SCHED;
            PG8_LDA(At, 0, 1); PG8_STAGEB(PG8_SB(0, 0), b2); PG8_STAGEB(PG8_SB(0, 1), b2 + hstep); PG8_STAGEA(PG8_SA(0, 0), a200, a201);
            PG8_WAIT_V(8); PG8_WAIT_L(0); PG8_BAR; PG8_MMA(1, 0, At, B0); PG8_MMA(1, 1, At, B1); PG8_BAR; PG8_SCHED;
            PG8_LDB(B0, 1, 0); PG8_LDB(B1, 1, 1); PG8_SCHED; PG8_LDA(At, 1, 0); PG8_STAGEA(PG8_SA(0, 1), a210, a211);
            PG8_WAIT_V(8); PG8_WAIT_L(0); PG8_BAR; PG8_MMA(0, 0, At, B0); PG8_MMA(0, 1, At, B1); PG8_BAR; PG8_SCHED;
            PG8_LDA(At, 1, 1); PG8_STAGEB(PG8_SB(1, 0), b3); PG8_STAGEB(PG8_SB(1, 1), b3 + hstep); PG8_STAGEA(PG8_SA(1, 0), a200 + 128u, a201 + 128u);
            PG8_WAIT_V(8); PG8_WAIT_L(0); PG8_BAR; PG8_MMA(1, 0, At, B0); PG8_MMA(1, 1, At, B1); PG8_BAR; PG8_SCHED;
        }
        if constexpr (FP8) asm volatile("s_nop 15\n\ts_nop 15" ::: "memory");
#pragma unroll
        for (int a = 0; a < 2; ++a)
#pragma unroll
            for (int b = 0; b < 2; ++b)
#pragma unroll
                for (int m = 0; m < 4; ++m) asm volatile("" : "+v"(acc[a][b][m][0]), "+v"(acc[a][b][m][1]));
        if constexpr (ALIGN_EPI) { if (wr == 0) PG8_BAR; }
        E(acc, cur, wr, wc, fr, fq);
        S.after_unit(ui);
        if (!has_next) break;
        if (!S.keep_acc(ui)) {
#pragma unroll
        for (int a = 0; a < 2; ++a)
#pragma unroll
            for (int b = 0; b < 2; ++b)
#pragma unroll
                for (int m = 0; m < 4; ++m)
#pragma unroll
                    for (int n = 0; n < 2; ++n) acc[a][b][m][n] = (f32x4){0.f, 0.f, 0.f, 0.f};
        }
        PG8_ZPAD();
        cur = nxt; cB = nB; ++ui;
        ac00 = S.arow(cur, ui, RA[0]) + CA[0]; ac01 = S.arow(cur, ui, RA[1]) + CA[1]; ac10 = S.arow(cur, ui, HALF + RA[0]) + CA[0]; ac11 = S.arow(cur, ui, HALF + RA[1]) + CA[1];
        if constexpr (ALIGN_EPI) { if (wr == 1) PG8_BAR; }
    }
    PG8_WAIT_V(0);
    if constexpr (!ALIGN_EPI) { if (wr == 0) PG8_BAR; }
    PG8_BAR;
#undef PG8_SA
#undef PG8_SB
#undef PG8_STAGEA
#undef PG8_STAGEB
#undef PG8_LDA
#undef PG8_LDB
#undef PG8_MMA
#undef PG8_F8
#undef PG8_ZPAD
#undef PG8_WAIT_V
#undef PG8_WAIT_L
#undef PG8_BAR
#undef PG8_SCHED
}
}

#define XB_TMO      128
#define XB_XCNT(j)  (256  + 64 * (j))
#define XB_XSUB(j)  (1280 + 64 * (j))
#define XB_XGEN(j)  (2304 + 64 * (j))
#define XB_TOP      3328
#define XB_TOPGEN   3392
#define XCD_BAR_WORDS 3456
#define XB_SPIN_CAP (1u << 18)
__device__ __forceinline__ unsigned xb_ld(unsigned* p)              { return __hip_atomic_load(p, __ATOMIC_RELAXED, __HIP_MEMORY_SCOPE_AGENT); }
__device__ __forceinline__ unsigned xb_add(unsigned* p, unsigned v) { return __hip_atomic_fetch_add(p, v, __ATOMIC_RELAXED, __HIP_MEMORY_SCOPE_AGENT); }
__device__ __forceinline__ unsigned xb_xcc_id() { return (unsigned)__builtin_amdgcn_s_getreg((3 << 11) | 20) & 0xFu; }
#define XB_SPIN(cond, bar) do { unsigned _sp = 0; while (cond) { __builtin_amdgcn_s_sleep(1); \
    if ((++_sp & 255u) == 0u) { if (xb_ld(&(bar)[XB_TMO])) break; if (_sp > XB_SPIN_CAP) { atomicAdd(&(bar)[XB_TMO], 1u); break; } } } } while (0)
struct XcdBarrier { unsigned* bar; unsigned x; volatile LAS unsigned* st; };
__device__ __forceinline__ XcdBarrier xcd_barrier_post(unsigned* bar, volatile LAS unsigned* st) {
    XcdBarrier b; b.bar = bar; b.x = xb_xcc_id(); b.st = st;
    if (threadIdx.x == 0) (void)xb_add(&bar[XB_XCNT(b.x)], 1u);
    return b;
}
__device__ __forceinline__ void xcd_barrier_complete(unsigned* bar, unsigned x, unsigned& nloc, unsigned& nx) {
    const unsigned G = gridDim.x * gridDim.y * gridDim.z;
    unsigned sum, cnt, mine, sp = 0u;
    for (;;) {
        sum = 0u; cnt = 0u; mine = 0u;
#pragma unroll
        for (unsigned j = 0; j < 16; ++j) { const unsigned c = xb_ld(&bar[XB_XCNT(j)]); sum += c; cnt += (c > 0u) ? 1u : 0u; mine = (j == x) ? c : mine; }
        if (sum == G) break;
        __builtin_amdgcn_s_sleep(1);
        if ((++sp & 255u) == 0u) { if (xb_ld(&bar[XB_TMO])) break; if (sp > XB_SPIN_CAP) { atomicAdd(&bar[XB_TMO], 1u); break; } }
    }
    nloc = mine > 0u ? mine : 1u; nx = cnt > 0u ? cnt : 1u;
}
__device__ __forceinline__ void xcd_barrier(const XcdBarrier& b) {
    asm volatile("s_waitcnt vmcnt(0)" ::: "memory");
    __syncthreads();
    if (threadIdx.x == 0) {
        unsigned* bar = b.bar;
        __builtin_amdgcn_s_waitcnt(0);
        unsigned nloc = b.st[0], nx = b.st[1];
        if (nloc == 0u) { xcd_barrier_complete(bar, b.x, nloc, nx); b.st[0] = nloc; b.st[1] = nx; }
        const unsigned old = xb_add(&bar[XB_XSUB(b.x)], 1u);
        const unsigned gen = old / nloc;
        if (old + 1u == (gen + 1u) * nloc) {
            __builtin_amdgcn_fence(__ATOMIC_RELEASE, "agent");
            asm volatile("s_waitcnt vmcnt(0)" ::: "memory");
            const unsigned og = xb_add(&bar[XB_TOP], 1u);
            const unsigned tg = og / nx;
            if (og + 1u == (tg + 1u) * nx) xb_add(&bar[XB_TOPGEN], 1u);
            else XB_SPIN(xb_ld(&bar[XB_TOPGEN]) == tg, bar);
            __builtin_amdgcn_fence(__ATOMIC_ACQUIRE, "agent");
            xb_add(&bar[XB_XGEN(b.x)], 1u);
            asm volatile("s_waitcnt vmcnt(0)" ::: "memory");
        } else {
            XB_SPIN(xb_ld(&bar[XB_XGEN(b.x)]) == gen, bar);
            __builtin_amdgcn_fence(__ATOMIC_ACQUIRE, "agent");
            asm volatile("s_waitcnt vmcnt(0)" ::: "memory");
        }
    }
    __syncthreads();
}

struct Frame {
    LAS unsigned char* lds;
    volatile LAS unsigned* MISC;
    unsigned* ctl;
    int tid, lane, wave, vcu, G;
    unsigned char* ws;
    const float *x, *g_mix, *w_in, *w_up, *b_alpha, *g_gla, *w_conv, *w_a, *w_b, *w_out, *g_ffn, *w_router, *b_router, *w_gu, *b_gu, *w_d, *b_d, *g_final;
    float* out;
};
#define WSP(T, off) ((T*)(F.ws + (off)))

__device__ __forceinline__ void tr_item64(const float* W, int ld, int k0, int n0, bf16* WT, size_t dst_row0, int K, LAS unsigned* T, int lane) {
    const int nq = lane & 15, kr = lane >> 4;
    const float* src = W + (size_t)(k0 + 2 * kr) * ld + n0 + 4 * nq;
    f32x4 a0[8], a1[8];
#pragma unroll
    for (int it = 0; it < 8; ++it) { a0[it] = __builtin_nontemporal_load((const f32x4*)(src + (size_t)(8 * it) * ld)); a1[it] = __builtin_nontemporal_load((const f32x4*)(src + (size_t)(8 * it + 1) * ld)); }
    const int c = lane & 7;
#pragma unroll
    for (int hf = 0; hf < 2; ++hf) {
        if ((nq >> 3) == hf) {
#pragma unroll
            for (int it = 0; it < 8; ++it)
#pragma unroll
                for (int q = 0; q < 4; ++q) T[(4 * (nq & 7) + q) * 33 + 4 * it + kr] = pk2(a0[it][q], a1[it][q]);
        }
        LDS_WAIT(); asm volatile("" ::: "memory");
#pragma unroll
        for (int j = 0; j < 4; ++j) { const int n = (lane >> 3) + 8 * j; const LAS unsigned* t = T + n * 33 + 4 * c;
            u32x4 o; o.x = t[0]; o.y = t[1]; o.z = t[2]; o.w = t[3];
            *(u32x4*)(WT + (dst_row0 + 32 * hf + n) * (size_t)K + k0 + 8 * c) = o; }
        LDS_WAIT(); asm volatile("" ::: "memory");
    }
}

__device__ __forceinline__ void tr_item8(const float* W, int ld, int k0, int n0, unsigned char* WT8, size_t dst_row0, int KB, float scale, LAS unsigned* T, int lane) {
    const int nq = lane & 7, kr = lane >> 3;
    const float* src = W + (size_t)(k0 + 4 * kr) * ld + n0 + 4 * nq;
    f32x4 a[4][4];
#pragma unroll
    for (int it = 0; it < 4; ++it)
#pragma unroll
        for (int j = 0; j < 4; ++j) a[it][j] = __builtin_nontemporal_load((const f32x4*)(src + (size_t)(32 * it + j) * ld));
    const int c = lane & 7;
#pragma unroll
    for (int hf = 0; hf < 2; ++hf) {
        if ((nq >> 2) == hf) {
#pragma unroll
            for (int it = 0; it < 4; ++it)
#pragma unroll
                for (int q = 0; q < 4; ++q) T[(4 * (nq & 3) + q) * 33 + 8 * it + kr] = pk4_fp8(a[it][0][q] * scale, a[it][1][q] * scale, a[it][2][q] * scale, a[it][3][q] * scale);
        }
        LDS_WAIT(); asm volatile("" ::: "memory");
#pragma unroll
        for (int j = 0; j < 2; ++j) { const int n = (lane >> 3) + 8 * j; const LAS unsigned* t = T + n * 33 + 4 * c;
            u32x4 o; o.x = t[0]; o.y = t[1]; o.z = t[2]; o.w = t[3];
            __builtin_nontemporal_store(o, (u32x4*)(WT8 + (dst_row0 + 16 * hf + n) * (size_t)KB + k0 + 16 * c)); }
        LDS_WAIT(); asm volatile("" ::: "memory");
    }
}
constexpr int MOE_NIT = NE * 64 * 8 + NE * 32 * 8;
#ifndef MK_MOE_SPLIT
#define MK_MOE_SPLIT 0
#endif
constexpr int MOE_SPLIT = MK_MOE_SPLIT;
__device__ __forceinline__ void moe_convert_range(const float* w_gu, const float* w_d, unsigned char* ws, LAS unsigned* T, int first, int step, int end, int lane) {
    constexpr int I_GU = NE * 64 * 8;
    for (int it = first; it < end; it += step) {
        int r = it;
        if (r < I_GU) { const int e = r >> 9, q = r & 511, kb = q >> 6, nb = q & 63, j0 = 32 * nb, pn = j0 >> 8, within = j0 & 255, half = within >> 7;
            tr_item8(w_gu + (size_t)e * 1024 * 2048, 2048, 128 * kb, half * 1024 + pn * 128 + (within & 127), ws + WS_WGU + (size_t)e * 2048 * 1024, j0, 1024, 32.0f, T, lane); continue; } r -= I_GU;
        { const int e = r >> 8, q = r & 255, kb = q >> 5, nb = q & 31;
            tr_item8(w_d + (size_t)e * 1024 * 1024, 1024, 128 * kb, 32 * nb, ws + WS_WD + (size_t)e * 1024 * 1024, 32 * nb, 1024, 32.0f, T, lane); }
    }
}
__device__ __forceinline__ void moe_convert_share(const float* w_gu, const float* w_d, unsigned char* ws, LAS unsigned char* lds, int c, int G, int wave, int lane) {
    moe_convert_range(w_gu, w_d, ws, (LAS unsigned*)(lds + EXTRA_OFF + wave * 2176), MOE_SPLIT + c * NWAVES + wave, G * NWAVES, MOE_NIT, lane);
}
struct P1Order : pg8::StaticOrder {
    const float* w_gu; const float* w_d; unsigned char* ws; LAS unsigned char* lds; int slot, wave, lane;
    __device__ __forceinline__ void after_unit(int ui) const { if (ui == slot) { int ln = lane; asm volatile("" : "+v"(ln));
            moe_convert_share(w_gu, w_d, ws, lds, c, G, wave, ln); } }
};

constexpr int P0_T_BYTES = 4352;
constexpr int P0_WLD = 2064;
constexpr int P0_WL = 8 * P0_T_BYTES;
constexpr int P0_WU = P0_WL + 16 * P0_WLD;
constexpr int P0_BA = P0_WU + 16384;
constexpr int P0_AS = P0_BA + 2048;

__device__ __forceinline__ void p0_items(Frame& F, const int nrep) {
    LAS unsigned* scr = (LAS unsigned*)(F.lds + F.wave * P0_T_BYTES);
    const int gw = F.vcu * NWAVES + F.wave, NGW = F.G * NWAVES;
    constexpr int I_IN = 128 * 16, I_SQ = 16 * 16;
    constexpr int NITEMS = I_IN + 3 * I_SQ;
    bf16* Win_t = WSP(bf16, WS_WIN);
    for (int it0 = gw; it0 < NITEMS * nrep; it0 += NGW) {
        int r = it0 % NITEMS;
        if (r < I_IN) { const int kb = r >> 7, nb = r & 127, j0 = 64 * nb;
            int srcc = j0 < 3072 ? j0 : j0 + 16;
            if (j0 >= 4096 && j0 < 6144) { const int pn = j0 >> 8, within = j0 & 255; srcc = ((within >> 7) ? 5136 : 4112) + (pn - 16) * 128 + (within & 127); }
            tr_item64(F.w_in, NZS, 64 * kb, srcc, Win_t, j0, 1024, scr, F.lane); continue; } r -= I_IN;
        if (r < I_SQ) { tr_item64(F.w_a, 1024, 64 * (r >> 4), 64 * (r & 15), WSP(bf16, WS_WA), 64 * (r & 15), 1024, scr, F.lane); continue; } r -= I_SQ;
        if (r < I_SQ) { tr_item64(F.w_b, 1024, 64 * (r >> 4), 64 * (r & 15), WSP(bf16, WS_WB), 64 * (r & 15), 1024, scr, F.lane); continue; } r -= I_SQ;
        tr_item64(F.w_out, 1024, 64 * (r >> 4), 64 * (r & 15), WSP(bf16, WS_WO), 64 * (r & 15), 1024, scr, F.lane);
    }
    moe_convert_range(F.w_gu, F.w_d, F.ws, scr, gw, NGW, MOE_SPLIT, F.lane);
}

__device__ __forceinline__ void p0_rows(Frame& F, const int nrep2) {
    const int gw = F.vcu * NWAVES + F.wave, NGW = F.G * NWAVES, lane = F.lane, r32 = lane & 31, h = lane >> 5;
    LAS unsigned char* L = F.lds;
    LAS float* BA = (LAS float*)(L + P0_BA);
    LAS float* AS = (LAS float*)(L + P0_AS + F.wave * 512);
    f32x4 g[4];
#pragma unroll
    for (int j = 0; j < 4; ++j) g[j] = *((const f32x4*)F.g_mix + lane + 64 * j);
    bf16* XN = WSP(bf16, WS_XN); bf16* LA = WSP(bf16, WS_LA);
#pragma unroll 1
    for (int b8 = 0; (b8 * 8) * NGW + gw < M * nrep2; ++b8) {
        f32x4 nx[4];
        { const f32x4* xr = (const f32x4*)(F.x + (size_t)(((b8 * 8) * NGW + gw) % M) * D) + lane;
#pragma unroll
          for (int j = 0; j < 4; ++j) nx[j] = __builtin_nontemporal_load(xr + 64 * j); }
#pragma unroll 1
        for (int i = 0; i < 8; ++i) {
            const int m = ((b8 * 8 + i) * NGW + gw) % M;
            f32x4 v[4]; float s = 0.f;
#pragma unroll
            for (int j = 0; j < 4; ++j) { v[j] = nx[j]; s += (v[j].x * v[j].x + v[j].y * v[j].y) + (v[j].z * v[j].z + v[j].w * v[j].w); }
            if (i < 7) { const f32x4* xr = (const f32x4*)(F.x + (size_t)(((b8 * 8 + i + 1) * NGW + gw) % M) * D) + lane;
#pragma unroll
                for (int j = 0; j < 4; ++j) nx[j] = __builtin_nontemporal_load(xr + 64 * j); }
            const float rstd = 1.0f / sqrtf(wave_sum(s) * (1.f / D) + 1e-6f);
            unsigned long long* o8 = (unsigned long long*)(XN + (size_t)m * D) + lane;
#pragma unroll
            for (int j = 0; j < 4; ++j) { v[j] = v[j] * rstd * g[j]; o8[64 * j] = (unsigned long long)pk2(v[j].x, v[j].y) | ((unsigned long long)pk2(v[j].z, v[j].w) << 32); }
        }
        asm volatile("s_waitcnt vmcnt(0)" ::: "memory");
        {
            const int tl = lane & 7, kg = lane >> 4, rr = lane & 15;
            const bf16* ap = XN + (size_t)(((b8 * 8 + tl) * NGW + gw) % M) * D + 8 * kg;
            const LAS unsigned char* bp = L + P0_WL + rr * P0_WLD + 16 * kg;
            f32x4 ac = {0.f, 0.f, 0.f, 0.f};
#pragma unroll
            for (int k8 = 0; k8 < 4; ++k8) {
                bf16x8 af[8];
#pragma unroll
                for (int q = 0; q < 8; ++q) af[q] = *(const bf16x8*)(ap + 32 * (8 * k8 + q));
#pragma unroll
                for (int q = 0; q < 8; ++q) ac = __builtin_amdgcn_mfma_f32_16x16x32_bf16(af[q], *(const LAS bf16x8*)(bp + 64 * (8 * k8 + q)), ac, 0, 0, 0);
            }
            if (lane < 32) {
#pragma unroll
                for (int q = 0; q < 4; ++q) AS[(4 * kg + q) * 16 + rr] = ac[q]; }
        }
        {
            f32x4 a0 = {0.f, 0.f, 0.f, 0.f}, a1 = a0;
            if (r32 < 8) { a0 = *(const LAS f32x4*)(AS + r32 * 16 + 8 * h); a1 = *(const LAS f32x4*)(AS + r32 * 16 + 8 * h + 4); }
            u32x4 hi, lo;
            hi.x = pk2(a0[0], a0[1]); hi.y = pk2(a0[2], a0[3]); hi.z = pk2(a1[0], a1[1]); hi.w = pk2(a1[2], a1[3]);
            lo.x = pk2(a0[0] - bf_lo(hi.x), a0[1] - bf_hi(hi.x)); lo.y = pk2(a0[2] - bf_lo(hi.y), a0[3] - bf_hi(hi.y)); lo.z = pk2(a1[0] - bf_lo(hi.z), a1[1] - bf_hi(hi.z)); lo.w = pk2(a1[2] - bf_lo(hi.w), a1[3] - bf_hi(hi.w));
            const bf16x8 ahi = __builtin_bit_cast(bf16x8, hi), alo = __builtin_bit_cast(bf16x8, lo);
            int mrow[4];
#pragma unroll
            for (int q = 0; q < 4; ++q) mrow[q] = ((b8 * 8 + q + 4 * h) * NGW + gw) % M;
#pragma unroll 4
            for (int nt = 0; nt < 16; ++nt) {
                const bf16x8 bw = *(const LAS bf16x8*)(L + P0_WU + (32 * nt + r32) * 32 + 16 * h);
                f32x16 c16;
#pragma unroll
                for (int q = 0; q < 16; ++q) c16[q] = 0.f;
                c16 = __builtin_amdgcn_mfma_f32_32x32x16_bf16(ahi, bw, c16, 0, 0, 0);
                c16 = __builtin_amdgcn_mfma_f32_32x32x16_bf16(alo, bw, c16, 0, 0, 0);
                const float bb = BA[32 * nt + r32];
#pragma unroll
                for (int q = 0; q < 4; ++q) { const float pre = c16[q] + bb;
                    const float ls = fminf(pre, 0.f) - __logf(1.0f + __expf(-fabsf(pre)));
                    LA[((size_t)(nt >> 2) * M + mrow[q]) * 128 + 32 * (nt & 3) + r32] = (bf16)(pk2(ls * (1.0f / 16.0f), 0.f) & 0xffffu); }
            }
        }
    }
}

__device__ __forceinline__ void p0_prologue(Frame& F, const int nrep, const int nrep2) {
    {
        LAS unsigned char* L = F.lds;
        for (int i = 0; i < 32; ++i) { const int idx = F.tid + 512 * i, k = idx >> 4, r = idx & 15; *(LAS bf16*)(L + P0_WL + r * P0_WLD + 2 * k) = (bf16)(pk2(F.w_in[(size_t)k * NZS + 3072 + r], 0.f) & 0xffffu); }
        for (int i = 0; i < 16; ++i) { const int idx = F.tid + 512 * i, r = idx >> 9, n = idx & 511; *(LAS bf16*)(L + P0_WU + n * 32 + 2 * r) = (bf16)(pk2(F.w_up[idx], 0.f) & 0xffffu); }
        ((LAS float*)(L + P0_BA))[F.tid] = F.b_alpha[F.tid];
        __syncthreads();
    }
#pragma unroll 1
    for (int pass = 0; pass < 2; ++pass) {
        if (((pass ^ F.wave) & 1) == 0) p0_items(F, nrep); else p0_rows(F, nrep2);
    }
}

struct EpiZ {
    static constexpr bool PERM = true;
    bf16* Z;
    __device__ __forceinline__ void operator()(const f32x4 (&acc)[2][2][4][2], const pg8::Unit& u, int wr, int wc, int fr, int fq) const {
        const int row0 = u.pm * 256 + wr * 64 + fr, c0 = wc * 32 + 8 * fq;
        const int pn = u.pn;
        const int kind = pn < 2 ? 1 : (pn < 8 ? 0 : (pn < 12 ? 2 : (pn < 24 ? 0 : 3)));
        bf16* base; int ld; size_t bjs;
        if (pn < 4) { base = Z + (pn < 2 ? ZQ : ZK) + (size_t)(2 * (pn & 1)) * M * 128; ld = 128; bjs = (size_t)M * 128; }
        else if (pn < 12) { base = Z + (pn < 8 ? ZV : ZR) + (size_t)(pn & 3) * M * 256; ld = 256; bjs = 128; }
        else { const int t = (pn - 12) >> 2; base = Z + ZCB + (size_t)t * M * 1024 + (size_t)((pn - 12) & 3) * 256; ld = 1024; bjs = 128; }
        if (pn >= 16 && pn < 24) {
            bf16* ub = Z + ZCC + (size_t)(pn - 16) * 128;
#pragma unroll
            for (int ai = 0; ai < 2; ++ai)
#pragma unroll
                for (int m = 0; m < 4; ++m) { const f32x4 v0 = acc[ai][0][m][0] * acc[ai][1][m][0], v1 = acc[ai][0][m][1] * acc[ai][1][m][1];
                    u32x4 w; w.x = pk2(v0[0], v0[1]); w.y = pk2(v0[2], v0[3]); w.z = pk2(v1[0], v1[1]); w.w = pk2(v1[2], v1[3]);
                    *(u32x4*)(ub + (size_t)(row0 + ai * 128 + m * 16) * 1024 + c0) = w; }
            return;
        }
#pragma unroll
        for (int ai = 0; ai < 2; ++ai)
#pragma unroll
            for (int m = 0; m < 4; ++m) { bf16* rowp = base + (size_t)(row0 + ai * 128 + m * 16) * ld + c0;
#pragma unroll
                for (int bj = 0; bj < 2; ++bj) { f32x4 v0 = acc[ai][bj][m][0], v1 = acc[ai][bj][m][1];
                    if (kind == 1) { v0 = v0 * 0.08838834764831845f; v1 = v1 * 0.08838834764831845f; }
                    else if (kind == 2) {
#pragma unroll
                        for (int j = 0; j < 4; ++j) { v0[j] = v0[j] * fast_sigmoid(v0[j]); v1[j] = v1[j] * fast_sigmoid(v1[j]); } }
                    else if (kind == 3) {
                        unsigned q[8];
#pragma unroll
                        for (int j = 0; j < 4; ++j) { q[j] = (unsigned)__builtin_rintf(fast_sigmoid(v0[j]) * 255.0f); q[4 + j] = (unsigned)__builtin_rintf(fast_sigmoid(v1[j]) * 255.0f); }
                        u32x2 wq; wq.x = q[0] | (q[1] << 8) | (q[2] << 16) | (q[3] << 24); wq.y = q[4] | (q[5] << 8) | (q[6] << 16) | (q[7] << 24);
                        unsigned char* gbase = (unsigned char*)(Z + (pn < 28 ? ZGA : ZGB)) + (size_t)((pn - 24) & 3) * 256;
                        *(u32x2*)(gbase + (size_t)(row0 + ai * 128 + m * 16) * 1024 + c0 + bj * 128) = wq;
                        continue; }
                    u32x4 w; w.x = pk2(v0[0], v0[1]); w.y = pk2(v0[2], v0[3]); w.z = pk2(v1[0], v1[1]); w.w = pk2(v1[2], v1[3]);
                    *(u32x4*)(rowp + bj * bjs) = w; } }
    }
};

constexpr int QD_STRIDE = 272, KT_STRIDE = 144, SC_STRIDE = 144, OT_STRIDE = 1040;
constexpr int L_GG = 134144, L_WC = 135168;
constexpr int L_QD = 0, L_KI = 17408, L_KT = 34816, L_SC = 53248, L_DEC = 62464, L_SEG = 62976, L_OT = 67584;
__device__ __forceinline__ int crow(int reg, int h) { return (reg & 3) + 8 * (reg >> 2) + 4 * h; }

template <bool OUT>
__device__ __forceinline__ void gla_item(Frame& F, int item, const int cblk = -1) {
    const int bh = item >> 3, sc = item & 7, b = bh >> 2, hd = bh & 3;
    const int t0 = b * SEQ + sc * 256;
    const int tid = F.tid, lane = F.lane, w = F.wave, r32 = lane & 31, h = lane >> 5;
    const bf16* Z = WSP(const bf16, WS_Z);
    const bf16* LA = WSP(const bf16, WS_LA);
    LAS unsigned char* L = F.lds;
    f32x16 S[4];
    unsigned* Sbuf = (OUT ? WSP(unsigned, WS_SIN) : WSP(unsigned, WS_U)) + (size_t)item * 16384 + (size_t)w * 2048;
    if (OUT) {
#pragma unroll
        for (int kb = 0; kb < 4; ++kb)
#pragma unroll
            for (int r = 0; r < 16; r += 2) { const unsigned pw = Sbuf[(kb * 8 + (r >> 1)) * 64 + lane]; S[kb][r] = bf_lo(pw); S[kb][r + 1] = bf_hi(pw); }
    } else {
#pragma unroll
        for (int kb = 0; kb < 4; ++kb)
#pragma unroll
            for (int r = 0; r < 16; ++r) S[kb][r] = 0.f;
    }
    float btot_run0 = 0.f, btot_run1 = 0.f;
    const int tok_n = tid >> 3, part = tid & 7;
    unsigned la2[8], kk[8], qq[8]; bf16x8 Bv[4]; u32x4 rc[4];
#define GLA_LOAD(tcx) do { \
        const size_t rb_ = ((size_t)hd * M + (tcx) + 8 * w) * 128 + 2 * lane; \
        _Pragma("unroll") for (int i = 0; i < 8; ++i) { la2[i] = *(const unsigned*)(LA + rb_ + (size_t)i * 128); kk[i] = *(const unsigned*)(Z + ZK + rb_ + (size_t)i * 128); if (OUT) qq[i] = *(const unsigned*)(Z + ZQ + rb_ + (size_t)i * 128); } \
    } while (0)
#define GLA_LOADV(tcx) do { \
        _Pragma("unroll") for (int ks = 0; ks < 4; ++ks) _Pragma("unroll") for (int j = 0; j < 8; ++j) Bv[ks][j] = (short)Z[ZV + ((size_t)hd * M + (tcx) + 16 * ks + 8 * h + j) * 256 + 32 * w + r32]; \
    } while (0)
#define GLA_LOADR(tcx) do { \
        if (OUT) { const u32x4* rp_ = (const u32x4*)(Z + ZR + ((size_t)hd * M + (tcx) + tok_n) * 256 + 32 * part); _Pragma("unroll") for (int i = 0; i < 4; ++i) rc[i] = __builtin_nontemporal_load(rp_ + i); } \
    } while (0)
    u32x4 cv_c[4], cv_b[4], cv_p2, cv_p1; float cu1[8], cu2[8];
    const bool do_conv = !OUT && cblk >= 0;
    const int cm0 = cblk * 8, cs0 = do_conv ? cm0 % SEQ : 0;
#define CONV_ISSUE(sub) do { if (do_conv) { const int cj_ = (sub) >> 1, chb_ = (sub) & 1, cc_ = 8 * lane + 512 * cj_; \
        if (chb_ == 0) { const size_t rp_ = (size_t)(cs0 > 0 ? cm0 - 2 : cm0); \
            cv_p2 = __builtin_nontemporal_load((const u32x4*)(Z + ZCC + rp_ * 1024 + cc_)); cv_p1 = __builtin_nontemporal_load((const u32x4*)(Z + ZCC + (rp_ + 1) * 1024 + cc_)); \
 } \
        _Pragma("unroll") for (int rr = 0; rr < 4; ++rr) { const size_t row_ = (size_t)(cm0 + 4 * chb_ + rr); \
            cv_c[rr] = __builtin_nontemporal_load((const u32x4*)(Z + ZCC + row_ * 1024 + cc_)); cv_b[rr] = __builtin_nontemporal_load((const u32x4*)(Z + ZCB + row_ * 1024 + cc_)); } } } while (0)
#define CONV_FINISH(sub) do { if (do_conv) { const int cj_ = (sub) >> 1, chb_ = (sub) & 1, cc_ = 8 * lane + 512 * cj_; float cw0[8], cw1[8], cw2[8]; \
        { const LAS f32x4* wp_ = (const LAS f32x4*)(L + L_WC + 4 * cc_); _Pragma("unroll") for (int i = 0; i < 2; ++i) { const f32x4 t0_ = wp_[i], t1_ = wp_[256 + i], t2_ = wp_[512 + i]; \
            _Pragma("unroll") for (int q = 0; q < 4; ++q) { cw0[4 * i + q] = t0_[q]; cw1[4 * i + q] = t1_[q]; cw2[4 * i + q] = t2_[q]; } } } \
        if (chb_ == 0) { const float keep_ = cs0 > 0 ? 1.0f : 0.0f; \
            _Pragma("unroll") for (int i = 0; i < 4; ++i) { cu2[2 * i] = keep_ * bf_lo(cv_p2[i]); cu2[2 * i + 1] = keep_ * bf_hi(cv_p2[i]); cu1[2 * i] = keep_ * bf_lo(cv_p1[i]); cu1[2 * i + 1] = keep_ * bf_hi(cv_p1[i]); } } \
        _Pragma("unroll") for (int rr = 0; rr < 4; ++rr) { float u0_[8], y_[8]; \
            _Pragma("unroll") for (int i = 0; i < 4; ++i) { u0_[2 * i] = bf_lo(cv_c[rr][i]); u0_[2 * i + 1] = bf_hi(cv_c[rr][i]); } \
            _Pragma("unroll") for (int i = 0; i < 8; ++i) y_[i] = cw0[i] * cu2[i] + cw1[i] * cu1[i] + cw2[i] * u0_[i]; \
            u32x4 ow_; _Pragma("unroll") for (int i = 0; i < 4; ++i) ow_[i] = pk2(bf_lo(cv_b[rr][i]) * y_[2 * i], bf_hi(cv_b[rr][i]) * y_[2 * i + 1]); \
            *(u32x4*)(WSP(bf16, WS_PB) + (size_t)(cm0 + 4 * chb_ + rr) * 1024 + cc_) = ow_; \
            _Pragma("unroll") for (int i = 0; i < 8; ++i) { cu2[i] = cu1[i]; cu1[i] = u0_[i]; } } } } while (0)
    if (OUT) { if (tid < 256) ((LAS float*)(L + L_GG))[tid] = F.g_gla[hd * 256 + tid]; }
    else if (do_conv) {
#pragma unroll
        for (int i = 0; i < 6; ++i) ((LAS float*)(L + L_WC))[tid + 512 * i] = F.w_conv[tid + 512 * i]; }
    GLA_LOAD(t0); GLA_LOADV(t0);
#pragma unroll 1
    for (int c = 0; c < 4; ++c) {
        const int tc = t0 + c * 64;
        float p0[8], p1[8];
        { float r0 = 0.f, r1 = 0.f;
#pragma unroll
          for (int i = 0; i < 8; ++i) { r0 += bf_lo(la2[i]); r1 += bf_hi(la2[i]); p0[i] = r0; p1[i] = r1; }
          *(LAS f32x2*)(L + L_SEG + (w * 128 + 2 * lane) * 4) = (f32x2){r0, r1}; }
        GLA_LOADR(tc);
        CONV_ISSUE(c);
        __syncthreads();
        float off0 = 0.f, off1 = 0.f, bt0 = 0.f, bt1 = 0.f;
#pragma unroll
        for (int sgi = 0; sgi < 8; ++sgi) { const f32x2 sv = *(const LAS f32x2*)(L + L_SEG + (sgi * 128 + 2 * lane) * 4); if (sgi < w) { off0 += sv.x; off1 += sv.y; } bt0 += sv.x; bt1 += sv.y; }
        if (w == 0) { *(LAS f32x2*)(L + L_DEC + 8 * lane) = (f32x2){__expf(bt0), __expf(bt1)}; btot_run0 += bt0; btot_run1 += bt1; }
        {
            unsigned kt0[4], kt1[4];
#pragma unroll
            for (int i = 0; i < 8; i += 2) {
                const float b00 = off0 + p0[i], b01 = off1 + p1[i], b10 = off0 + p0[i + 1], b11 = off1 + p1[i + 1];
                const float k00 = bf_lo(kk[i]), k01 = bf_hi(kk[i]), k10 = bf_lo(kk[i + 1]), k11 = bf_hi(kk[i + 1]);
                kt0[i >> 1] = pk2(k00 * __expf(bt0 - b00), k10 * __expf(bt0 - b10));
                kt1[i >> 1] = pk2(k01 * __expf(bt1 - b01), k11 * __expf(bt1 - b11));
                if (OUT) {
                    const float q00 = bf_lo(qq[i]), q01 = bf_hi(qq[i]), q10 = bf_lo(qq[i + 1]), q11 = bf_hi(qq[i + 1]);
                    *(LAS unsigned*)(L + L_QD + (8 * w + i) * QD_STRIDE + 4 * lane) = pk2(q00 * __expf(b00), q01 * __expf(b01));
                    *(LAS unsigned*)(L + L_QD + (8 * w + i + 1) * QD_STRIDE + 4 * lane) = pk2(q10 * __expf(b10), q11 * __expf(b11));
                    *(LAS unsigned*)(L + L_KI + (8 * w + i) * QD_STRIDE + 4 * lane) = pk2(k00 * __expf(-b00), k01 * __expf(-b01));
                    *(LAS unsigned*)(L + L_KI + (8 * w + i + 1) * QD_STRIDE + 4 * lane) = pk2(k10 * __expf(-b10), k11 * __expf(-b11));
                }
            }
            *(LAS u32x4*)(L + L_KT + (2 * lane) * KT_STRIDE + 16 * w) = (u32x4){kt0[0], kt0[1], kt0[2], kt0[3]};
            *(LAS u32x4*)(L + L_KT + (2 * lane + 1) * KT_STRIDE + 16 * w) = (u32x4){kt1[0], kt1[1], kt1[2], kt1[3]};
        }
        __syncthreads();
        if (c < 3) GLA_LOAD(tc + 64);
        f32x16 o[2];
        if (OUT) {
            if (w < 3) {
                const int ib = w == 0 ? 0 : 1, jb = w == 2 ? 1 : 0;
                f32x16 sacc;
#pragma unroll
                for (int r = 0; r < 16; ++r) sacc[r] = 0.f;
#pragma unroll
                for (int kb = 0; kb < 8; ++kb) {
                    const bf16x8 a = *(const LAS bf16x8*)(L + L_QD + (32 * ib + r32) * QD_STRIDE + 2 * (16 * kb + 8 * h));
                    const bf16x8 bb = *(const LAS bf16x8*)(L + L_KI + (32 * jb + r32) * QD_STRIDE + 2 * (16 * kb + 8 * h));
                    sacc = __builtin_amdgcn_mfma_f32_32x32x16_bf16(a, bb, sacc, 0, 0, 0);
                }
#pragma unroll
                for (int r = 0; r < 16; r += 1) {
                    const int i = 32 * ib + crow(r, h), j = 32 * jb + r32;
                    const float v = (j <= i) ? sacc[r] : 0.f;
                    *(LAS bf16*)(L + L_SC + i * SC_STRIDE + 2 * j) = (bf16)(pk2(v, 0.f) & 0xffffu);
                }
            }
#pragma unroll
            for (int ib = 0; ib < 2; ++ib)
#pragma unroll
                for (int r = 0; r < 16; ++r) o[ib][r] = 0.f;
#pragma unroll
            for (int kb = 0; kb < 4; ++kb)
#pragma unroll
                for (int s2 = 0; s2 < 2; ++s2) {
                    u32x4 pb; pb.x = pk2(S[kb][8 * s2 + 0], S[kb][8 * s2 + 1]); pb.y = pk2(S[kb][8 * s2 + 2], S[kb][8 * s2 + 3]); pb.z = pk2(S[kb][8 * s2 + 4], S[kb][8 * s2 + 5]); pb.w = pk2(S[kb][8 * s2 + 6], S[kb][8 * s2 + 7]);
                    const bf16x8 bfrag = __builtin_bit_cast(bf16x8, pb);
#pragma unroll
                    for (int ib = 0; ib < 2; ++ib) {
                        const LAS unsigned char* qp = L + L_QD + (32 * ib + r32) * QD_STRIDE + 2 * (32 * kb + 16 * s2 + 4 * h);
                        const u32x2 lo = *(const LAS u32x2*)qp, hi = *(const LAS u32x2*)(qp + 16);
                        const bf16x8 afrag = __builtin_bit_cast(bf16x8, (u32x4){lo.x, lo.y, hi.x, hi.y});
                        o[ib] = __builtin_amdgcn_mfma_f32_32x32x16_bf16(afrag, bfrag, o[ib], 0, 0, 0);
                    }
                }
            __syncthreads();
#pragma unroll
            for (int ks = 0; ks < 4; ++ks)
#pragma unroll
                for (int ib = 0; ib < 2; ++ib) {
                    if (ib == 0 && ks >= 2) continue;
                    const bf16x8 a = *(const LAS bf16x8*)(L + L_SC + (32 * ib + r32) * SC_STRIDE + 2 * (16 * ks + 8 * h));
                    o[ib] = __builtin_amdgcn_mfma_f32_32x32x16_bf16(a, Bv[ks], o[ib], 0, 0, 0);
                }
        }
#pragma unroll
        for (int kb = 0; kb < 4; ++kb) {
#pragma unroll
            for (int g4 = 0; g4 < 4; ++g4) { const f32x4 dc = *(const LAS f32x4*)(L + L_DEC + 4 * (32 * kb + 8 * g4 + 4 * h));
#pragma unroll
                for (int j = 0; j < 4; ++j) S[kb][4 * g4 + j] *= dc[j]; }
#pragma unroll
            for (int ks = 0; ks < 4; ++ks) {
                const bf16x8 a = *(const LAS bf16x8*)(L + L_KT + (32 * kb + r32) * KT_STRIDE + 2 * (16 * ks + 8 * h));
                S[kb] = __builtin_amdgcn_mfma_f32_32x32x16_bf16(a, Bv[ks], S[kb], 0, 0, 0);
            }
        }
        if (c < 3) GLA_LOADV(tc + 64);
        CONV_FINISH(c);
        if (OUT) {
#pragma unroll
            for (int ib = 0; ib < 2; ++ib)
#pragma unroll
                for (int r = 0; r < 16; ++r) *(LAS float*)(L + L_OT + (32 * ib + crow(r, h)) * OT_STRIDE + 4 * (32 * w + r32)) = o[ib][r];
            __syncthreads();
            f32x4 ov[8]; float ss = 0.f;
#pragma unroll
            for (int i = 0; i < 8; ++i) { ov[i] = *(const LAS f32x4*)(L + L_OT + tok_n * OT_STRIDE + 4 * (32 * part + 4 * i)); ss += (ov[i].x * ov[i].x + ov[i].y * ov[i].y) + (ov[i].z * ov[i].z + ov[i].w * ov[i].w); }
            ss += __shfl_xor(ss, 1); ss += __shfl_xor(ss, 2); ss += __shfl_xor(ss, 4);
            const float rs = 1.0f / sqrtf(ss * (1.0f / 256.0f) + 1e-6f);
            const size_t trow = (size_t)(tc + tok_n);
            const LAS f32x4* gp = (const LAS f32x4*)(L + L_GG + 4 * (32 * part));
            u32x4* op = (u32x4*)(WSP(bf16, WS_OG) + trow * 1024 + hd * 256 + 32 * part);
#pragma unroll
            for (int i = 0; i < 4; ++i) {
                const u32x4 rr = rc[i]; const f32x4 g0 = gp[2 * i], g1 = gp[2 * i + 1]; const f32x4 a0 = ov[2 * i], a1 = ov[2 * i + 1];
                u32x4 ow;
                ow.x = pk2(a0.x * rs * g0.x * bf_lo(rr.x), a0.y * rs * g0.y * bf_hi(rr.x));
                ow.y = pk2(a0.z * rs * g0.z * bf_lo(rr.y), a0.w * rs * g0.w * bf_hi(rr.y));
                ow.z = pk2(a1.x * rs * g1.x * bf_lo(rr.z), a1.y * rs * g1.y * bf_hi(rr.z));
                ow.w = pk2(a1.z * rs * g1.z * bf_lo(rr.w), a1.w * rs * g1.w * bf_hi(rr.w));
                op[i] = ow;
            }
        }
    }
#undef GLA_LOAD
#undef GLA_LOADV
#undef GLA_LOADR
#undef CONV_ISSUE
#undef CONV_FINISH
    if (!OUT) {
#pragma unroll
        for (int kb = 0; kb < 4; ++kb)
#pragma unroll
            for (int r = 0; r < 16; r += 2) Sbuf[(kb * 8 + (r >> 1)) * 64 + lane] = pk2(S[kb][r], S[kb][r + 1]);
        if (w == 0) *(f32x2*)(WSP(float, WS_DECS) + item * 128 + 2 * lane) = (f32x2){__expf(btot_run0), __expf(btot_run1)};
    }
    __syncthreads();
}

__device__ __forceinline__ void conv_rows(Frame& F, const int nrep, const int first_skip) {
    const int gw = F.vcu * NWAVES + F.wave, NGW = F.G * NWAVES;
    const bf16* Z = WSP(const bf16, WS_Z); bf16* PB = WSP(bf16, WS_PB);
    for (int blk0 = gw + first_skip * NGW; blk0 < (M / 8) * nrep; blk0 += NGW) {
        const int blk = blk0 % (M / 8);
        const int m0 = blk * 8, s0 = m0 % SEQ;
#pragma unroll 1
        for (int j = 0; j < 2; ++j) {
            const int c = 8 * F.lane + 512 * j;
            const size_t rp = (size_t)(s0 > 0 ? m0 - 2 : m0);
            const u32x4 p2c = *(const u32x4*)(Z + ZCC + rp * 1024 + c);
            const u32x4 p1c = *(const u32x4*)(Z + ZCC + (rp + 1) * 1024 + c);
            float w0[8], w1[8], w2[8];
#pragma unroll
            for (int i = 0; i < 8; ++i) { w0[i] = F.w_conv[c + i]; w1[i] = F.w_conv[1024 + c + i]; w2[i] = F.w_conv[2048 + c + i]; }
            float u1[8], u2[8];
            const float keep = s0 > 0 ? 1.0f : 0.0f;
#pragma unroll
            for (int i = 0; i < 4; ++i) { u2[2 * i] = keep * bf_lo(p2c[i]); u2[2 * i + 1] = keep * bf_hi(p2c[i]); u1[2 * i] = keep * bf_lo(p1c[i]); u1[2 * i + 1] = keep * bf_hi(p1c[i]); }
#pragma unroll
            for (int hb = 0; hb < 2; ++hb) {
                u32x4 cc[4], cb[4];
#pragma unroll
                for (int rr = 0; rr < 4; ++rr) { const size_t row = (size_t)(m0 + 4 * hb + rr); cc[rr] = __builtin_nontemporal_load((const u32x4*)(Z + ZCC + row * 1024 + c)); cb[rr] = __builtin_nontemporal_load((const u32x4*)(Z + ZCB + row * 1024 + c)); }
#pragma unroll
                for (int rr = 0; rr < 4; ++rr) {
                    float u0[8], y[8];
#pragma unroll
                    for (int i = 0; i < 4; ++i) { u0[2 * i] = bf_lo(cc[rr][i]); u0[2 * i + 1] = bf_hi(cc[rr][i]); }
#pragma unroll
                    for (int i = 0; i < 8; ++i) y[i] = w0[i] * u2[i] + w1[i] * u1[i] + w2[i] * u0[i];
                    u32x4 ow;
#pragma unroll
                    for (int i = 0; i < 4; ++i) ow[i] = pk2(bf_lo(cb[rr][i]) * y[2 * i], bf_hi(cb[rr][i]) * y[2 * i + 1]);
                    *(u32x4*)(PB + (size_t)(m0 + 4 * hb + rr) * 1024 + c) = ow;
#pragma unroll
                    for (int i = 0; i < 8; ++i) { u2[i] = u1[i]; u1[i] = u0[i]; }
                }
                asm volatile("" ::: "memory");
            }
        }
    }
}

__device__ __forceinline__ void gla_scan(Frame& F, const int nrep) {
    const unsigned* U = WSP(const unsigned, WS_U); unsigned* SIN = WSP(unsigned, WS_SIN); const float* DECS = WSP(const float, WS_DECS);
    const int gt = F.vcu * 512 + F.tid, NT = F.G * 512;
    for (int idx0 = gt; idx0 < 32 * 16384 * nrep; idx0 += NT) {
        const int idx = idx0 & (32 * 16384 - 1);
        const int bh = idx >> 14, e = idx & 16383;
        const int ln = e & 63, rp = (e >> 6) & 7, kb = (e >> 9) & 3;
        const int dk = 32 * kb + crow(2 * rp, ln >> 5);
        float s0 = 0.f, s1 = 0.f;
        unsigned uw[8];
#pragma unroll
        for (int sc = 0; sc < 8; ++sc) uw[sc] = U[(size_t)(bh * 8 + sc) * 16384 + e];
#pragma unroll
        for (int sc = 0; sc < 8; ++sc) {
            const int item = bh * 8 + sc;
            SIN[(size_t)item * 16384 + e] = pk2(s0, s1);
            const f32x2 dc = *(const f32x2*)(DECS + item * 128 + dk);
            s0 = dc.x * s0 + bf_lo(uw[sc]); s1 = dc.y * s1 + bf_hi(uw[sc]);
        }
    }
}

struct P3Order : pg8::StaticOrder {
    __device__ __forceinline__ bool next(int i, pg8::Unit& u) const {
        if (!pg8::StaticOrder::next(i >> 1, u)) return false;
        u.e = i & 1; u.pn += 4 * u.e; return true;
    }
    __device__ __forceinline__ unsigned arow(const pg8::Unit& u, int ui, int r) const { return (unsigned)(u.e * M + u.pm * 256 + r) * 2048u; }
    __device__ __forceinline__ void after_unit(int ui) const {}
    __device__ __forceinline__ bool keep_acc(int ui) const { return (ui & 1) == 0; }
};
struct EpiBranch {
    static constexpr bool PERM = true;
    const bf16* Z; bf16* MIX;
    __device__ __forceinline__ void operator()(f32x4 (&acc)[2][2][4][2], const pg8::Unit& u, int wr, int wc, int fr, int fq) const {
        const int row0 = u.pm * 256 + wr * 64 + fr, col0 = (u.pn & 3) * 256 + wc * 32 + 8 * fq;
#pragma unroll
        for (int ai = 0; ai < 2; ++ai)
#pragma unroll
            for (int m = 0; m < 4; ++m) { const size_t row = (size_t)(row0 + ai * 128 + m * 16);
#pragma unroll
                for (int bj = 0; bj < 2; ++bj) {
                    const u32x2 gb = __builtin_nontemporal_load((const u32x2*)((const unsigned char*)(Z + ZGB) + row * 1024 + col0 + bj * 128));
                    float sb[8];
#pragma unroll
                    for (int j = 0; j < 4; ++j) { sb[j] = (float)((gb.x >> (8 * j)) & 255u); sb[4 + j] = (float)((gb.y >> (8 * j)) & 255u); }
#pragma unroll
                    for (int j = 0; j < 8; ++j) sb[j] = fmaxf(sb[j], 1.0f) * (1.0f / 255.0f);
                    if (u.e == 0) {
                        const u32x2 ga = __builtin_nontemporal_load((const u32x2*)((const unsigned char*)(Z + ZGA) + row * 1024 + col0 + bj * 128));
                        float sa[8];
#pragma unroll
                        for (int j = 0; j < 4; ++j) { sa[j] = (float)((ga.x >> (8 * j)) & 255u) * (1.0f / 255.0f); sa[4 + j] = (float)((ga.y >> (8 * j)) & 255u) * (1.0f / 255.0f); }
#pragma unroll
                        for (int j = 0; j < 4; ++j) { acc[ai][bj][m][0][j] *= sa[j] * __builtin_amdgcn_rcpf(sb[j]); acc[ai][bj][m][1][j] *= sa[4 + j] * __builtin_amdgcn_rcpf(sb[4 + j]); }
                    } else {
                        const f32x4 v0 = acc[ai][bj][m][0], v1 = acc[ai][bj][m][1];
                        u32x4 w; w.x = pk2(v0[0] * sb[0], v0[1] * sb[1]); w.y = pk2(v0[2] * sb[2], v0[3] * sb[3]); w.z = pk2(v1[0] * sb[4], v1[1] * sb[5]); w.w = pk2(v1[2] * sb[6], v1[3] * sb[7]);
                        *(u32x4*)(MIX + row * 1024 + col0 + bj * 128) = w; }
                } }
    }
};
struct EpiX1 {
    static constexpr bool PERM = true;
    const float* x; bf16* X1;
    __device__ __forceinline__ void operator()(const f32x4 (&acc)[2][2][4][2], const pg8::Unit& u, int wr, int wc, int fr, int fq) const {
        const int row0 = u.pm * 256 + wr * 64 + fr, col0 = u.pn * 256 + wc * 32 + 8 * fq;
#pragma unroll
        for (int ai = 0; ai < 2; ++ai)
#pragma unroll
            for (int m = 0; m < 4; ++m) { const size_t off = (size_t)(row0 + ai * 128 + m * 16) * 1024 + col0;
#pragma unroll
                for (int bj = 0; bj < 2; ++bj) { const f32x4 x0 = __builtin_nontemporal_load((const f32x4*)(x + off + bj * 128)), x1 = __builtin_nontemporal_load((const f32x4*)(x + off + bj * 128 + 4));
                    const f32x4 v0 = x0 + acc[ai][bj][m][0], v1 = x1 + acc[ai][bj][m][1];
                    u32x4 w; w.x = pk2(v0[0], v0[1]); w.y = pk2(v0[2], v0[3]); w.z = pk2(v1[0], v1[1]); w.w = pk2(v1[2], v1[3]);
                    *(u32x4*)(X1 + off + bj * 128) = w; } }
    }
};

constexpr int P5_WLD = 2064;
constexpr int P5_WH = 0, P5_WL = 32 * P5_WLD;
constexpr int P5_RSTD = 133120, P5_LOGT = 133376;
constexpr int P5_HIST = 141824, P5_BASE = P5_HIST + 128, P5_PLE = P5_HIST + 256;
__device__ __forceinline__ void p5_router(Frame& F) {
    LAS unsigned char* L = F.lds;
    LAS float* RSTD = (LAS float*)(L + P5_RSTD); LAS float* LOGT = (LAS float*)(L + P5_LOGT);
    LAS int* hist = (LAS int*)(L + P5_HIST); LAS int* base = (LAS int*)(L + P5_BASE); LAS int* ple = (LAS int*)(L + P5_PLE);
    const bf16* X1 = WSP(const bf16, WS_X1); unsigned char* H2 = WSP(unsigned char, WS_XN);
    unsigned* cnt = F.ctl + CW_CNT; int* list = WSP(int, WS_LIST); float* gate = WSP(float, WS_GATE);
    const int lane = F.lane, w = F.wave, r32 = lane & 31, h = lane >> 5;
    f32x4 g[4];
#pragma unroll
    for (int j = 0; j < 4; ++j) g[j] = *((const f32x4*)F.g_ffn + lane + 64 * j);
    for (int grp = F.vcu; grp < M / 64; grp += F.G) {
        for (int i = 0; i < 64; ++i) { const int idx = F.tid + 512 * i, k = idx >> 5, e = idx & 31; const float wv = F.w_router[idx] * F.g_ffn[k];
            const unsigned hi = pk2(wv, 0.f) & 0xffffu; const float rem = wv - __builtin_bit_cast(float, hi << 16);
            *(LAS bf16*)(L + P5_WH + e * P5_WLD + 2 * k) = (bf16)hi; *(LAS bf16*)(L + P5_WL + e * P5_WLD + 2 * k) = (bf16)(pk2(rem, 0.f) & 0xffffu); }
        if (F.tid < 32) hist[F.tid] = 0;
        const size_t tok0 = (size_t)grp * 64;
        { u32x2 xv[8][4];
#pragma unroll
          for (int i = 0; i < 8; ++i) { const u32x2* xa = (const u32x2*)(X1 + (tok0 + 8 * w + i) * D) + lane;
#pragma unroll
              for (int j = 0; j < 4; ++j) xv[i][j] = xa[64 * j]; }
#pragma unroll
          for (int i = 0; i < 8; ++i) { f32x4 v[4]; float ss = 0.f;
#pragma unroll
              for (int j = 0; j < 4; ++j) { v[j] = (f32x4){bf_lo(xv[i][j].x), bf_hi(xv[i][j].x), bf_lo(xv[i][j].y), bf_hi(xv[i][j].y)};
#pragma unroll
                  for (int c = 0; c < 4; ++c) ss = fmaf(v[j][c], v[j][c], ss); }
              const float rs = 1.0f / sqrtf(wave_sum(ss) * (1.f / D) + 1e-6f);
              if (lane == 0) RSTD[8 * w + i] = rs;
              unsigned* o4 = (unsigned*)(H2 + (tok0 + 8 * w + i) * D) + lane;
#pragma unroll
              for (int j = 0; j < 4; ++j) { const f32x4 hv = v[j] * rs * g[j]; o4[64 * j] = pk4_fp8(hv.x, hv.y, hv.z, hv.w); } } }
        bf16x8 af[2][8];
        { const bf16* xa = X1 + (tok0 + r32) * D + 128 * w + 8 * h;
#pragma unroll
          for (int mt = 0; mt < 2; ++mt)
#pragma unroll
              for (int ks = 0; ks < 8; ++ks) af[mt][ks] = *(const bf16x8*)(xa + (size_t)mt * 32 * D + 16 * ks); }
        __syncthreads();
        f32x16 acc[2];
#pragma unroll
        for (int mt = 0; mt < 2; ++mt)
#pragma unroll
            for (int r = 0; r < 16; ++r) acc[mt][r] = 0.f;
#pragma unroll
        for (int ks = 0; ks < 8; ++ks) {
            const bf16x8 bh = *(const LAS bf16x8*)(L + P5_WH + r32 * P5_WLD + 2 * (128 * w + 16 * ks + 8 * h));
            const bf16x8 bl = *(const LAS bf16x8*)(L + P5_WL + r32 * P5_WLD + 2 * (128 * w + 16 * ks + 8 * h));
#pragma unroll
            for (int mt = 0; mt < 2; ++mt) { acc[mt] = __builtin_amdgcn_mfma_f32_32x32x16_bf16(af[mt][ks], bh, acc[mt], 0, 0, 0); acc[mt] = __builtin_amdgcn_mfma_f32_32x32x16_bf16(af[mt][ks], bl, acc[mt], 0, 0, 0); }
        }
        __syncthreads();
#pragma unroll
        for (int mt = 0; mt < 2; ++mt)
#pragma unroll
            for (int r = 0; r < 16; ++r) *(LAS float*)(L + ((w * 64 + 32 * mt + crow(r, h)) * 32 + r32) * 4) = acc[mt][r];
        __syncthreads();
        { const int tk = F.tid >> 3, eq = F.tid & 7;
          f32x4 sum = *(const LAS f32x4*)(L + ((0 * 64 + tk) * 32 + 4 * eq) * 4);
#pragma unroll
          for (int ww = 1; ww < 8; ++ww) sum = sum + *(const LAS f32x4*)(L + ((ww * 64 + tk) * 32 + 4 * eq) * 4);
          const float rs = RSTD[tk]; const f32x4 bb = *(const f32x4*)(F.b_router + 4 * eq);
#pragma unroll
          for (int c = 0; c < 4; ++c) LOGT[tk * 33 + 4 * eq + c] = sum[c] * rs + bb[c]; }
        __syncthreads();
        if (F.tid < 64) {
            const int tk = F.tid; float tv[4]; int ti[4];
#pragma unroll
            for (int k = 0; k < 4; ++k) { float bv = -3.0e38f; int bi = 0;
                for (int e = 0; e < 32; ++e) { const float v = LOGT[tk * 33 + e]; if (v > bv) { bv = v; bi = e; } }
                tv[k] = bv; ti[k] = bi; LOGT[tk * 33 + bi] = -3.0e38f; }
            const float e1 = __expf(tv[1] - tv[0]), e2 = __expf(tv[2] - tv[0]), e3 = __expf(tv[3] - tv[0]);
            const float inv = 1.0f / (1.0f + e1 + e2 + e3);
            const float gk[4] = {inv, e1 * inv, e2 * inv, e3 * inv};
#pragma unroll
            for (int k = 0; k < 4; ++k) { const int lr = __hip_atomic_fetch_add(&hist[ti[k]], 1, __ATOMIC_RELAXED, __HIP_MEMORY_SCOPE_WORKGROUP);
                ple[tk * 4 + k] = ti[k] | (lr << 8); gate[(tok0 + tk) * 4 + k] = gk[k]; }
        }
        __syncthreads();
        if (F.tid < 32) base[F.tid] = (int)__hip_atomic_fetch_add(cnt + F.tid, (unsigned)hist[F.tid], RLX_AGENT);
        __syncthreads();
        if (F.tid < 256) { const int pe = ple[F.tid], e = pe & 255, lr = pe >> 8; list[e * CAP + base[e] + lr] = (grp * 64) * 4 + F.tid; }
        __syncthreads();
    }
}

#ifndef MK_MAXU
#define MK_MAXU 12
#endif
constexpr int MAXU = MK_MAXU;
template <int NP>
struct MoeOrder {
    LAS const int* rt0;
    LAS const int* tokl;
    int nwg, G, c, reps;
    __device__ __forceinline__ bool next(int i, pg8::Unit& u) const {
        const long L = (long)i * G + c; if (L >= (long)nwg * reps) return false;
        int wgid = (int)(L % nwg); { const int q = nwg / 8, r = nwg % 8, xcd = wgid % 8, off = wgid / 8; wgid = (xcd < r ? xcd * (q + 1) : r * (q + 1) + (xcd - r) * q) + off; }
        int e = 0;
#pragma unroll
        for (int q = 0; q < 8; ++q) { const i32x4 r4 = *(const LAS i32x4*)(rt0 + 4 * q);
#pragma unroll
            for (int t = 0; t < 4; ++t) if (4 * q + t >= 1) e += (wgid >= NP * r4[t]) ? 1 : 0; }
        const int l = wgid - NP * rt0[e], nte = rt0[e + 1] - rt0[e];
        const int pn = l / nte, rt = l - pn * nte;
        u.pm = __builtin_amdgcn_readfirstlane(rt0[e] + rt); u.pn = __builtin_amdgcn_readfirstlane(e * NP + pn); u.e = __builtin_amdgcn_readfirstlane(e); u.rt = __builtin_amdgcn_readfirstlane(rt); u.ui = i; return true;
    }
};
struct MoeOrder1 : MoeOrder<8> {
    __device__ __forceinline__ void after_unit(int ui) const {}
    __device__ __forceinline__ bool keep_acc(int ui) const { return false; }
    __device__ __forceinline__ unsigned arow(const pg8::Unit& u, int ui, int r) const { return (unsigned)tokl[ui * 256 + r] * 1024u; }
};
struct MoeOrder2 : MoeOrder<4> {
    __device__ __forceinline__ void after_unit(int ui) const {}
    __device__ __forceinline__ bool keep_acc(int ui) const { return false; }
    __device__ __forceinline__ unsigned arow(const pg8::Unit& u, int ui, int r) const { return (unsigned)(u.pm * 256 + r) * 1024u; }
};
struct EpiAct {
    static constexpr bool PERM = true;
    const float* b_gu; unsigned char* ACT;
    __device__ __forceinline__ void operator()(const f32x4 (&acc)[2][2][4][2], const pg8::Unit& u, int wr, int wc, int fr, int fq) const {
        const int pn = u.pn & 7, cl = pn * 128 + wc * 32 + 8 * fq;
        const int row0 = u.pm * 256 + wr * 64 + fr;
        const f32x4 bg0 = *(const f32x4*)(b_gu + u.e * 2048 + cl), bg1 = *(const f32x4*)(b_gu + u.e * 2048 + cl + 4);
        const f32x4 bl0 = *(const f32x4*)(b_gu + u.e * 2048 + 1024 + cl), bl1 = *(const f32x4*)(b_gu + u.e * 2048 + 1024 + cl + 4);
#pragma unroll
        for (int ai = 0; ai < 2; ++ai)
#pragma unroll
            for (int m = 0; m < 4; ++m) {
                f32x4 g0 = acc[ai][0][m][0] + bg0, g1 = acc[ai][0][m][1] + bg1, l0 = acc[ai][1][m][0] + bl0, l1 = acc[ai][1][m][1] + bl1;
                float r0[4], r1[4];
#pragma unroll
                for (int j = 0; j < 4; ++j) {
                    const float ga = fminf(g0[j], 7.0f), gb = fminf(g1[j], 7.0f);
                    const float la = fminf(fmaxf(l0[j], -7.0f), 7.0f), lb = fminf(fmaxf(l1[j], -7.0f), 7.0f);
                    r0[j] = (la + 1.0f) * (ga * fast_sigmoid(1.702f * ga)); r1[j] = (lb + 1.0f) * (gb * fast_sigmoid(1.702f * gb));
                }
                u32x2 w; w.x = pk4_fp8(r0[0], r0[1], r0[2], r0[3]); w.y = pk4_fp8(r1[0], r1[1], r1[2], r1[3]);
                *(u32x2*)(ACT + (size_t)(row0 + ai * 128 + m * 16) * 1024 + cl) = w;
            }
    }
};
constexpr int MAXU2 = 8;
struct EpiYP {
    static constexpr bool PERM = true;
    const float* b_d; LAS const int* pidl; LAS const float* gatel; unsigned char* YP;
    __device__ __forceinline__ void operator()(const f32x4 (&acc)[2][2][4][2], const pg8::Unit& u, int wr, int wc, int fr, int fq) const {
        const int pn = u.pn & 3, col0 = pn * 256 + wc * 32 + 8 * fq;
        f32x4 bv[2][2];
#pragma unroll
        for (int bj = 0; bj < 2; ++bj)
#pragma unroll
            for (int n = 0; n < 2; ++n) bv[bj][n] = *(const f32x4*)(b_d + u.e * 1024 + col0 + bj * 128 + 4 * n);
#pragma unroll
        for (int ai = 0; ai < 2; ++ai)
#pragma unroll
            for (int m = 0; m < 4; ++m) {
                const int rl = ai * 128 + wr * 64 + m * 16 + fr;
                const int pid = pidl[u.ui * 256 + rl];
                if (pid >= 0) {
                    const float gw = gatel[u.ui * 256 + rl];
#pragma unroll
                    for (int bj = 0; bj < 2; ++bj) { const f32x4 v0 = (acc[ai][bj][m][0] + bv[bj][0]) * gw, v1 = (acc[ai][bj][m][1] + bv[bj][1]) * gw;
                        u32x2 w; w.x = pk4_fp8(v0[0], v0[1], v0[2], v0[3]); w.y = pk4_fp8(v1[0], v1[1], v1[2], v1[3]);
                        *(u32x2*)(YP + (size_t)pid * 1024 + col0 + bj * 128) = w; }
                }
            }
    }
};
__device__ __forceinline__ int moe_setup(Frame& F, LAS int* rt0) {
    if (F.tid < 64) {
        const int e = F.lane & 31; int v = ((int)F.ctl[CW_CNT + e] + 255) >> 8, incl = v;
#pragma unroll
        for (int o = 1; o < 32; o <<= 1) { const int t = __shfl_up(incl, o, 32); if (e >= o) incl += t; }
        if (F.lane < 32) { rt0[e] = incl - v; if (e == 31) rt0[32] = incl; }
    }
    __syncthreads();
    return rt0[32];
}

__device__ __forceinline__ void p8_final(Frame& F, const int nrep) {
    const int gw = F.vcu * NWAVES + F.wave, NGW = F.G * NWAVES;
    const bf16* X1 = WSP(const bf16, WS_X1); const unsigned char* YP = WSP(const unsigned char, WS_YP);
    f32x4 g[4];
#pragma unroll
    for (int j = 0; j < 4; ++j) g[j] = *((const f32x4*)F.g_final + F.lane + 64 * j);
    float pscale = 1.0f;
#ifdef MK_TPROBE
    { const unsigned long long* st = (const unsigned long long*)(F.ctl + CW_STAMP); const float dt_us = (float)(st[MK_TPROBE_J] - st[MK_TPROBE_I]) * 0.01f; pscale = 1.0f + sqrtf(dt_us * 1e-5f); }
#endif
    for (int m0 = gw; m0 < M * nrep; m0 += NGW) {
        const int m = m0 % M;
        const u32x2* xr = (const u32x2*)(X1 + (size_t)m * D) + F.lane;
        f32x4 v[4]; float s = 0.f;
#pragma unroll
        for (int j = 0; j < 4; ++j) { const u32x2 xw = __builtin_nontemporal_load(xr + 64 * j); v[j] = (f32x4){bf_lo(xw.x), bf_hi(xw.x), bf_lo(xw.y), bf_hi(xw.y)}; }
        f32x4 ys[4];
#pragma unroll
        for (int j = 0; j < 4; ++j) ys[j] = (f32x4){0.f, 0.f, 0.f, 0.f};
#pragma unroll
        for (int k = 0; k < 4; ++k) { const unsigned* yr = (const unsigned*)(YP + ((size_t)m * 4 + k) * 1024) + F.lane;
#pragma unroll
            for (int j = 0; j < 4; ++j) { const int y = (int)__builtin_nontemporal_load(yr + 64 * j); const f32x2 lo = __builtin_amdgcn_cvt_pk_f32_fp8(y, false), hi = __builtin_amdgcn_cvt_pk_f32_fp8(y, true);
                ys[j].x += lo.x; ys[j].y += lo.y; ys[j].z += hi.x; ys[j].w += hi.y; } }
#pragma unroll
        for (int j = 0; j < 4; ++j) v[j] = v[j] + ys[j] * 0.0625f;
#pragma unroll
        for (int j = 0; j < 4; ++j) s += (v[j].x * v[j].x + v[j].y * v[j].y) + (v[j].z * v[j].z + v[j].w * v[j].w);
        const float rstd = 1.0f / sqrtf(wave_sum(s) * (1.f / D) + 1e-6f);
        f32x4* op = (f32x4*)(F.out + (size_t)m * D) + F.lane;
#pragma unroll
        for (int j = 0; j < 4; ++j) __builtin_nontemporal_store(v[j] * (rstd * pscale) * g[j], op + 64 * j);
    }
}

struct Args { const float* in[18]; float* out; unsigned char* ws; int ph_lo, ph_hi, rep_k, rep_n; };
__global__ void __launch_bounds__(NWAVES * 64, 2) mk_fwd(Args args) {
    extern __shared__ __attribute__((aligned(16))) unsigned char lds[];
    Frame F;
    F.lds = (LAS unsigned char*)lds;
    F.MISC = (volatile LAS unsigned*)(F.lds + MISC_OFF);
    F.tid = threadIdx.x; F.lane = F.tid & 63; F.wave = __builtin_amdgcn_readfirstlane(F.tid >> 6);
    F.G = gridDim.x; { const int bx = blockIdx.x; F.vcu = (F.G % 8 == 0) ? (bx % 8) * (F.G / 8) + bx / 8 : bx; }
    F.ws = args.ws; F.ctl = (unsigned*)(args.ws + WS_CTL);
    F.x = args.in[0]; F.g_mix = args.in[1]; F.w_in = args.in[2]; F.w_up = args.in[3]; F.b_alpha = args.in[4]; F.g_gla = args.in[5]; F.w_conv = args.in[6];
    F.w_a = args.in[7]; F.w_b = args.in[8]; F.w_out = args.in[9]; F.g_ffn = args.in[10]; F.w_router = args.in[11]; F.b_router = args.in[12];
    F.w_gu = args.in[13]; F.b_gu = args.in[14]; F.w_d = args.in[15]; F.b_d = args.in[16]; F.g_final = args.in[17]; F.out = args.out;
    if (F.tid < 128) ((LAS unsigned*)(F.lds + MISC_OFF))[F.tid] = 0u;
    __syncthreads();
    XcdBarrier bar; bar.bar = F.ctl + CW_BAR; bar.x = 0; bar.st = nullptr;
    if (N_LAUNCHES == 1) bar = xcd_barrier_post(F.ctl + CW_BAR, F.MISC + 8);
    const int lo = args.ph_lo, hi = args.ph_hi;
#ifdef MK_ONLY
#define IN(k) ((k) == MK_ONLY && lo <= (k) && (k) < hi)
#else
#define IN(k) (lo <= (k) && (k) < hi)
#endif
#define REPS(k) (((k) == args.rep_k) ? 1 + args.rep_n : 1)
#if defined(MK_TPROBE) || defined(MK_DELAY_K)
#define STAMP(k) do { if (blockIdx.x == 0 && F.tid == 0) ((unsigned long long*)(F.ctl + CW_STAMP))[k] = __builtin_amdgcn_s_memrealtime(); } while (0)
#else
#define STAMP(k) do { } while (0)
#endif
#ifdef MK_DELAY_K
#define DELAY(k) do { if ((k) == MK_DELAY_K) { const unsigned long long dl = __hip_atomic_load((unsigned long long*)(F.ctl + CW_STAMP), RLX_AGENT) + (unsigned long long)(MK_DELAY_US) * 100ull; \
    while (__builtin_amdgcn_s_memrealtime() < dl) __builtin_amdgcn_s_sleep(8); } } while (0)
#else
#define DELAY(k) do { } while (0)
#endif
#define SEAM(k) do { if (IN(k) && IN((k) + 1)) xcd_barrier(bar); STAMP((k) + 1); DELAY(k); } while (0)

    STAMP(0);
    if (IN(0)) { p0_prologue(F, REPS(0), REPS(11)); SEAM(0); }
    if (IN(1)) { const int nrep = REPS(1);
        P1Order S; S.init(M, NZ, D, F.G, (int)blockIdx.x, nrep); S.w_gu = F.w_gu; S.w_d = F.w_d; S.ws = F.ws; S.lds = F.lds; S.slot = ((int)blockIdx.x >> 3) & 7; S.wave = F.wave; S.lane = F.lane;
        EpiZ E{WSP(bf16, WS_Z)};
        pg8::gemm_phase<EpiZ, P1Order, true>(F.lds, WSP(const bf16, WS_XN), WSP(const bf16, WS_WIN), D, S, E);
        SEAM(1);
    }
    if (IN(2)) { const int nrep = REPS(2); const int gwc = F.vcu * NWAVES + F.wave;
        for (int it = F.vcu; it < 256 * nrep; it += F.G) gla_item<false>(F, it & 255, (it == F.vcu && gwc < M / 8) ? gwc : -1);
        conv_rows(F, REPS(12), (F.vcu < 256) ? 1 : 0); SEAM(2); }
    if (IN(3)) { gla_scan(F, REPS(3)); SEAM(3); }
    if (IN(4)) { const int nrep = REPS(4); for (int it = F.vcu; it < 256 * nrep; it += F.G) gla_item<true>(F, it & 255); SEAM(4); }
    if (IN(5)) { const int nrep = REPS(5);
        static_assert(WS_PB == WS_OG + (size_t)M * 1024 * 2 && WS_WB == WS_WA + (size_t)1024 * 1024 * 2, "P3Order addresses PB / Wb from OG / Wa");
        P3Order S; S.init(M, D, D, F.G, (int)blockIdx.x, nrep);
        EpiBranch E{WSP(const bf16, WS_Z), WSP(bf16, WS_MIX)};
        pg8::gemm_phase<EpiBranch, P3Order, true>(F.lds, WSP(const bf16, WS_OG), WSP(const bf16, WS_WA), D, S, E);
        SEAM(5);
    }
    if (IN(6)) { const int nrep = REPS(6);
        pg8::StaticOrder S; S.init(M, D, D, F.G, (int)blockIdx.x, nrep);
        EpiX1 E{F.x, WSP(bf16, WS_X1)};
        pg8::gemm_phase<EpiX1, pg8::StaticOrder, false>(F.lds, WSP(const bf16, WS_MIX), WSP(const bf16, WS_WO), D, S, E);
        SEAM(6);
    }
    if (IN(7)) { p5_router(F); SEAM(7); }
    if (IN(8)) { const int nrep = REPS(8);
        LAS int* rt0 = (LAS int*)(F.lds + EXTRA_OFF); LAS int* tokl = (LAS int*)(F.lds + EXTRA_OFF + 256);
        const int R = moe_setup(F, rt0);
        MoeOrder1 S; S.rt0 = rt0; S.tokl = tokl; S.nwg = R * 8; S.G = F.G; S.c = (int)blockIdx.x; S.reps = nrep;
        const int* list = WSP(const int, WS_LIST);
#pragma unroll
        for (int uo = 0; uo < 2; ++uo) { const int ui = F.wave + 8 * uo; pg8::Unit u;
            if (ui < MAXU && S.next(ui, u)) { const int ne = (int)F.ctl[CW_CNT + u.e]; int tk[4];
#pragma unroll
                for (int j = 0; j < 4; ++j) { const int slot = u.rt * 256 + F.lane + 64 * j; tk[j] = slot < ne ? list[u.e * CAP + slot] : 0; }
#pragma unroll
                for (int j = 0; j < 4; ++j) tokl[ui * 256 + F.lane + 64 * j] = tk[j] >> 2; } }
        __syncthreads();
        EpiAct E{F.b_gu, WSP(unsigned char, WS_ACT)};
        pg8::gemm_phase<EpiAct, MoeOrder1, true, true, 122>(F.lds, WSP(const void, WS_XN), WSP(const void, WS_WGU), D, S, E);
        SEAM(8);
    }
    if (IN(9)) { const int nrep = REPS(9);
        LAS int* rt0 = (LAS int*)(F.lds + EXTRA_OFF);
        const int R = moe_setup(F, rt0);
        MoeOrder2 S; S.rt0 = rt0; S.tokl = nullptr; S.nwg = R * 4; S.G = F.G; S.c = (int)blockIdx.x; S.reps = nrep;
        LAS int* pidl = (LAS int*)(F.lds + EXTRA_OFF + 256); LAS float* gatel = (LAS float*)(F.lds + EXTRA_OFF + 256 + MAXU2 * 1024);
        { const int* list = WSP(const int, WS_LIST); const float* gate = WSP(const float, WS_GATE);
          const int ui = F.wave; pg8::Unit u;
          if (ui < MAXU2 && S.next(ui, u)) { const int ne = (int)F.ctl[CW_CNT + u.e]; int pd[4]; float gv[4];
#pragma unroll
              for (int j = 0; j < 4; ++j) { const int slot = u.rt * 256 + F.lane + 64 * j; pd[j] = slot < ne ? list[u.e * CAP + slot] : -1; }
#pragma unroll
              for (int j = 0; j < 4; ++j) gv[j] = pd[j] >= 0 ? gate[pd[j]] * 16.0f : 0.f;
#pragma unroll
              for (int j = 0; j < 4; ++j) { pidl[ui * 256 + F.lane + 64 * j] = pd[j]; gatel[ui * 256 + F.lane + 64 * j] = gv[j]; } } }
        __syncthreads();
        EpiYP E{F.b_d, pidl, gatel, WSP(unsigned char, WS_YP)};
        pg8::gemm_phase<EpiYP, MoeOrder2, true, true, 122>(F.lds, WSP(const void, WS_ACT), WSP(const void, WS_WD), D, S, E);
        SEAM(9);
    }
    if (IN(10)) { p8_final(F, REPS(10)); }
#undef IN
#undef SEAM
}

extern "C" void kernel_launch(void* const* d_in, const int* in_sizes, int n_in, void* d_out, int out_size, void* d_ws, size_t ws_size, hipStream_t stream) {
    static int grid = 0;
    if (grid == 0) {
        if (n_in != 18 || out_size != M * D || ws_size < WS_END) { fprintf(stderr, "kernel_launch: unexpected shapes (n_in %d, out %d, ws %zu < %zu)\n", n_in, out_size, ws_size, (size_t)WS_END); grid = -1; return; }
        int dev = 0, cus = 0, per_cu = 0;
        if (hipGetDevice(&dev) != hipSuccess || hipDeviceGetAttribute(&cus, hipDeviceAttributeMultiprocessorCount, dev) != hipSuccess) { grid = -1; return; }
        if (hipFuncSetAttribute((const void*)mk_fwd, hipFuncAttributeMaxDynamicSharedMemorySize, LDS_BYTES) != hipSuccess) { fprintf(stderr, "kernel_launch: hipFuncSetAttribute(%d B LDS) failed\n", LDS_BYTES); grid = -1; return; }
        if (hipOccupancyMaxActiveBlocksPerMultiprocessor(&per_cu, (const void*)mk_fwd, NWAVES * 64, LDS_BYTES) != hipSuccess || per_cu < 1) fprintf(stderr, "kernel_launch: occupancy query says %d\n", per_cu);
        (void)hipGetLastError();
        grid = cus;
        if (grid != 256) fprintf(stderr, "kernel_launch: %d CUs (built for 256)\n", grid);
    }
    if (grid < 0) return;
    (void)hipMemsetAsync((char*)d_ws + WS_CTL, 0, CTL_ZERO_BYTES, stream);
    Args a{};
    for (int i = 0; i < 18; ++i) a.in[i] = (const float*)d_in[i];
    a.out = (float*)d_out; a.ws = (unsigned char*)d_ws;
#ifdef MK_REPEAT
    a.rep_k = MK_REPEAT; a.rep_n = MK_REPEAT_N;
#else
    a.rep_k = -1; a.rep_n = 0;
#endif
    for (int li = 0; li < N_LAUNCHES; ++li) {
        a.ph_lo = (N_LAUNCHES == 1) ? 0 : li; a.ph_hi = (N_LAUNCHES == 1) ? NPH : li + 1;
        hipLaunchKernelGGL(mk_fwd, dim3(grid), dim3(NWAVES * 64), LDS_BYTES, stream, a);
    }
}
```

```cpp
#include <hip/hip_runtime.h>
#include <cstdio>
#include <cstdint>

#ifndef MK_N_LAUNCHES
#define MK_N_LAUNCHES 1
#endif

#define LAS __attribute__((address_space(3)))
#define GAS __attribute__((address_space(1)))
typedef unsigned short bf16;
typedef short bf16x8 __attribute__((ext_vector_type(8)));
typedef float f32x4 __attribute__((ext_vector_type(4)));
typedef float f32x2 __attribute__((ext_vector_type(2)));
typedef float f32x16 __attribute__((ext_vector_type(16)));
typedef unsigned u32x4 __attribute__((ext_vector_type(4)));
typedef unsigned u32x2 __attribute__((ext_vector_type(2)));
typedef __bf16 bf16x2_t __attribute__((ext_vector_type(2)));
typedef int v8i32 __attribute__((ext_vector_type(8)));
typedef int i32x4 __attribute__((ext_vector_type(4)));

constexpr int NWAVES = 8;
constexpr int M = 16384, D = 1024, SEQ = 2048;
constexpr int NZS = 8208;
constexpr int NZ = 8192;
constexpr int NE = 32, CAP = 16384;
constexpr int NPH = 11;
constexpr int N_LAUNCHES = MK_N_LAUNCHES;
constexpr size_t ZQ = 0, ZK = ZQ + (size_t)4 * M * 128, ZV = ZK + (size_t)4 * M * 128, ZR = ZV + (size_t)4 * M * 256, ZCB = ZR + (size_t)4 * M * 256, ZCC = ZCB + (size_t)M * 1024, ZCX = ZCC + (size_t)M * 1024, ZGA = ZCX + (size_t)M * 1024, ZGB = ZGA + (size_t)M * 1024;

constexpr size_t MiB = 1u << 20;
constexpr size_t WS_CTL = 0, CTL_ZERO_BYTES = 65536;
constexpr size_t WS_LIST = 1 * MiB;
constexpr size_t WS_GATE = 3 * MiB;
constexpr size_t WS_DECS = 4 * MiB;
constexpr size_t WS_WIN = 16 * MiB;
constexpr size_t WS_WA = 32 * MiB, WS_WB = 34 * MiB, WS_WO = 36 * MiB;
constexpr size_t WS_WGU = 40 * MiB;
constexpr size_t WS_WD = 168 * MiB;
constexpr size_t WS_XN = 232 * MiB;
constexpr size_t WS_LA = 264 * MiB;
constexpr size_t WS_Z = 296 * MiB;
constexpr size_t WS_YP = WS_Z;
constexpr size_t WS_U = 552 * MiB;
constexpr size_t WS_SIN = 584 * MiB;
constexpr size_t WS_OG = 616 * MiB;
constexpr size_t WS_PB = 648 * MiB;
constexpr size_t WS_M1 = 680 * MiB;
constexpr size_t WS_MIX = 744 * MiB;
constexpr size_t WS_X1 = 776 * MiB;
constexpr size_t WS_ACT = 840 * MiB;
constexpr size_t WS_END = 984 * MiB;
constexpr int CW_TMO = 0;
constexpr int CW_BAR = 4096;
constexpr int CW_CNT = 8192;
constexpr int CW_STAMP = 12288;

constexpr int RING_BYTES = 131072;
constexpr int EXTRA_OFF = RING_BYTES;
constexpr int LDS_BYTES = 155648 + 512;
constexpr int MISC_OFF = 155648;

#define RLX_AGENT __ATOMIC_RELAXED, __HIP_MEMORY_SCOPE_AGENT
#define LDS_WAIT() asm volatile("s_waitcnt lgkmcnt(0)" ::: "memory")
#define VM_WAIT() asm volatile("s_waitcnt vmcnt(0)" ::: "memory")
__device__ __forceinline__ unsigned pk2(float lo, float hi) { f32x2 v = {lo, hi}; bf16x2_t b = __builtin_convertvector(v, bf16x2_t); return __builtin_bit_cast(unsigned, b); }
__device__ __forceinline__ unsigned pk4_fp8(float a, float b, float c, float d) { int w = 0; w = __builtin_amdgcn_cvt_pk_fp8_f32(a, b, w, false); w = __builtin_amdgcn_cvt_pk_fp8_f32(c, d, w, true); return (unsigned)w; }
__device__ __forceinline__ float bf_lo(unsigned w) { return __builtin_bit_cast(float, w << 16); }
__device__ __forceinline__ float bf_hi(unsigned w) { return __builtin_bit_cast(float, w & 0xffff0000u); }
__device__ __forceinline__ float bf1(bf16 b) { return __builtin_bit_cast(float, ((unsigned)b) << 16); }
__device__ __forceinline__ float fast_sigmoid(float x) { return __builtin_amdgcn_rcpf(1.0f + __expf(-x)); }
__device__ __forceinline__ float wave_sum(float v) {
#pragma unroll
    for (int o = 1; o < 64; o <<= 1) v += __shfl_xor(v, o);
    return v;
}

namespace pg8 {
constexpr int BM = 256, BK = 64, HALF = 128, HTB = HALF * BK * 2, STAGE_BYTES = 8 * HTB, NXCD = 8, WGM = 8;
__device__ __forceinline__ int lds_byte(int r, int c) { const int st = (r >> 4) * 2 + (c >> 5), rr = r & 15, cc = c & 31, ob = rr * 64 + cc * 2; return st * 1024 + (ob ^ (((ob >> 9) & 1) << 5)); }
__device__ __forceinline__ void stage_rc(int b, int& R, int& C) { const int st = b / 1024, sb = b % 1024, swz = sb ^ (((sb >> 9) & 1) << 5); R = (st >> 1) * 16 + swz / 64; C = (st & 1) * 32 + (swz % 64) / 2; }
__device__ __forceinline__ int perm32(int rho) { const int n = rho >> 4, i = rho & 15; return 8 * (i >> 2) + 4 * n + (i & 3); }

struct Unit { int pm, pn, e, rt, ui; };

struct StaticOrder {
    int nM, nN, nwg, G, c, K, reps;
    __device__ __forceinline__ void init(int M_, int N_, int K_, int G_, int c_, int reps_) { nM = M_ / BM; nN = N_ / BM; nwg = nM * nN; G = G_; c = c_; K = K_; reps = reps_; }
    __device__ __forceinline__ bool next(int i, Unit& u) const {
        const long L = (long)i * G + c; if (L >= (long)nwg * reps) return false;
        int wgid = (int)(L % nwg); { const int q = nwg / NXCD, r = nwg % NXCD, xcd = wgid % NXCD, off = wgid / NXCD; wgid = (xcd < r ? xcd * (q + 1) : r * (q + 1) + (xcd - r) * q) + off; }
        const int nig = WGM * nN, gid = wgid / nig, fm = gid * WGM, gsz = (nM - fm) < WGM ? (nM - fm) : WGM;
        u.pm = fm + ((wgid % nig) % gsz); u.pn = (wgid % nig) / gsz; u.e = 0; u.rt = 0; u.ui = i; return true;
    }
    __device__ __forceinline__ unsigned arow(const Unit& u, int ui, int r) const { return (unsigned)(u.pm * BM + r) * (unsigned)(K * 2); }
    __device__ __forceinline__ void after_unit(int ui) const {}
    __device__ __forceinline__ bool keep_acc(int ui) const { return false; }
};

template <class Epi, class Sched, bool ALIGN_EPI, bool FP8 = false, int SCW = 127>
__device__ __forceinline__ void gemm_phase(LAS unsigned char* lds, const void* Ag, const void* Btg, const int K, const Sched& S, const Epi& E) {
    const int tid = threadIdx.x, wid = __builtin_amdgcn_readfirstlane(tid >> 6), lane = tid & 63, wr = wid >> 2, wc = wid & 3, fr = lane & 15, fq = lane >> 4;
    const int RB = FP8 ? K : 2 * K;
    const int nt = RB / 128;
    int RA[2], CA[2]; unsigned voffB[2];
#pragma unroll
    for (int i = 0; i < 2; ++i) { int R, C; stage_rc(tid * 16 + i * 8192, R, C); const int Rb = Epi::PERM ? ((R & ~31) + perm32(R & 31)) : R;
        RA[i] = R; CA[i] = C * 2; voffB[i] = (unsigned)(Rb * RB + C * 2); }
    const size_t kstep = (size_t)(BK * 2);
    const size_t hstep = (size_t)HALF * RB;
    const size_t tstep = 2 * hstep;
    const unsigned ldsw = (unsigned)wid * 1024u;
    const int aoff = lds_byte(wr * 64 + fr, fq * 8), boff = lds_byte(wc * 32 + fr, fq * 8);
#define PG8_SA(b, h) (((b) * 2 + (h)) * HTB)
#define PG8_SB(b, h) ((4 + (b) * 2 + (h)) * HTB)
#define PG8_STAGEB(bufoff, gbase) do { _Pragma("unroll") for (int _i = 0; _i < 2; ++_i) \
        __builtin_amdgcn_global_load_lds((const unsigned*)((const char*)(gbase) + voffB[_i]), (LAS unsigned*)(lds + (bufoff) + ldsw + _i * 8192), 16, 0, 0); } while (0)
#define PG8_STAGEA(bufoff, o0, o1) do { \
        __builtin_amdgcn_global_load_lds((const unsigned*)((const char*)Ag + (o0)), (LAS unsigned*)(lds + (bufoff) + ldsw), 16, 0, 0); \
        __builtin_amdgcn_global_load_lds((const unsigned*)((const char*)Ag + (o1)), (LAS unsigned*)(lds + (bufoff) + ldsw + 8192), 16, 0, 0); } while (0)
#define PG8_LDA(dst, b, h) do { if constexpr (FP8) { _Pragma("unroll") for (int m = 0; m < 4; ++m) { dst[m][0] = *(const LAS bf16x8*)(lds + PG8_SA(b, h) + aoff + m * 2048); dst[m][1] = *(const LAS bf16x8*)(lds + PG8_SA(b, h) + aoff + m * 2048 + 1024); } } \
        else { _Pragma("unroll") for (int m = 0; m < 4; ++m) _Pragma("unroll") for (int k = 0; k < 2; ++k) dst[m][k] = *(const LAS bf16x8*)(lds + PG8_SA(b, h) + aoff + m * 2048 + k * 1024); } } while (0)
#define PG8_LDB(dst, b, h) do { if constexpr (FP8) { _Pragma("unroll") for (int n = 0; n < 2; ++n) { dst[n][0] = *(const LAS bf16x8*)(lds + PG8_SB(b, h) + boff + n * 2048); dst[n][1] = *(const LAS bf16x8*)(lds + PG8_SB(b, h) + boff + n * 2048 + 1024); } } \
        else { _Pragma("unroll") for (int n = 0; n < 2; ++n) _Pragma("unroll") for (int k = 0; k < 2; ++k) dst[n][k] = *(const LAS bf16x8*)(lds + PG8_SB(b, h) + boff + n * 2048 + k * 1024); } } while (0)
#define PG8_F8(x) __builtin_bit_cast(v8i32, __builtin_shufflevector(__builtin_bit_cast(u32x4, (x)[0]), __builtin_bit_cast(u32x4, (x)[1]), 0, 1, 2, 3, 4, 5, 6, 7))
#define PG8_MMA(ai, bj, At, Bt) do { __builtin_amdgcn_s_setprio(1); if constexpr (FP8) { _Pragma("unroll") for (int m = 0; m < 4; ++m) _Pragma("unroll") for (int n = 0; n < 2; ++n) \
        asm volatile("v_mfma_scale_f32_16x16x128_f8f6f4 %0, %1, %2, %0, %3, %4 op_sel_hi:[0,0,0]" : "+v"(acc[ai][bj][m][n]) : "v"(PG8_F8(Bt[n])), "v"(PG8_F8(At[m])), "v"(scw_reg), "v"(sca_reg)); } \
        else { _Pragma("unroll") for (int m = 0; m < 4; ++m) _Pragma("unroll") for (int n = 0; n < 2; ++n) _Pragma("unroll") for (int k = 0; k < 2; ++k) \
        acc[ai][bj][m][n] = __builtin_amdgcn_mfma_f32_16x16x32_bf16(Bt[n][k], At[m][k], acc[ai][bj][m][n], 0, 0, 0); } __builtin_amdgcn_s_setprio(0); } while (0)
#define PG8_WAIT_V(n) asm volatile("s_waitcnt vmcnt(" #n ")" ::: "memory")
#define PG8_WAIT_L(n) asm volatile("s_waitcnt lgkmcnt(" #n ")" ::: "memory")
#define PG8_BAR __builtin_amdgcn_s_barrier()
#define PG8_SCHED __builtin_amdgcn_sched_barrier(0)
    Unit cur, nxt; int ui = 0;
    if (!S.next(0, cur)) return;
    int scw_reg = SCW, sca_reg = 127;
    asm volatile("" : "+v"(scw_reg), "+v"(sca_reg));
    f32x4 acc[2][2][4][2];
#pragma unroll
    for (int a = 0; a < 2; ++a)
#pragma unroll
        for (int b = 0; b < 2; ++b)
#pragma unroll
            for (int m = 0; m < 4; ++m)
#pragma unroll
                for (int n = 0; n < 2; ++n) acc[a][b][m][n] = (f32x4){0.f, 0.f, 0.f, 0.f};
#define PG8_ZPAD() do { if constexpr (FP8) { _Pragma("unroll") for (int a = 0; a < 2; ++a) _Pragma("unroll") for (int b = 0; b < 2; ++b) _Pragma("unroll") for (int m = 0; m < 4; ++m) asm volatile("s_nop 1" : "+v"(acc[a][b][m][0]), "+v"(acc[a][b][m][1])); } } while (0)
    PG8_ZPAD();
    bf16x8 At[4][2], B0[2][2], B1[2][2];
    unsigned ac00, ac01, ac10, ac11;
    ac00 = S.arow(cur, 0, RA[0]) + CA[0]; ac01 = S.arow(cur, 0, RA[1]) + CA[1]; ac10 = S.arow(cur, 0, HALF + RA[0]) + CA[0]; ac11 = S.arow(cur, 0, HALF + RA[1]) + CA[1];
    const char* cB = (const char*)Btg + (size_t)cur.pn * tstep;
    PG8_STAGEB(PG8_SB(0, 0), cB); PG8_STAGEB(PG8_SB(0, 1), cB + hstep); PG8_STAGEA(PG8_SA(0, 0), ac00, ac01); PG8_STAGEA(PG8_SA(0, 1), ac10, ac11);
    if (wr == 1) PG8_BAR;
    PG8_WAIT_V(2); PG8_BAR;
    PG8_STAGEB(PG8_SB(1, 0), cB + kstep); PG8_STAGEA(PG8_SA(1, 0), ac00 + 128u, ac01 + 128u); PG8_STAGEB(PG8_SB(1, 1), cB + hstep + kstep);
    PG8_WAIT_V(6); PG8_BAR;
    for (;;) {
        const bool has_next = S.next(ui + 1, nxt);
        const char* nB = has_next ? (const char*)Btg + (size_t)nxt.pn * tstep : cB;
#pragma unroll 1
        for (int t = 0; t < nt; t += 2) {
            const bool last = (t == nt - 2);
            const unsigned k1 = (unsigned)(t + 1) * 128u, k2 = (unsigned)(t + 2) * 128u;
            unsigned a200 = ac00 + k2, a201 = ac01 + k2, a210 = ac10 + k2, a211 = ac11 + k2;
            if (last) { if (has_next) { a200 = S.arow(nxt, ui + 1, RA[0]) + CA[0]; a201 = S.arow(nxt, ui + 1, RA[1]) + CA[1]; a210 = S.arow(nxt, ui + 1, HALF + RA[0]) + CA[0]; a211 = S.arow(nxt, ui + 1, HALF + RA[1]) + CA[1]; }
                        else { a200 = ac00; a201 = ac01; a210 = ac10; a211 = ac11; } }
            const char* b2 = last ? nB : cB + (size_t)k2; const char* b3 = b2 + kstep;
            PG8_LDB(B0, 0, 0); PG8_LDB(B1, 0, 1); PG8_SCHED; PG8_LDA(At, 0, 0); PG8_STAGEA(PG8_SA(1, 1), ac10 + k1, ac11 + k1);
            PG8_WAIT_V(8); PG8_WAIT_L(0); PG8_BAR; PG8_MMA(0, 0, At, B0); PG8_MMA(0, 1, At, B1); PG8_BAR; PG8_SCHED;
            PG8_LDA(At, 0, 1); PG8_STAGEB(PG8_SB(0, 0), b2); PG8_STAGEB(PG8_SB(0, 1), b2 + hstep); PG8_STAGEA(PG8_SA(0, 0), a200, a201);
            PG8_WAIT_V(8); PG8_WAIT_L(0); PG8_BAR; PG8_MMA(1, 0, At, B0); PG8_MMA(1, 1, At, B1); PG8_BAR; PG8_SCHED;
            PG8_LDB(B0, 1, 0); PG8_LDB(B1, 1, 1); PG8_SCHED; PG8_LDA(At, 1, 0); PG8_STAGEA(PG8_SA(0, 1), a210, a211);
            PG8_WAIT_V(8); PG8_WAIT_L(0); PG8_BAR; PG8_MMA(0, 0, At, B0); PG8_MMA(0, 1, At, B1); PG8_BAR; PG8_SCHED;
            PG8_LDA(At, 1, 1); PG8_STAGEB(PG8_SB(1, 0), b3); PG8_STAGEB(PG8_SB(1, 1), b3 + hstep); PG8_STAGEA(PG8_SA(1, 0), a200 + 128u, a201 + 128u);
            PG8_WAIT_V(8); PG8_WAIT_L(0); PG8_BAR; PG8_MMA(1, 0, At, B0); PG8_MMA(1, 1, At, B1); PG8_BAR; PG8_SCHED;
        }
        if constexpr (FP8) asm volatile("s_nop 15\n\ts_nop 15" ::: "memory");
#pragma unroll
        for (int a = 0; a < 2; ++a)
#pragma unroll
            for (int b = 0; b < 2; ++b)
#pragma unroll
                for (int m = 0; m < 4; ++m) asm volatile("" : "+v"(acc[a][b][m][0]), "+v"(acc[a][b][m][1]));
        if constexpr (ALIGN_EPI) { if (wr == 0) PG8_BAR; }
        E(acc, cur, wr, wc, fr, fq);
        S.after_unit(ui);
        if (!has_next) break;
        if (!S.keep_acc(ui)) {
#pragma unroll
        for (int a = 0; a < 2; ++a)
#pragma unroll
            for (int b = 0; b < 2; ++b)
#pragma unroll
                for (int m = 0; m < 4; ++m)
#pragma unroll
                    for (int n = 0; n < 2; ++n) acc[a][b][m][n] = (f32x4){0.f, 0.f, 0.f, 0.f};
        }
        PG8_ZPAD();
        cur = nxt; cB = nB; ++ui;
        ac00 = S.arow(cur, ui, RA[0]) + CA[0]; ac01 = S.arow(cur, ui, RA[1]) + CA[1]; ac10 = S.arow(cur, ui, HALF + RA[0]) + CA[0]; ac11 = S.arow(cur, ui, HALF + RA[1]) + CA[1];
        if constexpr (ALIGN_EPI) { if (wr == 1) PG8_BAR; }
    }
    PG8_WAIT_V(0);
    if constexpr (!ALIGN_EPI) { if (wr == 0) PG8_BAR; }
    PG8_BAR;
#undef PG8_SA
#undef PG8_SB
#undef PG8_STAGEA
#undef PG8_STAGEB
#undef PG8_LDA
#undef PG8_LDB
#undef PG8_MMA
#undef PG8_F8
#undef PG8_ZPAD
#undef PG8_WAIT_V
#undef PG8_WAIT_L
#undef PG8_BAR
#undef PG8_SCHED
}
}

#define XB_TMO      128
#define XB_XCNT(j)  (256  + 64 * (j))
#define XB_XSUB(j)  (1280 + 64 * (j))
#define XB_XGEN(j)  (2304 + 64 * (j))
#define XB_TOP      3328
#define XB_TOPGEN   3392
#define XCD_BAR_WORDS 3456
#define XB_SPIN_CAP (1u << 18)
__device__ __forceinline__ unsigned xb_ld(unsigned* p)              { return __hip_atomic_load(p, __ATOMIC_RELAXED, __HIP_MEMORY_SCOPE_AGENT); }
__device__ __forceinline__ unsigned xb_add(unsigned* p, unsigned v) { return __hip_atomic_fetch_add(p, v, __ATOMIC_RELAXED, __HIP_MEMORY_SCOPE_AGENT); }
__device__ __forceinline__ unsigned xb_xcc_id() { return (unsigned)__builtin_amdgcn_s_getreg((3 << 11) | 20) & 0xFu; }
#define XB_SPIN(cond, bar) do { unsigned _sp = 0; while (cond) { __builtin_amdgcn_s_sleep(1); \
    if ((++_sp & 255u) == 0u) { if (xb_ld(&(bar)[XB_TMO])) break; if (_sp > XB_SPIN_CAP) { atomicAdd(&(bar)[XB_TMO], 1u); break; } } } } while (0)
struct XcdBarrier { unsigned* bar; unsigned x; volatile LAS unsigned* st; };
__device__ __forceinline__ XcdBarrier xcd_barrier_post(unsigned* bar, volatile LAS unsigned* st) {
    XcdBarrier b; b.bar = bar; b.x = xb_xcc_id(); b.st = st;
    if (threadIdx.x == 0) (void)xb_add(&bar[XB_XCNT(b.x)], 1u);
    return b;
}
__device__ __forceinline__ void xcd_barrier_complete(unsigned* bar, unsigned x, unsigned& nloc, unsigned& nx) {
    const unsigned G = gridDim.x * gridDim.y * gridDim.z;
    unsigned sum, cnt, mine, sp = 0u;
    for (;;) {
        sum = 0u; cnt = 0u; mine = 0u;
#pragma unroll
        for (unsigned j = 0; j < 16; ++j) { const unsigned c = xb_ld(&bar[XB_XCNT(j)]); sum += c; cnt += (c > 0u) ? 1u : 0u; mine = (j == x) ? c : mine; }
        if (sum == G) break;
        __builtin_amdgcn_s_sleep(1);
        if ((++sp & 255u) == 0u) { if (xb_ld(&bar[XB_TMO])) break; if (sp > XB_SPIN_CAP) { atomicAdd(&bar[XB_TMO], 1u); break; } }
    }
    nloc = mine > 0u ? mine : 1u; nx = cnt > 0u ? cnt : 1u;
}
__device__ __forceinline__ void xcd_barrier(const XcdBarrier& b) {
    asm volatile("s_waitcnt vmcnt(0)" ::: "memory");
    __syncthreads();
    if (threadIdx.x == 0) {
        unsigned* bar = b.bar;
        __builtin_amdgcn_s_waitcnt(0);
        unsigned nloc = b.st[0], nx = b.st[1];
        if (nloc == 0u) { xcd_barrier_complete(bar, b.x, nloc, nx); b.st[0] = nloc; b.st[1] = nx; }
        const unsigned old = xb_add(&bar[XB_XSUB(b.x)], 1u);
        const unsigned gen = old / nloc;
        if (old + 1u == (gen + 1u) * nloc) {
            __builtin_amdgcn_fence(__ATOMIC_RELEASE, "agent");
            asm volatile("s_waitcnt vmcnt(0)" ::: "memory");
            const unsigned og = xb_add(&bar[XB_TOP], 1u);
            const unsigned tg = og / nx;
            if (og + 1u == (tg + 1u) * nx) xb_add(&bar[XB_TOPGEN], 1u);
            else XB_SPIN(xb_ld(&bar[XB_TOPGEN]) == tg, bar);
            __builtin_amdgcn_fence(__ATOMIC_ACQUIRE, "agent");
            xb_add(&bar[XB_XGEN(b.x)], 1u);
            asm volatile("s_waitcnt vmcnt(0)" ::: "memory");
        } else {
            XB_SPIN(xb_ld(&bar[XB_XGEN(b.x)]) == gen, bar);
            __builtin_amdgcn_fence(__ATOMIC_ACQUIRE, "agent");
            asm volatile("s_waitcnt vmcnt(0)" ::: "memory");
        }
    }
    __syncthreads();
}

struct Frame {
    LAS unsigned char* lds;
    volatile LAS unsigned* MISC;
    unsigned* ctl;
    int tid, lane, wave, vcu, G;
    unsigned char* ws;
    const float *x, *g_mix, *w_in, *w_up, *b_alpha, *g_gla, *w_conv, *w_a, *w_b, *w_out, *g_ffn, *w_router, *b_router, *w_gu, *b_gu, *w_d, *b_d, *g_final;
    float* out;
};
#define WSP(T, off) ((T*)(F.ws + (off)))

__device__ __forceinline__ void tr_item64(const float* W, int ld, int k0, int n0, bf16* WT, size_t dst_row0, int K, LAS unsigned* T, int lane) {
    const int nq = lane & 15, kr = lane >> 4;
    const float* src = W + (size_t)(k0 + 2 * kr) * ld + n0 + 4 * nq;
    f32x4 a0[8], a1[8];
#pragma unroll
    for (int it = 0; it < 8; ++it) { a0[it] = __builtin_nontemporal_load((const f32x4*)(src + (size_t)(8 * it) * ld)); a1[it] = __builtin_nontemporal_load((const f32x4*)(src + (size_t)(8 * it + 1) * ld)); }
    const int c = lane & 7;
#pragma unroll
    for (int hf = 0; hf < 2; ++hf) {
        if ((nq >> 3) == hf) {
#pragma unroll
            for (int it = 0; it < 8; ++it)
#pragma unroll
                for (int q = 0; q < 4; ++q) T[(4 * (nq & 7) + q) * 33 + 4 * it + kr] = pk2(a0[it][q], a1[it][q]);
        }
        LDS_WAIT(); asm volatile("" ::: "memory");
#pragma unroll
        for (int j = 0; j < 4; ++j) { const int n = (lane >> 3) + 8 * j; const LAS unsigned* t = T + n * 33 + 4 * c;
            u32x4 o; o.x = t[0]; o.y = t[1]; o.z = t[2]; o.w = t[3];
            *(u32x4*)(WT + (dst_row0 + 32 * hf + n) * (size_t)K + k0 + 8 * c) = o; }
        LDS_WAIT(); asm volatile("" ::: "memory");
    }
}

__device__ __forceinline__ void tr_item8(const float* W, int ld, int k0, int n0, unsigned char* WT8, size_t dst_row0, int KB, float scale, LAS unsigned* T, int lane) {
    const int nq = lane & 7, kr = lane >> 3;
    const float* src = W + (size_t)(k0 + 4 * kr) * ld + n0 + 4 * nq;
    f32x4 a[4][4];
#pragma unroll
    for (int it = 0; it < 4; ++it)
#pragma unroll
        for (int j = 0; j < 4; ++j) a[it][j] = __builtin_nontemporal_load((const f32x4*)(src + (size_t)(32 * it + j) * ld));
    const int c = lane & 7;
#pragma unroll
    for (int hf = 0; hf < 2; ++hf) {
        if ((nq >> 2) == hf) {
#pragma unroll
            for (int it = 0; it < 4; ++it)
#pragma unroll
                for (int q = 0; q < 4; ++q) T[(4 * (nq & 3) + q) * 33 + 8 * it + kr] = pk4_fp8(a[it][0][q] * scale, a[it][1][q] * scale, a[it][2][q] * scale, a[it][3][q] * scale);
        }
        LDS_WAIT(); asm volatile("" ::: "memory");
#pragma unroll
        for (int j = 0; j < 2; ++j) { const int n = (lane >> 3) + 8 * j; const LAS unsigned* t = T + n * 33 + 4 * c;
            u32x4 o; o.x = t[0]; o.y = t[1]; o.z = t[2]; o.w = t[3];
            __builtin_nontemporal_store(o, (u32x4*)(WT8 + (dst_row0 + 16 * hf + n) * (size_t)KB + k0 + 16 * c)); }
        LDS_WAIT(); asm volatile("" ::: "memory");
    }
}
constexpr int MOE_NIT = NE * 64 * 8 + NE * 32 * 8;
#ifndef MK_MOE_SPLIT
#define MK_MOE_SPLIT 0
#endif
constexpr int MOE_SPLIT = MK_MOE_SPLIT;
__device__ __forceinline__ void moe_convert_range(const float* w_gu, const float* w_d, unsigned char* ws, LAS unsigned* T, int first, int step, int end, int lane) {
    constexpr int I_GU = NE * 64 * 8;
    for (int it = first; it < end; it += step) {
        int r = it;
        if (r < I_GU) { const int e = r >> 9, q = r & 511, kb = q >> 6, nb = q & 63, j0 = 32 * nb, pn = j0 >> 8, within = j0 & 255, half = within >> 7;
            tr_item8(w_gu + (size_t)e * 1024 * 2048, 2048, 128 * kb, half * 1024 + pn * 128 + (within & 127), ws + WS_WGU + (size_t)e * 2048 * 1024, j0, 1024, 32.0f, T, lane); continue; } r -= I_GU;
        { const int e = r >> 8, q = r & 255, kb = q >> 5, nb = q & 31;
            tr_item8(w_d + (size_t)e * 1024 * 1024, 1024, 128 * kb, 32 * nb, ws + WS_WD + (size_t)e * 1024 * 1024, 32 * nb, 1024, 32.0f, T, lane); }
    }
}
__device__ __forceinline__ void moe_convert_share(const float* w_gu, const float* w_d, unsigned char* ws, LAS unsigned char* lds, int c, int G, int wave, int lane) {
    moe_convert_range(w_gu, w_d, ws, (LAS unsigned*)(lds + EXTRA_OFF + wave * 2176), MOE_SPLIT + c * NWAVES + wave, G * NWAVES, MOE_NIT, lane);
}
struct P1Order : pg8::StaticOrder {
    const float* w_gu; const float* w_d; unsigned char* ws; LAS unsigned char* lds; int slot, wave, lane;
    __device__ __forceinline__ void after_unit(int ui) const { if (ui == slot) { int ln = lane; asm volatile("" : "+v"(ln));
            moe_convert_share(w_gu, w_d, ws, lds, c, G, wave, ln); } }
};

constexpr int P0_T_BYTES = 4352;
constexpr int P0_WLD = 2064;
constexpr int P0_WL = 8 * P0_T_BYTES;
constexpr int P0_WU = P0_WL + 16 * P0_WLD;
constexpr int P0_BA = P0_WU + 16384;
constexpr int P0_AS = P0_BA + 2048;

__device__ __forceinline__ void p0_items(Frame& F, const int nrep) {
    LAS unsigned* scr = (LAS unsigned*)(F.lds + F.wave * P0_T_BYTES);
    const int gw = F.vcu * NWAVES + F.wave, NGW = F.G * NWAVES;
    constexpr int I_IN = 128 * 16, I_SQ = 16 * 16;
    constexpr int NITEMS = I_IN + 3 * I_SQ;
    bf16* Win_t = WSP(bf16, WS_WIN);
    for (int it0 = gw; it0 < NITEMS * nrep; it0 += NGW) {
        int r = it0 % NITEMS;
        if (r < I_IN) { const int kb = r >> 7, nb = r & 127, j0 = 64 * nb;
            int srcc = j0 < 3072 ? j0 : j0 + 16;
            if (j0 >= 4096 && j0 < 6144) { const int pn = j0 >> 8, within = j0 & 255; srcc = ((within >> 7) ? 5136 : 4112) + (pn - 16) * 128 + (within & 127); }
            tr_item64(F.w_in, NZS, 64 * kb, srcc, Win_t, j0, 1024, scr, F.lane); continue; } r -= I_IN;
        if (r < I_SQ) { tr_item64(F.w_a, 1024, 64 * (r >> 4), 64 * (r & 15), WSP(bf16, WS_WA), 64 * (r & 15), 1024, scr, F.lane); continue; } r -= I_SQ;
        if (r < I_SQ) { tr_item64(F.w_b, 1024, 64 * (r >> 4), 64 * (r & 15), WSP(bf16, WS_WB), 64 * (r & 15), 1024, scr, F.lane); continue; } r -= I_SQ;
        tr_item64(F.w_out, 1024, 64 * (r >> 4), 64 * (r & 15), WSP(bf16, WS_WO), 64 * (r & 15), 1024, scr, F.lane);
    }
    moe_convert_range(F.w_gu, F.w_d, F.ws, scr, gw, NGW, MOE_SPLIT, F.lane);
}

__device__ __forceinline__ void p0_rows(Frame& F, const int nrep2) {
    const int gw = F.vcu * NWAVES + F.wave, NGW = F.G * NWAVES, lane = F.lane, r32 = lane & 31, h = lane >> 5;
    LAS unsigned char* L = F.lds;
    LAS float* BA = (LAS float*)(L + P0_BA);
    LAS float* AS = (LAS float*)(L + P0_AS + F.wave * 512);
    f32x4 g[4];
#pragma unroll
    for (int j = 0; j < 4; ++j) g[j] = *((const f32x4*)F.g_mix + lane + 64 * j);
    bf16* XN = WSP(bf16, WS_XN); bf16* LA = WSP(bf16, WS_LA);
#pragma unroll 1
    for (int b8 = 0; (b8 * 8) * NGW + gw < M * nrep2; ++b8) {
        f32x4 nx[4];
        { const f32x4* xr = (const f32x4*)(F.x + (size_t)(((b8 * 8) * NGW + gw) % M) * D) + lane;
#pragma unroll
          for (int j = 0; j < 4; ++j) nx[j] = __builtin_nontemporal_load(xr + 64 * j); }
#pragma unroll 1
        for (int i = 0; i < 8; ++i) {
            const int m = ((b8 * 8 + i) * NGW + gw) % M;
            f32x4 v[4]; float s = 0.f;
#pragma unroll
            for (int j = 0; j < 4; ++j) { v[j] = nx[j]; s += (v[j].x * v[j].x + v[j].y * v[j].y) + (v[j].z * v[j].z + v[j].w * v[j].w); }
            if (i < 7) { const f32x4* xr = (const f32x4*)(F.x + (size_t)(((b8 * 8 + i + 1) * NGW + gw) % M) * D) + lane;
#pragma unroll
                for (int j = 0; j < 4; ++j) nx[j] = __builtin_nontemporal_load(xr + 64 * j); }
            const float rstd = 1.0f / sqrtf(wave_sum(s) * (1.f / D) + 1e-6f);
            unsigned long long* o8 = (unsigned long long*)(XN + (size_t)m * D) + lane;
#pragma unroll
            for (int j = 0; j < 4; ++j) { v[j] = v[j] * rstd * g[j]; o8[64 * j] = (unsigned long long)pk2(v[j].x, v[j].y) | ((unsigned long long)pk2(v[j].z, v[j].w) << 32); }
        }
        asm volatile("s_waitcnt vmcnt(0)" ::: "memory");
        {
            const int tl = lane & 7, kg = lane >> 4, rr = lane & 15;
            const bf16* ap = XN + (size_t)(((b8 * 8 + tl) * NGW + gw) % M) * D + 8 * kg;
            const LAS unsigned char* bp = L + P0_WL + rr * P0_WLD + 16 * kg;
            f32x4 ac = {0.f, 0.f, 0.f, 0.f};
#pragma unroll
            for (int k8 = 0; k8 < 4; ++k8) {
                bf16x8 af[8];
#pragma unroll
                for (int q = 0; q < 8; ++q) af[q] = *(const bf16x8*)(ap + 32 * (8 * k8 + q));
#pragma unroll
                for (int q = 0; q < 8; ++q) ac = __builtin_amdgcn_mfma_f32_16x16x32_bf16(af[q], *(const LAS bf16x8*)(bp + 64 * (8 * k8 + q)), ac, 0, 0, 0);
            }
            if (lane < 32) {
#pragma unroll
                for (int q = 0; q < 4; ++q) AS[(4 * kg + q) * 16 + rr] = ac[q]; }
        }
        {
            f32x4 a0 = {0.f, 0.f, 0.f, 0.f}, a1 = a0;
            if (r32 < 8) { a0 = *(const LAS f32x4*)(AS + r32 * 16 + 8 * h); a1 = *(const LAS f32x4*)(AS + r32 * 16 + 8 * h + 4); }
            u32x4 hi, lo;
            hi.x = pk2(a0[0], a0[1]); hi.y = pk2(a0[2], a0[3]); hi.z = pk2(a1[0], a1[1]); hi.w = pk2(a1[2], a1[3]);
            lo.x = pk2(a0[0] - bf_lo(hi.x), a0[1] - bf_hi(hi.x)); lo.y = pk2(a0[2] - bf_lo(hi.y), a0[3] - bf_hi(hi.y)); lo.z = pk2(a1[0] - bf_lo(hi.z), a1[1] - bf_hi(hi.z)); lo.w = pk2(a1[2] - bf_lo(hi.w), a1[3] - bf_hi(hi.w));
            const bf16x8 ahi = __builtin_bit_cast(bf16x8, hi), alo = __builtin_bit_cast(bf16x8, lo);
            int mrow[4];
#pragma unroll
            for (int q = 0; q < 4; ++q) mrow[q] = ((b8 * 8 + q + 4 * h) * NGW + gw) % M;
#pragma unroll 4
            for (int nt = 0; nt < 16; ++nt) {
                const bf16x8 bw = *(const LAS bf16x8*)(L + P0_WU + (32 * nt + r32) * 32 + 16 * h);
                f32x16 c16;
#pragma unroll
                for (int q = 0; q < 16; ++q) c16[q] = 0.f;
                c16 = __builtin_amdgcn_mfma_f32_32x32x16_bf16(ahi, bw, c16, 0, 0, 0);
                c16 = __builtin_amdgcn_mfma_f32_32x32x16_bf16(alo, bw, c16, 0, 0, 0);
                const float bb = BA[32 * nt + r32];
#pragma unroll
                for (int q = 0; q < 4; ++q) { const float pre = c16[q] + bb;
                    const float ls = fminf(pre, 0.f) - __logf(1.0f + __expf(-fabsf(pre)));
                    LA[((size_t)(nt >> 2) * M + mrow[q]) * 128 + 32 * (nt & 3) + r32] = (bf16)(pk2(ls * (1.0f / 16.0f), 0.f) & 0xffffu); }
            }
        }
    }
}

__device__ __forceinline__ void p0_prologue(Frame& F, const int nrep, const int nrep2) {
    {
        LAS unsigned char* L = F.lds;
        for (int i = 0; i < 32; ++i) { const int idx = F.tid + 512 * i, k = idx >> 4, r = idx & 15; *(LAS bf16*)(L + P0_WL + r * P0_WLD + 2 * k) = (bf16)(pk2(F.w_in[(size_t)k * NZS + 3072 + r], 0.f) & 0xffffu); }
        for (int i = 0; i < 16; ++i) { const int idx = F.tid + 512 * i, r = idx >> 9, n = idx & 511; *(LAS bf16*)(L + P0_WU + n * 32 + 2 * r) = (bf16)(pk2(F.w_up[idx], 0.f) & 0xffffu); }
        ((LAS float*)(L + P0_BA))[F.tid] = F.b_alpha[F.tid];
        __syncthreads();
    }
#pragma unroll 1
    for (int pass = 0; pass < 2; ++pass) {
        if (((pass ^ F.wave) & 1) == 0) p0_items(F, nrep); else p0_rows(F, nrep2);
    }
}

struct EpiZ {
    static constexpr bool PERM = true;
    bf16* Z;
    __device__ __forceinline__ void operator()(const f32x4 (&acc)[2][2][4][2], const pg8::Unit& u, int wr, int wc, int fr, int fq) const {
        const int row0 = u.pm * 256 + wr * 64 + fr, c0 = wc * 32 + 8 * fq;
        const int pn = u.pn;
        const int kind = pn < 2 ? 1 : (pn < 8 ? 0 : (pn < 12 ? 2 : (pn < 24 ? 0 : 3)));
        bf16* base; int ld; size_t bjs;
        if (pn < 4) { base = Z + (pn < 2 ? ZQ : ZK) + (size_t)(2 * (pn & 1)) * M * 128; ld = 128; bjs = (size_t)M * 128; }
        else if (pn < 12) { base = Z + (pn < 8 ? ZV : ZR) + (size_t)(pn & 3) * M * 256; ld = 256; bjs = 128; }
        else { const int t = (pn - 12) >> 2; base = Z + ZCB + (size_t)t * M * 1024 + (size_t)((pn - 12) & 3) * 256; ld = 1024; bjs = 128; }
        if (pn >= 16 && pn < 24) {
            bf16* ub = Z + ZCC + (size_t)(pn - 16) * 128;
#pragma unroll
            for (int ai = 0; ai < 2; ++ai)
#pragma unroll
                for (int m = 0; m < 4; ++m) { const f32x4 v0 = acc[ai][0][m][0] * acc[ai][1][m][0], v1 = acc[ai][0][m][1] * acc[ai][1][m][1];
                    u32x4 w; w.x = pk2(v0[0], v0[1]); w.y = pk2(v0[2], v0[3]); w.z = pk2(v1[0], v1[1]); w.w = pk2(v1[2], v1[3]);
                    *(u32x4*)(ub + (size_t)(row0 + ai * 128 + m * 16) * 1024 + c0) = w; }
            return;
        }
#pragma unroll
        for (int ai = 0; ai < 2; ++ai)
#pragma unroll
            for (int m = 0; m < 4; ++m) { bf16* rowp = base + (size_t)(row0 + ai * 128 + m * 16) * ld + c0;
#pragma unroll
                for (int bj = 0; bj < 2; ++bj) { f32x4 v0 = acc[ai][bj][m][0], v1 = acc[ai][bj][m][1];
                    if (kind == 1) { v0 = v0 * 0.08838834764831845f; v1 = v1 * 0.08838834764831845f; }
                    else if (kind == 2) {
#pragma unroll
                        for (int j = 0; j < 4; ++j) { v0[j] = v0[j] * fast_sigmoid(v0[j]); v1[j] = v1[j] * fast_sigmoid(v1[j]); } }
                    else if (kind == 3) {
                        unsigned q[8];
#pragma unroll
                        for (int j = 0; j < 4; ++j) { q[j] = (unsigned)__builtin_rintf(fast_sigmoid(v0[j]) * 255.0f); q[4 + j] = (unsigned)__builtin_rintf(fast_sigmoid(v1[j]) * 255.0f); }
                        u32x2 wq; wq.x = q[0] | (q[1] << 8) | (q[2] << 16) | (q[3] << 24); wq.y = q[4] | (q[5] << 8) | (q[6] << 16) | (q[7] << 24);
                        unsigned char* gbase = (unsigned char*)(Z + (pn < 28 ? ZGA : ZGB)) + (size_t)((pn - 24) & 3) * 256;
                        *(u32x2*)(gbase + (size_t)(row0 + ai * 128 + m * 16) * 1024 + c0 + bj * 128) = wq;
                        continue; }
                    u32x4 w; w.x = pk2(v0[0], v0[1]); w.y = pk2(v0[2], v0[3]); w.z = pk2(v1[0], v1[1]); w.w = pk2(v1[2], v1[3]);
                    *(u32x4*)(rowp + bj * bjs) = w; } }
    }
};

constexpr int QD_STRIDE = 272, KT_STRIDE = 144, SC_STRIDE = 144, OT_STRIDE = 1040;
constexpr int L_GG = 134144, L_WC = 135168;
constexpr int L_QD = 0, L_KI = 17408, L_KT = 34816, L_SC = 53248, L_DEC = 62464, L_SEG = 62976, L_OT = 67584;
__device__ __forceinline__ int crow(int reg, int h) { return (reg & 3) + 8 * (reg >> 2) + 4 * h; }

template <bool OUT>
__device__ __forceinline__ void gla_item(Frame& F, int item, const int cblk = -1) {
    const int bh = item >> 3, sc = item & 7, b = bh >> 2, hd = bh & 3;
    const int t0 = b * SEQ + sc * 256;
    const int tid = F.tid, lane = F.lane, w = F.wave, r32 = lane & 31, h = lane >> 5;
    const bf16* Z = WSP(const bf16, WS_Z);
    const bf16* LA = WSP(const bf16, WS_LA);
    LAS unsigned char* L = F.lds;
    f32x16 S[4];
    unsigned* Sbuf = (OUT ? WSP(unsigned, WS_SIN) : WSP(unsigned, WS_U)) + (size_t)item * 16384 + (size_t)w * 2048;
    if (OUT) {
#pragma unroll
        for (int kb = 0; kb < 4; ++kb)
#pragma unroll
            for (int r = 0; r < 16; r += 2) { const unsigned pw = Sbuf[(kb * 8 + (r >> 1)) * 64 + lane]; S[kb][r] = bf_lo(pw); S[kb][r + 1] = bf_hi(pw); }
    } else {
#pragma unroll
        for (int kb = 0; kb < 4; ++kb)
#pragma unroll
            for (int r = 0; r < 16; ++r) S[kb][r] = 0.f;
    }
    float btot_run0 = 0.f, btot_run1 = 0.f;
    const int tok_n = tid >> 3, part = tid & 7;
    unsigned la2[8], kk[8], qq[8]; bf16x8 Bv[4]; u32x4 rc[4];
#define GLA_LOAD(tcx) do { \
        const size_t rb_ = ((size_t)hd * M + (tcx) + 8 * w) * 128 + 2 * lane; \
        _Pragma("unroll") for (int i = 0; i < 8; ++i) { la2[i] = *(const unsigned*)(LA + rb_ + (size_t)i * 128); kk[i] = *(const unsigned*)(Z + ZK + rb_ + (size_t)i * 128); if (OUT) qq[i] = *(const unsigned*)(Z + ZQ + rb_ + (size_t)i * 128); } \
    } while (0)
#define GLA_LOADV(tcx) do { \
        _Pragma("unroll") for (int ks = 0; ks < 4; ++ks) _Pragma("unroll") for (int j = 0; j < 8; ++j) Bv[ks][j] = (short)Z[ZV + ((size_t)hd * M + (tcx) + 16 * ks + 8 * h + j) * 256 + 32 * w + r32]; \
    } while (0)
#define GLA_LOADR(tcx) do { \
        if (OUT) { const u32x4* rp_ = (const u32x4*)(Z + ZR + ((size_t)hd * M + (tcx) + tok_n) * 256 + 32 * part); _Pragma("unroll") for (int i = 0; i < 4; ++i) rc[i] = __builtin_nontemporal_load(rp_ + i); } \
    } while (0)
    u32x4 cv_c[4], cv_b[4], cv_p2, cv_p1; float cu1[8], cu2[8];
    const bool do_conv = !OUT && cblk >= 0;
    const int cm0 = cblk * 8, cs0 = do_conv ? cm0 % SEQ : 0;
#define CONV_ISSUE(sub) do { if (do_conv) { const int cj_ = (sub) >> 1, chb_ = (sub) & 1, cc_ = 8 * lane + 512 * cj_; \
        if (chb_ == 0) { const size_t rp_ = (size_t)(cs0 > 0 ? cm0 - 2 : cm0); \
            cv_p2 = __builtin_nontemporal_load((const u32x4*)(Z + ZCC + rp_ * 1024 + cc_)); cv_p1 = __builtin_nontemporal_load((const u32x4*)(Z + ZCC + (rp_ + 1) * 1024 + cc_)); \
 } \
        _Pragma("unroll") for (int rr = 0; rr < 4; ++rr) { const size_t row_ = (size_t)(cm0 + 4 * chb_ + rr); \
            cv_c[rr] = __builtin_nontemporal_load((const u32x4*)(Z + ZCC + row_ * 1024 + cc_)); cv_b[rr] = __builtin_nontemporal_load((const u32x4*)(Z + ZCB + row_ * 1024 + cc_)); } } } while (0)
#define CONV_FINISH(sub) do { if (do_conv) { const int cj_ = (sub) >> 1, chb_ = (sub) & 1, cc_ = 8 * lane + 512 * cj_; float cw0[8], cw1[8], cw2[8]; \
        { const LAS f32x4* wp_ = (const LAS f32x4*)(L + L_WC + 4 * cc_); _Pragma("unroll") for (int i = 0; i < 2; ++i) { const f32x4 t0_ = wp_[i], t1_ = wp_[256 + i], t2_ = wp_[512 + i]; \
            _Pragma("unroll") for (int q = 0; q < 4; ++q) { cw0[4 * i + q] = t0_[q]; cw1[4 * i + q] = t1_[q]; cw2[4 * i + q] = t2_[q]; } } } \
        if (chb_ == 0) { const float keep_ = cs0 > 0 ? 1.0f : 0.0f; \
            _Pragma("unroll") for (int i = 0; i < 4; ++i) { cu2[2 * i] = keep_ * bf_lo(cv_p2[i]); cu2[2 * i + 1] = keep_ * bf_hi(cv_p2[i]); cu1[2 * i] = keep_ * bf_lo(cv_p1[i]); cu1[2 * i + 1] = keep_ * bf_hi(cv_p1[i]); } } \
        _Pragma("unroll") for (int rr = 0; rr < 4; ++rr) { float u0_[8], y_[8]; \
            _Pragma("unroll") for (int i = 0; i < 4; ++i) { u0_[2 * i] = bf_lo(cv_c[rr][i]); u0_[2 * i + 1] = bf_hi(cv_c[rr][i]); } \
            _Pragma("unroll") for (int i = 0; i < 8; ++i) y_[i] = cw0[i] * cu2[i] + cw1[i] * cu1[i] + cw2[i] * u0_[i]; \
            u32x4 ow_; _Pragma("unroll") for (int i = 0; i < 4; ++i) ow_[i] = pk2(bf_lo(cv_b[rr][i]) * y_[2 * i], bf_hi(cv_b[rr][i]) * y_[2 * i + 1]); \
            *(u32x4*)(WSP(bf16, WS_PB) + (size_t)(cm0 + 4 * chb_ + rr) * 1024 + cc_) = ow_; \
            _Pragma("unroll") for (int i = 0; i < 8; ++i) { cu2[i] = cu1[i]; cu1[i] = u0_[i]; } } } } while (0)
    if (OUT) { if (tid < 256) ((LAS float*)(L + L_GG))[tid] = F.g_gla[hd * 256 + tid]; }
    else if (do_conv) {
#pragma unroll
        for (int i = 0; i < 6; ++i) ((LAS float*)(L + L_WC))[tid + 512 * i] = F.w_conv[tid + 512 * i]; }
    GLA_LOAD(t0); GLA_LOADV(t0);
#pragma unroll 1
    for (int c = 0; c < 4; ++c) {
        const int tc = t0 + c * 64;
        float p0[8], p1[8];
        { float r0 = 0.f, r1 = 0.f;
#pragma unroll
          for (int i = 0; i < 8; ++i) { r0 += bf_lo(la2[i]); r1 += bf_hi(la2[i]); p0[i] = r0; p1[i] = r1; }
          *(LAS f32x2*)(L + L_SEG + (w * 128 + 2 * lane) * 4) = (f32x2){r0, r1}; }
        GLA_LOADR(tc);
        CONV_ISSUE(c);
        __syncthreads();
        float off0 = 0.f, off1 = 0.f, bt0 = 0.f, bt1 = 0.f;
#pragma unroll
        for (int sgi = 0; sgi < 8; ++sgi) { const f32x2 sv = *(const LAS f32x2*)(L + L_SEG + (sgi * 128 + 2 * lane) * 4); if (sgi < w) { off0 += sv.x; off1 += sv.y; } bt0 += sv.x; bt1 += sv.y; }
        if (w == 0) { *(LAS f32x2*)(L + L_DEC + 8 * lane) = (f32x2){__expf(bt0), __expf(bt1)}; btot_run0 += bt0; btot_run1 += bt1; }
        {
            unsigned kt0[4], kt1[4];
#pragma unroll
            for (int i = 0; i < 8; i += 2) {
                const float b00 = off0 + p0[i], b01 = off1 + p1[i], b10 = off0 + p0[i + 1], b11 = off1 + p1[i + 1];
                const float k00 = bf_lo(kk[i]), k01 = bf_hi(kk[i]), k10 = bf_lo(kk[i + 1]), k11 = bf_hi(kk[i + 1]);
                kt0[i >> 1] = pk2(k00 * __expf(bt0 - b00), k10 * __expf(bt0 - b10));
                kt1[i >> 1] = pk2(k01 * __expf(bt1 - b01), k11 * __expf(bt1 - b11));
                if (OUT) {
                    const float q00 = bf_lo(qq[i]), q01 = bf_hi(qq[i]), q10 = bf_lo(qq[i + 1]), q11 = bf_hi(qq[i + 1]);
                    *(LAS unsigned*)(L + L_QD + (8 * w + i) * QD_STRIDE + 4 * lane) = pk2(q00 * __expf(b00), q01 * __expf(b01));
                    *(LAS unsigned*)(L + L_QD + (8 * w + i + 1) * QD_STRIDE + 4 * lane) = pk2(q10 * __expf(b10), q11 * __expf(b11));
                    *(LAS unsigned*)(L + L_KI + (8 * w + i) * QD_STRIDE + 4 * lane) = pk2(k00 * __expf(-b00), k01 * __expf(-b01));
                    *(LAS unsigned*)(L + L_KI + (8 * w + i + 1) * QD_STRIDE + 4 * lane) = pk2(k10 * __expf(-b10), k11 * __expf(-b11));
                }
            }
            *(LAS u32x4*)(L + L_KT + (2 * lane) * KT_STRIDE + 16 * w) = (u32x4){kt0[0], kt0[1], kt0[2], kt0[3]};
            *(LAS u32x4*)(L + L_KT + (2 * lane + 1) * KT_STRIDE + 16 * w) = (u32x4){kt1[0], kt1[1], kt1[2], kt1[3]};
        }
        __syncthreads();
        if (c < 3) GLA_LOAD(tc + 64);
        f32x16 o[2];
        if (OUT) {
            if (w < 3) {
                const int ib = w == 0 ? 0 : 1, jb = w == 2 ? 1 : 0;
                f32x16 sacc;
#pragma unroll
                for (int r = 0; r < 16; ++r) sacc[r] = 0.f;
#pragma unroll
                for (int kb = 0; kb < 8; ++kb) {
                    const bf16x8 a = *(const LAS bf16x8*)(L + L_QD + (32 * ib + r32) * QD_STRIDE + 2 * (16 * kb + 8 * h));
                    const bf16x8 bb = *(const LAS bf16x8*)(L + L_KI + (32 * jb + r32) * QD_STRIDE + 2 * (16 * kb + 8 * h));
                    sacc = __builtin_amdgcn_mfma_f32_32x32x16_bf16(a, bb, sacc, 0, 0, 0);
                }
#pragma unroll
                for (int r = 0; r < 16; r += 1) {
                    const int i = 32 * ib + crow(r, h), j = 32 * jb + r32;
                    const float v = (j <= i) ? sacc[r] : 0.f;
                    *(LAS bf16*)(L + L_SC + i * SC_STRIDE + 2 * j) = (bf16)(pk2(v, 0.f) & 0xffffu);
                }
            }
#pragma unroll
            for (int ib = 0; ib < 2; ++ib)
#pragma unroll
                for (int r = 0; r < 16; ++r) o[ib][r] = 0.f;
#pragma unroll
            for (int kb = 0; kb < 4; ++kb)
#pragma unroll
                for (int s2 = 0; s2 < 2; ++s2) {
                    u32x4 pb; pb.x = pk2(S[kb][8 * s2 + 0], S[kb][8 * s2 + 1]); pb.y = pk2(S[kb][8 * s2 + 2], S[kb][8 * s2 + 3]); pb.z = pk2(S[kb][8 * s2 + 4], S[kb][8 * s2 + 5]); pb.w = pk2(S[kb][8 * s2 + 6], S[kb][8 * s2 + 7]);
                    const bf16x8 bfrag = __builtin_bit_cast(bf16x8, pb);
#pragma unroll
                    for (int ib = 0; ib < 2; ++ib) {
                        const LAS unsigned char* qp = L + L_QD + (32 * ib + r32) * QD_STRIDE + 2 * (32 * kb + 16 * s2 + 4 * h);
                        const u32x2 lo = *(const LAS u32x2*)qp, hi = *(const LAS u32x2*)(qp + 16);
                        const bf16x8 afrag = __builtin_bit_cast(bf16x8, (u32x4){lo.x, lo.y, hi.x, hi.y});
                        o[ib] = __builtin_amdgcn_mfma_f32_32x32x16_bf16(afrag, bfrag, o[ib], 0, 0, 0);
                    }
                }
            __syncthreads();
#pragma unroll
            for (int ks = 0; ks < 4; ++ks)
#pragma unroll
                for (int ib = 0; ib < 2; ++ib) {
                    if (ib == 0 && ks >= 2) continue;
                    const bf16x8 a = *(const LAS bf16x8*)(L + L_SC + (32 * ib + r32) * SC_STRIDE + 2 * (16 * ks + 8 * h));
                    o[ib] = __builtin_amdgcn_mfma_f32_32x32x16_bf16(a, Bv[ks], o[ib], 0, 0, 0);
                }
        }
#pragma unroll
        for (int kb = 0; kb < 4; ++kb) {
#pragma unroll
            for (int g4 = 0; g4 < 4; ++g4) { const f32x4 dc = *(const LAS f32x4*)(L + L_DEC + 4 * (32 * kb + 8 * g4 + 4 * h));
#pragma unroll
                for (int j = 0; j < 4; ++j) S[kb][4 * g4 + j] *= dc[j]; }
#pragma unroll
            for (int ks = 0; ks < 4; ++ks) {
                const bf16x8 a = *(const LAS bf16x8*)(L + L_KT + (32 * kb + r32) * KT_STRIDE + 2 * (16 * ks + 8 * h));
                S[kb] = __builtin_amdgcn_mfma_f32_32x32x16_bf16(a, Bv[ks], S[kb], 0, 0, 0);
            }
        }
        if (c < 3) GLA_LOADV(tc + 64);
        CONV_FINISH(c);
        if (OUT) {
#pragma unroll
            for (int ib = 0; ib < 2; ++ib)
#pragma unroll
                for (int r = 0; r < 16; ++r) *(LAS float*)(L + L_OT + (32 * ib + crow(r, h)) * OT_STRIDE + 4 * (32 * w + r32)) = o[ib][r];
            __syncthreads();
            f32x4 ov[8]; float ss = 0.f;
#pragma unroll
            for (int i = 0; i < 8; ++i) { ov[i] = *(const LAS f32x4*)(L + L_OT + tok_n * OT_STRIDE + 4 * (32 * part + 4 * i)); ss += (ov[i].x * ov[i].x + ov[i].y * ov[i].y) + (ov[i].z * ov[i].z + ov[i].w * ov[i].w); }
            ss += __shfl_xor(ss, 1); ss += __shfl_xor(ss, 2); ss += __shfl_xor(ss, 4);
            const float rs = 1.0f / sqrtf(ss * (1.0f / 256.0f) + 1e-6f);
            const size_t trow = (size_t)(tc + tok_n);
            const LAS f32x4* gp = (const LAS f32x4*)(L + L_GG + 4 * (32 * part));
            u32x4* op = (u32x4*)(WSP(bf16, WS_OG) + trow * 1024 + hd * 256 + 32 * part);
#pragma unroll
            for (int i = 0; i < 4; ++i) {
                const u32x4 rr = rc[i]; const f32x4 g0 = gp[2 * i], g1 = gp[2 * i + 1]; const f32x4 a0 = ov[2 * i], a1 = ov[2 * i + 1];
                u32x4 ow;
                ow.x = pk2(a0.x * rs * g0.x * bf_lo(rr.x), a0.y * rs * g0.y * bf_hi(rr.x));
                ow.y = pk2(a0.z * rs * g0.z * bf_lo(rr.y), a0.w * rs * g0.w * bf_hi(rr.y));
                ow.z = pk2(a1.x * rs * g1.x * bf_lo(rr.z), a1.y * rs * g1.y * bf_hi(rr.z));
                ow.w = pk2(a1.z * rs * g1.z * bf_lo(rr.w), a1.w * rs * g1.w * bf_hi(rr.w));
                op[i] = ow;
            }
        }
    }
#undef GLA_LOAD
#undef GLA_LOADV
#undef GLA_LOADR
#undef CONV_ISSUE
#undef CONV_FINISH
    if (!OUT) {
#pragma unroll
        for (int kb = 0; kb < 4; ++kb)
#pragma unroll
            for (int r = 0; r < 16; r += 2) Sbuf[(kb * 8 + (r >> 1)) * 64 + lane] = pk2(S[kb][r], S[kb][r + 1]);
        if (w == 0) *(f32x2*)(WSP(float, WS_DECS) + item * 128 + 2 * lane) = (f32x2){__expf(btot_run0), __expf(btot_run1)};
    }
    __syncthreads();
}

__device__ __forceinline__ void conv_rows(Frame& F, const int nrep, const int first_skip) {
    const int gw = F.vcu * NWAVES + F.wave, NGW = F.G * NWAVES;
    const bf16* Z = WSP(const bf16, WS_Z); bf16* PB = WSP(bf16, WS_PB);
    for (int blk0 = gw + first_skip * NGW; blk0 < (M / 8) * nrep; blk0 += NGW) {
        const int blk = blk0 % (M / 8);
        const int m0 = blk * 8, s0 = m0 % SEQ;
#pragma unroll 1
        for (int j = 0; j < 2; ++j) {
            const int c = 8 * F.lane + 512 * j;
            const size_t rp = (size_t)(s0 > 0 ? m0 - 2 : m0);
            const u32x4 p2c = *(const u32x4*)(Z + ZCC + rp * 1024 + c);
            const u32x4 p1c = *(const u32x4*)(Z + ZCC + (rp + 1) * 1024 + c);
            float w0[8], w1[8], w2[8];
#pragma unroll
            for (int i = 0; i < 8; ++i) { w0[i] = F.w_conv[c + i]; w1[i] = F.w_conv[1024 + c + i]; w2[i] = F.w_conv[2048 + c + i]; }
            float u1[8], u2[8];
            const float keep = s0 > 0 ? 1.0f : 0.0f;
#pragma unroll
            for (int i = 0; i < 4; ++i) { u2[2 * i] = keep * bf_lo(p2c[i]); u2[2 * i + 1] = keep * bf_hi(p2c[i]); u1[2 * i] = keep * bf_lo(p1c[i]); u1[2 * i + 1] = keep * bf_hi(p1c[i]); }
#pragma unroll
            for (int hb = 0; hb < 2; ++hb) {
                u32x4 cc[4], cb[4];
#pragma unroll
                for (int rr = 0; rr < 4; ++rr) { const size_t row = (size_t)(m0 + 4 * hb + rr); cc[rr] = __builtin_nontemporal_load((const u32x4*)(Z + ZCC + row * 1024 + c)); cb[rr] = __builtin_nontemporal_load((const u32x4*)(Z + ZCB + row * 1024 + c)); }
#pragma unroll
                for (int rr = 0; rr < 4; ++rr) {
                    float u0[8], y[8];
#pragma unroll
                    for (int i = 0; i < 4; ++i) { u0[2 * i] = bf_lo(cc[rr][i]); u0[2 * i + 1] = bf_hi(cc[rr][i]); }
#pragma unroll
                    for (int i = 0; i < 8; ++i) y[i] = w0[i] * u2[i] + w1[i] * u1[i] + w2[i] * u0[i];
                    u32x4 ow;
#pragma unroll
                    for (int i = 0; i < 4; ++i) ow[i] = pk2(bf_lo(cb[rr][i]) * y[2 * i], bf_hi(cb[rr][i]) * y[2 * i + 1]);
                    *(u32x4*)(PB + (size_t)(m0 + 4 * hb + rr) * 1024 + c) = ow;
#pragma unroll
                    for (int i = 0; i < 8; ++i) { u2[i] = u1[i]; u1[i] = u0[i]; }
                }
                asm volatile("" ::: "memory");
            }
        }
    }
}

__device__ __forceinline__ void gla_scan(Frame& F, const int nrep) {
    const unsigned* U = WSP(const unsigned, WS_U); unsigned* SIN = WSP(unsigned, WS_SIN); const float* DECS = WSP(const float, WS_DECS);
    const int gt = F.vcu * 512 + F.tid, NT = F.G * 512;
    for (int idx0 = gt; idx0 < 32 * 16384 * nrep; idx0 += NT) {
        const int idx = idx0 & (32 * 16384 - 1);
        const int bh = idx >> 14, e = idx & 16383;
        const int ln = e & 63, rp = (e >> 6) & 7, kb = (e >> 9) & 3;
        const int dk = 32 * kb + crow(2 * rp, ln >> 5);
        float s0 = 0.f, s1 = 0.f;
        unsigned uw[8];
#pragma unroll
        for (int sc = 0; sc < 8; ++sc) uw[sc] = U[(size_t)(bh * 8 + sc) * 16384 + e];
#pragma unroll
        for (int sc = 0; sc < 8; ++sc) {
            const int item = bh * 8 + sc;
            SIN[(size_t)item * 16384 + e] = pk2(s0, s1);
            const f32x2 dc = *(const f32x2*)(DECS + item * 128 + dk);
            s0 = dc.x * s0 + bf_lo(uw[sc]); s1 = dc.y * s1 + bf_hi(uw[sc]);
        }
    }
}

struct P3Order : pg8::StaticOrder {
    __device__ __forceinline__ bool next(int i, pg8::Unit& u) const {
        if (!pg8::StaticOrder::next(i >> 1, u)) return false;
        u.e = i & 1; u.pn += 4 * u.e; return true;
    }
    __device__ __forceinline__ unsigned arow(const pg8::Unit& u, int ui, int r) const { return (unsigned)(u.e * M + u.pm * 256 + r) * 2048u; }
    __device__ __forceinline__ void after_unit(int ui) const {}
    __device__ __forceinline__ bool keep_acc(int ui) const { return (ui & 1) == 0; }
};
struct EpiBranch {
    static constexpr bool PERM = true;
    const bf16* Z; bf16* MIX;
    __device__ __forceinline__ void operator()(f32x4 (&acc)[2][2][4][2], const pg8::Unit& u, int wr, int wc, int fr, int fq) const {
        const int row0 = u.pm * 256 + wr * 64 + fr, col0 = (u.pn & 3) * 256 + wc * 32 + 8 * fq;
#pragma unroll
        for (int ai = 0; ai < 2; ++ai)
#pragma unroll
            for (int m = 0; m < 4; ++m) { const size_t row = (size_t)(row0 + ai * 128 + m * 16);
#pragma unroll
                for (int bj = 0; bj < 2; ++bj) {
                    const u32x2 gb = __builtin_nontemporal_load((const u32x2*)((const unsigned char*)(Z + ZGB) + row * 1024 + col0 + bj * 128));
                    float sb[8];
#pragma unroll
                    for (int j = 0; j < 4; ++j) { sb[j] = (float)((gb.x >> (8 * j)) & 255u); sb[4 + j] = (float)((gb.y >> (8 * j)) & 255u); }
#pragma unroll
                    for (int j = 0; j < 8; ++j) sb[j] = fmaxf(sb[j], 1.0f) * (1.0f / 255.0f);
                    if (u.e == 0) {
                        const u32x2 ga = __builtin_nontemporal_load((const u32x2*)((const unsigned char*)(Z + ZGA) + row * 1024 + col0 + bj * 128));
                        float sa[8];
#pragma unroll
                        for (int j = 0; j < 4; ++j) { sa[j] = (float)((ga.x >> (8 * j)) & 255u) * (1.0f / 255.0f); sa[4 + j] = (float)((ga.y >> (8 * j)) & 255u) * (1.0f / 255.0f); }
#pragma unroll
                        for (int j = 0; j < 4; ++j) { acc[ai][bj][m][0][j] *= sa[j] * __builtin_amdgcn_rcpf(sb[j]); acc[ai][bj][m][1][j] *= sa[4 + j] * __builtin_amdgcn_rcpf(sb[4 + j]); }
                    } else {
                        const f32x4 v0 = acc[ai][bj][m][0], v1 = acc[ai][bj][m][1];
                        u32x4 w; w.x = pk2(v0[0] * sb[0], v0[1] * sb[1]); w.y = pk2(v0[2] * sb[2], v0[3] * sb[3]); w.z = pk2(v1[0] * sb[4], v1[1] * sb[5]); w.w = pk2(v1[2] * sb[6], v1[3] * sb[7]);
                        *(u32x4*)(MIX + row * 1024 + col0 + bj * 128) = w; }
                } }
    }
};
struct EpiX1 {
    static constexpr bool PERM = true;
    const float* x; bf16* X1;
    __device__ __forceinline__ void operator()(const f32x4 (&acc)[2][2][4][2], const pg8::Unit& u, int wr, int wc, int fr, int fq) const {
        const int row0 = u.pm * 256 + wr * 64 + fr, col0 = u.pn * 256 + wc * 32 + 8 * fq;
#pragma unroll
        for (int ai = 0; ai < 2; ++ai)
#pragma unroll
            for (int m = 0; m < 4; ++m) { const size_t off = (size_t)(row0 + ai * 128 + m * 16) * 1024 + col0;
#pragma unroll
                for (int bj = 0; bj < 2; ++bj) { const f32x4 x0 = __builtin_nontemporal_load((const f32x4*)(x + off + bj * 128)), x1 = __builtin_nontemporal_load((const f32x4*)(x + off + bj * 128 + 4));
                    const f32x4 v0 = x0 + acc[ai][bj][m][0], v1 = x1 + acc[ai][bj][m][1];
                    u32x4 w; w.x = pk2(v0[0], v0[1]); w.y = pk2(v0[2], v0[3]); w.z = pk2(v1[0], v1[1]); w.w = pk2(v1[2], v1[3]);
                    *(u32x4*)(X1 + off + bj * 128) = w; } }
    }
};

constexpr int P5_WLD = 2064;
constexpr int P5_WH = 0, P5_WL = 32 * P5_WLD;
constexpr int P5_RSTD = 133120, P5_LOGT = 133376;
constexpr int P5_HIST = 141824, P5_BASE = P5_HIST + 128, P5_PLE = P5_HIST + 256;
__device__ __forceinline__ void p5_router(Frame& F) {
    LAS unsigned char* L = F.lds;
    LAS float* RSTD = (LAS float*)(L + P5_RSTD); LAS float* LOGT = (LAS float*)(L + P5_LOGT);
    LAS int* hist = (LAS int*)(L + P5_HIST); LAS int* base = (LAS int*)(L + P5_BASE); LAS int* ple = (LAS int*)(L + P5_PLE);
    const bf16* X1 = WSP(const bf16, WS_X1); unsigned char* H2 = WSP(unsigned char, WS_XN);
    unsigned* cnt = F.ctl + CW_CNT; int* list = WSP(int, WS_LIST); float* gate = WSP(float, WS_GATE);
    const int lane = F.lane, w = F.wave, r32 = lane & 31, h = lane >> 5;
    f32x4 g[4];
#pragma unroll
    for (int j = 0; j < 4; ++j) g[j] = *((const f32x4*)F.g_ffn + lane + 64 * j);
    for (int grp = F.vcu; grp < M / 64; grp += F.G) {
        for (int i = 0; i < 64; ++i) { const int idx = F.tid + 512 * i, k = idx >> 5, e = idx & 31; const float wv = F.w_router[idx] * F.g_ffn[k];
            const unsigned hi = pk2(wv, 0.f) & 0xffffu; const float rem = wv - __builtin_bit_cast(float, hi << 16);
            *(LAS bf16*)(L + P5_WH + e * P5_WLD + 2 * k) = (bf16)hi; *(LAS bf16*)(L + P5_WL + e * P5_WLD + 2 * k) = (bf16)(pk2(rem, 0.f) & 0xffffu); }
        if (F.tid < 32) hist[F.tid] = 0;
        const size_t tok0 = (size_t)grp * 64;
        { u32x2 xv[8][4];
#pragma unroll
          for (int i = 0; i < 8; ++i) { const u32x2* xa = (const u32x2*)(X1 + (tok0 + 8 * w + i) * D) + lane;
#pragma unroll
              for (int j = 0; j < 4; ++j) xv[i][j] = xa[64 * j]; }
#pragma unroll
          for (int i = 0; i < 8; ++i) { f32x4 v[4]; float ss = 0.f;
#pragma unroll
              for (int j = 0; j < 4; ++j) { v[j] = (f32x4){bf_lo(xv[i][j].x), bf_hi(xv[i][j].x), bf_lo(xv[i][j].y), bf_hi(xv[i][j].y)};
#pragma unroll
                  for (int c = 0; c < 4; ++c) ss = fmaf(v[j][c], v[j][c], ss); }
              const float rs = 1.0f / sqrtf(wave_sum(ss) * (1.f / D) + 1e-6f);
              if (lane == 0) RSTD[8 * w + i] = rs;
              unsigned* o4 = (unsigned*)(H2 + (tok0 + 8 * w + i) * D) + lane;
#pragma unroll
              for (int j = 0; j < 4; ++j) { const f32x4 hv = v[j] * rs * g[j]; o4[64 * j] = pk4_fp8(hv.x, hv.y, hv.z, hv.w); } } }
        bf16x8 af[2][8];
        { const bf16* xa = X1 + (tok0 + r32) * D + 128 * w + 8 * h;
#pragma unroll
          for (int mt = 0; mt < 2; ++mt)
#pragma unroll
              for (int ks = 0; ks < 8; ++ks) af[mt][ks] = *(const bf16x8*)(xa + (size_t)mt * 32 * D + 16 * ks); }
        __syncthreads();
        f32x16 acc[2];
#pragma unroll
        for (int mt = 0; mt < 2; ++mt)
#pragma unroll
            for (int r = 0; r < 16; ++r) acc[mt][r] = 0.f;
#pragma unroll
        for (int ks = 0; ks < 8; ++ks) {
            const bf16x8 bh = *(const LAS bf16x8*)(L + P5_WH + r32 * P5_WLD + 2 * (128 * w + 16 * ks + 8 * h));
            const bf16x8 bl = *(const LAS bf16x8*)(L + P5_WL + r32 * P5_WLD + 2 * (128 * w + 16 * ks + 8 * h));
#pragma unroll
            for (int mt = 0; mt < 2; ++mt) { acc[mt] = __builtin_amdgcn_mfma_f32_32x32x16_bf16(af[mt][ks], bh, acc[mt], 0, 0, 0); acc[mt] = __builtin_amdgcn_mfma_f32_32x32x16_bf16(af[mt][ks], bl, acc[mt], 0, 0, 0); }
        }
        __syncthreads();
#pragma unroll
        for (int mt = 0; mt < 2; ++mt)
#pragma unroll
            for (int r = 0; r < 16; ++r) *(LAS float*)(L + ((w * 64 + 32 * mt + crow(r, h)) * 32 + r32) * 4) = acc[mt][r];
        __syncthreads();
        { const int tk = F.tid >> 3, eq = F.tid & 7;
          f32x4 sum = *(const LAS f32x4*)(L + ((0 * 64 + tk) * 32 + 4 * eq) * 4);
#pragma unroll
          for (int ww = 1; ww < 8; ++ww) sum = sum + *(const LAS f32x4*)(L + ((ww * 64 + tk) * 32 + 4 * eq) * 4);
          const float rs = RSTD[tk]; const f32x4 bb = *(const f32x4*)(F.b_router + 4 * eq);
#pragma unroll
          for (int c = 0; c < 4; ++c) LOGT[tk * 33 + 4 * eq + c] = sum[c] * rs + bb[c]; }
        __syncthreads();
        if (F.tid < 64) {
            const int tk = F.tid; float tv[4]; int ti[4];
#pragma unroll
            for (int k = 0; k < 4; ++k) { float bv = -3.0e38f; int bi = 0;
                for (int e = 0; e < 32; ++e) { const float v = LOGT[tk * 33 + e]; if (v > bv) { bv = v; bi = e; } }
                tv[k] = bv; ti[k] = bi; LOGT[tk * 33 + bi] = -3.0e38f; }
            const float e1 = __expf(tv[1] - tv[0]), e2 = __expf(tv[2] - tv[0]), e3 = __expf(tv[3] - tv[0]);
            const float inv = 1.0f / (1.0f + e1 + e2 + e3);
            const float gk[4] = {inv, e1 * inv, e2 * inv, e3 * inv};
#pragma unroll
            for (int k = 0; k < 4; ++k) { const int lr = __hip_atomic_fetch_add(&hist[ti[k]], 1, __ATOMIC_RELAXED, __HIP_MEMORY_SCOPE_WORKGROUP);
                ple[tk * 4 + k] = ti[k] | (lr << 8); gate[(tok0 + tk) * 4 + k] = gk[k]; }
        }
        __syncthreads();
        if (F.tid < 32) base[F.tid] = (int)__hip_atomic_fetch_add(cnt + F.tid, (unsigned)hist[F.tid], RLX_AGENT);
        __syncthreads();
        if (F.tid < 256) { const int pe = ple[F.tid], e = pe & 255, lr = pe >> 8; list[e * CAP + base[e] + lr] = (grp * 64) * 4 + F.tid; }
        __syncthreads();
    }
}

#ifndef MK_MAXU
#define MK_MAXU 12
#endif
constexpr int MAXU = MK_MAXU;
template <int NP>
struct MoeOrder {
    LAS const int* rt0;
    LAS const int* tokl;
    LAS const i32x4* ut;
    int nwg, G, c, reps, nun;
    __device__ __forceinline__ bool next(int i, pg8::Unit& u) const {
        if (i >= nun) return false;
        const i32x4 t = ut[i];
        u.pm = __builtin_amdgcn_readfirstlane(t.x); u.pn = __builtin_amdgcn_readfirstlane(t.y); u.e = __builtin_amdgcn_readfirstlane(t.z); u.rt = __builtin_amdgcn_readfirstlane(t.w); u.ui = i; return true;
    }
    __device__ __forceinline__ bool compute(int i, pg8::Unit& u) const {
        const long L = (long)i * G + c; if (L >= (long)nwg * reps) return false;
        int wgid = (int)(L % nwg); { const int q = nwg / 8, r = nwg % 8, xcd = wgid % 8, off = wgid / 8; wgid = (xcd < r ? xcd * (q + 1) : r * (q + 1) + (xcd - r) * q) + off; }
        int e = 0;
#pragma unroll
        for (int q = 0; q < 8; ++q) { const i32x4 r4 = *(const LAS i32x4*)(rt0 + 4 * q);
#pragma unroll
            for (int t = 0; t < 4; ++t) if (4 * q + t >= 1) e += (wgid >= NP * r4[t]) ? 1 : 0; }
        const int l = wgid - NP * rt0[e], nte = rt0[e + 1] - rt0[e];
        const int pn = l / nte, rt = l - pn * nte;
        u.pm = __builtin_amdgcn_readfirstlane(rt0[e] + rt); u.pn = __builtin_amdgcn_readfirstlane(e * NP + pn); u.e = __builtin_amdgcn_readfirstlane(e); u.rt = __builtin_amdgcn_readfirstlane(rt); u.ui = i; return true;
    }
};
struct MoeOrder1 : MoeOrder<8> {
    __device__ __forceinline__ void after_unit(int ui) const {}
    __device__ __forceinline__ bool keep_acc(int ui) const { return false; }
    __device__ __forceinline__ unsigned arow(const pg8::Unit& u, int ui, int r) const { return (unsigned)tokl[ui * 256 + r] * 1024u; }
};
struct MoeOrder2 : MoeOrder<4> {
    __device__ __forceinline__ void after_unit(int ui) const {}
    __device__ __forceinline__ bool keep_acc(int ui) const { return false; }
    __device__ __forceinline__ unsigned arow(const pg8::Unit& u, int ui, int r) const { return (unsigned)(u.pm * 256 + r) * 1024u; }
};
struct EpiAct {
    static constexpr bool PERM = true;
    const float* b_gu; unsigned char* ACT;
    __device__ __forceinline__ void operator()(const f32x4 (&acc)[2][2][4][2], const pg8::Unit& u, int wr, int wc, int fr, int fq) const {
        const int pn = u.pn & 7, cl = pn * 128 + wc * 32 + 8 * fq;
        const int row0 = u.pm * 256 + wr * 64 + fr;
        const f32x4 bg0 = *(const f32x4*)(b_gu + u.e * 2048 + cl), bg1 = *(const f32x4*)(b_gu + u.e * 2048 + cl + 4);
        const f32x4 bl0 = *(const f32x4*)(b_gu + u.e * 2048 + 1024 + cl), bl1 = *(const f32x4*)(b_gu + u.e * 2048 + 1024 + cl + 4);
#pragma unroll
        for (int ai = 0; ai < 2; ++ai)
#pragma unroll
            for (int m = 0; m < 4; ++m) {
                f32x4 g0 = acc[ai][0][m][0] + bg0, g1 = acc[ai][0][m][1] + bg1, l0 = acc[ai][1][m][0] + bl0, l1 = acc[ai][1][m][1] + bl1;
                float r0[4], r1[4];
#pragma unroll
                for (int j = 0; j < 4; ++j) {
                    const float ga = fminf(g0[j], 7.0f), gb = fminf(g1[j], 7.0f);
                    const float la = fminf(fmaxf(l0[j], -7.0f), 7.0f), lb = fminf(fmaxf(l1[j], -7.0f), 7.0f);
                    r0[j] = (la + 1.0f) * (ga * fast_sigmoid(1.702f * ga)); r1[j] = (lb + 1.0f) * (gb * fast_sigmoid(1.702f * gb));
                }
                u32x2 w; w.x = pk4_fp8(r0[0], r0[1], r0[2], r0[3]); w.y = pk4_fp8(r1[0], r1[1], r1[2], r1[3]);
                *(u32x2*)(ACT + (size_t)(row0 + ai * 128 + m * 16) * 1024 + cl) = w;
            }
    }
};
constexpr int MAXU2 = 8;
struct EpiYP {
    static constexpr bool PERM = true;
    const float* b_d; LAS const int* pidl; LAS const float* gatel; unsigned char* YP;
    __device__ __forceinline__ void operator()(const f32x4 (&acc)[2][2][4][2], const pg8::Unit& u, int wr, int wc, int fr, int fq) const {
        const int pn = u.pn & 3, col0 = pn * 256 + wc * 32 + 8 * fq;
        f32x4 bv[2][2];
#pragma unroll
        for (int bj = 0; bj < 2; ++bj)
#pragma unroll
            for (int n = 0; n < 2; ++n) bv[bj][n] = *(const f32x4*)(b_d + u.e * 1024 + col0 + bj * 128 + 4 * n);
#pragma unroll
        for (int ai = 0; ai < 2; ++ai)
#pragma unroll
            for (int m = 0; m < 4; ++m) {
                const int rl = ai * 128 + wr * 64 + m * 16 + fr;
                const int pid = pidl[u.ui * 256 + rl];
                if (pid >= 0) {
                    const float gw = gatel[u.ui * 256 + rl];
#pragma unroll
                    for (int bj = 0; bj < 2; ++bj) { const f32x4 v0 = (acc[ai][bj][m][0] + bv[bj][0]) * gw, v1 = (acc[ai][bj][m][1] + bv[bj][1]) * gw;
                        u32x2 w; w.x = pk4_fp8(v0[0], v0[1], v0[2], v0[3]); w.y = pk4_fp8(v1[0], v1[1], v1[2], v1[3]);
                        *(u32x2*)(YP + (size_t)pid * 1024 + col0 + bj * 128) = w; }
                }
            }
    }
};
__device__ __forceinline__ int moe_setup(Frame& F, LAS int* rt0) {
    if (F.tid < 64) {
        const int e = F.lane & 31; int v = ((int)F.ctl[CW_CNT + e] + 255) >> 8, incl = v;
#pragma unroll
        for (int o = 1; o < 32; o <<= 1) { const int t = __shfl_up(incl, o, 32); if (e >= o) incl += t; }
        if (F.lane < 32) { rt0[e] = incl - v; if (e == 31) rt0[32] = incl; }
    }
    __syncthreads();
    return rt0[32];
}

__device__ __forceinline__ void p8_final(Frame& F, const int nrep) {
    const int gw = F.vcu * NWAVES + F.wave, NGW = F.G * NWAVES;
    const bf16* X1 = WSP(const bf16, WS_X1); const unsigned char* YP = WSP(const unsigned char, WS_YP);
    f32x4 g[4];
#pragma unroll
    for (int j = 0; j < 4; ++j) g[j] = *((const f32x4*)F.g_final + F.lane + 64 * j);
    float pscale = 1.0f;
#ifdef MK_TPROBE
    { const unsigned long long* st = (const unsigned long long*)(F.ctl + CW_STAMP); const float dt_us = (float)(st[MK_TPROBE_J] - st[MK_TPROBE_I]) * 0.01f; pscale = 1.0f + sqrtf(dt_us * 1e-5f); }
#endif
    for (int m0 = gw; m0 < M * nrep; m0 += NGW) {
        const int m = m0 % M;
        const u32x2* xr = (const u32x2*)(X1 + (size_t)m * D) + F.lane;
        f32x4 v[4]; float s = 0.f;
#pragma unroll
        for (int j = 0; j < 4; ++j) { const u32x2 xw = __builtin_nontemporal_load(xr + 64 * j); v[j] = (f32x4){bf_lo(xw.x), bf_hi(xw.x), bf_lo(xw.y), bf_hi(xw.y)}; }
        f32x4 ys[4];
#pragma unroll
        for (int j = 0; j < 4; ++j) ys[j] = (f32x4){0.f, 0.f, 0.f, 0.f};
#pragma unroll
        for (int k = 0; k < 4; ++k) { const unsigned* yr = (const unsigned*)(YP + ((size_t)m * 4 + k) * 1024) + F.lane;
#pragma unroll
            for (int j = 0; j < 4; ++j) { const int y = (int)__builtin_nontemporal_load(yr + 64 * j); const f32x2 lo = __builtin_amdgcn_cvt_pk_f32_fp8(y, false), hi = __builtin_amdgcn_cvt_pk_f32_fp8(y, true);
                ys[j].x += lo.x; ys[j].y += lo.y; ys[j].z += hi.x; ys[j].w += hi.y; } }
#pragma unroll
        for (int j = 0; j < 4; ++j) v[j] = v[j] + ys[j] * 0.0625f;
#pragma unroll
        for (int j = 0; j < 4; ++j) s += (v[j].x * v[j].x + v[j].y * v[j].y) + (v[j].z * v[j].z + v[j].w * v[j].w);
        const float rstd = 1.0f / sqrtf(wave_sum(s) * (1.f / D) + 1e-6f);
        f32x4* op = (f32x4*)(F.out + (size_t)m * D) + F.lane;
#pragma unroll
        for (int j = 0; j < 4; ++j) __builtin_nontemporal_store(v[j] * (rstd * pscale) * g[j], op + 64 * j);
    }
}

struct Args { const float* in[18]; float* out; unsigned char* ws; int ph_lo, ph_hi, rep_k, rep_n; };
__global__ void __launch_bounds__(NWAVES * 64, 2) mk_fwd(Args args) {
    extern __shared__ __attribute__((aligned(16))) unsigned char lds[];
    Frame F;
    F.lds = (LAS unsigned char*)lds;
    F.MISC = (volatile LAS unsigned*)(F.lds + MISC_OFF);
    F.tid = threadIdx.x; F.lane = F.tid & 63; F.wave = __builtin_amdgcn_readfirstlane(F.tid >> 6);
    F.G = gridDim.x; { const int bx = blockIdx.x; F.vcu = (F.G % 8 == 0) ? (bx % 8) * (F.G / 8) + bx / 8 : bx; }
    F.ws = args.ws; F.ctl = (unsigned*)(args.ws + WS_CTL);
    F.x = args.in[0]; F.g_mix = args.in[1]; F.w_in = args.in[2]; F.w_up = args.in[3]; F.b_alpha = args.in[4]; F.g_gla = args.in[5]; F.w_conv = args.in[6];
    F.w_a = args.in[7]; F.w_b = args.in[8]; F.w_out = args.in[9]; F.g_ffn = args.in[10]; F.w_router = args.in[11]; F.b_router = args.in[12];
    F.w_gu = args.in[13]; F.b_gu = args.in[14]; F.w_d = args.in[15]; F.b_d = args.in[16]; F.g_final = args.in[17]; F.out = args.out;
    if (F.tid < 128) ((LAS unsigned*)(F.lds + MISC_OFF))[F.tid] = 0u;
    __syncthreads();
    XcdBarrier bar; bar.bar = F.ctl + CW_BAR; bar.x = 0; bar.st = nullptr;
    if (N_LAUNCHES == 1) bar = xcd_barrier_post(F.ctl + CW_BAR, F.MISC + 8);
    const int lo = args.ph_lo, hi = args.ph_hi;
#ifdef MK_ONLY
#define IN(k) ((k) == MK_ONLY && lo <= (k) && (k) < hi)
#else
#define IN(k) (lo <= (k) && (k) < hi)
#endif
#define REPS(k) (((k) == args.rep_k) ? 1 + args.rep_n : 1)
#if defined(MK_TPROBE) || defined(MK_DELAY_K)
#define STAMP(k) do { if (blockIdx.x == 0 && F.tid == 0) ((unsigned long long*)(F.ctl + CW_STAMP))[k] = __builtin_amdgcn_s_memrealtime(); } while (0)
#else
#define STAMP(k) do { } while (0)
#endif
#ifdef MK_DELAY_K
#define DELAY(k) do { if ((k) == MK_DELAY_K) { const unsigned long long dl = __hip_atomic_load((unsigned long long*)(F.ctl + CW_STAMP), RLX_AGENT) + (unsigned long long)(MK_DELAY_US) * 100ull; \
    while (__builtin_amdgcn_s_memrealtime() < dl) __builtin_amdgcn_s_sleep(8); } } while (0)
#else
#define DELAY(k) do { } while (0)
#endif
#define SEAM(k) do { if (IN(k) && IN((k) + 1)) xcd_barrier(bar); STAMP((k) + 1); DELAY(k); } while (0)

    STAMP(0);
    if (IN(0)) { p0_prologue(F, REPS(0), REPS(11)); SEAM(0); }
    if (IN(1)) { const int nrep = REPS(1);
        P1Order S; S.init(M, NZ, D, F.G, (int)blockIdx.x, nrep); S.w_gu = F.w_gu; S.w_d = F.w_d; S.ws = F.ws; S.lds = F.lds; S.slot = ((int)blockIdx.x >> 3) & 7; S.wave = F.wave; S.lane = F.lane;
        EpiZ E{WSP(bf16, WS_Z)};
        pg8::gemm_phase<EpiZ, P1Order, true>(F.lds, WSP(const bf16, WS_XN), WSP(const bf16, WS_WIN), D, S, E);
        SEAM(1);
    }
    if (IN(2)) { const int nrep = REPS(2); const int gwc = F.vcu * NWAVES + F.wave;
        for (int it = F.vcu; it < 256 * nrep; it += F.G) gla_item<false>(F, it & 255, (it == F.vcu && gwc < M / 8) ? gwc : -1);
        conv_rows(F, REPS(12), (F.vcu < 256) ? 1 : 0); SEAM(2); }
    if (IN(3)) { gla_scan(F, REPS(3)); SEAM(3); }
    if (IN(4)) { const int nrep = REPS(4); for (int it = F.vcu; it < 256 * nrep; it += F.G) gla_item<true>(F, it & 255); SEAM(4); }
    if (IN(5)) { const int nrep = REPS(5);
        static_assert(WS_PB == WS_OG + (size_t)M * 1024 * 2 && WS_WB == WS_WA + (size_t)1024 * 1024 * 2, "P3Order addresses PB / Wb from OG / Wa");
        P3Order S; S.init(M, D, D, F.G, (int)blockIdx.x, nrep);
        EpiBranch E{WSP(const bf16, WS_Z), WSP(bf16, WS_MIX)};
        pg8::gemm_phase<EpiBranch, P3Order, true>(F.lds, WSP(const bf16, WS_OG), WSP(const bf16, WS_WA), D, S, E);
        SEAM(5);
    }
    if (IN(6)) { const int nrep = REPS(6);
        pg8::StaticOrder S; S.init(M, D, D, F.G, (int)blockIdx.x, nrep);
        EpiX1 E{F.x, WSP(bf16, WS_X1)};
        pg8::gemm_phase<EpiX1, pg8::StaticOrder, false>(F.lds, WSP(const bf16, WS_MIX), WSP(const bf16, WS_WO), D, S, E);
        SEAM(6);
    }
    if (IN(7)) { p5_router(F); SEAM(7); }
    if (IN(8)) { const int nrep = REPS(8);
        LAS int* rt0 = (LAS int*)(F.lds + EXTRA_OFF); LAS int* tokl = (LAS int*)(F.lds + EXTRA_OFF + 256);
        const int R = moe_setup(F, rt0);
        MoeOrder1 S; S.rt0 = rt0; S.tokl = tokl; S.nwg = R * 8; S.G = F.G; S.c = (int)blockIdx.x; S.reps = nrep;
        S.ut = (LAS const i32x4*)(F.lds + EXTRA_OFF + 20480); { const int nu = (S.nwg * nrep - S.c + S.G - 1) / S.G; S.nun = nu < MAXU ? nu : MAXU; }
        const int* list = WSP(const int, WS_LIST);
#pragma unroll
        for (int uo = 0; uo < 2; ++uo) { const int ui = F.wave + 8 * uo; pg8::Unit u;
            if (ui < MAXU && S.compute(ui, u)) { const int ne = (int)F.ctl[CW_CNT + u.e]; int tk[4];
                if (F.lane == 0) ((LAS i32x4*)(F.lds + EXTRA_OFF + 20480))[ui] = (i32x4){u.pm, u.pn, u.e, u.rt};
#pragma unroll
                for (int j = 0; j < 4; ++j) { const int slot = u.rt * 256 + F.lane + 64 * j; tk[j] = slot < ne ? list[u.e * CAP + slot] : 0; }
#pragma unroll
                for (int j = 0; j < 4; ++j) tokl[ui * 256 + F.lane + 64 * j] = tk[j] >> 2; } }
        __syncthreads();
        EpiAct E{F.b_gu, WSP(unsigned char, WS_ACT)};
        pg8::gemm_phase<EpiAct, MoeOrder1, true, true, 122>(F.lds, WSP(const void, WS_XN), WSP(const void, WS_WGU), D, S, E);
        SEAM(8);
    }
    if (IN(9)) { const int nrep = REPS(9);
        LAS int* rt0 = (LAS int*)(F.lds + EXTRA_OFF);
        const int R = moe_setup(F, rt0);
        MoeOrder2 S; S.rt0 = rt0; S.tokl = nullptr; S.nwg = R * 4; S.G = F.G; S.c = (int)blockIdx.x; S.reps = nrep;
        S.ut = (LAS const i32x4*)(F.lds + EXTRA_OFF + 20480); { const int nu = (S.nwg * nrep - S.c + S.G - 1) / S.G; S.nun = nu < MAXU2 ? nu : MAXU2; }
        LAS int* pidl = (LAS int*)(F.lds + EXTRA_OFF + 256); LAS float* gatel = (LAS float*)(F.lds + EXTRA_OFF + 256 + MAXU2 * 1024);
        { const int* list = WSP(const int, WS_LIST); const float* gate = WSP(const float, WS_GATE);
          const int ui = F.wave; pg8::Unit u;
          if (ui < MAXU2 && S.compute(ui, u)) { const int ne = (int)F.ctl[CW_CNT + u.e]; int pd[4]; float gv[4];
              if (F.lane == 0) ((LAS i32x4*)(F.lds + EXTRA_OFF + 20480))[ui] = (i32x4){u.pm, u.pn, u.e, u.rt};
#pragma unroll
              for (int j = 0; j < 4; ++j) { const int slot = u.rt * 256 + F.lane + 64 * j; pd[j] = slot < ne ? list[u.e * CAP + slot] : -1; }
#pragma unroll
              for (int j = 0; j < 4; ++j) gv[j] = pd[j] >= 0 ? gate[pd[j]] * 16.0f : 0.f;
#pragma unroll
              for (int j = 0; j < 4; ++j) { pidl[ui * 256 + F.lane + 64 * j] = pd[j]; gatel[ui * 256 + F.lane + 64 * j] = gv[j]; } } }
        __syncthreads();
        EpiYP E{F.b_d, pidl, gatel, WSP(unsigned char, WS_YP)};
        pg8::gemm_phase<EpiYP, MoeOrder2, true, true, 122>(F.lds, WSP(const void, WS_ACT), WSP(const void, WS_WD), D, S, E);
        SEAM(9);
    }
    if (IN(10)) { p8_final(F, REPS(10)); }
#undef IN
#undef SEAM
}

extern "C" void kernel_launch(void* const* d_in, const int* in_sizes, int n_in, void* d_out, int out_size, void* d_ws, size_t ws_size, hipStream_t stream) {
    static int grid = 0;
    if (grid == 0) {
        if (n_in != 18 || out_size != M * D || ws_size < WS_END) { fprintf(stderr, "kernel_launch: unexpected shapes (n_in %d, out %d, ws %zu < %zu)\n", n_in, out_size, ws_size, (size_t)WS_END); grid = -1; return; }
        int dev = 0, cus = 0, per_cu = 0;
        if (hipGetDevice(&dev) != hipSuccess || hipDeviceGetAttribute(&cus, hipDeviceAttributeMultiprocessorCount, dev) != hipSuccess) { grid = -1; return; }
        if (hipFuncSetAttribute((const void*)mk_fwd, hipFuncAttributeMaxDynamicSharedMemorySize, LDS_BYTES) != hipSuccess) { fprintf(stderr, "kernel_launch: hipFuncSetAttribute(%d B LDS) failed\n", LDS_BYTES); grid = -1; return; }
        if (hipOccupancyMaxActiveBlocksPerMultiprocessor(&per_cu, (const void*)mk_fwd, NWAVES * 64, LDS_BYTES) != hipSuccess || per_cu < 1) fprintf(stderr, "kernel_launch: occupancy query says %d\n", per_cu);
        (void)hipGetLastError();
        grid = cus;
        if (grid != 256) fprintf(stderr, "kernel_launch: %d CUs (built for 256)\n", grid);
    }
    if (grid < 0) return;
    (void)hipMemsetAsync((char*)d_ws + WS_CTL, 0, CTL_ZERO_BYTES, stream);
    Args a{};
    for (int i = 0; i < 18; ++i) a.in[i] = (const float*)d_in[i];
    a.out = (float*)d_out; a.ws = (unsigned char*)d_ws;
#ifdef MK_REPEAT
    a.rep_k = MK_REPEAT; a.rep_n = MK_REPEAT_N;
#else
    a.rep_k = -1; a.rep_n = 0;
#endif
    for (int li = 0; li < N_LAUNCHES; ++li) {
        a.ph_lo = (N_LAUNCHES == 1) ? 0 : li; a.ph_hi = (N_LAUNCHES == 1) ? NPH : li + 1;
        hipLaunchKernelGGL(mk_fwd, dim3(grid), dim3(NWAVES * 64), LDS_BYTES, stream, a);
    }
}
```

```cpp
#include <hip/hip_runtime.h>
#include <cstdio>
#include <cstdint>

#ifndef MK_OV8
#define MK_OV8 1
#endif
#ifndef MK_TSPLIT
#define MK_TSPLIT 1
#endif
#ifndef MK_P0PF
#define MK_P0PF 4
#endif
#ifndef MK_P0AF
#define MK_P0AF 4
#endif
#ifndef MK_N_LAUNCHES
#define MK_N_LAUNCHES 1
#endif

#define LAS __attribute__((address_space(3)))
#define GAS __attribute__((address_space(1)))
typedef unsigned short bf16;
typedef short bf16x8 __attribute__((ext_vector_type(8)));
typedef short s16x4 __attribute__((ext_vector_type(4)));
typedef float f32x4 __attribute__((ext_vector_type(4)));
typedef float f32x2 __attribute__((ext_vector_type(2)));
typedef float f32x16 __attribute__((ext_vector_type(16)));
typedef unsigned u32x4 __attribute__((ext_vector_type(4)));
typedef unsigned u32x2 __attribute__((ext_vector_type(2)));
typedef __bf16 bf16x2_t __attribute__((ext_vector_type(2)));
typedef int v8i32 __attribute__((ext_vector_type(8)));
typedef int i32x4 __attribute__((ext_vector_type(4)));

constexpr int NWAVES = 8;
constexpr int M = 16384, D = 1024, SEQ = 2048;
constexpr int NZS = 8208;
constexpr int NZ = 8192;
constexpr int NE = 32, CAP = 16384;
constexpr int NPH = 11;
constexpr int N_LAUNCHES = MK_N_LAUNCHES;
constexpr size_t ZQ = 0, ZK = ZQ + (size_t)4 * M * 128, ZV = ZK + (size_t)4 * M * 128, ZR = ZV + (size_t)4 * M * 256, ZCB = ZR + (size_t)4 * M * 256, ZCC = ZCB + (size_t)M * 1024, ZCX = ZCC + (size_t)M * 1024, ZGA = ZCX + (size_t)M * 1024, ZGB = ZGA + (size_t)M * 1024;

constexpr size_t MiB = 1u << 20;
constexpr size_t WS_CTL = 0, CTL_ZERO_BYTES = 65536;
constexpr size_t WS_LIST = 1 * MiB;
constexpr size_t WS_GLIST = 6 * MiB;
constexpr size_t WS_RT   = 3 * MiB + 512 * 1024;
constexpr size_t WS_DECS = 4 * MiB;
constexpr size_t WS_WIN = 16 * MiB;
constexpr size_t WS_WA = 32 * MiB, WS_WB = 34 * MiB, WS_WO = 36 * MiB;
constexpr size_t WS_WGU = 40 * MiB;
constexpr size_t WS_WD = 168 * MiB;
constexpr size_t WS_XN = 232 * MiB;
constexpr size_t WS_LA = 264 * MiB;
constexpr size_t WS_Z = 296 * MiB;
constexpr size_t WS_YP = WS_Z;
constexpr size_t WS_U = 552 * MiB;
constexpr size_t WS_SIN = 584 * MiB;
constexpr size_t WS_OG = 616 * MiB;
constexpr size_t WS_PB = 648 * MiB;
constexpr size_t WS_M1 = 680 * MiB;
constexpr size_t WS_MIX = 744 * MiB;
constexpr size_t WS_X1 = 776 * MiB;
constexpr size_t WS_ACT = 840 * MiB;
constexpr size_t WS_END = 984 * MiB;
constexpr int CW_TMO = 0;
constexpr int CW_RDY2 = 8448;
constexpr int CW_RDY3 = 0, CW_RDY4 = 2048;
constexpr int CW_BAR = 4096;
constexpr int CW_CNT = 8192;
constexpr int CW_STAMP = 12288;

constexpr int RING_BYTES = 131072;
constexpr int EXTRA_OFF = RING_BYTES;
constexpr int LDS_BYTES = 155648 + 512;
constexpr int MISC_OFF = 155648;

#define RLX_AGENT __ATOMIC_RELAXED, __HIP_MEMORY_SCOPE_AGENT
#define LDS_WAIT() asm volatile("s_waitcnt lgkmcnt(0)" ::: "memory")
#define VM_WAIT() asm volatile("s_waitcnt vmcnt(0)" ::: "memory")
__device__ __forceinline__ unsigned pk2(float lo, float hi) { f32x2 v = {lo, hi}; bf16x2_t b = __builtin_convertvector(v, bf16x2_t); return __builtin_bit_cast(unsigned, b); }
__device__ __forceinline__ unsigned pk4_fp8(float a, float b, float c, float d) { int w = 0; w = __builtin_amdgcn_cvt_pk_fp8_f32(a, b, w, false); w = __builtin_amdgcn_cvt_pk_fp8_f32(c, d, w, true); return (unsigned)w; }
__device__ __forceinline__ float bf_lo(unsigned w) { return __builtin_bit_cast(float, w << 16); }
__device__ __forceinline__ float bf_hi(unsigned w) { return __builtin_bit_cast(float, w & 0xffff0000u); }
__device__ __forceinline__ float bf1(bf16 b) { return __builtin_bit_cast(float, ((unsigned)b) << 16); }
__device__ __forceinline__ float fast_sigmoid(float x) { return __builtin_amdgcn_rcpf(1.0f + __expf(-x)); }
__device__ __forceinline__ float wave_sum(float v) {
#pragma unroll
    for (int o = 1; o < 64; o <<= 1) v += __shfl_xor(v, o);
    return v;
}

namespace pg8 {
constexpr int BM = 256, BK = 64, HALF = 128, HTB = HALF * BK * 2, STAGE_BYTES = 8 * HTB, NXCD = 8, WGM = 8;
__device__ __forceinline__ int lds_byte(int r, int c) { const int st = (r >> 4) * 2 + (c >> 5), rr = r & 15, cc = c & 31, ob = rr * 64 + cc * 2; return st * 1024 + (ob ^ (((ob >> 9) & 1) << 5)); }
__device__ __forceinline__ void stage_rc(int b, int& R, int& C) { const int st = b / 1024, sb = b % 1024, swz = sb ^ (((sb >> 9) & 1) << 5); R = (st >> 1) * 16 + swz / 64; C = (st & 1) * 32 + (swz % 64) / 2; }
__device__ __forceinline__ int perm32(int rho) { const int n = rho >> 4, i = rho & 15; return 8 * (i >> 2) + 4 * n + (i & 3); }

struct Unit { int pm, pn, e, rt, ui, hm = 3; };

struct StaticOrder {
    static constexpr bool PARTIAL = false;
    int nM, nN, nwg, G, c, K, reps;
    __device__ __forceinline__ void init(int M_, int N_, int K_, int G_, int c_, int reps_) { nM = M_ / BM; nN = N_ / BM; nwg = nM * nN; G = G_; c = c_; K = K_; reps = reps_; }
    __device__ __forceinline__ bool next(int i, Unit& u) const {
        const long L = (long)i * G + c; if (L >= (long)nwg * reps) return false;
        int wgid = (int)(L % nwg); { const int q = nwg / NXCD, r = nwg % NXCD, xcd = wgid % NXCD, off = wgid / NXCD; wgid = (xcd < r ? xcd * (q + 1) : r * (q + 1) + (xcd - r) * q) + off; }
        const int nig = WGM * nN, gid = wgid / nig, fm = gid * WGM, gsz = (nM - fm) < WGM ? (nM - fm) : WGM;
        u.pm = fm + ((wgid % nig) % gsz); u.pn = (wgid % nig) / gsz; u.e = 0; u.rt = 0; u.ui = i; return true;
    }
    __device__ __forceinline__ unsigned arow(const Unit& u, int ui, int r) const { return (unsigned)(u.pm * BM + r) * (unsigned)(K * 2); }
    __device__ __forceinline__ void after_unit(int ui) const {}
    __device__ __forceinline__ bool keep_acc(int ui) const { return false; }
};

template <class Epi, class Sched, bool ALIGN_EPI, bool FP8 = false, int SCW = 127>
__device__ __forceinline__ void gemm_phase(LAS unsigned char* lds, const void* Ag, const void* Btg, const int K, const Sched& S, const Epi& E) {
    const int tid = threadIdx.x, wid = __builtin_amdgcn_readfirstlane(tid >> 6), lane = tid & 63, wr = wid >> 2, wc = wid & 3, fr = lane & 15, fq = lane >> 4;
    const int RB = FP8 ? K : 2 * K;
    const int nt = RB / 128;
    int RA[2], CA[2]; unsigned voffB[2];
#pragma unroll
    for (int i = 0; i < 2; ++i) { int R, C; stage_rc(tid * 16 + i * 8192, R, C); const int Rb = Epi::PERM ? ((R & ~31) + perm32(R & 31)) : R;
        RA[i] = R; CA[i] = C * 2; voffB[i] = (unsigned)(Rb * RB + C * 2); }
    const size_t kstep = (size_t)(BK * 2);
    const size_t hstep = (size_t)HALF * RB;
    const size_t tstep = 2 * hstep;
    const unsigned ldsw = (unsigned)wid * 1024u;
    const int aoff = lds_byte(wr * 64 + fr, fq * 8), boff = lds_byte(wc * 32 + fr, fq * 8);
#define PG8_SA(b, h) (((b) * 2 + (h)) * HTB)
#define PG8_SB(b, h) ((4 + (b) * 2 + (h)) * HTB)
#define PG8_STAGEB(bufoff, gbase) do { _Pragma("unroll") for (int _i = 0; _i < 2; ++_i) \
        __builtin_amdgcn_global_load_lds((const unsigned*)((const char*)(gbase) + voffB[_i]), (LAS unsigned*)(lds + (bufoff) + ldsw + _i * 8192), 16, 0, 0); } while (0)
#define PG8_STAGEA(bufoff, o0, o1) do { \
        __builtin_amdgcn_global_load_lds((const unsigned*)((const char*)Ag + (o0)), (LAS unsigned*)(lds + (bufoff) + ldsw), 16, 0, 0); \
        __builtin_amdgcn_global_load_lds((const unsigned*)((const char*)Ag + (o1)), (LAS unsigned*)(lds + (bufoff) + ldsw + 8192), 16, 0, 0); } while (0)
#define PG8_LDA(dst, b, h) do { if constexpr (FP8) { _Pragma("unroll") for (int m = 0; m < 4; ++m) { dst[m][0] = *(const LAS bf16x8*)(lds + PG8_SA(b, h) + aoff + m * 2048); dst[m][1] = *(const LAS bf16x8*)(lds + PG8_SA(b, h) + aoff + m * 2048 + 1024); } } \
        else { _Pragma("unroll") for (int m = 0; m < 4; ++m) _Pragma("unroll") for (int k = 0; k < 2; ++k) dst[m][k] = *(const LAS bf16x8*)(lds + PG8_SA(b, h) + aoff + m * 2048 + k * 1024); } } while (0)
#define PG8_LDB(dst, b, h) do { if constexpr (FP8) { _Pragma("unroll") for (int n = 0; n < 2; ++n) { dst[n][0] = *(const LAS bf16x8*)(lds + PG8_SB(b, h) + boff + n * 2048); dst[n][1] = *(const LAS bf16x8*)(lds + PG8_SB(b, h) + boff + n * 2048 + 1024); } } \
        else { _Pragma("unroll") for (int n = 0; n < 2; ++n) _Pragma("unroll") for (int k = 0; k < 2; ++k) dst[n][k] = *(const LAS bf16x8*)(lds + PG8_SB(b, h) + boff + n * 2048 + k * 1024); } } while (0)
#define PG8_F8(x) __builtin_bit_cast(v8i32, __builtin_shufflevector(__builtin_bit_cast(u32x4, (x)[0]), __builtin_bit_cast(u32x4, (x)[1]), 0, 1, 2, 3, 4, 5, 6, 7))
#define PG8_MMA(ai, bj, At, Bt) do { __builtin_amdgcn_s_setprio(1); if constexpr (FP8) { _Pragma("unroll") for (int m = 0; m < 4; ++m) _Pragma("unroll") for (int n = 0; n < 2; ++n) \
        asm volatile("v_mfma_scale_f32_16x16x128_f8f6f4 %0, %1, %2, %0, %3, %4 op_sel_hi:[0,0,0]" : "+v"(acc[ai][bj][m][n]) : "v"(PG8_F8(Bt[n])), "v"(PG8_F8(At[m])), "v"(scw_reg), "v"(sca_reg)); } \
        else { _Pragma("unroll") for (int m = 0; m < 4; ++m) _Pragma("unroll") for (int n = 0; n < 2; ++n) _Pragma("unroll") for (int k = 0; k < 2; ++k) \
        acc[ai][bj][m][n] = __builtin_amdgcn_mfma_f32_16x16x32_bf16(Bt[n][k], At[m][k], acc[ai][bj][m][n], 0, 0, 0); } __builtin_amdgcn_s_setprio(0); } while (0)
#define PG8_IF(c, ...) do { if constexpr (PART) { if (c) { __VA_ARGS__; } } else { __VA_ARGS__; } } while (0)
#define PG8_WAIT_V(n) asm volatile("s_waitcnt vmcnt(" #n ")" ::: "memory")
#define PG8_WAIT_L(n) asm volatile("s_waitcnt lgkmcnt(" #n ")" ::: "memory")
#define PG8_BAR __builtin_amdgcn_s_barrier()
#define PG8_SCHED __builtin_amdgcn_sched_barrier(0)
    constexpr bool PART = FP8 && Sched::PARTIAL;
    Unit cur, nxt; int ui = 0;
    if (!S.next(0, cur)) return;
    int scw_reg = SCW, sca_reg = 127;
    asm volatile("" : "+v"(scw_reg), "+v"(sca_reg));
    f32x4 acc[2][2][4][2];
#pragma unroll
    for (int a = 0; a < 2; ++a)
#pragma unroll
        for (int b = 0; b < 2; ++b)
#pragma unroll
            for (int m = 0; m < 4; ++m)
#pragma unroll
                for (int n = 0; n < 2; ++n) acc[a][b][m][n] = (f32x4){0.f, 0.f, 0.f, 0.f};
#define PG8_ZPAD() do { if constexpr (FP8) { _Pragma("unroll") for (int a = 0; a < 2; ++a) _Pragma("unroll") for (int b = 0; b < 2; ++b) _Pragma("unroll") for (int m = 0; m < 4; ++m) asm volatile("s_nop 1" : "+v"(acc[a][b][m][0]), "+v"(acc[a][b][m][1])); } } while (0)
    PG8_ZPAD();
    bf16x8 At[4][2], B0[2][2], B1[2][2];
    unsigned ac00, ac01, ac10, ac11;
    ac00 = S.arow(cur, 0, RA[0]) + CA[0]; ac01 = S.arow(cur, 0, RA[1]) + CA[1]; ac10 = S.arow(cur, 0, HALF + RA[0]) + CA[0]; ac11 = S.arow(cur, 0, HALF + RA[1]) + CA[1];
    const char* cB = (const char*)Btg + (size_t)cur.pn * tstep;
    PG8_STAGEB(PG8_SB(0, 0), cB); PG8_STAGEB(PG8_SB(0, 1), cB + hstep); PG8_STAGEA(PG8_SA(0, 0), ac00, ac01); PG8_STAGEA(PG8_SA(0, 1), ac10, ac11);
    if (wr == 1) PG8_BAR;
    PG8_WAIT_V(2); PG8_BAR;
    PG8_STAGEB(PG8_SB(1, 0), cB + kstep); PG8_STAGEA(PG8_SA(1, 0), ac00 + 128u, ac01 + 128u); PG8_STAGEB(PG8_SB(1, 1), cB + hstep + kstep);
    PG8_WAIT_V(6); PG8_BAR;
    for (;;) {
        const bool has_next = S.next(ui + 1, nxt);
        const char* nB = has_next ? (const char*)Btg + (size_t)nxt.pn * tstep : cB;
        const bool d0 = !PART || (cur.hm & 1), d1 = !PART || (cur.hm & 2);
#pragma unroll 1
        for (int t = 0; t < nt; t += 2) {
            const bool last = (t == nt - 2);
            const unsigned k1 = (unsigned)(t + 1) * 128u, k2 = (unsigned)(t + 2) * 128u;
            unsigned a200 = ac00 + k2, a201 = ac01 + k2, a210 = ac10 + k2, a211 = ac11 + k2;
            if (last) { if (has_next) { a200 = S.arow(nxt, ui + 1, RA[0]) + CA[0]; a201 = S.arow(nxt, ui + 1, RA[1]) + CA[1]; a210 = S.arow(nxt, ui + 1, HALF + RA[0]) + CA[0]; a211 = S.arow(nxt, ui + 1, HALF + RA[1]) + CA[1]; }
                        else { a200 = ac00; a201 = ac01; a210 = ac10; a211 = ac11; } }
            const char* b2 = last ? nB : cB + (size_t)k2; const char* b3 = b2 + kstep;
            PG8_IF(d0, PG8_LDB(B0, 0, 0)); PG8_IF(d1, PG8_LDB(B1, 0, 1)); PG8_SCHED; PG8_LDA(At, 0, 0); PG8_STAGEA(PG8_SA(1, 1), ac10 + k1, ac11 + k1);
            PG8_WAIT_V(8); PG8_WAIT_L(0); PG8_BAR; PG8_IF(d0, PG8_MMA(0, 0, At, B0)); PG8_IF(d1, PG8_MMA(0, 1, At, B1)); PG8_BAR; PG8_SCHED;
            PG8_LDA(At, 0, 1); PG8_STAGEB(PG8_SB(0, 0), b2); PG8_STAGEB(PG8_SB(0, 1), b2 + hstep); PG8_STAGEA(PG8_SA(0, 0), a200, a201);
            PG8_WAIT_V(8); PG8_WAIT_L(0); PG8_BAR; PG8_IF(d0, PG8_MMA(1, 0, At, B0)); PG8_IF(d1, PG8_MMA(1, 1, At, B1)); PG8_BAR; PG8_SCHED;
            PG8_IF(d0, PG8_LDB(B0, 1, 0)); PG8_IF(d1, PG8_LDB(B1, 1, 1)); PG8_SCHED; PG8_LDA(At, 1, 0); PG8_STAGEA(PG8_SA(0, 1), a210, a211);
            PG8_WAIT_V(8); PG8_WAIT_L(0); PG8_BAR; PG8_IF(d0, PG8_MMA(0, 0, At, B0)); PG8_IF(d1, PG8_MMA(0, 1, At, B1)); PG8_BAR; PG8_SCHED;
            PG8_LDA(At, 1, 1); PG8_STAGEB(PG8_SB(1, 0), b3); PG8_STAGEB(PG8_SB(1, 1), b3 + hstep); PG8_STAGEA(PG8_SA(1, 0), a200 + 128u, a201 + 128u);
            PG8_WAIT_V(8); PG8_WAIT_L(0); PG8_BAR; PG8_IF(d0, PG8_MMA(1, 0, At, B0)); PG8_IF(d1, PG8_MMA(1, 1, At, B1)); PG8_BAR; PG8_SCHED;
        }
        if constexpr (FP8) asm volatile("s_nop 15\n\ts_nop 15" ::: "memory");
#pragma unroll
        for (int a = 0; a < 2; ++a)
#pragma unroll
            for (int b = 0; b < 2; ++b)
#pragma unroll
                for (int m = 0; m < 4; ++m) asm volatile("" : "+v"(acc[a][b][m][0]), "+v"(acc[a][b][m][1]));
        if constexpr (ALIGN_EPI) { if (wr == 0) PG8_BAR; }
        E(acc, cur, wr, wc, fr, fq);
        S.after_unit(ui);
        if (!has_next) break;
        if (!S.keep_acc(ui)) {
#pragma unroll
        for (int a = 0; a < 2; ++a)
#pragma unroll
            for (int b = 0; b < 2; ++b)
#pragma unroll
                for (int m = 0; m < 4; ++m)
#pragma unroll
                    for (int n = 0; n < 2; ++n) acc[a][b][m][n] = (f32x4){0.f, 0.f, 0.f, 0.f};
        }
        PG8_ZPAD();
        cur = nxt; cB = nB; ++ui;
        ac00 = S.arow(cur, ui, RA[0]) + CA[0]; ac01 = S.arow(cur, ui, RA[1]) + CA[1]; ac10 = S.arow(cur, ui, HALF + RA[0]) + CA[0]; ac11 = S.arow(cur, ui, HALF + RA[1]) + CA[1];
        if constexpr (ALIGN_EPI) { if (wr == 1) PG8_BAR; }
    }
    PG8_WAIT_V(0);
    if constexpr (!ALIGN_EPI) { if (wr == 0) PG8_BAR; }
    PG8_BAR;
#undef PG8_SA
#undef PG8_SB
#undef PG8_STAGEA
#undef PG8_STAGEB
#undef PG8_LDA
#undef PG8_LDB
#undef PG8_MMA
#undef PG8_F8
#undef PG8_ZPAD
#undef PG8_IF
#undef PG8_WAIT_V
#undef PG8_WAIT_L
#undef PG8_BAR
#undef PG8_SCHED
}
}

#define XB_TMO      128
#define XB_XCNT(j)  (256  + 64 * (j))
#define XB_XSUB(j)  (1280 + 64 * (j))
#define XB_XGEN(j)  (2304 + 64 * (j))
#define XB_TOP      3328
#define XB_TOPGEN   3392
#define XCD_BAR_WORDS 3456
#define XB_SPIN_CAP (1u << 18)
__device__ __forceinline__ unsigned xb_ld(unsigned* p)              { return __hip_atomic_load(p, __ATOMIC_RELAXED, __HIP_MEMORY_SCOPE_AGENT); }
__device__ __forceinline__ unsigned xb_add(unsigned* p, unsigned v) { return __hip_atomic_fetch_add(p, v, __ATOMIC_RELAXED, __HIP_MEMORY_SCOPE_AGENT); }
__device__ __forceinline__ unsigned xb_xcc_id() { return (unsigned)__builtin_amdgcn_s_getreg((3 << 11) | 20) & 0xFu; }
#define XB_SPIN(cond, bar) do { unsigned _sp = 0; while (cond) { __builtin_amdgcn_s_sleep(1); \
    if ((++_sp & 255u) == 0u) { if (xb_ld(&(bar)[XB_TMO])) break; if (_sp > XB_SPIN_CAP) { atomicAdd(&(bar)[XB_TMO], 1u); break; } } } } while (0)
struct XcdBarrier { unsigned* bar; unsigned x; volatile LAS unsigned* st; };
__device__ __forceinline__ XcdBarrier xcd_barrier_post(unsigned* bar, volatile LAS unsigned* st) {
    XcdBarrier b; b.bar = bar; b.x = xb_xcc_id(); b.st = st;
    if (threadIdx.x == 0) (void)xb_add(&bar[XB_XCNT(b.x)], 1u);
    return b;
}
__device__ __forceinline__ void xcd_barrier_complete(unsigned* bar, unsigned x, unsigned& nloc, unsigned& nx) {
    const unsigned G = gridDim.x * gridDim.y * gridDim.z;
    unsigned sum, cnt, mine, sp = 0u;
    for (;;) {
        sum = 0u; cnt = 0u; mine = 0u;
#pragma unroll
        for (unsigned j = 0; j < 16; ++j) { const unsigned c = xb_ld(&bar[XB_XCNT(j)]); sum += c; cnt += (c > 0u) ? 1u : 0u; mine = (j == x) ? c : mine; }
        if (sum == G) break;
        __builtin_amdgcn_s_sleep(1);
        if ((++sp & 255u) == 0u) { if (xb_ld(&bar[XB_TMO])) break; if (sp > XB_SPIN_CAP) { atomicAdd(&bar[XB_TMO], 1u); break; } }
    }
    nloc = mine > 0u ? mine : 1u; nx = cnt > 0u ? cnt : 1u;
}
__device__ __forceinline__ void xcd_barrier(const XcdBarrier& b) {
    asm volatile("s_waitcnt vmcnt(0)" ::: "memory");
    __syncthreads();
    if (threadIdx.x == 0) {
        unsigned* bar = b.bar;
        __builtin_amdgcn_s_waitcnt(0);
        unsigned nloc = b.st[0], nx = b.st[1];
        if (nloc == 0u) { xcd_barrier_complete(bar, b.x, nloc, nx); b.st[0] = nloc; b.st[1] = nx; }
        const unsigned old = xb_add(&bar[XB_XSUB(b.x)], 1u);
        const unsigned gen = old / nloc;
        if (old + 1u == (gen + 1u) * nloc) {
            __builtin_amdgcn_fence(__ATOMIC_RELEASE, "agent");
            asm volatile("s_waitcnt vmcnt(0)" ::: "memory");
            const unsigned og = xb_add(&bar[XB_TOP], 1u);
            const unsigned tg = og / nx;
            if (og + 1u == (tg + 1u) * nx) xb_add(&bar[XB_TOPGEN], 1u);
            else XB_SPIN(xb_ld(&bar[XB_TOPGEN]) == tg, bar);
            __builtin_amdgcn_fence(__ATOMIC_ACQUIRE, "agent");
            xb_add(&bar[XB_XGEN(b.x)], 1u);
            asm volatile("s_waitcnt vmcnt(0)" ::: "memory");
        } else {
            XB_SPIN(xb_ld(&bar[XB_XGEN(b.x)]) == gen, bar);
            __builtin_amdgcn_fence(__ATOMIC_ACQUIRE, "agent");
            asm volatile("s_waitcnt vmcnt(0)" ::: "memory");
        }
    }
    __syncthreads();
}

template <class W>
__device__ __forceinline__ void xcd_barrier_overlap(const XcdBarrier& b, const W& work) {
    asm volatile("s_waitcnt vmcnt(0)" ::: "memory");
    __syncthreads();
    const unsigned duty = blockDim.x - 64u;
    if (threadIdx.x >= duty) {
        if (threadIdx.x == duty) {
            unsigned* bar = b.bar;
            __builtin_amdgcn_s_waitcnt(0);
            unsigned nloc = b.st[0], nx = b.st[1];
            if (nloc == 0u) { xcd_barrier_complete(bar, b.x, nloc, nx); b.st[0] = nloc; b.st[1] = nx; }
            const unsigned old = xb_add(&bar[XB_XSUB(b.x)], 1u);
            const unsigned gen = old / nloc;
            if (old + 1u == (gen + 1u) * nloc) {
                __builtin_amdgcn_fence(__ATOMIC_RELEASE, "agent");
                asm volatile("s_waitcnt vmcnt(0)" ::: "memory");
                const unsigned og = xb_add(&bar[XB_TOP], 1u);
                const unsigned tg = og / nx;
                if (og + 1u == (tg + 1u) * nx) xb_add(&bar[XB_TOPGEN], 1u);
                else XB_SPIN(xb_ld(&bar[XB_TOPGEN]) == tg, bar);
                __builtin_amdgcn_fence(__ATOMIC_ACQUIRE, "agent");
                xb_add(&bar[XB_XGEN(b.x)], 1u);
                asm volatile("s_waitcnt vmcnt(0)" ::: "memory");
            } else {
                XB_SPIN(xb_ld(&bar[XB_XGEN(b.x)]) == gen, bar);
                __builtin_amdgcn_fence(__ATOMIC_ACQUIRE, "agent");
                asm volatile("s_waitcnt vmcnt(0)" ::: "memory");
            }
        }
    } else work();
    __syncthreads();
}

struct Frame {
    LAS unsigned char* lds;
    volatile LAS unsigned* MISC;
    unsigned* ctl;
    int tid, lane, wave, vcu, G;
    unsigned char* ws;
    const float *x, *g_mix, *w_in, *w_up, *b_alpha, *g_gla, *w_conv, *w_a, *w_b, *w_out, *g_ffn, *w_router, *b_router, *w_gu, *b_gu, *w_d, *b_d, *g_final;
    float* out;
};
#define WSP(T, off) ((T*)(F.ws + (off)))

__device__ __forceinline__ void tr_item64(const float* W, int ld, int k0, int n0, bf16* WT, size_t dst_row0, int K, LAS unsigned* T, int lane) {
    const int nq = lane & 15, kr = lane >> 4;
    const float* src = W + (size_t)(k0 + 2 * kr) * ld + n0 + 4 * nq;
    f32x4 a0[8], a1[8];
#pragma unroll
    for (int it = 0; it < 8; ++it) { a0[it] = __builtin_nontemporal_load((const f32x4*)(src + (size_t)(8 * it) * ld)); a1[it] = __builtin_nontemporal_load((const f32x4*)(src + (size_t)(8 * it + 1) * ld)); }
    __builtin_amdgcn_sched_barrier(0);
    const int c = lane & 7;
#pragma unroll
    for (int hf = 0; hf < 2; ++hf) {
        if ((nq >> 3) == hf) {
#pragma unroll
            for (int it = 0; it < 8; ++it)
#pragma unroll
                for (int q = 0; q < 4; ++q) T[(4 * (nq & 7) + q) * 33 + 4 * it + kr] = pk2(a0[it][q], a1[it][q]);
        }
        LDS_WAIT(); asm volatile("" ::: "memory");
#pragma unroll
        for (int j = 0; j < 4; ++j) { const int n = (lane >> 3) + 8 * j; const LAS unsigned* t = T + n * 33 + 4 * c;
            u32x4 o; o.x = t[0]; o.y = t[1]; o.z = t[2]; o.w = t[3];
            *(u32x4*)(WT + (dst_row0 + 32 * hf + n) * (size_t)K + k0 + 8 * c) = o; }
        LDS_WAIT(); asm volatile("" ::: "memory");
    }
}

__device__ __forceinline__ void tr_item8(const float* W, int ld, int k0, int n0, unsigned char* WT8, size_t dst_row0, int KB, float scale, LAS unsigned* T, int lane) {
    const int nq = lane & 7, kr = lane >> 3;
    const float* src = W + (size_t)(k0 + 4 * kr) * ld + n0 + 4 * nq;
    f32x4 a[4][4];
#pragma unroll
    for (int it = 0; it < 4; ++it)
#pragma unroll
        for (int j = 0; j < 4; ++j) a[it][j] = __builtin_nontemporal_load((const f32x4*)(src + (size_t)(32 * it + j) * ld));
    __builtin_amdgcn_sched_barrier(0);
    const int c = lane & 7;
#pragma unroll
    for (int hf = 0; hf < 2; ++hf) {
        if ((nq >> 2) == hf) {
#pragma unroll
            for (int it = 0; it < 4; ++it)
#pragma unroll
                for (int q = 0; q < 4; ++q) T[(4 * (nq & 3) + q) * 33 + 8 * it + kr] = pk4_fp8(a[it][0][q] * scale, a[it][1][q] * scale, a[it][2][q] * scale, a[it][3][q] * scale);
        }
        LDS_WAIT(); asm volatile("" ::: "memory");
#pragma unroll
        for (int j = 0; j < 2; ++j) { const int n = (lane >> 3) + 8 * j; const LAS unsigned* t = T + n * 33 + 4 * c;
            u32x4 o; o.x = t[0]; o.y = t[1]; o.z = t[2]; o.w = t[3];
            __builtin_nontemporal_store(o, (u32x4*)(WT8 + (dst_row0 + 16 * hf + n) * (size_t)KB + k0 + 16 * c)); }
        LDS_WAIT(); asm volatile("" ::: "memory");
    }
}
constexpr int MOE_NIT = NE * 64 * 8 + NE * 32 * 8;
#ifndef MK_MOE_SPLIT
#define MK_MOE_SPLIT 0
#endif
constexpr int MOE_SPLIT = MK_MOE_SPLIT;
__device__ __forceinline__ void moe_convert_range(const float* w_gu, const float* w_d, unsigned char* ws, LAS unsigned* T, int first, int step, int end, int lane) {
    constexpr int I_GU = NE * 64 * 8;
    for (int it = first; it < end; it += step) {
        int r = it;
        if (r < I_GU) { const int e = r >> 9, q = r & 511, kb = q >> 6, nb = q & 63, j0 = 32 * nb, pn = j0 >> 8, within = j0 & 255, half = within >> 7;
            tr_item8(w_gu + (size_t)e * 1024 * 2048, 2048, 128 * kb, half * 1024 + pn * 128 + (within & 127), ws + WS_WGU + (size_t)e * 2048 * 1024, j0, 1024, 32.0f, T, lane); continue; } r -= I_GU;
        { const int e = r >> 8, q = r & 255, kb = q >> 5, nb = q & 31;
            tr_item8(w_d + (size_t)e * 1024 * 1024, 1024, 128 * kb, 32 * nb, ws + WS_WD + (size_t)e * 1024 * 1024, 32 * nb, 1024, 32.0f, T, lane); }
    }
}
__device__ __forceinline__ void moe_convert_share(const float* w_gu, const float* w_d, unsigned char* ws, LAS unsigned char* lds, int c, int G, int wave, int lane) {
    moe_convert_range(w_gu, w_d, ws, (LAS unsigned*)(lds + EXTRA_OFF + wave * 2176), MOE_SPLIT + c * NWAVES + wave, G * NWAVES, MOE_NIT, lane);
}
struct P1Order : pg8::StaticOrder {
    const float* w_gu; const float* w_d; unsigned char* ws; LAS unsigned char* lds; int slot, wave, lane;
    __device__ __forceinline__ void after_unit(int ui) const { if (ui == slot) { int ln = lane; asm volatile("" : "+v"(ln));
            moe_convert_share(w_gu, w_d, ws, lds, c, G, wave, ln); } }
};

constexpr int P0_T_BYTES = 4352;
constexpr int P0_WLD = 2064;
constexpr int P0_WL = 8 * P0_T_BYTES;
constexpr int P0_WU = P0_WL + 16 * P0_WLD;
constexpr int P0_BA = P0_WU + 16384;
constexpr int P0_AS = P0_BA + 2048;

__device__ __forceinline__ void p0_items(Frame& F, const int nrep) {
    LAS unsigned* scr = (LAS unsigned*)(F.lds + F.wave * P0_T_BYTES);
    const int gw = F.vcu * NWAVES + F.wave, NGW = F.G * NWAVES;
    constexpr int I_IN = 128 * 16, I_SQ = 16 * 16;
    constexpr int NITEMS = I_IN + 3 * I_SQ;
    bf16* Win_t = WSP(bf16, WS_WIN);
    for (int it0 = gw; it0 < NITEMS * nrep; it0 += NGW) {
        int r = it0 % NITEMS;
        if (r < I_IN) { const int kb = r >> 7, nb = r & 127, j0 = 64 * nb;
            int srcc = j0 < 3072 ? j0 : j0 + 16;
            if (j0 >= 4096 && j0 < 6144) { const int pn = j0 >> 8, within = j0 & 255; srcc = ((within >> 7) ? 5136 : 4112) + (pn - 16) * 128 + (within & 127); }
            tr_item64(F.w_in, NZS, 64 * kb, srcc, Win_t, j0, 1024, scr, F.lane); continue; } r -= I_IN;
        if (r < I_SQ) { tr_item64(F.w_a, 1024, 64 * (r >> 4), 64 * (r & 15), WSP(bf16, WS_WA), 64 * (r & 15), 1024, scr, F.lane); continue; } r -= I_SQ;
        if (r < I_SQ) { tr_item64(F.w_b, 1024, 64 * (r >> 4), 64 * (r & 15), WSP(bf16, WS_WB), 64 * (r & 15), 1024, scr, F.lane); continue; } r -= I_SQ;
        tr_item64(F.w_out, 1024, 64 * (r >> 4), 64 * (r & 15), WSP(bf16, WS_WO), 64 * (r & 15), 1024, scr, F.lane);
    }
    moe_convert_range(F.w_gu, F.w_d, F.ws, scr, gw, NGW, MOE_SPLIT, F.lane);
}

__device__ __forceinline__ void p0_rows(Frame& F, const int nrep2) {
    const int gw = F.vcu * NWAVES + F.wave, NGW = F.G * NWAVES, lane = F.lane, r32 = lane & 31, h = lane >> 5;
    LAS unsigned char* L = F.lds;
    LAS float* BA = (LAS float*)(L + P0_BA);
    LAS float* AS = (LAS float*)(L + P0_AS + F.wave * 512);
    f32x4 g[4];
#pragma unroll
    for (int j = 0; j < 4; ++j) g[j] = *((const f32x4*)F.g_mix + lane + 64 * j);
    bf16* XN = WSP(bf16, WS_XN); bf16* LA = WSP(bf16, WS_LA);
#pragma unroll 1
    for (int b8 = 0; (b8 * 8) * NGW + gw < M * nrep2; ++b8) {
        f32x4 nx[MK_P0PF][4];
#pragma unroll
        for (int p = 0; p < MK_P0PF; ++p) { const f32x4* xr = (const f32x4*)(F.x + (size_t)(((b8 * 8 + p) * NGW + gw) % M) * D) + lane;
#pragma unroll
          for (int j = 0; j < 4; ++j) nx[p][j] = __builtin_nontemporal_load(xr + 64 * j); }
#pragma unroll
        for (int i = 0; i < 8; ++i) {
            const int m = ((b8 * 8 + i) * NGW + gw) % M;
            f32x4 v[4]; float s = 0.f;
#pragma unroll
            for (int j = 0; j < 4; ++j) { v[j] = nx[i % MK_P0PF][j]; s += (v[j].x * v[j].x + v[j].y * v[j].y) + (v[j].z * v[j].z + v[j].w * v[j].w); }
            if (i + MK_P0PF < 8) { const f32x4* xr = (const f32x4*)(F.x + (size_t)(((b8 * 8 + i + MK_P0PF) * NGW + gw) % M) * D) + lane;
#pragma unroll
                for (int j = 0; j < 4; ++j) nx[i % MK_P0PF][j] = __builtin_nontemporal_load(xr + 64 * j); }
            const float rstd = 1.0f / sqrtf(wave_sum(s) * (1.f / D) + 1e-6f);
            unsigned long long* o8 = (unsigned long long*)(XN + (size_t)m * D) + lane;
#pragma unroll
            for (int j = 0; j < 4; ++j) { v[j] = v[j] * rstd * g[j]; o8[64 * j] = (unsigned long long)pk2(v[j].x, v[j].y) | ((unsigned long long)pk2(v[j].z, v[j].w) << 32); }
        }
        asm volatile("s_waitcnt vmcnt(0)" ::: "memory");
        {
            const int tl = lane & 7, kg = lane >> 4, rr = lane & 15;
            const bf16* ap = XN + (size_t)(((b8 * 8 + tl) * NGW + gw) % M) * D + 8 * kg;
            const LAS unsigned char* bp = L + P0_WL + rr * P0_WLD + 16 * kg;
            f32x4 ac = {0.f, 0.f, 0.f, 0.f};
#pragma unroll
            for (int k8 = 0; k8 < 4; k8 += MK_P0AF) {
                bf16x8 af[8 * MK_P0AF];
#pragma unroll
                for (int q = 0; q < 8 * MK_P0AF; ++q) af[q] = *(const bf16x8*)(ap + 32 * (8 * k8 + q));
#pragma unroll
                for (int q = 0; q < 8 * MK_P0AF; ++q) ac = __builtin_amdgcn_mfma_f32_16x16x32_bf16(af[q], *(const LAS bf16x8*)(bp + 64 * (8 * k8 + q)), ac, 0, 0, 0);
            }
            if (lane < 32) {
#pragma unroll
                for (int q = 0; q < 4; ++q) AS[(4 * kg + q) * 16 + rr] = ac[q]; }
        }
        {
            f32x4 a0 = {0.f, 0.f, 0.f, 0.f}, a1 = a0;
            if (r32 < 8) { a0 = *(const LAS f32x4*)(AS + r32 * 16 + 8 * h); a1 = *(const LAS f32x4*)(AS + r32 * 16 + 8 * h + 4); }
            u32x4 hi, lo;
            hi.x = pk2(a0[0], a0[1]); hi.y = pk2(a0[2], a0[3]); hi.z = pk2(a1[0], a1[1]); hi.w = pk2(a1[2], a1[3]);
            lo.x = pk2(a0[0] - bf_lo(hi.x), a0[1] - bf_hi(hi.x)); lo.y = pk2(a0[2] - bf_lo(hi.y), a0[3] - bf_hi(hi.y)); lo.z = pk2(a1[0] - bf_lo(hi.z), a1[1] - bf_hi(hi.z)); lo.w = pk2(a1[2] - bf_lo(hi.w), a1[3] - bf_hi(hi.w));
            const bf16x8 ahi = __builtin_bit_cast(bf16x8, hi), alo = __builtin_bit_cast(bf16x8, lo);
            int mrow[4];
#pragma unroll
            for (int q = 0; q < 4; ++q) mrow[q] = ((b8 * 8 + q + 4 * h) * NGW + gw) % M;
#pragma unroll 4
            for (int nt = 0; nt < 16; ++nt) {
                const bf16x8 bw = *(const LAS bf16x8*)(L + P0_WU + (32 * nt + r32) * 32 + 16 * h);
                f32x16 c16;
#pragma unroll
                for (int q = 0; q < 16; ++q) c16[q] = 0.f;
                c16 = __builtin_amdgcn_mfma_f32_32x32x16_bf16(ahi, bw, c16, 0, 0, 0);
                c16 = __builtin_amdgcn_mfma_f32_32x32x16_bf16(alo, bw, c16, 0, 0, 0);
                const float bb = BA[32 * nt + r32];
#pragma unroll
                for (int q = 0; q < 4; ++q) { const float pre = c16[q] + bb;
                    const float ls = fminf(pre, 0.f) - __logf(1.0f + __expf(-fabsf(pre)));
                    LA[((size_t)(nt >> 2) * M + mrow[q]) * 128 + 32 * (nt & 3) + r32] = (bf16)(pk2(ls * (1.0f / 16.0f), 0.f) & 0xffffu); }
            }
        }
    }
}

__device__ __forceinline__ void p0_prologue(Frame& F, const int nrep, const int nrep2) {
    {
        LAS unsigned char* L = F.lds;
        for (int i = 0; i < 32; ++i) { const int idx = F.tid + 512 * i, k = idx >> 4, r = idx & 15; *(LAS bf16*)(L + P0_WL + r * P0_WLD + 2 * k) = (bf16)(pk2(F.w_in[(size_t)k * NZS + 3072 + r], 0.f) & 0xffffu); }
        for (int i = 0; i < 16; ++i) { const int idx = F.tid + 512 * i, r = idx >> 9, n = idx & 511; *(LAS bf16*)(L + P0_WU + n * 32 + 2 * r) = (bf16)(pk2(F.w_up[idx], 0.f) & 0xffffu); }
        ((LAS float*)(L + P0_BA))[F.tid] = F.b_alpha[F.tid];
        __syncthreads();
    }
    if (F.vcu < 64) {
        const int idx = F.vcu * 512 + F.tid, k = idx >> 5, e = idx & 31; const float wv = F.w_router[idx] * F.g_ffn[k];
        const unsigned hi = pk2(wv, 0.f) & 0xffffu; const float rem = wv - __builtin_bit_cast(float, hi << 16);
        unsigned char* RT = F.ws + WS_RT;
        *(bf16*)(RT + e * 2064 + 2 * k) = (bf16)hi; *(bf16*)(RT + 32 * 2064 + e * 2064 + 2 * k) = (bf16)(pk2(rem, 0.f) & 0xffffu);
    }
#pragma unroll 1
    for (int pass = 0; pass < 2; ++pass) {
        if (((pass ^ F.wave) & 1) == 0) p0_items(F, nrep); else p0_rows(F, nrep2);
    }
}

struct EpiZ {
    static constexpr bool PERM = true;
    bf16* Z;
    __device__ __forceinline__ void operator()(const f32x4 (&acc)[2][2][4][2], const pg8::Unit& u, int wr, int wc, int fr, int fq) const {
        const int row0 = u.pm * 256 + wr * 64 + fr, c0 = wc * 32 + 8 * fq;
        const int pn = u.pn;
        const int kind = pn < 2 ? 1 : (pn < 8 ? 0 : (pn < 12 ? 2 : (pn < 24 ? 0 : 3)));
        bf16* base; int ld; size_t bjs;
        if (pn < 4) { base = Z + (pn < 2 ? ZQ : ZK) + (size_t)(2 * (pn & 1)) * M * 128; ld = 128; bjs = (size_t)M * 128; }
        else if (pn < 12) { base = Z + (pn < 8 ? ZV : ZR) + (size_t)(pn & 3) * M * 256; ld = 256; bjs = 128; }
        else { const int t = (pn - 12) >> 2; base = Z + ZCB + (size_t)t * M * 1024 + (size_t)((pn - 12) & 3) * 256; ld = 1024; bjs = 128; }
        if (pn >= 16 && pn < 24) {
            bf16* ub = Z + ZCC + (size_t)(pn - 16) * 128;
#pragma unroll
            for (int ai = 0; ai < 2; ++ai)
#pragma unroll
                for (int m = 0; m < 4; ++m) { const f32x4 v0 = acc[ai][0][m][0] * acc[ai][1][m][0], v1 = acc[ai][0][m][1] * acc[ai][1][m][1];
                    u32x4 w; w.x = pk2(v0[0], v0[1]); w.y = pk2(v0[2], v0[3]); w.z = pk2(v1[0], v1[1]); w.w = pk2(v1[2], v1[3]);
                    *(u32x4*)(ub + (size_t)(row0 + ai * 128 + m * 16) * 1024 + c0) = w; }
            return;
        }
#pragma unroll
        for (int ai = 0; ai < 2; ++ai)
#pragma unroll
            for (int m = 0; m < 4; ++m) { bf16* rowp = base + (size_t)(row0 + ai * 128 + m * 16) * ld + c0;
#pragma unroll
                for (int bj = 0; bj < 2; ++bj) { f32x4 v0 = acc[ai][bj][m][0], v1 = acc[ai][bj][m][1];
                    if (kind == 1) { v0 = v0 * 0.08838834764831845f; v1 = v1 * 0.08838834764831845f; }
                    else if (kind == 2) {
#pragma unroll
                        for (int j = 0; j < 4; ++j) { v0[j] = v0[j] * fast_sigmoid(v0[j]); v1[j] = v1[j] * fast_sigmoid(v1[j]); } }
                    else if (kind == 3) {
                        unsigned q[8];
#pragma unroll
                        for (int j = 0; j < 4; ++j) { q[j] = (unsigned)__builtin_rintf(fast_sigmoid(v0[j]) * 255.0f); q[4 + j] = (unsigned)__builtin_rintf(fast_sigmoid(v1[j]) * 255.0f); }
                        u32x2 wq; wq.x = q[0] | (q[1] << 8) | (q[2] << 16) | (q[3] << 24); wq.y = q[4] | (q[5] << 8) | (q[6] << 16) | (q[7] << 24);
                        unsigned char* gbase = (unsigned char*)(Z + (pn < 28 ? ZGA : ZGB)) + (size_t)((pn - 24) & 3) * 256;
                        *(u32x2*)(gbase + (size_t)(row0 + ai * 128 + m * 16) * 1024 + c0 + bj * 128) = wq;
                        continue; }
                    u32x4 w; w.x = pk2(v0[0], v0[1]); w.y = pk2(v0[2], v0[3]); w.z = pk2(v1[0], v1[1]); w.w = pk2(v1[2], v1[3]);
                    *(u32x4*)(rowp + bj * bjs) = w; } }
    }
};

constexpr int QD_STRIDE = 272, KT_STRIDE = 144, SC_STRIDE = 144, OT_STRIDE = 1040;
constexpr int L_GG = 134144, L_WC = 135168;
constexpr int L_QD = 0, L_KI = 17408, L_KT = 34816, L_SC = 53248, L_DEC = 62464, L_SEG = 62976, L_OT = 67584;
__device__ __forceinline__ int crow(int reg, int h) { return (reg & 3) + 8 * (reg >> 2) + 4 * h; }

typedef __amdgpu_buffer_rsrc_t rsrc_t;
__device__ __forceinline__ void st16_wt(rsrc_t r, unsigned off, u32x4 v) { __builtin_amdgcn_raw_buffer_store_b128(v, r, (int)off, 0, 16); }
__device__ __forceinline__ void panel_publish(unsigned* word) { asm volatile("s_waitcnt vmcnt(0)" ::: "memory"); if ((threadIdx.x & 63) == 0) (void)__hip_atomic_fetch_add(word, 1u, __ATOMIC_RELAXED, __HIP_MEMORY_SCOPE_AGENT); }
#ifndef MK_HORNER
#define MK_HORNER 1
#endif
#ifndef MK_HANDOFF
#define MK_HANDOFF 1
#endif
#ifndef MK_HB
#define MK_HB 3
#endif
template <bool OUT>
__device__ __forceinline__ void gla_item(Frame& F, int item, const int cblk = -1, const bool ho = false) {
    const int bh = item >> 3, sc = item & 7, b = bh >> 2, hd = bh & 3;
    const int t0 = b * SEQ + sc * 256;
    const int tid = F.tid, lane = F.lane, w = F.wave, r32 = lane & 31, h = lane >> 5;
    const bf16* Z = WSP(const bf16, WS_Z);
    const bf16* LA = WSP(const bf16, WS_LA);
    LAS unsigned char* L = F.lds;
    f32x16 S[4];
    unsigned* Sbuf = (OUT ? WSP(unsigned, WS_SIN) : WSP(unsigned, WS_U)) + (size_t)item * 16384 + (size_t)w * 2048;
    if (OUT) {
#if MK_HORNER
        *(LAS f32x2*)(L + L_OT + 8 * tid) = *(const f32x2*)(WSP(const float, WS_DECS) + (size_t)bh * 1024 + 2 * tid);
#pragma unroll
        for (int kb = 0; kb < 4; ++kb)
#pragma unroll
            for (int r = 0; r < 16; ++r) S[kb][r] = 0.f;
#else
#pragma unroll
        for (int kb = 0; kb < 4; ++kb)
#pragma unroll
            for (int r = 0; r < 16; r += 2) { const unsigned pw = Sbuf[(kb * 8 + (r >> 1)) * 64 + lane]; S[kb][r] = bf_lo(pw); S[kb][r + 1] = bf_hi(pw); }
#endif
    } else {
#pragma unroll
        for (int kb = 0; kb < 4; ++kb)
#pragma unroll
            for (int r = 0; r < 16; ++r) S[kb][r] = 0.f;
    }
    float btot_run0 = 0.f, btot_run1 = 0.f;
    const int tok_n = tid >> 3, part = tid & 7;
    unsigned la2[8], kk[8], qq[8]; bf16x8 Bv[4]; u32x4 rc[4]; u32x4 Vst[4];
#define GLA_LOAD(tcx) do { \
        const size_t rb_ = ((size_t)hd * M + (tcx) + 8 * w) * 128 + 2 * lane; \
        _Pragma("unroll") for (int i = 0; i < 8; ++i) { if (OUT) { la2[i] = __builtin_nontemporal_load((const unsigned*)(LA + rb_ + (size_t)i * 128)); kk[i] = __builtin_nontemporal_load((const unsigned*)(Z + ZK + rb_ + (size_t)i * 128)); qq[i] = __builtin_nontemporal_load((const unsigned*)(Z + ZQ + rb_ + (size_t)i * 128)); } \
            else { la2[i] = *(const unsigned*)(LA + rb_ + (size_t)i * 128); kk[i] = *(const unsigned*)(Z + ZK + rb_ + (size_t)i * 128); } } \
    } while (0)
#define GLA_LOADV(tcx) do { \
        _Pragma("unroll") for (int i = 0; i < 4; ++i) { const u32x4* vp_ = (const u32x4*)(Z + ZV + ((size_t)hd * M + (tcx) + (lane >> 2) + 16 * i) * 256 + 32 * w + 8 * (lane & 3)); Vst[i] = OUT ? __builtin_nontemporal_load(vp_) : *vp_; } \
    } while (0)
#define GLA_VFRAG() do { LAS unsigned char* vb_ = L + L_OT + w * 4096; \
        _Pragma("unroll") for (int i = 0; i < 4; ++i) *(LAS u32x4*)(vb_ + i * 1024 + lane * 16) = Vst[i]; \
        const int li_ = lane & 15, g_ = lane >> 4; \
        LAS unsigned char* tp_ = vb_ + ((8 * (g_ >> 1) + (li_ >> 2)) * 64 + (16 * (g_ & 1) + 4 * (li_ & 3)) * 2); \
        _Pragma("unroll") for (int ks = 0; ks < 4; ++ks) { \
            const s16x4 lo_ = __builtin_amdgcn_ds_read_tr16_b64_v4i16((LAS s16x4*)(tp_ + (16 * ks) * 64)), hi_ = __builtin_amdgcn_ds_read_tr16_b64_v4i16((LAS s16x4*)(tp_ + (16 * ks + 4) * 64)); \
            Bv[ks] = __builtin_shufflevector(lo_, hi_, 0, 1, 2, 3, 4, 5, 6, 7); } \
    } while (0)
#define GLA_LOADR(tcx) do { \
        if (OUT) { const u32x4* rp_ = (const u32x4*)(Z + ZR + ((size_t)hd * M + (tcx) + tok_n) * 256 + 32 * part); _Pragma("unroll") for (int i = 0; i < 4; ++i) rc[i] = __builtin_nontemporal_load(rp_ + i); } \
    } while (0)
    u32x4 cv_c[4], cv_b[4], cv_p2, cv_p1; float cu1[8], cu2[8];
    const bool do_conv = !OUT && cblk >= 0;
    const int cm0 = cblk * 8, cs0 = do_conv ? cm0 % SEQ : 0;
#define CONV_ISSUE(sub) do { if (do_conv) { const int cj_ = (sub) >> 1, chb_ = (sub) & 1, cc_ = 8 * lane + 512 * cj_; \
        if (chb_ == 0) { const size_t rp_ = (size_t)(cs0 > 0 ? cm0 - 2 : cm0); \
            cv_p2 = __builtin_nontemporal_load((const u32x4*)(Z + ZCC + rp_ * 1024 + cc_)); cv_p1 = __builtin_nontemporal_load((const u32x4*)(Z + ZCC + (rp_ + 1) * 1024 + cc_)); \
 } \
        _Pragma("unroll") for (int rr = 0; rr < 4; ++rr) { const size_t row_ = (size_t)(cm0 + 4 * chb_ + rr); \
            cv_c[rr] = __builtin_nontemporal_load((const u32x4*)(Z + ZCC + row_ * 1024 + cc_)); cv_b[rr] = __builtin_nontemporal_load((const u32x4*)(Z + ZCB + row_ * 1024 + cc_)); } } } while (0)
#define CONV_FINISH(sub) do { if (do_conv) { const int cj_ = (sub) >> 1, chb_ = (sub) & 1, cc_ = 8 * lane + 512 * cj_; float cw0[8], cw1[8], cw2[8]; \
        { const LAS f32x4* wp_ = (const LAS f32x4*)(L + L_WC + 4 * cc_); _Pragma("unroll") for (int i = 0; i < 2; ++i) { const f32x4 t0_ = wp_[i], t1_ = wp_[256 + i], t2_ = wp_[512 + i]; \
            _Pragma("unroll") for (int q = 0; q < 4; ++q) { cw0[4 * i + q] = t0_[q]; cw1[4 * i + q] = t1_[q]; cw2[4 * i + q] = t2_[q]; } } } \
        if (chb_ == 0) { const float keep_ = cs0 > 0 ? 1.0f : 0.0f; \
            _Pragma("unroll") for (int i = 0; i < 4; ++i) { cu2[2 * i] = keep_ * bf_lo(cv_p2[i]); cu2[2 * i + 1] = keep_ * bf_hi(cv_p2[i]); cu1[2 * i] = keep_ * bf_lo(cv_p1[i]); cu1[2 * i + 1] = keep_ * bf_hi(cv_p1[i]); } } \
        _Pragma("unroll") for (int rr = 0; rr < 4; ++rr) { float u0_[8], y_[8]; \
            _Pragma("unroll") for (int i = 0; i < 4; ++i) { u0_[2 * i] = bf_lo(cv_c[rr][i]); u0_[2 * i + 1] = bf_hi(cv_c[rr][i]); } \
            _Pragma("unroll") for (int i = 0; i < 8; ++i) y_[i] = cw0[i] * cu2[i] + cw1[i] * cu1[i] + cw2[i] * u0_[i]; \
            u32x4 ow_; _Pragma("unroll") for (int i = 0; i < 4; ++i) ow_[i] = pk2(bf_lo(cv_b[rr][i]) * y_[2 * i], bf_hi(cv_b[rr][i]) * y_[2 * i + 1]); \
            *(u32x4*)(WSP(bf16, WS_PB) + (size_t)(cm0 + 4 * chb_ + rr) * 1024 + cc_) = ow_; \
            _Pragma("unroll") for (int i = 0; i < 8; ++i) { cu2[i] = cu1[i]; cu1[i] = u0_[i]; } } } } while (0)
    if (OUT) { if (tid < 256) ((LAS float*)(L + L_GG))[tid] = F.g_gla[hd * 256 + tid]; }
    else if (do_conv) {
#pragma unroll
        for (int i = 0; i < 6; ++i) ((LAS float*)(L + L_WC))[tid + 512 * i] = F.w_conv[tid + 512 * i]; }
    GLA_LOAD(t0);
#if MK_HORNER
    if (OUT) {
        __syncthreads();
        constexpr int HB = MK_HB;
        const unsigned* Ub = WSP(const unsigned, WS_U) + (size_t)(bh * 8) * 16384 + (size_t)w * 2048 + lane;
#pragma unroll 1
        for (int j0 = 0; j0 < sc; j0 += HB) {
            unsigned uw[HB][32];
#pragma unroll
            for (int jj = 0; jj < HB; ++jj) if (j0 + jj < sc) {
#pragma unroll
                for (int q = 0; q < 32; ++q) uw[jj][q] = Ub[(size_t)(j0 + jj) * 16384 + q * 64]; }
#pragma unroll
            for (int jj = 0; jj < HB; ++jj) if (j0 + jj < sc) {
                const LAS float* dl = (const LAS float*)(L + L_OT) + (j0 + jj) * 128;
#pragma unroll
                for (int kb = 0; kb < 4; ++kb)
#pragma unroll
                    for (int rp = 0; rp < 8; ++rp) { const f32x2 dc = *(const LAS f32x2*)(dl + 32 * kb + crow(2 * rp, h)); const unsigned u = uw[jj][kb * 8 + rp];
                        S[kb][2 * rp] = dc.x * S[kb][2 * rp] + bf_lo(u); S[kb][2 * rp + 1] = dc.y * S[kb][2 * rp + 1] + bf_hi(u); } }
        }
    }
#endif
    GLA_LOADV(t0);
#pragma unroll 1
    for (int c = 0; c < 4; ++c) {
        const int tc = t0 + c * 64;
        float p0[8], p1[8];
        { float r0 = 0.f, r1 = 0.f;
#pragma unroll
          for (int i = 0; i < 8; ++i) { r0 += bf_lo(la2[i]); r1 += bf_hi(la2[i]); p0[i] = r0; p1[i] = r1; }
          *(LAS f32x2*)(L + L_SEG + (w * 128 + 2 * lane) * 4) = (f32x2){r0, r1}; }
        GLA_LOADR(tc);
        CONV_ISSUE(c);
        __syncthreads();
        GLA_VFRAG();
        float off0 = 0.f, off1 = 0.f, bt0 = 0.f, bt1 = 0.f;
#pragma unroll
        for (int sgi = 0; sgi < 8; ++sgi) { const f32x2 sv = *(const LAS f32x2*)(L + L_SEG + (sgi * 128 + 2 * lane) * 4); if (sgi < w) { off0 += sv.x; off1 += sv.y; } bt0 += sv.x; bt1 += sv.y; }
        if (w == 0) { *(LAS f32x2*)(L + L_DEC + 8 * lane) = (f32x2){__expf(bt0), __expf(bt1)}; btot_run0 += bt0; btot_run1 += bt1; }
        {
            unsigned kt0[4], kt1[4];
#pragma unroll
            for (int i = 0; i < 8; i += 2) {
                const float b00 = off0 + p0[i], b01 = off1 + p1[i], b10 = off0 + p0[i + 1], b11 = off1 + p1[i + 1];
                const float k00 = bf_lo(kk[i]), k01 = bf_hi(kk[i]), k10 = bf_lo(kk[i + 1]), k11 = bf_hi(kk[i + 1]);
                kt0[i >> 1] = pk2(k00 * __expf(bt0 - b00), k10 * __expf(bt0 - b10));
                kt1[i >> 1] = pk2(k01 * __expf(bt1 - b01), k11 * __expf(bt1 - b11));
                if (OUT) {
                    const float q00 = bf_lo(qq[i]), q01 = bf_hi(qq[i]), q10 = bf_lo(qq[i + 1]), q11 = bf_hi(qq[i + 1]);
                    *(LAS unsigned*)(L + L_QD + (8 * w + i) * QD_STRIDE + 4 * lane) = pk2(q00 * __expf(b00), q01 * __expf(b01));
                    *(LAS unsigned*)(L + L_QD + (8 * w + i + 1) * QD_STRIDE + 4 * lane) = pk2(q10 * __expf(b10), q11 * __expf(b11));
                    *(LAS unsigned*)(L + L_KI + (8 * w + i) * QD_STRIDE + 4 * lane) = pk2(k00 * __expf(-b00), k01 * __expf(-b01));
                    *(LAS unsigned*)(L + L_KI + (8 * w + i + 1) * QD_STRIDE + 4 * lane) = pk2(k10 * __expf(-b10), k11 * __expf(-b11));
                }
            }
            *(LAS u32x4*)(L + L_KT + (2 * lane) * KT_STRIDE + 16 * w) = (u32x4){kt0[0], kt0[1], kt0[2], kt0[3]};
            *(LAS u32x4*)(L + L_KT + (2 * lane + 1) * KT_STRIDE + 16 * w) = (u32x4){kt1[0], kt1[1], kt1[2], kt1[3]};
        }
        __syncthreads();
        if (c < 3) GLA_LOAD(tc + 64);
        f32x16 o[2];
        if (OUT) {
            if (w < 3) {
                const int ib = w == 0 ? 0 : 1, jb = w == 2 ? 1 : 0;
                f32x16 sacc;
#pragma unroll
                for (int r = 0; r < 16; ++r) sacc[r] = 0.f;
#pragma unroll
                for (int kb = 0; kb < 8; ++kb) {
                    const bf16x8 a = *(const LAS bf16x8*)(L + L_QD + (32 * ib + r32) * QD_STRIDE + 2 * (16 * kb + 8 * h));
                    const bf16x8 bb = *(const LAS bf16x8*)(L + L_KI + (32 * jb + r32) * QD_STRIDE + 2 * (16 * kb + 8 * h));
                    sacc = __builtin_amdgcn_mfma_f32_32x32x16_bf16(a, bb, sacc, 0, 0, 0);
                }
#pragma unroll
                for (int r = 0; r < 16; r += 1) {
                    const int i = 32 * ib + crow(r, h), j = 32 * jb + r32;
                    const float v = (j <= i) ? sacc[r] : 0.f;
                    *(LAS bf16*)(L + L_SC + i * SC_STRIDE + 2 * j) = (bf16)(pk2(v, 0.f) & 0xffffu);
                }
            }
#pragma unroll
            for (int ib = 0; ib < 2; ++ib)
#pragma unroll
                for (int r = 0; r < 16; ++r) o[ib][r] = 0.f;
#pragma unroll
            for (int kb = 0; kb < 4; ++kb)
#pragma unroll
                for (int s2 = 0; s2 < 2; ++s2) {
                    u32x4 pb; pb.x = pk2(S[kb][8 * s2 + 0], S[kb][8 * s2 + 1]); pb.y = pk2(S[kb][8 * s2 + 2], S[kb][8 * s2 + 3]); pb.z = pk2(S[kb][8 * s2 + 4], S[kb][8 * s2 + 5]); pb.w = pk2(S[kb][8 * s2 + 6], S[kb][8 * s2 + 7]);
                    const bf16x8 bfrag = __builtin_bit_cast(bf16x8, pb);
#pragma unroll
                    for (int ib = 0; ib < 2; ++ib) {
                        const LAS unsigned char* qp = L + L_QD + (32 * ib + r32) * QD_STRIDE + 2 * (32 * kb + 16 * s2 + 4 * h);
                        const u32x2 lo = *(const LAS u32x2*)qp, hi = *(const LAS u32x2*)(qp + 16);
                        const bf16x8 afrag = __builtin_bit_cast(bf16x8, (u32x4){lo.x, lo.y, hi.x, hi.y});
                        o[ib] = __builtin_amdgcn_mfma_f32_32x32x16_bf16(afrag, bfrag, o[ib], 0, 0, 0);
                    }
                }
            __syncthreads();
#pragma unroll
            for (int ks = 0; ks < 4; ++ks)
#pragma unroll
                for (int ib = 0; ib < 2; ++ib) {
                    if (ib == 0 && ks >= 2) continue;
                    const bf16x8 a = *(const LAS bf16x8*)(L + L_SC + (32 * ib + r32) * SC_STRIDE + 2 * (16 * ks + 8 * h));
                    o[ib] = __builtin_amdgcn_mfma_f32_32x32x16_bf16(a, Bv[ks], o[ib], 0, 0, 0);
                }
        }
#pragma unroll
        for (int kb = 0; kb < 4; ++kb) {
#pragma unroll
            for (int g4 = 0; g4 < 4; ++g4) { const f32x4 dc = *(const LAS f32x4*)(L + L_DEC + 4 * (32 * kb + 8 * g4 + 4 * h));
#pragma unroll
                for (int j = 0; j < 4; ++j) S[kb][4 * g4 + j] *= dc[j]; }
#pragma unroll
            for (int ks = 0; ks < 4; ++ks) {
                const bf16x8 a = *(const LAS bf16x8*)(L + L_KT + (32 * kb + r32) * KT_STRIDE + 2 * (16 * ks + 8 * h));
                S[kb] = __builtin_amdgcn_mfma_f32_32x32x16_bf16(a, Bv[ks], S[kb], 0, 0, 0);
            }
        }
        if (c < 3) GLA_LOADV(tc + 64);
        CONV_FINISH(c);
        if (OUT) {
#pragma unroll
            for (int ib = 0; ib < 2; ++ib)
#pragma unroll
                for (int r = 0; r < 16; ++r) *(LAS float*)(L + L_OT + (32 * ib + crow(r, h)) * OT_STRIDE + 4 * (32 * w + r32)) = o[ib][r];
            __syncthreads();
            f32x4 ov[8]; float ss = 0.f;
#pragma unroll
            for (int i = 0; i < 8; ++i) { ov[i] = *(const LAS f32x4*)(L + L_OT + tok_n * OT_STRIDE + 4 * (32 * part + 4 * i)); ss += (ov[i].x * ov[i].x + ov[i].y * ov[i].y) + (ov[i].z * ov[i].z + ov[i].w * ov[i].w); }
            ss += __shfl_xor(ss, 1); ss += __shfl_xor(ss, 2); ss += __shfl_xor(ss, 4);
            const float rs = 1.0f / sqrtf(ss * (1.0f / 256.0f) + 1e-6f);
            const size_t trow = (size_t)(tc + tok_n);
            const LAS f32x4* gp = (const LAS f32x4*)(L + L_GG + 4 * (32 * part));
            u32x4* op = (u32x4*)(WSP(bf16, WS_OG) + trow * 1024 + hd * 256 + 32 * part);
            const rsrc_t ogr = __builtin_amdgcn_make_buffer_rsrc(F.ws + WS_OG, (short)0, (int)((size_t)M * 1024 * 2), 0x00020000);
#pragma unroll
            for (int i = 0; i < 4; ++i) {
                const u32x4 rr = rc[i]; const f32x4 g0 = gp[2 * i], g1 = gp[2 * i + 1]; const f32x4 a0 = ov[2 * i], a1 = ov[2 * i + 1];
                u32x4 ow;
                ow.x = pk2(a0.x * rs * g0.x * bf_lo(rr.x), a0.y * rs * g0.y * bf_hi(rr.x));
                ow.y = pk2(a0.z * rs * g0.z * bf_lo(rr.y), a0.w * rs * g0.w * bf_hi(rr.y));
                ow.z = pk2(a1.x * rs * g1.x * bf_lo(rr.z), a1.y * rs * g1.y * bf_hi(rr.z));
                ow.w = pk2(a1.z * rs * g1.z * bf_lo(rr.w), a1.w * rs * g1.w * bf_hi(rr.w));
                if (ho) st16_wt(ogr, (unsigned)((trow * 1024 + hd * 256 + 32 * part + 8 * i) * 2), ow); else op[i] = ow;
            }
        }
    }
#undef GLA_LOAD
#undef GLA_LOADV
#undef GLA_VFRAG
#undef GLA_LOADR
#undef CONV_ISSUE
#undef CONV_FINISH
    if (!OUT) {
#pragma unroll
        for (int kb = 0; kb < 4; ++kb)
#pragma unroll
            for (int r = 0; r < 16; r += 2) Sbuf[(kb * 8 + (r >> 1)) * 64 + lane] = pk2(S[kb][r], S[kb][r + 1]);
        if (w == 0) *(f32x2*)(WSP(float, WS_DECS) + item * 128 + 2 * lane) = (f32x2){__expf(btot_run0), __expf(btot_run1)};
    }
    if (OUT && ho) panel_publish(F.ctl + CW_RDY2 + 32 * (t0 / 256));
    __syncthreads();
}

__device__ __forceinline__ void conv_rows(Frame& F, const int nrep, const int first_skip) {
    const int gw = F.vcu * NWAVES + F.wave, NGW = F.G * NWAVES;
    const bf16* Z = WSP(const bf16, WS_Z); bf16* PB = WSP(bf16, WS_PB);
    for (int blk0 = gw + first_skip * NGW; blk0 < (M / 8) * nrep; blk0 += NGW) {
        const int blk = blk0 % (M / 8);
        const int m0 = blk * 8, s0 = m0 % SEQ;
#pragma unroll 1
        for (int j = 0; j < 2; ++j) {
            const int c = 8 * F.lane + 512 * j;
            const size_t rp = (size_t)(s0 > 0 ? m0 - 2 : m0);
            const u32x4 p2c = *(const u32x4*)(Z + ZCC + rp * 1024 + c);
            const u32x4 p1c = *(const u32x4*)(Z + ZCC + (rp + 1) * 1024 + c);
            float w0[8], w1[8], w2[8];
#pragma unroll
            for (int i = 0; i < 8; ++i) { w0[i] = F.w_conv[c + i]; w1[i] = F.w_conv[1024 + c + i]; w2[i] = F.w_conv[2048 + c + i]; }
            float u1[8], u2[8];
            const float keep = s0 > 0 ? 1.0f : 0.0f;
#pragma unroll
            for (int i = 0; i < 4; ++i) { u2[2 * i] = keep * bf_lo(p2c[i]); u2[2 * i + 1] = keep * bf_hi(p2c[i]); u1[2 * i] = keep * bf_lo(p1c[i]); u1[2 * i + 1] = keep * bf_hi(p1c[i]); }
#pragma unroll
            for (int hb = 0; hb < 2; ++hb) {
                u32x4 cc[4], cb[4];
#pragma unroll
                for (int rr = 0; rr < 4; ++rr) { const size_t row = (size_t)(m0 + 4 * hb + rr); cc[rr] = __builtin_nontemporal_load((const u32x4*)(Z + ZCC + row * 1024 + c)); cb[rr] = __builtin_nontemporal_load((const u32x4*)(Z + ZCB + row * 1024 + c)); }
#pragma unroll
                for (int rr = 0; rr < 4; ++rr) {
                    float u0[8], y[8];
#pragma unroll
                    for (int i = 0; i < 4; ++i) { u0[2 * i] = bf_lo(cc[rr][i]); u0[2 * i + 1] = bf_hi(cc[rr][i]); }
#pragma unroll
                    for (int i = 0; i < 8; ++i) y[i] = w0[i] * u2[i] + w1[i] * u1[i] + w2[i] * u0[i];
                    u32x4 ow;
#pragma unroll
                    for (int i = 0; i < 4; ++i) ow[i] = pk2(bf_lo(cb[rr][i]) * y[2 * i], bf_hi(cb[rr][i]) * y[2 * i + 1]);
                    *(u32x4*)(PB + (size_t)(m0 + 4 * hb + rr) * 1024 + c) = ow;
#pragma unroll
                    for (int i = 0; i < 8; ++i) { u2[i] = u1[i]; u1[i] = u0[i]; }
                }
                asm volatile("" ::: "memory");
            }
        }
    }
}

__device__ __forceinline__ void gla_scan(Frame& F, const int nrep) {
    const unsigned* U = WSP(const unsigned, WS_U); unsigned* SIN = WSP(unsigned, WS_SIN); const float* DECS = WSP(const float, WS_DECS);
    const int gt = F.vcu * 512 + F.tid, NT = F.G * 512;
    for (int idx0 = gt; idx0 < 32 * 16384 * nrep; idx0 += NT) {
        const int idx = idx0 & (32 * 16384 - 1);
        const int bh = idx >> 14, e = idx & 16383;
        const int ln = e & 63, rp = (e >> 6) & 7, kb = (e >> 9) & 3;
        const int dk = 32 * kb + crow(2 * rp, ln >> 5);
        float s0 = 0.f, s1 = 0.f;
        unsigned uw[8];
#pragma unroll
        for (int sc = 0; sc < 8; ++sc) uw[sc] = U[(size_t)(bh * 8 + sc) * 16384 + e];
#pragma unroll
        for (int sc = 0; sc < 8; ++sc) {
            const int item = bh * 8 + sc;
            SIN[(size_t)item * 16384 + e] = pk2(s0, s1);
            const f32x2 dc = *(const f32x2*)(DECS + item * 128 + dk);
            s0 = dc.x * s0 + bf_lo(uw[sc]); s1 = dc.y * s1 + bf_hi(uw[sc]);
        }
    }
}

struct P3Order : pg8::StaticOrder {
    unsigned* sig;
    __device__ __forceinline__ bool next(int i, pg8::Unit& u) const {
        if (!pg8::StaticOrder::next(i >> 1, u)) return false;
        u.e = i & 1; u.pn += 4 * u.e; return true;
    }
    __device__ __forceinline__ unsigned arow(const pg8::Unit& u, int ui, int r) const { return (unsigned)(u.e * M + u.pm * 256 + r) * 2048u; }
    __device__ __forceinline__ void after_unit(int ui) const { if (sig != nullptr && ui == 1) panel_publish(sig); }
    __device__ __forceinline__ bool keep_acc(int ui) const { return (ui & 1) == 0; }
};
struct EpiBranch {
    static constexpr bool PERM = true;
    const bf16* Z; bf16* MIX; rsrc_t mixr; bool wt;
    __device__ __forceinline__ void operator()(f32x4 (&acc)[2][2][4][2], const pg8::Unit& u, int wr, int wc, int fr, int fq) const {
        const int row0 = u.pm * 256 + wr * 64 + fr, col0 = (u.pn & 3) * 256 + wc * 32 + 8 * fq;
        const unsigned char* GA = (const unsigned char*)(Z + ZGA); const unsigned char* GB = (const unsigned char*)(Z + ZGB);
        if (u.e == 0) {
#pragma unroll
            for (int ai = 0; ai < 2; ++ai) {
                u32x2 gb[4][2], ga[4][2];
#pragma unroll
                for (int m = 0; m < 4; ++m)
#pragma unroll
                    for (int bj = 0; bj < 2; ++bj) { const size_t o = (size_t)(row0 + ai * 128 + m * 16) * 1024 + col0 + bj * 128;
                        gb[m][bj] = *(const u32x2*)(GB + o); ga[m][bj] = __builtin_nontemporal_load((const u32x2*)(GA + o)); }
#pragma unroll
                for (int m = 0; m < 4; ++m)
#pragma unroll
                    for (int bj = 0; bj < 2; ++bj) {
#pragma unroll
                        for (int j = 0; j < 4; ++j) {
                            const float b0 = fmaxf((float)((gb[m][bj].x >> (8 * j)) & 255u), 1.0f), b1 = fmaxf((float)((gb[m][bj].y >> (8 * j)) & 255u), 1.0f);
                            acc[ai][bj][m][0][j] *= (float)((ga[m][bj].x >> (8 * j)) & 255u) * __builtin_amdgcn_rcpf(b0);
                            acc[ai][bj][m][1][j] *= (float)((ga[m][bj].y >> (8 * j)) & 255u) * __builtin_amdgcn_rcpf(b1); } }
            }
        } else {
            u32x2 gb[2][4][2];
#pragma unroll
            for (int ai = 0; ai < 2; ++ai)
#pragma unroll
                for (int m = 0; m < 4; ++m)
#pragma unroll
                    for (int bj = 0; bj < 2; ++bj) gb[ai][m][bj] = __builtin_nontemporal_load((const u32x2*)(GB + (size_t)(row0 + ai * 128 + m * 16) * 1024 + col0 + bj * 128));
#pragma unroll
            for (int ai = 0; ai < 2; ++ai)
#pragma unroll
                for (int m = 0; m < 4; ++m) { const size_t row = (size_t)(row0 + ai * 128 + m * 16);
#pragma unroll
                    for (int bj = 0; bj < 2; ++bj) { float sb[8];
#pragma unroll
                        for (int j = 0; j < 4; ++j) { sb[j] = fmaxf((float)((gb[ai][m][bj].x >> (8 * j)) & 255u), 1.0f) * (1.0f / 255.0f); sb[4 + j] = fmaxf((float)((gb[ai][m][bj].y >> (8 * j)) & 255u), 1.0f) * (1.0f / 255.0f); }
                        const f32x4 v0 = acc[ai][bj][m][0], v1 = acc[ai][bj][m][1];
                        u32x4 w; w.x = pk2(v0[0] * sb[0], v0[1] * sb[1]); w.y = pk2(v0[2] * sb[2], v0[3] * sb[3]); w.z = pk2(v1[0] * sb[4], v1[1] * sb[5]); w.w = pk2(v1[2] * sb[6], v1[3] * sb[7]);
                        if (wt) st16_wt(mixr, (unsigned)((row * 1024 + col0 + bj * 128) * 2), w); else *(u32x4*)(MIX + row * 1024 + col0 + bj * 128) = w; } }
        }
    }
};
struct P4Order : pg8::StaticOrder {
    unsigned* sig;
    __device__ __forceinline__ void after_unit(int ui) const { if (sig != nullptr && ui == 0) panel_publish(sig); }
};
struct EpiX1 {
    static constexpr bool PERM = true;
    const float* x; bf16* X1; rsrc_t x1r; bool wt;
    __device__ __forceinline__ void operator()(const f32x4 (&acc)[2][2][4][2], const pg8::Unit& u, int wr, int wc, int fr, int fq) const {
        const int row0 = u.pm * 256 + wr * 64 + fr, col0 = u.pn * 256 + wc * 32 + 8 * fq;
#pragma unroll
        for (int ai = 0; ai < 2; ++ai) {
            f32x4 xv[4][2][2];
#pragma unroll
            for (int m = 0; m < 4; ++m) { const size_t off = (size_t)(row0 + ai * 128 + m * 16) * 1024 + col0;
#pragma unroll
                for (int bj = 0; bj < 2; ++bj) { xv[m][bj][0] = __builtin_nontemporal_load((const f32x4*)(x + off + bj * 128)); xv[m][bj][1] = __builtin_nontemporal_load((const f32x4*)(x + off + bj * 128 + 4)); } }
#pragma unroll
            for (int m = 0; m < 4; ++m) { const size_t off = (size_t)(row0 + ai * 128 + m * 16) * 1024 + col0;
#pragma unroll
                for (int bj = 0; bj < 2; ++bj) { const f32x4 v0 = xv[m][bj][0] + acc[ai][bj][m][0], v1 = xv[m][bj][1] + acc[ai][bj][m][1];
                    u32x4 w; w.x = pk2(v0[0], v0[1]); w.y = pk2(v0[2], v0[3]); w.z = pk2(v1[0], v1[1]); w.w = pk2(v1[2], v1[3]);
                    if (wt) st16_wt(x1r, (unsigned)((off + bj * 128) * 2), w); else *(u32x4*)(X1 + off + bj * 128) = w; } }
        }
    }
};

constexpr int P5_WLD = 2064;
constexpr int P5_WH = 0, P5_WL = 32 * P5_WLD;
constexpr int P5_RSTD = 133120, P5_LOGT = 133376;
constexpr int P5_HIST = 141824, P5_BASE = P5_HIST + 128, P5_PLE = P5_HIST + 256;
__device__ __forceinline__ void p5_router(Frame& F, const int grp_one = -1) {
    LAS unsigned char* L = F.lds;
    LAS float* RSTD = (LAS float*)(L + P5_RSTD); LAS float* LOGT = (LAS float*)(L + P5_LOGT);
    LAS int* hist = (LAS int*)(L + P5_HIST); LAS int* base = (LAS int*)(L + P5_BASE); LAS int* ple = (LAS int*)(L + P5_PLE);
    const bf16* X1 = WSP(const bf16, WS_X1); unsigned char* H2 = WSP(unsigned char, WS_XN);
    unsigned* cnt = F.ctl + CW_CNT; int* list = WSP(int, WS_LIST); float* glist = WSP(float, WS_GLIST); LAS float* plg = (LAS float*)(L + P5_PLE + 1024);
    const int lane = F.lane, w = F.wave, r32 = lane & 31, h = lane >> 5;
    f32x4 g[4];
#pragma unroll
    for (int j = 0; j < 4; ++j) g[j] = *((const f32x4*)F.g_ffn + lane + 64 * j);
    for (int grp = grp_one >= 0 ? grp_one : F.vcu; grp < M / 64; grp += (grp_one >= 0 ? M : F.G)) {
        { const unsigned char* RT = F.ws + WS_RT;
#pragma unroll
          for (int j = 0; j < 17; ++j) { const int ch = 8 * j + w; if (ch < 129) __builtin_amdgcn_global_load_lds((const unsigned*)(RT + ch * 1024 + lane * 16), (LAS unsigned*)(L + ch * 1024), 16, 0, 0); } }
        if (F.tid < 32) hist[F.tid] = 0;
        const size_t tok0 = (size_t)grp * 64;
        { u32x2 xv[8][4];
#pragma unroll
          for (int i = 0; i < 8; ++i) { const u32x2* xa = (const u32x2*)(X1 + (tok0 + 8 * w + i) * D) + lane;
#pragma unroll
              for (int j = 0; j < 4; ++j) xv[i][j] = xa[64 * j]; }
#pragma unroll
          for (int i = 0; i < 8; ++i) { f32x4 v[4]; float ss = 0.f;
#pragma unroll
              for (int j = 0; j < 4; ++j) { v[j] = (f32x4){bf_lo(xv[i][j].x), bf_hi(xv[i][j].x), bf_lo(xv[i][j].y), bf_hi(xv[i][j].y)};
#pragma unroll
                  for (int c = 0; c < 4; ++c) ss = fmaf(v[j][c], v[j][c], ss); }
              const float rs = 1.0f / sqrtf(wave_sum(ss) * (1.f / D) + 1e-6f);
              if (lane == 0) RSTD[8 * w + i] = rs;
              unsigned* o4 = (unsigned*)(H2 + (tok0 + 8 * w + i) * D) + lane;
#pragma unroll
              for (int j = 0; j < 4; ++j) { const f32x4 hv = v[j] * rs * g[j]; o4[64 * j] = pk4_fp8(hv.x, hv.y, hv.z, hv.w); } } }
        bf16x8 af[2][8];
        { const bf16* xa = X1 + (tok0 + r32) * D + 128 * w + 8 * h;
#pragma unroll
          for (int mt = 0; mt < 2; ++mt)
#pragma unroll
              for (int ks = 0; ks < 8; ++ks) af[mt][ks] = *(const bf16x8*)(xa + (size_t)mt * 32 * D + 16 * ks); }
        const f32x4 brv = *(const f32x4*)(F.b_router + 4 * (F.tid & 7));
        __syncthreads();
        f32x16 acc[2];
#pragma unroll
        for (int mt = 0; mt < 2; ++mt)
#pragma unroll
            for (int r = 0; r < 16; ++r) acc[mt][r] = 0.f;
#pragma unroll
        for (int ks = 0; ks < 8; ++ks) {
            const bf16x8 bh = *(const LAS bf16x8*)(L + P5_WH + r32 * P5_WLD + 2 * (128 * w + 16 * ks + 8 * h));
            const bf16x8 bl = *(const LAS bf16x8*)(L + P5_WL + r32 * P5_WLD + 2 * (128 * w + 16 * ks + 8 * h));
#pragma unroll
            for (int mt = 0; mt < 2; ++mt) { acc[mt] = __builtin_amdgcn_mfma_f32_32x32x16_bf16(af[mt][ks], bh, acc[mt], 0, 0, 0); acc[mt] = __builtin_amdgcn_mfma_f32_32x32x16_bf16(af[mt][ks], bl, acc[mt], 0, 0, 0); }
        }
        __syncthreads();
#pragma unroll
        for (int mt = 0; mt < 2; ++mt)
#pragma unroll
            for (int r = 0; r < 16; ++r) *(LAS float*)(L + ((w * 64 + 32 * mt + crow(r, h)) * 32 + r32) * 4) = acc[mt][r];
        __syncthreads();
        { const int tk = F.tid >> 3, eq = F.tid & 7;
          f32x4 sum = *(const LAS f32x4*)(L + ((0 * 64 + tk) * 32 + 4 * eq) * 4);
#pragma unroll
          for (int ww = 1; ww < 8; ++ww) sum = sum + *(const LAS f32x4*)(L + ((ww * 64 + tk) * 32 + 4 * eq) * 4);
          const float rs = RSTD[tk]; const f32x4 bb = brv;
#pragma unroll
          for (int c = 0; c < 4; ++c) LOGT[tk * 33 + 4 * eq + c] = sum[c] * rs + bb[c]; }
        __syncthreads();
        if (F.tid < 64) {
            const int tk = F.tid; float tv[4]; int ti[4];
#pragma unroll
            for (int k = 0; k < 4; ++k) { float bv = -3.0e38f; int bi = 0;
                for (int e = 0; e < 32; ++e) { const float v = LOGT[tk * 33 + e]; if (v > bv) { bv = v; bi = e; } }
                tv[k] = bv; ti[k] = bi; LOGT[tk * 33 + bi] = -3.0e38f; }
            const float e1 = __expf(tv[1] - tv[0]), e2 = __expf(tv[2] - tv[0]), e3 = __expf(tv[3] - tv[0]);
            const float inv = 1.0f / (1.0f + e1 + e2 + e3);
            const float gk[4] = {inv, e1 * inv, e2 * inv, e3 * inv};
#pragma unroll
            for (int k = 0; k < 4; ++k) { const int lr = __hip_atomic_fetch_add(&hist[ti[k]], 1, __ATOMIC_RELAXED, __HIP_MEMORY_SCOPE_WORKGROUP);
                ple[tk * 4 + k] = ti[k] | (lr << 8); plg[tk * 4 + k] = gk[k] * 16.0f; }
        }
        __syncthreads();
        if (F.tid < 32) base[F.tid] = (int)__hip_atomic_fetch_add(cnt + F.tid, (unsigned)hist[F.tid], RLX_AGENT);
        __syncthreads();
        if (F.tid < 256) { const int pe = ple[F.tid], e = pe & 255, lr = pe >> 8; list[e * CAP + base[e] + lr] = (grp * 64) * 4 + F.tid; glist[e * CAP + base[e] + lr] = plg[F.tid]; }
        __syncthreads();
    }
}

#ifndef MK_MAXU
#define MK_MAXU 9
#endif
constexpr int MAXU = MK_MAXU;
constexpr int MOE_BIAS1 = 256 + MAXU * 1024;
template <int NP>
struct MoeOrder {
    static constexpr bool PARTIAL = false;
    LAS const int* rt0;
    LAS const int* tokl;
    LAS const i32x4* ut;
    int nwg, G, c, reps, nun;
    __device__ __forceinline__ bool next(int i, pg8::Unit& u) const {
        if (i >= nun) return false;
        const i32x4 t = ut[i];
        u.pm = __builtin_amdgcn_readfirstlane(t.x); u.pn = __builtin_amdgcn_readfirstlane(t.y); u.e = __builtin_amdgcn_readfirstlane(t.z); { const int w_ = __builtin_amdgcn_readfirstlane(t.w); u.rt = w_ & 0xffff; u.hm = w_ >> 16; } u.ui = i; return true;
    }
    int split = 0;
    __device__ __forceinline__ int full_rounds() const { return nwg / G; }
    __device__ __forceinline__ bool tail_split() const { const int rem = nwg % G; return split && reps == 1 && rem > 0 && 2 * rem <= G; }
    __device__ __forceinline__ int count() const { if (tail_split()) return full_rounds() + (c < 2 * (nwg % G) ? 1 : 0); const int nu = (nwg * reps - c + G - 1) / G; return nu < 0 ? 0 : nu; }
    __device__ __forceinline__ bool compute(int i, pg8::Unit& u) const {
        long L = (long)i * G + c; u.hm = 3;
        if (tail_split() && i >= full_rounds()) { const int rem = nwg % G; if (i > full_rounds() || c >= 2 * rem) return false; L = (long)full_rounds() * G + (c % rem); u.hm = (c >= rem) ? 2 : 1; }
        if (L >= (long)nwg * reps) return false;
        int wgid = (int)(L % nwg); { const int q = nwg / 8, r = nwg % 8, xcd = wgid % 8, off = wgid / 8; wgid = (xcd < r ? xcd * (q + 1) : r * (q + 1) + (xcd - r) * q) + off; }
        int e = 0;
#pragma unroll
        for (int q = 0; q < 8; ++q) { const i32x4 r4 = *(const LAS i32x4*)(rt0 + 4 * q);
#pragma unroll
            for (int t = 0; t < 4; ++t) if (4 * q + t >= 1) e += (wgid >= NP * r4[t]) ? 1 : 0; }
        const int l = wgid - NP * rt0[e], nte = rt0[e + 1] - rt0[e];
        const int pn = l / nte, rt = l - pn * nte;
        u.pm = __builtin_amdgcn_readfirstlane(rt0[e] + rt); u.pn = __builtin_amdgcn_readfirstlane(e * NP + pn); u.e = __builtin_amdgcn_readfirstlane(e); u.rt = __builtin_amdgcn_readfirstlane(rt); u.ui = i; return true;
    }
};
struct MoeOrder1 : MoeOrder<8> {
    __device__ __forceinline__ void after_unit(int ui) const {}
    __device__ __forceinline__ bool keep_acc(int ui) const { return false; }
    __device__ __forceinline__ unsigned arow(const pg8::Unit& u, int ui, int r) const { return (unsigned)tokl[ui * 256 + r] * 1024u; }
};
struct MoeOrder2 : MoeOrder<4> {
    static constexpr bool PARTIAL = true;
    __device__ __forceinline__ void after_unit(int ui) const {}
    __device__ __forceinline__ bool keep_acc(int ui) const { return false; }
    __device__ __forceinline__ unsigned arow(const pg8::Unit& u, int ui, int r) const { return (unsigned)(u.pm * 256 + r) * 1024u; }
};
struct EpiAct {
    static constexpr bool PERM = true;
    LAS const float* biasl; unsigned char* ACT;
    __device__ __forceinline__ void operator()(const f32x4 (&acc)[2][2][4][2], const pg8::Unit& u, int wr, int wc, int fr, int fq) const {
        const int pn = u.pn & 7, cl = pn * 128 + wc * 32 + 8 * fq;
        const int row0 = u.pm * 256 + wr * 64 + fr;
        const LAS float* bp = biasl + u.ui * 256 + wc * 32 + 8 * fq;
        const f32x4 bg0 = *(const LAS f32x4*)bp, bg1 = *(const LAS f32x4*)(bp + 4), bl0 = *(const LAS f32x4*)(bp + 128), bl1 = *(const LAS f32x4*)(bp + 132);
#pragma unroll
        for (int ai = 0; ai < 2; ++ai)
#pragma unroll
            for (int m = 0; m < 4; ++m) {
                float r0[4], r1[4];
#pragma unroll
                for (int hh = 0; hh < 2; ++hh) {
                    const f32x4 gq = (hh == 0 ? acc[ai][0][m][0] + bg0 : acc[ai][0][m][1] + bg1), lq = (hh == 0 ? acc[ai][1][m][0] + bl0 : acc[ai][1][m][1] + bl1);
#pragma unroll
                    for (int p = 0; p < 2; ++p) {
                        const f32x2 g = {gq[2 * p], gq[2 * p + 1]}, l = {lq[2 * p], lq[2 * p + 1]};
                        const f32x2 ga = __builtin_elementwise_min(g, (f32x2){7.0f, 7.0f});
                        const f32x2 la = __builtin_elementwise_min(__builtin_elementwise_max(l, (f32x2){-7.0f, -7.0f}), (f32x2){7.0f, 7.0f});
                        const f32x2 t = ga * (-1.702f * 1.4426950408889634f);
                        f32x2 d; d.x = __builtin_amdgcn_exp2f(t.x); d.y = __builtin_amdgcn_exp2f(t.y);
                        d = d + 1.0f;
                        f32x2 rc2; rc2.x = __builtin_amdgcn_rcpf(d.x); rc2.y = __builtin_amdgcn_rcpf(d.y);
                        const f32x2 o = (la + 1.0f) * (ga * rc2);
                        if (hh == 0) { r0[2 * p] = o.x; r0[2 * p + 1] = o.y; } else { r1[2 * p] = o.x; r1[2 * p + 1] = o.y; }
                    }
                }
                u32x2 w; w.x = pk4_fp8(r0[0], r0[1], r0[2], r0[3]); w.y = pk4_fp8(r1[0], r1[1], r1[2], r1[3]);
                *(u32x2*)(ACT + (size_t)(row0 + ai * 128 + m * 16) * 1024 + cl) = w;
            }
    }
};
constexpr int MAXU2 = 5;
struct EpiYP {
    static constexpr bool PERM = true;
    LAS const float* biasl; LAS const int* pidl; LAS const float* gatel; unsigned char* YP;
    __device__ __forceinline__ void operator()(const f32x4 (&acc)[2][2][4][2], const pg8::Unit& u, int wr, int wc, int fr, int fq) const {
        const int pn = u.pn & 3, col0 = pn * 256 + wc * 32 + 8 * fq;
        f32x4 bv[2][2];
#pragma unroll
        for (int bj = 0; bj < 2; ++bj)
#pragma unroll
            for (int n = 0; n < 2; ++n) bv[bj][n] = *(const LAS f32x4*)(biasl + u.ui * 256 + wc * 32 + 8 * fq + bj * 128 + 4 * n);
#pragma unroll
        for (int ai = 0; ai < 2; ++ai)
#pragma unroll
            for (int m = 0; m < 4; ++m) {
                const int rl = ai * 128 + wr * 64 + m * 16 + fr;
                const int pid = pidl[u.ui * 256 + rl];
                if (pid >= 0) {
                    const float gw = gatel[u.ui * 256 + rl];
#pragma unroll
                    for (int bj = 0; bj < 2; ++bj) { if (!((u.hm >> bj) & 1)) continue; const f32x4 v0 = (acc[ai][bj][m][0] + bv[bj][0]) * gw, v1 = (acc[ai][bj][m][1] + bv[bj][1]) * gw;
                        u32x2 w; w.x = pk4_fp8(v0[0], v0[1], v0[2], v0[3]); w.y = pk4_fp8(v1[0], v1[1], v1[2], v1[3]);
                        *(u32x2*)(YP + (size_t)pid * 1024 + col0 + bj * 128) = w; }
                }
            }
    }
};
constexpr int MOE_CNTL = 20672;
__device__ __forceinline__ int moe_setup(Frame& F, LAS int* rt0) {
    if (F.tid < 64) {
        const int e = F.lane & 31, n = (int)F.ctl[CW_CNT + e]; int v = (n + 255) >> 8, incl = v;
#pragma unroll
        for (int o = 1; o < 32; o <<= 1) { const int t = __shfl_up(incl, o, 32); if (e >= o) incl += t; }
        if (F.lane < 32) { rt0[e] = incl - v; if (e == 31) rt0[32] = incl; ((LAS int*)(F.lds + EXTRA_OFF + MOE_CNTL))[e] = n; }
    }
    __syncthreads();
    return rt0[32];
}

__device__ __forceinline__ void moe2_fill(Frame& F, const MoeOrder2& S) {
    LAS int* pidl = (LAS int*)(F.lds + EXTRA_OFF + 256); LAS float* gatel = (LAS float*)(F.lds + EXTRA_OFF + 256 + MAXU2 * 1024);
    const int* list = WSP(const int, WS_LIST); const float* glist = WSP(const float, WS_GLIST);
    const int ui = F.wave; pg8::Unit u;
    if (ui < MAXU2 && S.compute(ui, u)) { const int ne = ((LAS const int*)(F.lds + EXTRA_OFF + MOE_CNTL))[u.e]; int pd[4]; float gv[4];
        if (F.lane == 0) ((LAS i32x4*)(F.lds + EXTRA_OFF + 20480))[ui] = (i32x4){u.pm, u.pn, u.e, u.rt | (u.hm << 16)};
#pragma unroll
        for (int j = 0; j < 4; ++j) { const int slot = u.rt * 256 + F.lane + 64 * j; pd[j] = slot < ne ? list[u.e * CAP + slot] : -1; }
#pragma unroll
        for (int j = 0; j < 4; ++j) { const int slot = u.rt * 256 + F.lane + 64 * j; gv[j] = slot < ne ? glist[u.e * CAP + slot] : 0.f; }
#pragma unroll
        for (int j = 0; j < 4; ++j) { pidl[ui * 256 + F.lane + 64 * j] = pd[j]; gatel[ui * 256 + F.lane + 64 * j] = gv[j]; }
        *(LAS f32x4*)(F.lds + EXTRA_OFF + 256 + 2 * MAXU2 * 1024 + (ui * 256 + 4 * F.lane) * 4) = *(const f32x4*)(F.b_d + u.e * 1024 + (u.pn & 3) * 256 + 4 * F.lane); }
}

__device__ __forceinline__ void p8_final(Frame& F, const int nrep) {
    const int gw = F.vcu * NWAVES + F.wave, NGW = F.G * NWAVES;
    const bf16* X1 = WSP(const bf16, WS_X1); const unsigned char* YP = WSP(const unsigned char, WS_YP);
    f32x4 g[4];
#pragma unroll
    for (int j = 0; j < 4; ++j) g[j] = *((const f32x4*)F.g_final + F.lane + 64 * j);
    float pscale = 1.0f;
#ifdef MK_TPROBE
    { const unsigned long long* st = (const unsigned long long*)(F.ctl + CW_STAMP); const float dt_us = (float)(st[MK_TPROBE_J] - st[MK_TPROBE_I]) * 0.01f; pscale = 1.0f + sqrtf(dt_us * 1e-5f); }
#endif
    for (int m0 = gw; m0 < M * nrep; m0 += NGW) {
        const int m = m0 % M;
        const u32x2* xr = (const u32x2*)(X1 + (size_t)m * D) + F.lane;
        f32x4 v[4]; float s = 0.f;
#pragma unroll
        for (int j = 0; j < 4; ++j) { const u32x2 xw = __builtin_nontemporal_load(xr + 64 * j); v[j] = (f32x4){bf_lo(xw.x), bf_hi(xw.x), bf_lo(xw.y), bf_hi(xw.y)}; }
        f32x4 ys[4];
#pragma unroll
        for (int j = 0; j < 4; ++j) ys[j] = (f32x4){0.f, 0.f, 0.f, 0.f};
#pragma unroll
        for (int k = 0; k < 4; ++k) { const unsigned* yr = (const unsigned*)(YP + ((size_t)m * 4 + k) * 1024) + F.lane;
#pragma unroll
            for (int j = 0; j < 4; ++j) { const int y = (int)__builtin_nontemporal_load(yr + 64 * j); const f32x2 lo = __builtin_amdgcn_cvt_pk_f32_fp8(y, false), hi = __builtin_amdgcn_cvt_pk_f32_fp8(y, true);
                ys[j].x += lo.x; ys[j].y += lo.y; ys[j].z += hi.x; ys[j].w += hi.y; } }
#pragma unroll
        for (int j = 0; j < 4; ++j) v[j] = v[j] + ys[j] * 0.0625f;
#pragma unroll
        for (int j = 0; j < 4; ++j) s += (v[j].x * v[j].x + v[j].y * v[j].y) + (v[j].z * v[j].z + v[j].w * v[j].w);
        const float rstd = 1.0f / sqrtf(wave_sum(s) * (1.f / D) + 1e-6f);
        f32x4* op = (f32x4*)(F.out + (size_t)m * D) + F.lane;
#pragma unroll
        for (int j = 0; j < 4; ++j) __builtin_nontemporal_store(v[j] * (rstd * pscale) * g[j], op + 64 * j);
    }
}

struct Args { const float* in[18]; float* out; unsigned char* ws; int ph_lo, ph_hi, rep_k, rep_n; };
__global__ void __launch_bounds__(NWAVES * 64, 2) mk_fwd(Args args) {
    extern __shared__ __attribute__((aligned(16))) unsigned char lds[];
    Frame F;
    F.lds = (LAS unsigned char*)lds;
    F.MISC = (volatile LAS unsigned*)(F.lds + MISC_OFF);
    F.tid = threadIdx.x; F.lane = F.tid & 63; F.wave = __builtin_amdgcn_readfirstlane(F.tid >> 6);
    F.G = gridDim.x; { const int bx = blockIdx.x; F.vcu = (F.G % 8 == 0) ? (bx % 8) * (F.G / 8) + bx / 8 : bx; }
    F.ws = args.ws; F.ctl = (unsigned*)(args.ws + WS_CTL);
    F.x = args.in[0]; F.g_mix = args.in[1]; F.w_in = args.in[2]; F.w_up = args.in[3]; F.b_alpha = args.in[4]; F.g_gla = args.in[5]; F.w_conv = args.in[6];
    F.w_a = args.in[7]; F.w_b = args.in[8]; F.w_out = args.in[9]; F.g_ffn = args.in[10]; F.w_router = args.in[11]; F.b_router = args.in[12];
    F.w_gu = args.in[13]; F.b_gu = args.in[14]; F.w_d = args.in[15]; F.b_d = args.in[16]; F.g_final = args.in[17]; F.out = args.out;
    if (F.tid < 128) ((LAS unsigned*)(F.lds + MISC_OFF))[F.tid] = 0u;
    __syncthreads();
    XcdBarrier bar; bar.bar = F.ctl + CW_BAR; bar.x = 0; bar.st = nullptr;
    if (N_LAUNCHES == 1) bar = xcd_barrier_post(F.ctl + CW_BAR, F.MISC + 8);
    const int lo = args.ph_lo, hi = args.ph_hi;
#ifdef MK_ONLY
#define IN(k) ((k) == MK_ONLY && lo <= (k) && (k) < hi)
#else
#define IN(k) (lo <= (k) && (k) < hi)
#endif
#define REPS(k) (((k) == args.rep_k) ? 1 + args.rep_n : 1)
#if defined(MK_TPROBE) || defined(MK_DELAY_K)
#define STAMP(k) do { if (blockIdx.x == 0 && F.tid == 0) ((unsigned long long*)(F.ctl + CW_STAMP))[k] = __builtin_amdgcn_s_memrealtime(); } while (0)
#else
#define STAMP(k) do { } while (0)
#endif
#ifdef MK_DELAY_K
#define DELAY(k) do { if ((k) == MK_DELAY_K) { const unsigned long long dl = __hip_atomic_load((unsigned long long*)(F.ctl + CW_STAMP), RLX_AGENT) + (unsigned long long)(MK_DELAY_US) * 100ull; \
    while (__builtin_amdgcn_s_memrealtime() < dl) __builtin_amdgcn_s_sleep(8); } } while (0)
#else
#define DELAY(k) do { } while (0)
#endif
#define SEAM(k) do { if (IN(k) && IN((k) + 1)) xcd_barrier(bar); STAMP((k) + 1); DELAY(k); } while (0)

    STAMP(0);
    if (IN(0)) { p0_prologue(F, REPS(0), REPS(11)); SEAM(0); }
    if (IN(1)) { const int nrep = REPS(1);
        P1Order S; S.init(M, NZ, D, F.G, (int)blockIdx.x, nrep); S.w_gu = F.w_gu; S.w_d = F.w_d; S.ws = F.ws; S.lds = F.lds; S.slot = ((int)blockIdx.x >> 3) & 7; S.wave = F.wave; S.lane = F.lane;
        EpiZ E{WSP(bf16, WS_Z)};
        pg8::gemm_phase<EpiZ, P1Order, true>(F.lds, WSP(const bf16, WS_XN), WSP(const bf16, WS_WIN), D, S, E);
        SEAM(1);
    }
    if (IN(2)) { const int nrep = REPS(2); const int gwc = F.vcu * NWAVES + F.wave;
        const bool no_state = MK_HORNER && nrep == 1 && F.G == 256 && (F.vcu & 7) == 7;
        if (!no_state) for (int it = F.vcu; it < 256 * nrep; it += F.G) gla_item<false>(F, it & 255, (it == F.vcu && gwc < M / 8) ? gwc : -1);
        conv_rows(F, REPS(12), (F.vcu < 256 && !no_state) ? 1 : 0); SEAM(2); }
#if MK_HORNER
    STAMP(4);
#else
    if (IN(3)) { gla_scan(F, REPS(3)); SEAM(3); }
#endif
    const bool ho = MK_HANDOFF && N_LAUNCHES == 1 && F.G == 256 && lo == 0 && hi == NPH && args.rep_k != 4 && args.rep_k != 5 && args.rep_k != 6 && args.rep_k != 7;
    int ho_pm = 0, ho_pn = 0;
    { pg8::StaticOrder S0; S0.init(M, D, D, F.G, (int)blockIdx.x, 1); pg8::Unit u0; if (S0.next(0, u0)) { ho_pm = u0.pm; ho_pn = u0.pn; } }
#define PANEL_WAIT(word, need) do { if (F.tid == 0) { XB_SPIN(xb_ld(word) < (unsigned)(need), F.ctl + CW_BAR); __builtin_amdgcn_fence(__ATOMIC_ACQUIRE, "agent"); asm volatile("s_waitcnt vmcnt(0)" ::: "memory"); } __syncthreads(); } while (0)
#define SEAMX(k, skip) do { if (IN(k) && IN((k) + 1) && !(skip)) xcd_barrier(bar); STAMP((k) + 1); DELAY(k); } while (0)
    if (IN(4)) { const int nrep = REPS(4); for (int it = F.vcu; it < 256 * nrep; it += F.G) gla_item<true>(F, it & 255, -1, ho); SEAMX(4, ho); }

    if (IN(5)) { const int nrep = REPS(5);
        static_assert(WS_PB == WS_OG + (size_t)M * 1024 * 2 && WS_WB == WS_WA + (size_t)1024 * 1024 * 2, "P3Order addresses PB / Wb from OG / Wa");
        P3Order S; S.init(M, D, D, F.G, (int)blockIdx.x, nrep); S.sig = ho ? F.ctl + CW_RDY3 + 32 * ho_pm : nullptr;
        EpiBranch E{WSP(const bf16, WS_Z), WSP(bf16, WS_MIX), __builtin_amdgcn_make_buffer_rsrc(F.ws + WS_MIX, (short)0, (int)((size_t)M * 1024 * 2), 0x00020000), ho};
        if (ho) PANEL_WAIT(F.ctl + CW_RDY2 + 32 * ho_pm, 4 * NWAVES);
        pg8::gemm_phase<EpiBranch, P3Order, true>(F.lds, WSP(const bf16, WS_OG), WSP(const bf16, WS_WA), D, S, E);
        SEAMX(5, ho);
    }
    if (IN(6)) { const int nrep = REPS(6);
        P4Order S; S.init(M, D, D, F.G, (int)blockIdx.x, nrep); S.sig = ho ? F.ctl + CW_RDY4 + 32 * ho_pm : nullptr;
        EpiX1 E{F.x, WSP(bf16, WS_X1), __builtin_amdgcn_make_buffer_rsrc(F.ws + WS_X1, (short)0, (int)((size_t)M * 1024 * 2), 0x00020000), ho};
        if (ho) PANEL_WAIT(F.ctl + CW_RDY3 + 32 * ho_pm, 4 * NWAVES);
        pg8::gemm_phase<EpiX1, P4Order, false>(F.lds, WSP(const bf16, WS_MIX), WSP(const bf16, WS_WO), D, S, E);
        SEAMX(6, ho);
    }
    if (IN(7)) {
        if (ho) { PANEL_WAIT(F.ctl + CW_RDY4 + 32 * ho_pm, 4 * NWAVES); p5_router(F, ho_pm * 4 + ho_pn); }
        else p5_router(F);
        SEAM(7); }
#undef PANEL_WAIT
#undef SEAMX
    const bool ov8 = MK_OV8 && N_LAUNCHES == 1 && lo == 0 && hi == NPH && args.rep_k != 8 && args.rep_k != 9;
    if (IN(8)) { const int nrep = REPS(8);
        LAS int* rt0 = (LAS int*)(F.lds + EXTRA_OFF); LAS int* tokl = (LAS int*)(F.lds + EXTRA_OFF + 256);
        const int R = moe_setup(F, rt0);
        MoeOrder1 S; S.rt0 = rt0; S.tokl = tokl; S.nwg = R * 8; S.G = F.G; S.c = (int)blockIdx.x; S.reps = nrep;
        S.ut = (LAS const i32x4*)(F.lds + EXTRA_OFF + 20480); { const int nu = (S.nwg * nrep - S.c + S.G - 1) / S.G; S.nun = nu < MAXU ? nu : MAXU; }
        const int* list = WSP(const int, WS_LIST);
        { pg8::Unit uu[2]; bool ok[2]; int ne2[2], tk[2][4]; f32x4 bsv[2];
#pragma unroll
          for (int uo = 0; uo < 2; ++uo) { const int ui = F.wave + 8 * uo; ok[uo] = ui < MAXU && S.compute(ui, uu[uo]);
              if (!ok[uo]) { uu[uo].pm = 0; uu[uo].pn = 0; uu[uo].e = 0; uu[uo].rt = 0; }
              ne2[uo] = ((LAS const int*)(F.lds + EXTRA_OFF + MOE_CNTL))[uu[uo].e]; }
#pragma unroll
          for (int uo = 0; uo < 2; ++uo) { const int nc = ne2[uo] > 0 ? ne2[uo] - 1 : 0;
#pragma unroll
              for (int j = 0; j < 4; ++j) { const int slot = uu[uo].rt * 256 + F.lane + 64 * j; tk[uo][j] = list[uu[uo].e * CAP + (slot < nc ? slot : nc)]; }
              bsv[uo] = *(const f32x4*)(F.b_gu + uu[uo].e * 2048 + (uu[uo].pn & 7) * 128 + (F.lane < 32 ? 4 * F.lane : 1024 + 4 * (F.lane - 32))); }
#pragma unroll
          for (int uo = 0; uo < 2; ++uo) if (ok[uo]) { const int ui = F.wave + 8 * uo;
              if (F.lane == 0) ((LAS i32x4*)(F.lds + EXTRA_OFF + 20480))[ui] = (i32x4){uu[uo].pm, uu[uo].pn, uu[uo].e, uu[uo].rt | (3 << 16)};
#pragma unroll
              for (int j = 0; j < 4; ++j) { const int slot = uu[uo].rt * 256 + F.lane + 64 * j; tokl[ui * 256 + F.lane + 64 * j] = slot < ne2[uo] ? (tk[uo][j] >> 2) : 0; }
              *(LAS f32x4*)(F.lds + EXTRA_OFF + MOE_BIAS1 + (ui * 256 + 4 * F.lane) * 4) = bsv[uo]; } }
        __syncthreads();
        EpiAct E{(LAS const float*)(F.lds + EXTRA_OFF + MOE_BIAS1), WSP(unsigned char, WS_ACT)};
        pg8::gemm_phase<EpiAct, MoeOrder1, true, true, 122>(F.lds, WSP(const void, WS_XN), WSP(const void, WS_WGU), D, S, E);
        if (ov8 && IN(9)) {
            MoeOrder2 S2; S2.rt0 = rt0; S2.tokl = nullptr; S2.nwg = R * 4; S2.G = F.G; S2.c = (int)blockIdx.x; S2.reps = 1; S2.nun = 0; S2.split = MK_TSPLIT; S2.ut = (LAS const i32x4*)(F.lds + EXTRA_OFF + 20480);
            xcd_barrier_overlap(bar, [&]() { moe2_fill(F, S2); });
            STAMP(9); DELAY(8);
        } else SEAM(8);
    }
    if (IN(9)) { const int nrep = REPS(9);
        LAS int* rt0 = (LAS int*)(F.lds + EXTRA_OFF);
        const int R = ov8 ? rt0[32] : moe_setup(F, rt0);
        MoeOrder2 S; S.rt0 = rt0; S.tokl = nullptr; S.nwg = R * 4; S.G = F.G; S.c = (int)blockIdx.x; S.reps = nrep;
        S.split = MK_TSPLIT; S.ut = (LAS const i32x4*)(F.lds + EXTRA_OFF + 20480); { const int nu = S.count(); S.nun = nu < MAXU2 ? nu : MAXU2; }
        LAS int* pidl = (LAS int*)(F.lds + EXTRA_OFF + 256); LAS float* gatel = (LAS float*)(F.lds + EXTRA_OFF + 256 + MAXU2 * 1024);
        if (!ov8) { moe2_fill(F, S); __syncthreads(); }
        EpiYP E{(LAS const float*)(F.lds + EXTRA_OFF + 256 + 2 * MAXU2 * 1024), pidl, gatel, WSP(unsigned char, WS_YP)};
        pg8::gemm_phase<EpiYP, MoeOrder2, true, true, 122>(F.lds, WSP(const void, WS_ACT), WSP(const void, WS_WD), D, S, E);
        SEAM(9);
    }
    if (IN(10)) { p8_final(F, REPS(10)); }
#undef IN
#undef SEAM
}

extern "C" void kernel_launch(void* const* d_in, const int* in_sizes, int n_in, void* d_out, int out_size, void* d_ws, size_t ws_size, hipStream_t stream) {
    static int grid = 0;
    if (grid == 0) {
        if (n_in != 18 || out_size != M * D || ws_size < WS_END) { fprintf(stderr, "kernel_launch: unexpected shapes (n_in %d, out %d, ws %zu < %zu)\n", n_in, out_size, ws_size, (size_t)WS_END); grid = -1; return; }
        int dev = 0, cus = 0, per_cu = 0;
        if (hipGetDevice(&dev) != hipSuccess || hipDeviceGetAttribute(&cus, hipDeviceAttributeMultiprocessorCount, dev) != hipSuccess) { grid = -1; return; }
        if (hipFuncSetAttribute((const void*)mk_fwd, hipFuncAttributeMaxDynamicSharedMemorySize, LDS_BYTES) != hipSuccess) { fprintf(stderr, "kernel_launch: hipFuncSetAttribute(%d B LDS) failed\n", LDS_BYTES); grid = -1; return; }
        if (hipOccupancyMaxActiveBlocksPerMultiprocessor(&per_cu, (const void*)mk_fwd, NWAVES * 64, LDS_BYTES) != hipSuccess || per_cu < 1) fprintf(stderr, "kernel_launch: occupancy query says %d\n", per_cu);
        (void)hipGetLastError();
        grid = cus;
        if (grid != 256) fprintf(stderr, "kernel_launch: %d CUs (built for 256)\n", grid);
    }
    if (grid < 0) return;
    (void)hipMemsetAsync((char*)d_ws + WS_CTL, 0, CTL_ZERO_BYTES, stream);
    Args a{};
    for (int i = 0; i < 18; ++i) a.in[i] = (const float*)d_in[i];
    a.out = (float*)d_out; a.ws = (unsigned char*)d_ws;
#ifdef MK_REPEAT
    a.rep_k = MK_REPEAT; a.rep_n = MK_REPEAT_N;
#else
    a.rep_k = -1; a.rep_n = 0;
#endif
    for (int li = 0; li < N_LAUNCHES; ++li) {
        a.ph_lo = (N_LAUNCHES == 1) ? 0 : li; a.ph_hi = (N_LAUNCHES == 1) ? NPH : li + 1;
        hipLaunchKernelGGL(mk_fwd, dim3(grid), dim3(NWAVES * 64), LDS_BYTES, stream, a);
    }
}
```
